# Optimizing an MI355X kernel written in HIP

```python
import math
import jax, jax.numpy as jnp
from jax import lax
import numpy as np

D_MODEL = 2048
BATCH = 4
SEQ = 4096
DEPTH = 4

GRID_W = 64
CTX_LEN = 256
MLA_HEADS = 8
MLA_Q_LORA = 512
MLA_KV_LORA = 256
MLA_NOPE = 128
MLA_ROPE = 64
MLA_V = 128
NA_HEADS = 16
NA_HEAD_DIM = 64
NA_WIN_ROWS = 8
NA_WIN_COLS = 16
LRU_WIDTH = 1024
LRU_BLOCKS = 16
LRU_BLOCK = LRU_WIDTH // LRU_BLOCKS
LRU_C = 8.0
CONV_WIDTH = 4
N_BRANCH = 3
BRANCH_W = 1024
ROPE_BASE = 10000.0
EPS = 1e-6
Q_BLOCK = 128
N_MIX = MLA_Q_LORA + MLA_KV_LORA + MLA_ROPE + 3 * NA_HEADS * NA_HEAD_DIM + LRU_WIDTH
N_GATE = N_BRANCH * BRANCH_W + N_BRANCH * D_MODEL
N_IN = N_MIX + N_GATE

kernel_name = "hybrid_mla_natten_rglru_dit"


def rms_norm(x, g):
    x32 = x.astype(jnp.float32)
    y = x32 * lax.rsqrt(jnp.mean(x32 * x32, axis=-1, keepdims=True) + EPS)
    return (y * g.astype(jnp.float32)).astype(x.dtype)


def rope_half(x, ang):
    n = x.shape[-1] // 2
    x1, x2 = x[..., :n], x[..., n:]
    cos = jnp.cos(ang).astype(x.dtype)
    sin = jnp.sin(ang).astype(x.dtype)
    return jnp.concatenate([x1 * cos - x2 * sin, x1 * sin + x2 * cos], axis=-1)


def axial_rope_angles(n_tokens, dim):
    t = jnp.arange(n_tokens)
    row = (t // GRID_W).astype(jnp.float32)
    col = (t % GRID_W).astype(jnp.float32)
    half = dim // 2
    inv = 1.0 / (ROPE_BASE ** (jnp.arange(0, half, 2, dtype=jnp.float32) / half))
    return row[:, None] * inv, col[:, None] * inv


def axial_rope(x, ang_row, ang_col):
    half = x.shape[-1] // 2
    return jnp.concatenate([rope_half(x[..., :half], ang_row), rope_half(x[..., half:], ang_col)], axis=-1)


def mla_branch(p_q, p_kv, p_kr, n_ctx, q_norm_g, kv_norm_g, w_uq, w_ukv, need_ctx):
    B, T, _ = p_q.shape
    S = T - n_ctx
    q = (rms_norm(p_q, q_norm_g) @ w_uq).reshape(B, T, MLA_HEADS, MLA_NOPE + MLA_ROPE)
    kv = (rms_norm(p_kv, kv_norm_g) @ w_ukv).reshape(B, T, MLA_HEADS, MLA_NOPE + MLA_V)
    q_nope, q_rope = q[..., :MLA_NOPE], q[..., MLA_NOPE:]
    k_nope, v = kv[..., :MLA_NOPE], kv[..., MLA_NOPE:]
    ang_r, ang_c = axial_rope_angles(S, MLA_ROPE)
    k_rope = jnp.concatenate([p_kr[:, :n_ctx], axial_rope(p_kr[:, n_ctx:], ang_r, ang_c)], axis=1)
    q_rope_lat = axial_rope(q_rope[:, n_ctx:], ang_r[:, None], ang_c[:, None])
    scale = (MLA_NOPE + MLA_ROPE) ** -0.5

    def attend(qn, qr, kn, kr, vv):
        s = jnp.einsum('bqhd,bkhd->bhqk', qn, kn) + jnp.einsum('bqhr,bkr->bhqk', qr, kr)
        p = jax.nn.softmax(s.astype(jnp.float32) * scale, axis=-1).astype(vv.dtype)
        return jnp.einsum('bhqk,bkhv->bqhv', p, vv)

    n_blk = S // Q_BLOCK
    qn_blk = q_nope[:, n_ctx:].reshape(B, n_blk, Q_BLOCK, MLA_HEADS, MLA_NOPE).transpose(1, 0, 2, 3, 4)
    qr_blk = q_rope_lat.reshape(B, n_blk, Q_BLOCK, MLA_HEADS, MLA_ROPE).transpose(1, 0, 2, 3, 4)
    o = lax.map(lambda qb: attend(qb[0], qb[1], k_nope, k_rope, v), (qn_blk, qr_blk))
    o_lat = o.transpose(1, 0, 2, 3, 4).reshape(B, S, MLA_HEADS * MLA_V)
    o_ctx = None
    if need_ctx:
        o_ctx = attend(q_nope[:, :n_ctx], q_rope[:, :n_ctx], k_nope[:, :n_ctx],
                       k_rope[:, :n_ctx], v[:, :n_ctx]).reshape(B, n_ctx, MLA_HEADS * MLA_V)
    return o_lat, o_ctx


def na_branch(p_q, p_k, p_v, n_ctx, rel_bias, need_ctx):
    B, T, _ = p_q.shape
    S = T - n_ctx
    rows = S // GRID_W
    kr = min(NA_WIN_ROWS, rows)
    kc = NA_WIN_COLS
    H, d = NA_HEADS, NA_HEAD_DIM
    q = p_q.reshape(B, T, H, d)
    k = p_k.reshape(B, T, H, d)
    v = p_v.reshape(B, T, H, d)
    q_ctx, k_ctx, v_ctx = q[:, :n_ctx], k[:, :n_ctx], v[:, :n_ctx]
    q_grid = q[:, n_ctx:].reshape(B, rows, GRID_W, H, d)
    k_grid = k[:, n_ctx:].reshape(B, rows, GRID_W, H, d)
    v_grid = v[:, n_ctx:].reshape(B, rows, GRID_W, H, d)
    cols = np.arange(GRID_W)
    col_start = np.clip(cols - kc // 2, 0, GRID_W - kc)
    col_idx = col_start[:, None] + np.arange(kc)[None, :]
    dc_idx = col_idx - cols[:, None] + (NA_WIN_COLS - 1)
    bias_c = rel_bias[:, :, dc_idx]
    scale = d ** -0.5

    def row_step(i):
        r0 = jnp.clip(i - kr // 2, 0, rows - kr)
        q_row = lax.dynamic_index_in_dim(q_grid, i, axis=1, keepdims=False)
        k_rows = lax.dynamic_slice_in_dim(k_grid, r0, kr, axis=1)
        v_rows = lax.dynamic_slice_in_dim(v_grid, r0, kr, axis=1)
        k_win = k_rows[:, :, col_idx]
        v_win = v_rows[:, :, col_idx]
        dr_idx = r0 + jnp.arange(kr) - i + (NA_WIN_ROWS - 1)
        bias = jnp.take(bias_c, dr_idx, axis=1).transpose(0, 2, 1, 3)
        s_loc = (jnp.einsum('bjhd,brjchd->bhjrc', q_row, k_win).astype(jnp.float32) * scale
                 + bias.astype(jnp.float32)[None])
        s_loc = s_loc.reshape(B, H, GRID_W, kr * kc)
        s_ctx = jnp.einsum('bjhd,bkhd->bhjk', q_row, k_ctx).astype(jnp.float32) * scale
        p = jax.nn.softmax(jnp.concatenate([s_loc, s_ctx], axis=-1), axis=-1).astype(v.dtype)
        p_loc = p[..., :kr * kc].reshape(B, H, GRID_W, kr, kc)
        p_ctx = p[..., kr * kc:]
        return (jnp.einsum('bhjrc,brjchd->bjhd', p_loc, v_win)
                + jnp.einsum('bhjk,bkhd->bjhd', p_ctx, v_ctx))

    o = lax.map(row_step, jnp.arange(rows))
    o_lat = o.transpose(1, 0, 2, 3, 4).reshape(B, S, H * d)
    o_ctx = None
    if need_ctx:
        s = jnp.einsum('bqhd,bkhd->bhqk', q_ctx, k_ctx).astype(jnp.float32) * scale
        p = jax.nn.softmax(s, axis=-1).astype(v.dtype)
        o_ctx = jnp.einsum('bhqk,bkhd->bqhd', p, v_ctx).reshape(B, n_ctx, H * d)
    return o_lat, o_ctx


def depthwise_conv_centred(x, w, b):
    L = x.shape[1]
    left = CONV_WIDTH // 2
    right = CONV_WIDTH - 1 - left
    xp = jnp.pad(x, ((0, 0), (left, right), (0, 0)))
    y = b
    for tap in range(CONV_WIDTH):
        y = y + xp[:, tap:tap + L] * w[tap]
    return y


def linear_combine(e1, e2):
    a1, b1 = e1
    a2, b2 = e2
    return a1 * a2, a2 * b1 + b2


def rglru_scan(x, w_gate, b_gate, lam, h0, reverse):
    B, L, W = x.shape
    x32 = x.astype(jnp.float32)
    xb = x32.reshape(B, L, LRU_BLOCKS, LRU_BLOCK)
    g = (jnp.einsum('blnk,nkj->blnj', xb, w_gate.astype(jnp.float32))
         + b_gate.astype(jnp.float32).reshape(LRU_BLOCKS, 2 * LRU_BLOCK))
    r = jax.nn.sigmoid(g[..., :LRU_BLOCK]).reshape(B, L, W)
    i_g = jax.nn.sigmoid(g[..., LRU_BLOCK:]).reshape(B, L, W)
    log_a = -LRU_C * r * jax.nn.softplus(-lam.astype(jnp.float32))
    a = jnp.exp(log_a)
    u = jnp.sqrt(jnp.maximum(-jnp.expm1(2.0 * log_a), 0.0)) * (i_g * x32)
    edge = -1 if reverse else 0
    u = u.at[:, edge].add(a[:, edge] * h0)
    _, h = lax.associative_scan(linear_combine, (a, u), reverse=reverse, axis=1)
    return h


def rglru_branch(p_x, n_ctx, conv_w, conv_b, w_gate, b_gate, lam, need_ctx):
    B = p_x.shape[0]
    xc = depthwise_conv_centred(p_x[:, :n_ctx], conv_w, conv_b)
    xl = depthwise_conv_centred(p_x[:, n_ctx:], conv_w, conv_b)
    zero = jnp.zeros((B, LRU_WIDTH), jnp.float32)
    hc_f = rglru_scan(xc, w_gate[0], b_gate[0], lam[0], zero, False)
    hc_b = rglru_scan(xc, w_gate[1], b_gate[1], lam[1], zero, True)
    hl_f = rglru_scan(xl, w_gate[0], b_gate[0], lam[0], hc_f[:, -1], False)
    hl_b = rglru_scan(xl, w_gate[1], b_gate[1], lam[1], hc_b[:, 0], True)
    o_lat = (hl_f + hl_b).astype(p_x.dtype)
    o_ctx = (hc_f + hc_b).astype(p_x.dtype) if need_ctx else None
    return o_lat, o_ctx


def merge_branches(o_a, o_b, o_c, pg, w_branch, w_out):
    B, L, _ = o_a.shape
    o = jnp.stack([o_a, o_b, o_c], axis=2)
    gp = pg[..., :N_BRANCH * BRANCH_W].reshape(B, L, N_BRANCH, BRANCH_W)
    mg = pg[..., N_BRANCH * BRANCH_W:].reshape(B, L, N_BRANCH, D_MODEL)
    y = jnp.einsum('blnw,nwd->blnd', o * jax.nn.silu(gp), w_branch)
    return jnp.sum(jax.nn.sigmoid(mg) * y, axis=2) @ w_out


def hybrid_mixer(h_lat, h_ctx, w_in, q_norm_g, kv_norm_g, w_uq, w_ukv, rel_bias,
                 conv_w, conv_b, lru_w_gate, lru_b_gate, lru_lambda, w_branch, w_out, need_ctx):
    n_ctx = h_ctx.shape[1]
    h_all = jnp.concatenate([h_ctx, h_lat], axis=1)
    p = h_all @ w_in[:, :N_MIX]
    na_w = NA_HEADS * NA_HEAD_DIM
    o0 = MLA_Q_LORA
    o1 = o0 + MLA_KV_LORA
    o2 = o1 + MLA_ROPE
    o3 = o2 + na_w
    o4 = o3 + na_w
    o5 = o4 + na_w
    p_q, p_kv, p_kr, na_q, na_k, na_v, p_x = jnp.split(p, [o0, o1, o2, o3, o4, o5], axis=-1)
    a_lat, a_ctx = mla_branch(p_q, p_kv, p_kr, n_ctx, q_norm_g, kv_norm_g, w_uq, w_ukv, need_ctx)
    b_lat, b_ctx = na_branch(na_q, na_k, na_v, n_ctx, rel_bias, need_ctx)
    c_lat, c_ctx = rglru_branch(p_x, n_ctx, conv_w, conv_b, lru_w_gate, lru_b_gate, lru_lambda, need_ctx)
    w_g = w_in[:, N_MIX:]
    y_lat = merge_branches(a_lat, b_lat, c_lat, h_lat @ w_g, w_branch, w_out)
    y_ctx = None
    if need_ctx:
        y_ctx = merge_branches(a_ctx, b_ctx, c_ctx, h_ctx @ w_g, w_branch, w_out)
    return y_lat, y_ctx


def setup_inputs(seed: int = 0) -> dict:
    key = jax.random.key(seed)
    ks = jax.random.split(key, 24)
    f32 = jnp.float32

    def nrm(k, shape, scale):
        return jax.random.normal(k, shape, f32) * scale

    u = jax.random.uniform(ks[15], (DEPTH, 2, LRU_WIDTH), f32, minval=0.9, maxval=0.999)
    a0 = u ** (1.0 / LRU_C)
    lru_lambda = jnp.log(a0) - jnp.log1p(-a0)
    return {
        "x": nrm(ks[0], (BATCH, SEQ, D_MODEL), 1.0),
        "c": nrm(ks[1], (BATCH, D_MODEL), 1.0),
        "ctx": nrm(ks[2], (BATCH, CTX_LEN, D_MODEL), 1.0),
        "c_ctx": nrm(ks[3], (D_MODEL,), 1.0),
        "ada_w": nrm(ks[4], (DEPTH, D_MODEL, 3 * D_MODEL), 0.01),
        "ada_b": nrm(ks[5], (DEPTH, 3 * D_MODEL), 0.02),
        "norm_g": 1.0 + nrm(ks[6], (DEPTH, D_MODEL), 0.02),
        "w_in": nrm(ks[7], (DEPTH, D_MODEL, N_IN), D_MODEL ** -0.5),
        "mla_q_norm_g": 1.0 + nrm(ks[8], (DEPTH, MLA_Q_LORA), 0.02),
        "mla_kv_norm_g": 1.0 + nrm(ks[9], (DEPTH, MLA_KV_LORA), 0.02),
        "mla_w_uq": nrm(ks[10], (DEPTH, MLA_Q_LORA, MLA_HEADS * (MLA_NOPE + MLA_ROPE)), MLA_Q_LORA ** -0.5),
        "mla_w_ukv": nrm(ks[11], (DEPTH, MLA_KV_LORA, MLA_HEADS * (MLA_NOPE + MLA_V)), MLA_KV_LORA ** -0.5),
        "na_rel_bias": nrm(ks[12], (DEPTH, NA_HEADS, 2 * NA_WIN_ROWS - 1, 2 * NA_WIN_COLS - 1), 0.1),
        "lru_conv_w": nrm(ks[13], (DEPTH, CONV_WIDTH, LRU_WIDTH), CONV_WIDTH ** -0.5),
        "lru_conv_b": nrm(ks[14], (DEPTH, LRU_WIDTH), 0.02),
        "lru_w_gate": nrm(ks[16], (DEPTH, 2, LRU_BLOCKS, LRU_BLOCK, 2 * LRU_BLOCK), LRU_BLOCK ** -0.5),
        "lru_b_gate": nrm(ks[17], (DEPTH, 2, 2 * LRU_WIDTH), 0.02),
        "lru_lambda": lru_lambda,
        "w_branch": nrm(ks[18], (DEPTH, N_BRANCH, BRANCH_W, D_MODEL), BRANCH_W ** -0.5),
        "w_out": nrm(ks[19], (DEPTH, D_MODEL, D_MODEL), D_MODEL ** -0.5),
        "final_norm_g": 1.0 + nrm(ks[20], (D_MODEL,), 0.02),
    }


def reference(x, c, ctx, c_ctx, ada_w, ada_b, norm_g, w_in, mla_q_norm_g, mla_kv_norm_g,
              mla_w_uq, mla_w_ukv, na_rel_bias, lru_conv_w, lru_conv_b, lru_w_gate, lru_b_gate,
              lru_lambda, w_branch, w_out, final_norm_g):
    silu_c = jax.nn.silu(c)
    silu_cc = jax.nn.silu(c_ctx)
    for layer in range(DEPTH):
        need_ctx = layer < DEPTH - 1
        mod_l = silu_c @ ada_w[layer] + ada_b[layer]
        mod_c = silu_cc @ ada_w[layer] + ada_b[layer]
        sh_l, sc_l, gt_l = jnp.split(mod_l, 3, axis=-1)
        sh_c, sc_c, gt_c = jnp.split(mod_c, 3, axis=-1)
        h_lat = rms_norm(x, norm_g[layer]) * (1.0 + sc_l[:, None]) + sh_l[:, None]
        h_ctx = rms_norm(ctx, norm_g[layer]) * (1.0 + sc_c) + sh_c
        y_lat, y_ctx = hybrid_mixer(h_lat, h_ctx, w_in[layer], mla_q_norm_g[layer], mla_kv_norm_g[layer],
                                    mla_w_uq[layer], mla_w_ukv[layer], na_rel_bias[layer],
                                    lru_conv_w[layer], lru_conv_b[layer], lru_w_gate[layer],
                                    lru_b_gate[layer], lru_lambda[layer], w_branch[layer], w_out[layer],
                                    need_ctx)
        x = x + gt_l[:, None] * y_lat
        if need_ctx:
            ctx = ctx + gt_c * y_ctx
    return rms_norm(x, final_norm_g)
```

```cpp
#include <hip/hip_runtime.h>
#include <hip/hip_cooperative_groups.h>
#include <cstdio>
#include <cstdint>
namespace cg = cooperative_groups;

typedef unsigned short bf16_t;
typedef short bf16x8 __attribute__((ext_vector_type(8)));
typedef float f32x4 __attribute__((ext_vector_type(4)));
typedef float f32x16 __attribute__((ext_vector_type(16)));
typedef unsigned u32x4 __attribute__((ext_vector_type(4)));
typedef unsigned u32x2 __attribute__((ext_vector_type(2)));
#define LAS __attribute__((address_space(3)))

constexpr int DM = 2048, NB = 4, SEQ = 4096, NCTXT = 256, DEPTH = 4;
constexpr int NLAT = NB * SEQ, NCTX = NB * NCTXT, MROWS = NLAT + NCTX;
constexpr int NMIX = 4928, NMIXP = 5120, NGP = 3072, NMG = 6144, NINP = NMIXP + NGP + NMG, NIN = 14144;
constexpr int O_KR = 768, O_NAQ = 832, O_NAK = 1856, O_NAV = 2880, O_PX = 3904;
constexpr float EPS = 1e-6f, LOG2E = 1.4426950408889634f;
constexpr float C_MLA = 0.07216878364870322f * LOG2E;
constexpr float C_NA = 0.125f * LOG2E;
constexpr int NCHUNK = 68;

constexpr size_t al256(size_t x) { return (x + 255) / 256 * 256; }
constexpr size_t WS_WIN = 0;
constexpr size_t WS_WUQ = WS_WIN + al256((size_t)DEPTH * NINP * DM * 2);
constexpr size_t WS_WUKV = WS_WUQ + al256((size_t)DEPTH * 1536 * 512 * 2);
constexpr size_t WS_WBR = WS_WUKV + al256((size_t)DEPTH * 2048 * 256 * 2);
constexpr size_t WS_WOUT = WS_WBR + al256((size_t)DEPTH * 3 * 2048 * 1024 * 2);
constexpr size_t WS_WG = WS_WOUT + al256((size_t)DEPTH * 2048 * 2048 * 2);
constexpr size_t WS_MOD = WS_WG + al256((size_t)DEPTH * 2 * 16 * 128 * 64 * 2);
constexpr size_t WS_ROPE = WS_MOD + al256((size_t)DEPTH * 5 * 6144 * 4);
constexpr size_t WS_XCUR = WS_ROPE + al256((size_t)64 * 16 * 2 * 4);
constexpr size_t WS_H = WS_XCUR + al256((size_t)MROWS * DM * 4);
constexpr size_t WS_PMIX = WS_H + al256((size_t)MROWS * DM * 2);
constexpr size_t WS_GP = WS_PMIX + al256((size_t)MROWS * NMIXP * 2);
constexpr size_t WS_MG = WS_GP + al256((size_t)MROWS * NGP * 2);
constexpr size_t WS_RSQ = WS_MG + al256((size_t)MROWS * NMG * 2);
constexpr size_t WS_Q = WS_RSQ + al256((size_t)MROWS * 12 * 4);
constexpr size_t WS_KV = WS_Q + al256((size_t)MROWS * 1536 * 2);
constexpr size_t WS_KR = WS_KV + al256((size_t)MROWS * 2048 * 2);
constexpr size_t WS_LA = WS_KR + al256((size_t)MROWS * 64 * 2);
constexpr size_t WS_LU = WS_LA + al256((size_t)2 * MROWS * 1024 * 4);
constexpr size_t WS_AGG = WS_LU + al256((size_t)2 * MROWS * 1024 * 4);
constexpr size_t WS_O = WS_AGG + al256((size_t)2 * NB * NCHUNK * 1024 * 2 * 4);
constexpr size_t WS_END = WS_O + al256((size_t)MROWS * 3072 * 2);

constexpr int LDS_BYTES = 147456;

struct Args { const float* in[21]; float* out; unsigned char* ws; };

typedef float f32x2_t __attribute__((ext_vector_type(2))); typedef __bf16 bf16x2_t __attribute__((ext_vector_type(2)));
__device__ __forceinline__ unsigned cvt_pk(float lo, float hi) { f32x2_t v = {lo, hi}; bf16x2_t b = __builtin_convertvector(v, bf16x2_t); return __builtin_bit_cast(unsigned, b); }
__device__ __forceinline__ float bflo(unsigned u) { return __uint_as_float(u << 16); }
__device__ __forceinline__ float bfhi(unsigned u) { return __uint_as_float(u & 0xffff0000u); }
__device__ __forceinline__ float bf1(bf16_t u) { return __uint_as_float(((unsigned)u) << 16); }
__device__ __forceinline__ u32x4 pack8(f32x4 a, f32x4 b) { u32x4 w; w.x = cvt_pk(a[0], a[1]); w.y = cvt_pk(a[2], a[3]); w.z = cvt_pk(b[0], b[1]); w.w = cvt_pk(b[2], b[3]); return w; }
__device__ __forceinline__ float sigmoidf_(float x) { return __builtin_amdgcn_rcpf(1.f + __expf(-x)); }
__device__ __forceinline__ float shx(float v, int lane, int m) { return __int_as_float(__builtin_amdgcn_ds_bpermute((lane ^ m) << 2, __float_as_int(v))); }
__device__ __forceinline__ float wave_sum(float v, int lane) {
#pragma unroll
    for (int o = 1; o < 64; o <<= 1) v += shx(v, lane, o);
    return v;
}
__device__ __forceinline__ int opaque_v(int x) { asm volatile("" : "+v"(x)); return x; }
__device__ __forceinline__ int crow(int r, int hi) { return (r & 3) + 8 * (r >> 2) + 4 * hi; }

namespace pg8 {
constexpr int BM = 256, BK = 64, HALF = 128, HTB = HALF * BK * 2, NXCD = 8, WGM = 8;
__host__ __device__ __forceinline__ int lds_byte(int r, int c) { const int st = (r >> 4) * 2 + (c >> 5), rr = r & 15, cc = c & 31, ob = rr * 64 + cc * 2; return st * 1024 + (ob ^ (((ob >> 9) & 1) << 5)); }
__host__ __device__ __forceinline__ void stage_rc(int b, int& R, int& C) { const int st = b / 1024, sb = b % 1024, swz = sb ^ (((sb >> 9) & 1) << 5); R = (st >> 1) * 16 + swz / 64; C = (st & 1) * 32 + (swz % 64) / 2; }
__host__ __device__ __forceinline__ int perm32(int rho) { const int n = rho >> 4, i = rho & 15; return 8 * (i >> 2) + 4 * n + (i & 3); }

struct Unit { int pm, pn, z; };
struct Gemm { const bf16_t* A; const bf16_t* Bt; int lda, ldb, K; size_t azs, bzs; };

struct Sched {
    int nM, nN, nwg, G, c, nz;
    __device__ void init(int M, int N, int G_, int c_, int nz_) { nM = M / BM; nN = N / BM; nwg = nM * nN; G = G_; c = c_; nz = nz_; }
    __device__ bool next(int i, Unit& u) const {
        const int it = i / nz; u.z = i - it * nz;
        const long L = (long)it * G + c; if (L >= nwg) return false;
        int wgid = (int)L; { const int q = nwg / NXCD, r = nwg % NXCD, xcd = wgid % NXCD, off = wgid / NXCD; wgid = (xcd < r ? xcd * (q + 1) : r * (q + 1) + (xcd - r) * q) + off; }
        const int nig = WGM * nN, gid = wgid / nig, fm = gid * WGM, gsz = (nM - fm) < WGM ? (nM - fm) : WGM;
        u.pm = fm + ((wgid % nig) % gsz); u.pn = (wgid % nig) / gsz; return true;
    }
};

template <class Epi>
__device__ __forceinline__ void gemm_phase(LAS unsigned char* lds, const Gemm g, const Sched& S, const Epi& E) {
    const int tid = opaque_v(threadIdx.x), wid = __builtin_amdgcn_readfirstlane(tid >> 6), lane = tid & 63, wr = wid >> 2, wc = wid & 3, fr = lane & 15, fq = lane >> 4;
    const int K = g.K, nt = K / BK;
    unsigned voffA[2], voffB[2];
#pragma unroll
    for (int i = 0; i < 2; ++i) { int R, C; stage_rc(tid * 16 + i * 8192, R, C); const int Rb = (R & ~31) + perm32(R & 31);
        voffA[i] = (unsigned)(R * g.lda + C) * 2u; voffB[i] = (unsigned)(Rb * g.ldb + C) * 2u; }
    const size_t kstep = (size_t)(BK * 2);
    const size_t hstepA = (size_t)HALF * g.lda * 2, hstepB = (size_t)HALF * g.ldb * 2;
    const unsigned ldsw = (unsigned)wid * 1024u;
    const int aoff = lds_byte(wr * 64 + fr, fq * 8), boff = lds_byte(wc * 32 + fr, fq * 8);
#define PG8_SA(b, h) (((b) * 2 + (h)) * HTB)
#define PG8_SB(b, h) ((4 + (b) * 2 + (h)) * HTB)
#define PG8_STAGE(bufoff, gbase, voff) do { _Pragma("unroll") for (int _i = 0; _i < 2; ++_i) \
        __builtin_amdgcn_global_load_lds((const unsigned*)((const char*)(gbase) + (voff)[_i]), (LAS unsigned*)(lds + (bufoff) + ldsw + _i * 8192), 16, 0, 0); } while (0)
#define PG8_LDA(dst, b, h) do { _Pragma("unroll") for (int m = 0; m < 4; ++m) _Pragma("unroll") for (int k = 0; k < 2; ++k) dst[m][k] = *(const LAS bf16x8*)(lds + PG8_SA(b, h) + aoff + m * 2048 + k * 1024); } while (0)
#define PG8_LDB(dst, b, h) do { _Pragma("unroll") for (int n = 0; n < 2; ++n) _Pragma("unroll") for (int k = 0; k < 2; ++k) dst[n][k] = *(const LAS bf16x8*)(lds + PG8_SB(b, h) + boff + n * 2048 + k * 1024); } while (0)
#define PG8_MMA(ai, bj, At, Bt) do { __builtin_amdgcn_s_setprio(1); _Pragma("unroll") for (int m = 0; m < 4; ++m) _Pragma("unroll") for (int n = 0; n < 2; ++n) _Pragma("unroll") for (int k = 0; k < 2; ++k) \
        acc[ai][bj][m][n] = __builtin_amdgcn_mfma_f32_16x16x32_bf16(Bt[n][k], At[m][k], acc[ai][bj][m][n], 0, 0, 0); __builtin_amdgcn_s_setprio(0); } while (0)
#define PG8_WAIT_V(n) asm volatile("s_waitcnt vmcnt(" #n ")" ::: "memory")
#define PG8_WAIT_L(n) asm volatile("s_waitcnt lgkmcnt(" #n ")" ::: "memory")
#define PG8_BAR __builtin_amdgcn_s_barrier()
#define PG8_SCHED __builtin_amdgcn_sched_barrier(0)
    Unit cur, nxt; int ui = 0;
    if (!S.next(0, cur)) return;
    f32x4 acc[2][2][4][2];
#pragma unroll
    for (int a = 0; a < 2; ++a)
#pragma unroll
        for (int b = 0; b < 2; ++b)
#pragma unroll
            for (int m = 0; m < 4; ++m)
#pragma unroll
                for (int n = 0; n < 2; ++n) acc[a][b][m][n] = (f32x4){0.f, 0.f, 0.f, 0.f};
    bf16x8 At[4][2], B0[2][2], B1[2][2];
    const char* cA = (const char*)g.A + ((size_t)cur.z * g.azs + (size_t)cur.pm * BM * g.lda) * 2;
    const char* cB = (const char*)g.Bt + ((size_t)cur.z * g.bzs + (size_t)cur.pn * BM * g.ldb) * 2;
    PG8_STAGE(PG8_SB(0, 0), cB, voffB); PG8_STAGE(PG8_SB(0, 1), cB + hstepB, voffB); PG8_STAGE(PG8_SA(0, 0), cA, voffA); PG8_STAGE(PG8_SA(0, 1), cA + hstepA, voffA);
    if (wr == 1) PG8_BAR;
    PG8_WAIT_V(2); PG8_BAR;
    PG8_STAGE(PG8_SB(1, 0), cB + kstep, voffB); PG8_STAGE(PG8_SA(1, 0), cA + kstep, voffA); PG8_STAGE(PG8_SB(1, 1), cB + hstepB + kstep, voffB);
    PG8_WAIT_V(6); PG8_BAR;
    for (;;) {
        const bool has_next = S.next(ui + 1, nxt);
        const char* nA = has_next ? (const char*)g.A + ((size_t)nxt.z * g.azs + (size_t)nxt.pm * BM * g.lda) * 2 : cA;
        const char* nB = has_next ? (const char*)g.Bt + ((size_t)nxt.z * g.bzs + (size_t)nxt.pn * BM * g.ldb) * 2 : cB;
        for (int t = 0; t < nt; t += 2) {
            const bool last = (t == nt - 2);
            const char* a1 = cA + (size_t)(t + 1) * kstep;
            const char* a2 = last ? nA : cA + (size_t)(t + 2) * kstep; const char* b2 = last ? nB : cB + (size_t)(t + 2) * kstep;
            const char* a3 = a2 + kstep; const char* b3 = b2 + kstep;
            PG8_LDB(B0, 0, 0); PG8_LDB(B1, 0, 1); PG8_SCHED; PG8_LDA(At, 0, 0); PG8_STAGE(PG8_SA(1, 1), a1 + hstepA, voffA);
            PG8_WAIT_V(8); PG8_WAIT_L(0); PG8_BAR; PG8_MMA(0, 0, At, B0); PG8_MMA(0, 1, At, B1); PG8_BAR; PG8_SCHED;
            PG8_LDA(At, 0, 1); PG8_STAGE(PG8_SB(0, 0), b2, voffB); PG8_STAGE(PG8_SB(0, 1), b2 + hstepB, voffB); PG8_STAGE(PG8_SA(0, 0), a2, voffA);
            PG8_WAIT_V(8); PG8_WAIT_L(0); PG8_BAR; PG8_MMA(1, 0, At, B0); PG8_MMA(1, 1, At, B1); PG8_BAR; PG8_SCHED;
            PG8_LDB(B0, 1, 0); PG8_LDB(B1, 1, 1); PG8_SCHED; PG8_LDA(At, 1, 0); PG8_STAGE(PG8_SA(0, 1), a2 + hstepA, voffA);
            PG8_WAIT_V(8); PG8_WAIT_L(0); PG8_BAR; PG8_MMA(0, 0, At, B0); PG8_MMA(0, 1, At, B1); PG8_BAR; PG8_SCHED;
            PG8_LDA(At, 1, 1); PG8_STAGE(PG8_SB(1, 0), b3, voffB); PG8_STAGE(PG8_SB(1, 1), b3 + hstepB, voffB); PG8_STAGE(PG8_SA(1, 0), a3, voffA);
            PG8_WAIT_V(8); PG8_WAIT_L(0); PG8_BAR; PG8_MMA(1, 0, At, B0); PG8_MMA(1, 1, At, B1); PG8_BAR; PG8_SCHED;
        }
        if (wr == 0) PG8_BAR;
        { const int l2 = opaque_v(lane); E(acc, cur, wr, wc, l2 & 15, l2 >> 4); }
        if (!has_next) break;
#pragma unroll
        for (int a = 0; a < 2; ++a)
#pragma unroll
            for (int b = 0; b < 2; ++b)
#pragma unroll
                for (int m = 0; m < 4; ++m)
#pragma unroll
                    for (int n = 0; n < 2; ++n) acc[a][b][m][n] = (f32x4){0.f, 0.f, 0.f, 0.f};
        cur = nxt; cA = nA; cB = nB; ++ui;
        if (wr == 1) PG8_BAR;
    }
    PG8_WAIT_V(0);
    PG8_BAR;
#undef PG8_SA
#undef PG8_SB
#undef PG8_STAGE
#undef PG8_LDA
#undef PG8_LDB
#undef PG8_MMA
#undef PG8_WAIT_V
#undef PG8_WAIT_L
#undef PG8_BAR
#undef PG8_SCHED
}
}
typedef f32x4 AccT[2][2][4][2];
#define EPI_FENCE(a, b) asm volatile("" : "+v"(a), "+v"(b) :: "memory")

struct EpiIn {
    bf16_t* pmix; bf16_t* gp; bf16_t* mg; float* rsq;
    __device__ __forceinline__ void operator()(const AccT& acc, const pg8::Unit& u, int wr, int wc, int fr, int fq) const {
        const int row0 = u.pm * 256 + wr * 64 + fr, pn = u.pn;
        if (pn < 20) {
#pragma unroll
            for (int ai = 0; ai < 2; ++ai)
#pragma unroll
                for (int m = 0; m < 4; ++m) {
                    __builtin_amdgcn_sched_barrier(0); const int row = row0 + ai * 128 + m * 16; float ss = 0.f;
#pragma unroll
                    for (int bj = 0; bj < 2; ++bj) {
                        const int col0 = pn * 256 + bj * 128 + wc * 32 + 8 * fq;
                        f32x4 v0 = acc[ai][bj][m][0], v1 = acc[ai][bj][m][1]; EPI_FENCE(v0, v1);
                        ss += (v0[0] * v0[0] + v0[1] * v0[1]) + (v0[2] * v0[2] + v0[3] * v0[3]) + (v1[0] * v1[0] + v1[1] * v1[1]) + (v1[2] * v1[2] + v1[3] * v1[3]);
                        const float sc = (col0 >= O_NAQ && col0 < O_NAK) ? C_NA : 1.f;
                        *(u32x4*)(pmix + (size_t)row * NMIXP + col0) = pack8(v0 * sc, v1 * sc);
                    }
                    if (pn < 3) { ss += shx(ss, fr + 16 * fq, 16); ss += shx(ss, fr + 16 * fq, 32); if (fq == 0) rsq[(size_t)row * 12 + pn * 4 + wc] = ss; }
                }
        } else if (pn < 32) {
#pragma unroll
            for (int ai = 0; ai < 2; ++ai)
#pragma unroll
                for (int m = 0; m < 4; ++m) {
                    __builtin_amdgcn_sched_barrier(0); const int row = row0 + ai * 128 + m * 16;
#pragma unroll
                    for (int bj = 0; bj < 2; ++bj) {
                        const int col0 = (pn - 20) * 256 + bj * 128 + wc * 32 + 8 * fq;
                        f32x4 v0 = acc[ai][bj][m][0], v1 = acc[ai][bj][m][1]; EPI_FENCE(v0, v1);
#pragma unroll
                        for (int e = 0; e < 4; ++e) { v0[e] = v0[e] * sigmoidf_(v0[e]); v1[e] = v1[e] * sigmoidf_(v1[e]); }
                        *(u32x4*)(gp + (size_t)row * NGP + col0) = pack8(v0, v1);
                    }
                }
        } else {
#pragma unroll
            for (int ai = 0; ai < 2; ++ai)
#pragma unroll
                for (int m = 0; m < 4; ++m) {
                    __builtin_amdgcn_sched_barrier(0); const int row = row0 + ai * 128 + m * 16;
#pragma unroll
                    for (int bj = 0; bj < 2; ++bj) {
                        const int col0 = (pn - 32) * 256 + bj * 128 + wc * 32 + 8 * fq;
                        f32x4 v0 = acc[ai][bj][m][0], v1 = acc[ai][bj][m][1]; EPI_FENCE(v0, v1);
#pragma unroll
                        for (int e = 0; e < 4; ++e) { v0[e] = sigmoidf_(v0[e]); v1[e] = sigmoidf_(v1[e]); }
                        *(u32x4*)(mg + (size_t)row * NMG + col0) = pack8(v0, v1);
                    }
                }
        }
    }
};
struct EpiQ {
    bf16_t* q; const float* rsq; const float* cs;
    __device__ __forceinline__ void operator()(const AccT& acc, const pg8::Unit& u, int wr, int wc, int fr, int fq) const {
        const int row0 = u.pm * 256 + wr * 64 + fr, pn = u.pn; const bool lat = u.pm < 64;
#pragma unroll
        for (int ai = 0; ai < 2; ++ai)
#pragma unroll
            for (int m = 0; m < 4; ++m) {
                __builtin_amdgcn_sched_barrier(0); const int row = row0 + ai * 128 + m * 16;
                const f32x4 r0 = *(const f32x4*)(rsq + (size_t)row * 12), r1 = *(const f32x4*)(rsq + (size_t)row * 12 + 4);
                const float ssum = ((r0[0] + r0[1]) + (r0[2] + r0[3])) + ((r1[0] + r1[1]) + (r1[2] + r1[3]));
                const float rinv = rsqrtf(ssum * (1.f / 512.f) + EPS) * C_MLA;
                const int s = row & 4095;
#pragma unroll
                for (int bj = 0; bj < 2; ++bj) {
                    const int g32 = pn * 8 + bj * 4 + wc, t6 = g32 % 6, col0 = g32 * 32 + 8 * fq;
                    f32x4 v0 = acc[ai][bj][m][0], v1 = acc[ai][bj][m][1]; EPI_FENCE(v0, v1); v0 = v0 * rinv; v1 = v1 * rinv;
                    if (t6 >= 4 && lat) {
                        const int pos = (t6 == 4) ? (s >> 6) : (s & 63);
                        const float* cp = cs + (pos * 16 + 8 * (fq & 1)) * 2;
                        const f32x4 c0 = *(const f32x4*)(cp), c1 = *(const f32x4*)(cp + 4), c2 = *(const f32x4*)(cp + 8), c3 = *(const f32x4*)(cp + 12);
                        const float cosv[8] = {c0[0], c0[2], c1[0], c1[2], c2[0], c2[2], c3[0], c3[2]};
                        const float sinv[8] = {c0[1], c0[3], c1[1], c1[3], c2[1], c2[3], c3[1], c3[3]};
                        float x[8] = {v0[0], v0[1], v0[2], v0[3], v1[0], v1[1], v1[2], v1[3]};
#pragma unroll
                        for (int e = 0; e < 8; ++e) { const float p = shx(x[e], fr + 16 * fq, 32); x[e] = (fq < 2) ? (x[e] * cosv[e] - p * sinv[e]) : (p * sinv[e] + x[e] * cosv[e]); }
                        v0 = (f32x4){x[0], x[1], x[2], x[3]}; v1 = (f32x4){x[4], x[5], x[6], x[7]};
                    }
                    *(u32x4*)(q + (size_t)row * 1536 + col0) = pack8(v0, v1);
                }
            }
    }
};
struct EpiKV {
    bf16_t* kv; const float* rsq;
    __device__ __forceinline__ void operator()(const AccT& acc, const pg8::Unit& u, int wr, int wc, int fr, int fq) const {
        const int row0 = u.pm * 256 + wr * 64 + fr, pn = u.pn;
#pragma unroll
        for (int ai = 0; ai < 2; ++ai)
#pragma unroll
            for (int m = 0; m < 4; ++m) {
                __builtin_amdgcn_sched_barrier(0); const int row = row0 + ai * 128 + m * 16;
                const f32x4 r0 = *(const f32x4*)(rsq + (size_t)row * 12 + 8);
                const float rinv = rsqrtf(((r0[0] + r0[1]) + (r0[2] + r0[3])) * (1.f / 256.f) + EPS);
#pragma unroll
                for (int bj = 0; bj < 2; ++bj) {
                    const int col0 = pn * 256 + bj * 128 + wc * 32 + 8 * fq;
                    f32x4 v0 = acc[ai][bj][m][0], v1 = acc[ai][bj][m][1]; EPI_FENCE(v0, v1);
                    *(u32x4*)(kv + (size_t)row * 2048 + col0) = pack8(v0 * rinv, v1 * rinv);
                }
            }
    }
};
struct EpiMerge {
    const bf16_t* mg; float* tmp; bf16_t* merged;
    __device__ __forceinline__ void operator()(const AccT& acc, const pg8::Unit& u, int wr, int wc, int fr, int fq) const {
        const int row0 = u.pm * 256 + wr * 64 + fr, pn = u.pn, z = u.z;
#pragma unroll
        for (int ai = 0; ai < 2; ++ai)
#pragma unroll
            for (int m = 0; m < 4; ++m) {
                __builtin_amdgcn_sched_barrier(0); const int row = row0 + ai * 128 + m * 16;
#pragma unroll
                for (int bj = 0; bj < 2; ++bj) {
                    const int col0 = pn * 256 + bj * 128 + wc * 32 + 8 * fq;
                    const u32x4 gw = *(const u32x4*)(mg + (size_t)row * NMG + z * 2048 + col0);
                    f32x4 v0 = acc[ai][bj][m][0], v1 = acc[ai][bj][m][1]; EPI_FENCE(v0, v1);
                    v0[0] *= bflo(gw.x); v0[1] *= bfhi(gw.x); v0[2] *= bflo(gw.y); v0[3] *= bfhi(gw.y);
                    v1[0] *= bflo(gw.z); v1[1] *= bfhi(gw.z); v1[2] *= bflo(gw.w); v1[3] *= bfhi(gw.w);
                    float* tp = tmp + (size_t)row * 2048 + col0;
                    if (z > 0) { v0 += *(const f32x4*)tp; v1 += *(const f32x4*)(tp + 4); }
                    if (z < 2) { *(f32x4*)tp = v0; *(f32x4*)(tp + 4) = v1; }
                    else *(u32x4*)(merged + (size_t)row * 2048 + col0) = pack8(v0, v1);
                }
            }
    }
};
struct EpiOut {
    const float* xin; const float* ctxin; float* xcur; const float* mod; int layer;
    __device__ __forceinline__ void operator()(const AccT& acc, const pg8::Unit& u, int wr, int wc, int fr, int fq) const {
        const int row0 = u.pm * 256 + wr * 64 + fr, pn = u.pn; const bool lat = u.pm < 64;
        const float* gt = mod + (size_t)(lat ? (u.pm >> 4) : 4) * 6144 + 4096;
#pragma unroll
        for (int ai = 0; ai < 2; ++ai)
#pragma unroll
            for (int m = 0; m < 4; ++m) {
                __builtin_amdgcn_sched_barrier(0); const int row = row0 + ai * 128 + m * 16;
                const float* xo = (layer == 0) ? (lat ? xin + (size_t)row * 2048 : ctxin + (size_t)(row - NLAT) * 2048) : xcur + (size_t)row * 2048;
#pragma unroll
                for (int bj = 0; bj < 2; ++bj) {
                    const int col0 = pn * 256 + bj * 128 + wc * 32 + 8 * fq;
                    f32x4 v0 = acc[ai][bj][m][0], v1 = acc[ai][bj][m][1]; EPI_FENCE(v0, v1);
                    const f32x4 g0 = *(const f32x4*)(gt + col0), g1 = *(const f32x4*)(gt + col0 + 4);
                    const f32x4 x0 = *(const f32x4*)(xo + col0), x1 = *(const f32x4*)(xo + col0 + 4);
                    *(f32x4*)(xcur + (size_t)row * 2048 + col0) = x0 + g0 * v0;
                    *(f32x4*)(xcur + (size_t)row * 2048 + col0 + 4) = x1 + g1 * v1;
                }
            }
    }
};

namespace mla {
typedef short s16x4 __attribute__((ext_vector_type(4)));
constexpr int SHM_V = 16384, SHM_K = 16384, SHM_KR = 8192;
constexpr int OFF_V = 0, OFF_K = 2 * SHM_V, OFF_KR = OFF_K + 2 * SHM_K, OFF_WS = OFF_KR + 2 * SHM_KR;
constexpr float THR2 = 8.f;
#define KSWZ(row, colB) ((row) * 256 + ((colB) ^ (((row) & 7) << 4)))
#define KRSWZ(row, colB) ((row) * 128 + ((colB) ^ (((row) & 7) << 4)))
#define SBAR() __builtin_amdgcn_sched_barrier(0)
__device__ __forceinline__ void partialSM(f32x16& p0, f32x16& p1, float& m_reg, float& mn, float& alpha) {
    float pmax = p0[0];
#pragma unroll
    for (int r = 1; r < 16; ++r) pmax = fmaxf(pmax, p0[r]);
#pragma unroll
    for (int r = 0; r < 16; ++r) pmax = fmaxf(pmax, p1[r]);
    { auto rr = __builtin_amdgcn_permlane32_swap(__float_as_uint(pmax), __float_as_uint(pmax), false, false);
      pmax = fmaxf(__uint_as_float(rr[0]), __uint_as_float(rr[1])); }
    if (__builtin_expect(__all(pmax - m_reg <= THR2), 1)) { mn = m_reg; alpha = 1.f; }
    else { mn = fmaxf(m_reg, pmax); alpha = __builtin_amdgcn_exp2f(m_reg - mn); m_reg = mn; }
#pragma unroll
    for (int r = 0; r < 16; ++r) p0[r] = p0[r] - mn;
#pragma unroll
    for (int r = 0; r < 16; ++r) p1[r] = p1[r] - mn;
#pragma unroll
    for (int r = 0; r < 16; ++r) p0[r] = __builtin_amdgcn_exp2f(p0[r]);
}
__device__ __forceinline__ void finishSM(f32x16& p0, f32x16& p1, float alpha, float& l_reg, bf16x8& pa0, bf16x8& pa1, bf16x8& pa2, bf16x8& pa3) {
#pragma unroll
    for (int r = 0; r < 16; ++r) p1[r] = __builtin_amdgcn_exp2f(p1[r]);
    float ps = 0;
#pragma unroll
    for (int r = 0; r < 16; ++r) ps += p0[r];
#pragma unroll
    for (int r = 0; r < 16; ++r) ps += p1[r];
    { auto rr = __builtin_amdgcn_permlane32_swap(__float_as_uint(ps), __float_as_uint(ps), false, false);
      ps = __uint_as_float(rr[0]) + __uint_as_float(rr[1]); }
    l_reg = l_reg * alpha + ps;
#define PK4(P, BASE, OUT) do { unsigned a0 = cvt_pk(P[BASE + 0], P[BASE + 1]), a1 = cvt_pk(P[BASE + 2], P[BASE + 3]);   \
    unsigned b0 = cvt_pk(P[BASE + 4], P[BASE + 5]), b1 = cvt_pk(P[BASE + 6], P[BASE + 7]);                              \
    auto r0 = __builtin_amdgcn_permlane32_swap(a0, b0, false, false); auto r1 = __builtin_amdgcn_permlane32_swap(a1, b1, false, false); \
    u32x4 w = {r0[0], r1[0], r0[1], r1[1]}; OUT = *reinterpret_cast<bf16x8*>(&w); } while (0)
    PK4(p0, 0, pa0); PK4(p0, 8, pa1); PK4(p1, 0, pa2); PK4(p1, 8, pa3);
#undef PK4
}
__device__ __forceinline__ void qkt(f32x16& p0, f32x16& p1, const char* Ks, const char* KRs, const bf16x8* qr, int r32, int hi) {
    p0 = f32x16{}; p1 = f32x16{};
#pragma unroll
    for (int d0 = 0; d0 < 8; ++d0) { const int cb = (d0 * 16 + hi * 8) * 2;
        bf16x8 b0 = *reinterpret_cast<const bf16x8*>(Ks + KSWZ(r32, cb));
        bf16x8 b1 = *reinterpret_cast<const bf16x8*>(Ks + KSWZ(32 + r32, cb));
        p0 = __builtin_amdgcn_mfma_f32_32x32x16_bf16(b0, qr[d0], p0, 0, 0, 0);
        p1 = __builtin_amdgcn_mfma_f32_32x32x16_bf16(b1, qr[d0], p1, 0, 0, 0); }
#pragma unroll
    for (int d0 = 0; d0 < 4; ++d0) { const int cb = (d0 * 16 + hi * 8) * 2;
        bf16x8 b0 = *reinterpret_cast<const bf16x8*>(KRs + KRSWZ(r32, cb));
        bf16x8 b1 = *reinterpret_cast<const bf16x8*>(KRs + KRSWZ(32 + r32, cb));
        p0 = __builtin_amdgcn_mfma_f32_32x32x16_bf16(b0, qr[8 + d0], p0, 0, 0, 0);
        p1 = __builtin_amdgcn_mfma_f32_32x32x16_bf16(b1, qr[8 + d0], p1, 0, 0, 0); }
}
__device__ __forceinline__ int v_st(int k, int c) { const int kk = (k & ~0xC) | ((k & 4) << 1) | ((k & 8) >> 1); return ((kk >> 3) * 4 + (c >> 5)) * 512 + ((kk & 7) * 32 + (c & 31)) * 2; }
__device__ __forceinline__ int v_rd_base(int lane) { return ((lane & 3) << 3) | (((lane >> 2) & 3) << 6) | (((lane >> 4) & 1) << 5) | (((lane >> 5) & 1) << 8); }
constexpr int v_rd_off(int d0, int ks, int half) { return d0 * 512 + ks * 4096 + half * 2048; }
template <int OFF> __device__ __forceinline__ s16x4 tr_read(int vb) {
    s16x4 r; asm volatile("ds_read_b64_tr_b16 %0, %1 offset:%2" : "=&v"(r) : "v"(vb), "i"(OFF) : "memory"); return r;
}
template <int D0> __device__ __forceinline__ void pv_one(f32x16& od, int vb, bf16x8 pa0, bf16x8 pa1, bf16x8 pa2, bf16x8 pa3) {
    const s16x4 l0 = tr_read<v_rd_off(D0, 0, 0)>(vb), h0 = tr_read<v_rd_off(D0, 0, 1)>(vb), l1 = tr_read<v_rd_off(D0, 1, 0)>(vb), h1 = tr_read<v_rd_off(D0, 1, 1)>(vb);
    const s16x4 l2 = tr_read<v_rd_off(D0, 2, 0)>(vb), h2 = tr_read<v_rd_off(D0, 2, 1)>(vb), l3 = tr_read<v_rd_off(D0, 3, 0)>(vb), h3 = tr_read<v_rd_off(D0, 3, 1)>(vb);
    asm volatile("s_waitcnt lgkmcnt(0)" ::: "memory"); SBAR();
#define PK(L, H) (bf16x8){L[0], L[1], L[2], L[3], H[0], H[1], H[2], H[3]}
    od = __builtin_amdgcn_mfma_f32_32x32x16_bf16(pa0, PK(l0, h0), od, 0, 0, 0);
    od = __builtin_amdgcn_mfma_f32_32x32x16_bf16(pa1, PK(l1, h1), od, 0, 0, 0);
    od = __builtin_amdgcn_mfma_f32_32x32x16_bf16(pa2, PK(l2, h2), od, 0, 0, 0);
    od = __builtin_amdgcn_mfma_f32_32x32x16_bf16(pa3, PK(l3, h3), od, 0, 0, 0);
#undef PK
}
__device__ __forceinline__ void pv_d0(f32x16* o, int vb, bf16x8 pa0, bf16x8 pa1, bf16x8 pa2, bf16x8 pa3) {
    pv_one<0>(o[0], vb, pa0, pa1, pa2, pa3); pv_one<1>(o[1], vb, pa0, pa1, pa2, pa3); pv_one<2>(o[2], vb, pa0, pa1, pa2, pa3); pv_one<3>(o[3], vb, pa0, pa1, pa2, pa3);
}
__device__ __forceinline__ void attn_unit(const bf16_t* __restrict__ Q, const bf16_t* __restrict__ KV, const bf16_t* __restrict__ KR, const bf16_t* __restrict__ GP, bf16_t* __restrict__ O,
                                          int qrow0, int h, int latbase, int ctxbase, int nlt, int NT, char* lds) {
    const int tid = opaque_v(threadIdx.x), wid = tid >> 6, lane = tid & 63, r32 = lane & 31, hi = lane >> 5;
    char* V_lds = lds + OFF_V; char* K_lds = lds + OFF_K; char* KR_lds = lds + OFF_KR;
    float* ws = (float*)(lds + OFF_WS) + wid * 64; float* li_l = ws; float* al_l = ws + 32;
    float m_reg = -1e30f, l_reg = 0; f32x16 o[4] = {}; bf16x8 qr[12];
    const bf16_t* Qw = Q + (size_t)(qrow0 + wid * 32 + r32) * 1536 + h * 192 + hi * 8;
#pragma unroll
    for (int d0 = 0; d0 < 12; ++d0) qr[d0] = *reinterpret_cast<const bf16x8*>(Qw + d0 * 16);
    const int sr = tid >> 4, sc = (tid & 15) * 8, vst0 = v_st(sr, sc), vst1 = v_st(32 + sr, sc);
    const int krr = tid >> 3, krc = (tid & 7) * 16;
    const int vb0 = (int)(uintptr_t)V_lds + v_rd_base(lane);
    const bf16_t* Kh = KV + h * 256 + sc; const bf16_t* Vh = KV + h * 256 + 128 + sc;
    bf16x8 s_v0, s_v1, s_k0, s_k1, s_kr;
#define TROW(j) ((j) < nlt ? latbase + 64 * (j) : ctxbase + 64 * ((j) - nlt))
#define SLOAD(j) do { const int _rb = TROW(j); \
    s_v0 = *reinterpret_cast<const bf16x8*>(Vh + (size_t)(_rb + sr) * 2048); s_v1 = *reinterpret_cast<const bf16x8*>(Vh + (size_t)(_rb + 32 + sr) * 2048); \
    s_k0 = *reinterpret_cast<const bf16x8*>(Kh + (size_t)(_rb + sr) * 2048); s_k1 = *reinterpret_cast<const bf16x8*>(Kh + (size_t)(_rb + 32 + sr) * 2048); \
    s_kr = *reinterpret_cast<const bf16x8*>((const char*)KR + (size_t)(_rb + krr) * 128 + krc); } while (0)
#define SWRITE(b) do { *(bf16x8*)(V_lds + (b) * SHM_V + vst0) = s_v0; *(bf16x8*)(V_lds + (b) * SHM_V + vst1) = s_v1; const int kc = sc * 2; \
    *(bf16x8*)(K_lds + (b) * SHM_K + KSWZ(sr, kc)) = s_k0; *(bf16x8*)(K_lds + (b) * SHM_K + KSWZ(32 + sr, kc)) = s_k1; \
    *(bf16x8*)(KR_lds + (b) * SHM_KR + KRSWZ(krr, krc)) = s_kr; } while (0)
#define RESC(a) do { if (__any((a) < 1.f)) { if (hi == 0) al_l[r32] = (a); asm volatile("s_waitcnt lgkmcnt(0)" ::: "memory"); \
    _Pragma("unroll") for (int d = 0; d < 4; ++d) _Pragma("unroll") for (int r = 0; r < 16; ++r) o[d][r] *= al_l[crow(r, hi)]; } } while (0)
    f32x16 pA0, pA1, pB0, pB1; float mnA, mnB, alA, alB; bf16x8 pa0, pa1, pa2, pa3;
    SLOAD(0); asm volatile("s_waitcnt vmcnt(0)" ::: "memory"); SWRITE(0); __syncthreads();
    qkt(pA0, pA1, K_lds, KR_lds, qr, r32, hi); partialSM(pA0, pA1, m_reg, mnA, alA);
    SLOAD(1);
    asm volatile("s_waitcnt vmcnt(0)" ::: "memory"); SWRITE(1); __syncthreads();
    for (int j = 1; j + 1 < NT; j += 2) {
        SBAR(); qkt(pB0, pB1, K_lds + SHM_K, KR_lds + SHM_KR, qr, r32, hi);
        finishSM(pA0, pA1, alA, l_reg, pa0, pa1, pa2, pa3); SBAR();
        SLOAD(j + 1); SBAR();
        pv_d0(o, vb0, pa0, pa1, pa2, pa3); partialSM(pB0, pB1, m_reg, mnB, alB);
        __syncthreads(); asm volatile("s_waitcnt vmcnt(0)" ::: "memory"); SWRITE(0);
        RESC(alB); __syncthreads();
        SBAR(); qkt(pA0, pA1, K_lds, KR_lds, qr, r32, hi);
        finishSM(pB0, pB1, alB, l_reg, pa0, pa1, pa2, pa3); SBAR();
        SLOAD(j + 2); SBAR();
        pv_d0(o, vb0 + SHM_V, pa0, pa1, pa2, pa3); partialSM(pA0, pA1, m_reg, mnA, alA);
        __syncthreads(); asm volatile("s_waitcnt vmcnt(0)" ::: "memory"); SWRITE(1);
        RESC(alA); __syncthreads();
    }
    SBAR(); qkt(pB0, pB1, K_lds + SHM_K, KR_lds + SHM_KR, qr, r32, hi);
    finishSM(pA0, pA1, alA, l_reg, pa0, pa1, pa2, pa3); SBAR();
    pv_d0(o, vb0, pa0, pa1, pa2, pa3); partialSM(pB0, pB1, m_reg, mnB, alB);
    __syncthreads(); RESC(alB);
    finishSM(pB0, pB1, alB, l_reg, pa0, pa1, pa2, pa3); SBAR();
    pv_d0(o, vb0 + SHM_V, pa0, pa1, pa2, pa3);
    if (hi == 0) li_l[r32] = l_reg; asm volatile("s_waitcnt lgkmcnt(0)" ::: "memory");
    const int orow0 = qrow0 + wid * 32;
#pragma unroll
    for (int r = 0; r < 16; ++r) { const int orow = orow0 + crow(r, hi); const float rl = __builtin_amdgcn_rcpf(li_l[crow(r, hi)]);
#pragma unroll
        for (int d0 = 0; d0 < 4; ++d0) { const size_t idx = (size_t)orow * 3072 + h * 128 + d0 * 32 + r32;
            const float v = o[d0][r] * rl * bf1(GP[idx]); O[idx] = (bf16_t)(cvt_pk(v, 0.f) & 0xffffu); } }
    __syncthreads();
#undef TROW
#undef SLOAD
#undef SWRITE
#undef RESC
}
}

__device__ __forceinline__ void na_item(const bf16_t* __restrict__ PMIX, const bf16_t* __restrict__ GP, bf16_t* __restrict__ O, const float* __restrict__ bias, int item, int lane, LAS unsigned char* wl) {
    const int q = lane & 31, hi = lane >> 5;
    const bool lat = item < 8192;
    int b, h, gi = 0, jh = 0, qrow;
    if (lat) { b = item >> 11; h = (item >> 7) & 15; gi = (item >> 1) & 63; jh = item & 1; qrow = b * 4096 + gi * 64 + jh * 32 + q; }
    else { const int it = item - 8192; b = it >> 7; h = (it >> 3) & 15; qrow = NLAT + b * 256 + (it & 7) * 32 + q; }
    const int j = jh * 32 + q;
    const int c0 = min(max(j - 8, 0), 48), r0 = min(max(gi - 4, 0), 56);
    const bf16_t* qp = PMIX + (size_t)qrow * NMIXP + O_NAQ + h * 64 + hi * 8;
    bf16x8 qf[4];
#pragma unroll
    for (int ks = 0; ks < 4; ++ks) qf[ks] = *reinterpret_cast<const bf16x8*>(qp + ks * 16);
    f32x16 oT0 = {}, oT1 = {}; float m = -1e30f, l = 0.f;
    const int ntiles = lat ? 24 : 8;
    const float* bh = bias + h * (15 * 31);
    for (int t = 0; t < ntiles; ++t) {
        int krow0, kr = 0, kblk = 0; const bool local = lat && t < 16;
        if (local) { kr = t >> 1; kblk = t & 1; krow0 = b * 4096 + (r0 + kr) * 64 + kblk * 32; }
        else { const int tc = lat ? t - 16 : t; krow0 = NLAT + b * 256 + tc * 32; }
        const bf16_t* kp = PMIX + (size_t)(krow0 + q) * NMIXP + O_NAK + h * 64 + hi * 8;
        bf16x8 kf[4];
#pragma unroll
        for (int ks = 0; ks < 4; ++ks) kf[ks] = *reinterpret_cast<const bf16x8*>(kp + ks * 16);
        const bf16_t* vp = PMIX + (size_t)(krow0 + (lane >> 1)) * NMIXP + O_NAV + h * 64 + (lane & 1) * 32;
        u32x4 vv[4];
#pragma unroll
        for (int c = 0; c < 4; ++c) vv[c] = *reinterpret_cast<const u32x4*>(vp + c * 8);
        f32x16 p = {};
#pragma unroll
        for (int ks = 0; ks < 4; ++ks) p = __builtin_amdgcn_mfma_f32_32x32x16_bf16(kf[ks], qf[ks], p, 0, 0, 0);
#pragma unroll
        for (int c = 0; c < 4; ++c) *(LAS u32x4*)(wl + (lane >> 1) * 144 + (lane & 1) * 64 + c * 16) = vv[c];
        if (local) {
            const float* brow = bh + (r0 + kr - gi + 7) * 31 + 15 - j;
#pragma unroll
            for (int r = 0; r < 16; ++r) { const int kc = kblk * 32 + crow(r, hi); const bool valid = (kc >= c0) && (kc < c0 + 16);
                const float bv = valid ? brow[kc] : 0.f; p[r] = valid ? fmaf(bv, LOG2E, p[r]) : -INFINITY; }
        }
        float tmax = p[0];
#pragma unroll
        for (int r = 1; r < 16; ++r) tmax = fmaxf(tmax, p[r]);
        tmax = fmaxf(tmax, shx(tmax, lane, 32));
        const float mn = fmaxf(m, tmax), alpha = __builtin_amdgcn_exp2f(m - mn); m = mn;
        float ps = 0.f;
#pragma unroll
        for (int r = 0; r < 16; ++r) { p[r] = __builtin_amdgcn_exp2f(p[r] - mn); ps += p[r]; }
        l = l * alpha + ps;
#pragma unroll
        for (int r = 0; r < 16; ++r) { oT0[r] *= alpha; oT1[r] *= alpha; }
        asm volatile("s_waitcnt lgkmcnt(0)" ::: "memory"); __builtin_amdgcn_wave_barrier();
#pragma unroll
        for (int ks = 0; ks < 2; ++ks) {
            u32x4 pw; pw.x = cvt_pk(p[8 * ks + 0], p[8 * ks + 1]); pw.y = cvt_pk(p[8 * ks + 2], p[8 * ks + 3]); pw.z = cvt_pk(p[8 * ks + 4], p[8 * ks + 5]); pw.w = cvt_pk(p[8 * ks + 6], p[8 * ks + 7]);
            const bf16x8 pf = *reinterpret_cast<bf16x8*>(&pw);
#pragma unroll
            for (int db = 0; db < 2; ++db) {
                bf16x8 vf;
#pragma unroll
                for (int jj = 0; jj < 8; ++jj) { const int key = 16 * ks + 8 * (jj >> 2) + 4 * hi + (jj & 3); vf[jj] = *(const LAS short*)(wl + key * 144 + (32 * db + q) * 2); }
                if (db == 0) oT0 = __builtin_amdgcn_mfma_f32_32x32x16_bf16(vf, pf, oT0, 0, 0, 0);
                else oT1 = __builtin_amdgcn_mfma_f32_32x32x16_bf16(vf, pf, oT1, 0, 0, 0);
            }
        }
        asm volatile("s_waitcnt lgkmcnt(0)" ::: "memory"); __builtin_amdgcn_wave_barrier();
    }
    const float inv = __builtin_amdgcn_rcpf(l + shx(l, lane, 32));
    const size_t ob = (size_t)qrow * 3072 + 1024 + h * 64;
#pragma unroll
    for (int db = 0; db < 2; ++db)
#pragma unroll
        for (int g = 0; g < 4; ++g) {
            const int d = 32 * db + 8 * g + 4 * hi;
            const u32x2 gw = *reinterpret_cast<const u32x2*>(GP + ob + d);
            float v0, v1, v2, v3;
            if (db == 0) { v0 = oT0[4 * g]; v1 = oT0[4 * g + 1]; v2 = oT0[4 * g + 2]; v3 = oT0[4 * g + 3]; } else { v0 = oT1[4 * g]; v1 = oT1[4 * g + 1]; v2 = oT1[4 * g + 2]; v3 = oT1[4 * g + 3]; }
            u32x2 w; w.x = cvt_pk(v0 * inv * bflo(gw.x), v1 * inv * bfhi(gw.x)); w.y = cvt_pk(v2 * inv * bflo(gw.y), v3 * inv * bfhi(gw.y));
            *reinterpret_cast<u32x2*>(O + ob + d) = w;
        }
}

__device__ __forceinline__ void lru_gate_item(const bf16_t* __restrict__ PMIX, const bf16_t* __restrict__ WG, const float* __restrict__ convw, const float* __restrict__ convb,
                                              const float* __restrict__ bg, const float* __restrict__ lam, float* __restrict__ LA, float* __restrict__ LU, int item, LAS unsigned char* lds) {
    const int tid = opaque_v(threadIdx.x), lane = tid & 63, wid = tid >> 6;
    const int tt = item >> 4, blk = item & 15, row0 = tt * 64;
    const int seg0 = row0 < NLAT ? (row0 & ~4095) : (NLAT + ((row0 - NLAT) & ~255)), seg1 = seg0 + (row0 < NLAT ? 4096 : 256);
    LAS float* xcf = (LAS float*)lds;
    LAS unsigned char* xcb = lds + 64 * 68 * 4;
    {
        const int tl = tid >> 3, cg8 = (tid & 7) * 8, row = row0 + tl, ch = blk * 64 + cg8;
        float xc[8];
        { const f32x4 b0 = *(const f32x4*)(convb + ch), b1 = *(const f32x4*)(convb + ch + 4); xc[0] = b0[0]; xc[1] = b0[1]; xc[2] = b0[2]; xc[3] = b0[3]; xc[4] = b1[0]; xc[5] = b1[1]; xc[6] = b1[2]; xc[7] = b1[3]; }
#pragma unroll
        for (int tap = 0; tap < 4; ++tap) {
            const int rr = row + tap - 2;
            if (rr >= seg0 && rr < seg1) {
                const u32x4 pv = *(const u32x4*)(PMIX + (size_t)rr * NMIXP + O_PX + ch);
                const f32x4 w0 = *(const f32x4*)(convw + tap * 1024 + ch), w1 = *(const f32x4*)(convw + tap * 1024 + ch + 4);
                xc[0] += w0[0] * bflo(pv.x); xc[1] += w0[1] * bfhi(pv.x); xc[2] += w0[2] * bflo(pv.y); xc[3] += w0[3] * bfhi(pv.y);
                xc[4] += w1[0] * bflo(pv.z); xc[5] += w1[1] * bfhi(pv.z); xc[6] += w1[2] * bflo(pv.w); xc[7] += w1[3] * bfhi(pv.w);
            }
        }
        *(LAS f32x4*)(xcf + tl * 68 + cg8) = (f32x4){xc[0], xc[1], xc[2], xc[3]}; *(LAS f32x4*)(xcf + tl * 68 + cg8 + 4) = (f32x4){xc[4], xc[5], xc[6], xc[7]};
        u32x4 w; w.x = cvt_pk(xc[0], xc[1]); w.y = cvt_pk(xc[2], xc[3]); w.z = cvt_pk(xc[4], xc[5]); w.w = cvt_pk(xc[6], xc[7]);
        *(LAS u32x4*)(xcb + tl * 144 + cg8 * 2) = w;
    }
    __syncthreads();
    {
        const int dir = wid >> 2, th = (wid >> 1) & 1, chh = wid & 1, q = lane & 31, hi = lane >> 5;
        const int cl = 32 * chh + q, ch = blk * 64 + cl;
        const bf16_t* wt = WG + (size_t)(dir * 16 + blk) * 128 * 64;
        f32x16 accR = {}, accI = {};
#pragma unroll
        for (int ks = 0; ks < 4; ++ks) {
            const bf16x8 af = *(const LAS bf16x8*)(xcb + (32 * th + q) * 144 + (16 * ks + 8 * hi) * 2);
            const bf16x8 br = *reinterpret_cast<const bf16x8*>(wt + (size_t)cl * 64 + 16 * ks + 8 * hi);
            const bf16x8 bi = *reinterpret_cast<const bf16x8*>(wt + (size_t)(64 + cl) * 64 + 16 * ks + 8 * hi);
            accR = __builtin_amdgcn_mfma_f32_32x32x16_bf16(af, br, accR, 0, 0, 0);
            accI = __builtin_amdgcn_mfma_f32_32x32x16_bf16(af, bi, accI, 0, 0, 0);
        }
        const float brv = bg[dir * 2048 + blk * 128 + cl], biv = bg[dir * 2048 + blk * 128 + 64 + cl];
        float sp; { const float xs = __expf(-lam[dir * 1024 + ch]);
            sp = xs < 0.05f ? xs * (1.f - xs * (0.5f - xs * ((1.f / 3.f) - xs * (0.25f - xs * 0.2f)))) : __logf(1.f + xs); }
#pragma unroll
        for (int r = 0; r < 16; ++r) {
            const int tl = 32 * th + crow(r, hi);
            const float rg = sigmoidf_(accR[r] + brv), ig = sigmoidf_(accI[r] + biv);
            const float log_a = -8.f * rg * sp, a = __expf(log_a), ym = -2.f * log_a;
            const float om = ym < 0.1f ? ym * (1.f - ym * (0.5f - ym * ((1.f / 6.f) - ym * ((1.f / 24.f) - ym * (1.f / 120.f))))) : 1.f - __expf(-ym);
            const float u = __builtin_sqrtf(fmaxf(om, 0.f)) * (ig * xcf[tl * 68 + cl]);
            const size_t idx = ((size_t)dir * MROWS + row0 + tl) * 1024 + ch;
            LA[idx] = a; LU[idx] = u;
        }
    }
    __syncthreads();
}
__device__ __forceinline__ int chunk_row0(int b, int c) { return c < 4 ? NLAT + b * 256 + c * 64 : b * 4096 + (c - 4) * 64; }
__device__ __forceinline__ void lru_pass1_item(const float* __restrict__ LA, const float* __restrict__ LU, float* __restrict__ AGG, int item) {
    const int g = item * 512 + opaque_v(threadIdx.x), ch = g & 1023, dir = (g >> 10) & 1, bc = g >> 11, c = bc % NCHUNK, b = bc / NCHUNK;
    const int row0 = chunk_row0(b, c);
    const float* ap = LA + ((size_t)dir * MROWS + row0) * 1024 + ch; const float* up = LU + ((size_t)dir * MROWS + row0) * 1024 + ch;
    float A = 1.f, H = 0.f;
#pragma unroll 8
    for (int t = 0; t < 64; ++t) { const int tt = dir ? 63 - t : t; const float a = ap[(size_t)tt * 1024], u = up[(size_t)tt * 1024]; A *= a; H = a * H + u; }
    float* o = AGG + (((size_t)(dir * NB + b) * NCHUNK + c) * 1024 + ch) * 2; o[0] = A; o[1] = H;
}
__device__ __forceinline__ void lru_pass3_item(const float* __restrict__ LA, float* LU, const float* __restrict__ AGG, const bf16_t* __restrict__ GP, bf16_t* __restrict__ O, int item) {
    const int g = item * 512 + opaque_v(threadIdx.x), ch = g & 1023, bc = g >> 10, c = bc % NCHUNK, b = bc / NCHUNK;
    const int row0 = chunk_row0(b, c);
    float h = 0.f;
    { const float* ag = AGG + ((size_t)(0 * NB + b) * NCHUNK * 1024 + ch) * 2;
      for (int cc = 0; cc < c; ++cc) { const float A = ag[(size_t)cc * 2048], H = ag[(size_t)cc * 2048 + 1]; h = A * h + H; } }
    { const float* ap = LA + ((size_t)row0) * 1024 + ch; float* up = LU + ((size_t)row0) * 1024 + ch;
#pragma unroll 8
      for (int t = 0; t < 64; ++t) { const float a = ap[(size_t)t * 1024], u = up[(size_t)t * 1024]; h = a * h + u; up[(size_t)t * 1024] = h; } }
    h = 0.f;
    { const float* ag = AGG + ((size_t)(1 * NB + b) * NCHUNK * 1024 + ch) * 2;
      if (c < 4) { for (int cc = 3; cc > c; --cc) { const float A = ag[(size_t)cc * 2048], H = ag[(size_t)cc * 2048 + 1]; h = A * h + H; } }
      else { for (int cc = 3; cc >= 0; --cc) { const float A = ag[(size_t)cc * 2048], H = ag[(size_t)cc * 2048 + 1]; h = A * h + H; }
             for (int cc = NCHUNK - 1; cc > c; --cc) { const float A = ag[(size_t)cc * 2048], H = ag[(size_t)cc * 2048 + 1]; h = A * h + H; } } }
    { const float* ap = LA + ((size_t)MROWS + row0) * 1024 + ch; const float* up = LU + ((size_t)MROWS + row0) * 1024 + ch; const float* hf = LU + ((size_t)row0) * 1024 + ch;
#pragma unroll 8
      for (int t = 63; t >= 0; --t) { const float a = ap[(size_t)t * 1024], u = up[(size_t)t * 1024]; h = a * h + u;
          const size_t oi = (size_t)(row0 + t) * 3072 + 2048 + ch; const float v = (hf[(size_t)t * 1024] + h) * bf1(GP[oi]); O[oi] = (bf16_t)(cvt_pk(v, 0.f) & 0xffffu); } }
}

__device__ __forceinline__ void transpose_item(const float* __restrict__ W, int ld_src, int k0, int n0src, const float* __restrict__ kscale, bf16_t* __restrict__ WT, int ldt, int n0dst, LAS float* scr, int lane) {
#pragma unroll 8
    for (int i = 0; i < 32; ++i) { const int kk = 2 * i + (lane >> 5); float v = W[(size_t)(k0 + kk) * ld_src + n0src + (lane & 31)]; if (kscale) v *= kscale[k0 + kk]; scr[kk * 33 + (lane & 31)] = v; }
    asm volatile("s_waitcnt lgkmcnt(0)" ::: "memory"); __builtin_amdgcn_wave_barrier();
    const int c = lane & 7;
#pragma unroll
    for (int jn = 0; jn < 4; ++jn) { const int n = (lane >> 3) + 8 * jn; const LAS float* s = scr + (8 * c) * 33 + n;
        u32x4 o; o.x = cvt_pk(s[0 * 33], s[1 * 33]); o.y = cvt_pk(s[2 * 33], s[3 * 33]); o.z = cvt_pk(s[4 * 33], s[5 * 33]); o.w = cvt_pk(s[6 * 33], s[7 * 33]);
        *(u32x4*)(WT + (size_t)(n0dst + n) * ldt + k0 + 8 * c) = o; }
    asm volatile("s_waitcnt lgkmcnt(0)" ::: "memory"); __builtin_amdgcn_wave_barrier();
}

#define GRID_SYNC() do { asm volatile("s_waitcnt vmcnt(0) lgkmcnt(0)" ::: "memory"); grid.sync(); __builtin_amdgcn_fence(__ATOMIC_ACQUIRE, "agent"); \
    asm volatile("buffer_inv sc1\n\ts_waitcnt vmcnt(0)" ::: "memory"); __syncthreads(); } while (0)
__device__ __forceinline__ unsigned char* opaque_p(unsigned char* p) { asm volatile("" : "+s"(p)); return p; }
__device__ __forceinline__ int opaque_s(int x) { asm volatile("" : "+s"(x)); return x; }
#define x_in (args.in[0])
#define c_in (args.in[1])
#define ctx_in (args.in[2])
#define cctx_in (args.in[3])
#define ada_w (args.in[4])
#define ada_b (args.in[5])
#define norm_g (args.in[6])
#define w_in (args.in[7])
#define qng (args.in[8])
#define kvng (args.in[9])
#define w_uq (args.in[10])
#define w_ukv (args.in[11])
#define rel_bias (args.in[12])
#define conv_w (args.in[13])
#define conv_b (args.in[14])
#define w_gate (args.in[15])
#define b_gate (args.in[16])
#define lam_in (args.in[17])
#define w_branch (args.in[18])
#define w_out (args.in[19])
#define fng (args.in[20])
#define WIN ((bf16_t*)(ws + WS_WIN))
#define WUQ ((bf16_t*)(ws + WS_WUQ))
#define WUKV ((bf16_t*)(ws + WS_WUKV))
#define WBR ((bf16_t*)(ws + WS_WBR))
#define WOUT ((bf16_t*)(ws + WS_WOUT))
#define WG ((bf16_t*)(ws + WS_WG))
#define MOD ((float*)(ws + WS_MOD))
#define ROPE ((float*)(ws + WS_ROPE))
#define XCUR ((float*)(ws + WS_XCUR))
#define HB ((bf16_t*)(ws + WS_H))
#define PMIX ((bf16_t*)(ws + WS_PMIX))
#define GP ((bf16_t*)(ws + WS_GP))
#define MG ((bf16_t*)(ws + WS_MG))
#define RSQ ((float*)(ws + WS_RSQ))
#define QB ((bf16_t*)(ws + WS_Q))
#define KVB ((bf16_t*)(ws + WS_KV))
#define KRB ((bf16_t*)(ws + WS_KR))
#define LA ((float*)(ws + WS_LA))
#define LU ((float*)(ws + WS_LU))
#define AGG ((float*)(ws + WS_AGG))
#define OB ((bf16_t*)(ws + WS_O))
#define MTMP LA
__global__ void __launch_bounds__(512, 2) mk_fwd(Args args) {
    extern __shared__ __attribute__((aligned(16))) unsigned char lds_raw[];
    cg::grid_group grid = cg::this_grid();
    LAS unsigned char* lds = (LAS unsigned char*)lds_raw;
#define PHASE_IDS const int tid = opaque_v(threadIdx.x), lane = tid & 63, wid = __builtin_amdgcn_readfirstlane(tid >> 6), G = opaque_s(gridDim.x), bid = opaque_s(blockIdx.x), NGW = G * 8, gw = bid * 8 + wid; unsigned char* ws = args.ws + (size_t)(unsigned)opaque_s(0); (void)lane; (void)gw; (void)NGW; (void)ws; (void)tid;

    {
        PHASE_IDS
        LAS float* scr = (LAS float*)(lds + wid * 8448);
        constexpr int I_IN = 32 * 442, I_UQ = 8 * 48, I_UKV = 4 * 64, I_BR = 3 * 16 * 64, I_OUT = 32 * 64, I_G = 32 * 4, I_L = I_IN + I_UQ + I_UKV + I_BR + I_OUT + I_G;
        for (int it = gw; it < DEPTH * I_L; it += NGW) {
            const int L = it / I_L; int r = it - L * I_L;
            if (r < I_IN) { const int kb = r / 442, nb = r % 442, n0 = nb * 32;
                transpose_item(w_in + (size_t)L * DM * NIN, NIN, kb * 64, n0, nullptr, WIN + (size_t)L * NINP * DM, DM, n0 < NMIX ? n0 : n0 + (NMIXP - NMIX), scr, lane); continue; } r -= I_IN;
            if (r < I_UQ) { const int kb = r / 48, nb = r % 48;
                transpose_item(w_uq + (size_t)L * 512 * 1536, 1536, kb * 64, nb * 32, qng + L * 512, WUQ + (size_t)L * 1536 * 512, 512, nb * 32, scr, lane); continue; } r -= I_UQ;
            if (r < I_UKV) { const int kb = r / 64, nb = r % 64;
                transpose_item(w_ukv + (size_t)L * 256 * 2048, 2048, kb * 64, nb * 32, kvng + L * 256, WUKV + (size_t)L * 2048 * 256, 256, nb * 32, scr, lane); continue; } r -= I_UKV;
            if (r < I_BR) { const int n3 = r / 1024, rr = r % 1024, kb = rr / 64, nb = rr % 64;
                transpose_item(w_branch + ((size_t)L * 3 + n3) * 1024 * 2048, 2048, kb * 64, nb * 32, nullptr, WBR + ((size_t)L * 3 + n3) * 2048 * 1024, 1024, nb * 32, scr, lane); continue; } r -= I_BR;
            if (r < I_OUT) { const int kb = r / 64, nb = r % 64;
                transpose_item(w_out + (size_t)L * DM * DM, DM, kb * 64, nb * 32, nullptr, WOUT + (size_t)L * DM * DM, DM, nb * 32, scr, lane); continue; } r -= I_OUT;
            { const int db = r / 4, nb = r % 4;
              transpose_item(w_gate + ((size_t)L * 32 + db) * 64 * 128, 128, 0, nb * 32, nullptr, WG + ((size_t)L * 32 + db) * 128 * 64, 64, nb * 32, scr, lane); }
        }
        for (int i = bid * 512 + tid; i < DEPTH * (NMIXP - NMIX) * (DM / 8); i += G * 512) {
            const int L = i / ((NMIXP - NMIX) * (DM / 8)), r = i % ((NMIXP - NMIX) * (DM / 8));
            *(u32x4*)(WIN + ((size_t)L * NINP + NMIX) * DM + (size_t)r * 8) = (u32x4){0u, 0u, 0u, 0u};
        }
        __syncthreads();
        LAS float* sil = (LAS float*)(lds + 69632);
        LAS float* red = (LAS float*)(lds + 69632 + 40960);
        for (int i = tid; i < 5 * 2048; i += 512) { const float v = i < 4 * 2048 ? c_in[i] : cctx_in[i - 4 * 2048]; sil[i] = v * (1.f / (1.f + expf(-v))); }
        __syncthreads();
        for (int it = bid; it < DEPTH * 96; it += G) {
            const int L = it / 96, cb = it % 96, ksl = tid >> 6, col = cb * 64 + (tid & 63);
            float a5[5] = {0.f, 0.f, 0.f, 0.f, 0.f};
            const float* wp = ada_w + (size_t)L * DM * 6144 + col;
            for (int k = ksl * 256; k < ksl * 256 + 256; ++k) { const float w = wp[(size_t)k * 6144];
#pragma unroll
                for (int r = 0; r < 5; ++r) a5[r] += sil[r * 2048 + k] * w; }
#pragma unroll
            for (int r = 0; r < 5; ++r) red[(ksl * 5 + r) * 64 + (tid & 63)] = a5[r];
            __syncthreads();
            if (tid < 320) { const int r = tid >> 6, cc = tid & 63; float s = 0.f;
#pragma unroll
                for (int k = 0; k < 8; ++k) s += red[(k * 5 + r) * 64 + cc];
                MOD[((size_t)L * 5 + r) * 6144 + cb * 64 + cc] = s + ada_b[(size_t)L * 6144 + cb * 64 + cc]; }
            __syncthreads();
        }
        if (bid == G - 1) for (int i = tid; i < 1024; i += 512) { const int pos = i >> 4, k = i & 15;
            const float inv = 1.0f / powf(10000.f, (float)k * (1.f / 16.f)), ang = (float)pos * inv; ROPE[2 * i] = cosf(ang); ROPE[2 * i + 1] = sinf(ang); }
    }
    GRID_SYNC();

    for (int layer = 0; layer < DEPTH; ++layer) {
        const bool need_ctx = layer < DEPTH - 1;
        { PHASE_IDS
        for (int row = gw; row < MROWS; row += NGW) {
            const bool lat = row < NLAT;
            const float* src = (layer == 0) ? (lat ? x_in + (size_t)row * DM : ctx_in + (size_t)(row - NLAT) * DM) : XCUR + (size_t)row * DM;
            const float* mr = MOD + (size_t)layer * 5 * 6144 + (size_t)(lat ? (row >> 12) : 4) * 6144;
            f32x4 v[8]; float ss = 0.f;
#pragma unroll
            for (int jv = 0; jv < 8; ++jv) { v[jv] = *(const f32x4*)(src + 4 * (lane + 64 * jv)); ss += (v[jv][0] * v[jv][0] + v[jv][1] * v[jv][1]) + (v[jv][2] * v[jv][2] + v[jv][3] * v[jv][3]); }
            const float rinv = rsqrtf(wave_sum(ss, lane) * (1.f / DM) + EPS);
#pragma unroll
            for (int jv = 0; jv < 8; ++jv) { const int col = 4 * (lane + 64 * jv);
                const f32x4 gg = *(const f32x4*)(norm_g + layer * DM + col), sh = *(const f32x4*)(mr + col), sc = *(const f32x4*)(mr + 2048 + col);
                const f32x4 hh = (v[jv] * rinv * gg) * (sc + 1.f) + sh;
                u32x2 w; w.x = cvt_pk(hh[0], hh[1]); w.y = cvt_pk(hh[2], hh[3]); *(u32x2*)(HB + (size_t)row * DM + col) = w; }
        } }
        GRID_SYNC();
        {
            PHASE_IDS
            pg8::Gemm g{HB, WIN + (size_t)layer * NINP * DM, DM, DM, DM, 0, 0}; pg8::Sched S; S.init(MROWS, NINP, G, bid, 1);
            EpiIn E{PMIX, GP, MG, RSQ};
            pg8::gemm_phase<EpiIn>(lds, g, S, E);
        }
        GRID_SYNC();
        {
            PHASE_IDS
            { pg8::Gemm g{PMIX, WUQ + (size_t)layer * 1536 * 512, NMIXP, 512, 512, 0, 0}; pg8::Sched S; S.init(MROWS, 1536, G, bid, 1);
              EpiQ E{QB, RSQ, ROPE}; pg8::gemm_phase<EpiQ>(lds, g, S, E); }
            { pg8::Gemm g{PMIX + 512, WUKV + (size_t)layer * 2048 * 256, NMIXP, 256, 256, 0, 0}; pg8::Sched S; S.init(MROWS, 2048, G, bid, 1);
              EpiKV E{KVB, RSQ}; pg8::gemm_phase<EpiKV>(lds, g, S, E); }
            for (int i = bid * 512 + tid; i < MROWS * 4; i += G * 512) {
                const int row = i >> 2, hf = (i >> 1) & 1, sub = i & 1;
                const bf16_t* src = PMIX + (size_t)row * NMIXP + O_KR + 32 * hf + 8 * sub;
                u32x4 a = *(const u32x4*)src, b2 = *(const u32x4*)(src + 16);
                if (row < NLAT) {
                    const int s = row & 4095, pos = hf ? (s & 63) : (s >> 6);
                    const float* cp = ROPE + (pos * 16 + 8 * sub) * 2;
                    float x1[8] = {bflo(a.x), bfhi(a.x), bflo(a.y), bfhi(a.y), bflo(a.z), bfhi(a.z), bflo(a.w), bfhi(a.w)};
                    float x2[8] = {bflo(b2.x), bfhi(b2.x), bflo(b2.y), bfhi(b2.y), bflo(b2.z), bfhi(b2.z), bflo(b2.w), bfhi(b2.w)};
                    float o1[8], o2[8];
#pragma unroll
                    for (int e = 0; e < 8; ++e) { const float cv = cp[2 * e], sv = cp[2 * e + 1]; o1[e] = x1[e] * cv - x2[e] * sv; o2[e] = x1[e] * sv + x2[e] * cv; }
                    a.x = cvt_pk(o1[0], o1[1]); a.y = cvt_pk(o1[2], o1[3]); a.z = cvt_pk(o1[4], o1[5]); a.w = cvt_pk(o1[6], o1[7]);
                    b2.x = cvt_pk(o2[0], o2[1]); b2.y = cvt_pk(o2[2], o2[3]); b2.z = cvt_pk(o2[4], o2[5]); b2.w = cvt_pk(o2[6], o2[7]);
                }
                bf16_t* dst = KRB + (size_t)row * 64 + 32 * hf + 8 * sub;
                *(u32x4*)dst = a; *(u32x4*)(dst + 16) = b2;
            }
            __syncthreads();
            for (int it = bid; it < (MROWS / 64) * 16; it += G)
                lru_gate_item(PMIX, WG + (size_t)layer * 32 * 128 * 64, conv_w + (size_t)layer * 4 * 1024, conv_b + (size_t)layer * 1024, b_gate + (size_t)layer * 2 * 2048, lam_in + (size_t)layer * 2 * 1024, LA, LU, it, lds);
        }
        GRID_SYNC();
        {
            PHASE_IDS
            const int nmla = 512 + (need_ctx ? 32 : 0);
            for (int u = bid; u < nmla; u += G) {
                if (u < 512) { const int b = u >> 7, h = (u >> 4) & 7, qb = u & 15;
                    mla::attn_unit(QB, KVB, KRB, GP, OB, b * 4096 + qb * 256, h, b * 4096, NLAT + b * 256, 64, 68, (char*)lds_raw); }
                else { const int b = (u - 512) >> 3, h = (u - 512) & 7;
                    mla::attn_unit(QB, KVB, KRB, GP, OB, NLAT + b * 256, h, 0, NLAT + b * 256, 0, 4, (char*)lds_raw); }
            }
            __syncthreads();
            const int nna = 8192 + (need_ctx ? 512 : 0);
            for (int it = gw; it < nna; it += NGW) na_item(PMIX, GP, OB, rel_bias + (size_t)layer * 16 * 15 * 31, it, lane, lds + wid * 4608);
            for (int it = bid; it < (NB * NCHUNK * 2 * 1024) / 512; it += G) lru_pass1_item(LA, LU, AGG, it);
        }
        GRID_SYNC();
        { PHASE_IDS
        for (int it = bid; it < (NB * NCHUNK * 1024) / 512; it += G) lru_pass3_item(LA, LU, AGG, GP, OB, it); }
        GRID_SYNC();
        {
            PHASE_IDS
            const int Mrows = need_ctx ? MROWS : NLAT;
            pg8::Gemm g{OB, WBR + (size_t)layer * 3 * 2048 * 1024, 3072, 1024, 1024, 1024, (size_t)2048 * 1024}; pg8::Sched S; S.init(Mrows, DM, G, bid, 3);
            EpiMerge E{MG, MTMP, HB}; pg8::gemm_phase<EpiMerge>(lds, g, S, E);
        }
        GRID_SYNC();
        {
            PHASE_IDS
            const int Mrows = need_ctx ? MROWS : NLAT;
            pg8::Gemm g{HB, WOUT + (size_t)layer * DM * DM, DM, DM, DM, 0, 0}; pg8::Sched S; S.init(Mrows, DM, G, bid, 1);
            EpiOut E{x_in, ctx_in, XCUR, MOD + (size_t)layer * 5 * 6144, layer}; pg8::gemm_phase<EpiOut>(lds, g, S, E);
        }
        GRID_SYNC();
    }
    { PHASE_IDS
    for (int row = gw; row < NLAT; row += NGW) {
        const float* src = XCUR + (size_t)row * DM;
        f32x4 v[8]; float ss = 0.f;
#pragma unroll
        for (int jv = 0; jv < 8; ++jv) { v[jv] = *(const f32x4*)(src + 4 * (lane + 64 * jv)); ss += (v[jv][0] * v[jv][0] + v[jv][1] * v[jv][1]) + (v[jv][2] * v[jv][2] + v[jv][3] * v[jv][3]); }
        const float rinv = rsqrtf(wave_sum(ss, lane) * (1.f / DM) + EPS);
#pragma unroll
        for (int jv = 0; jv < 8; ++jv) { const int col = 4 * (lane + 64 * jv); *(f32x4*)(args.out + (size_t)row * DM + col) = v[jv] * rinv * *(const f32x4*)(fng + col); }
    } }
}

extern "C" void kernel_launch(void* const* d_in, const int* in_sizes, int n_in, void* d_out, int out_size, void* d_ws, size_t ws_size, hipStream_t stream) {
    static int grid = 0;
    if (grid == 0) {
        if (n_in != 21 || ws_size < WS_END) { fprintf(stderr, "kernel_launch: n_in %d ws %zu (need %zu): nothing launched\n", n_in, ws_size, (size_t)WS_END); grid = -1; return; }
        int dev = 0, cus = 0, per_cu = 0;
        if (hipGetDevice(&dev) != hipSuccess || hipDeviceGetAttribute(&cus, hipDeviceAttributeMultiprocessorCount, dev) != hipSuccess) { grid = -1; return; }
        if (hipFuncSetAttribute((const void*)mk_fwd, hipFuncAttributeMaxDynamicSharedMemorySize, LDS_BYTES) != hipSuccess) { fprintf(stderr, "hipFuncSetAttribute failed\n"); grid = -1; return; }
        if (hipOccupancyMaxActiveBlocksPerMultiprocessor(&per_cu, (const void*)mk_fwd, 512, LDS_BYTES) != hipSuccess || per_cu < 1) { fprintf(stderr, "occupancy query: %d\n", per_cu); per_cu = 1; }
        (void)hipGetLastError();
        grid = cus * per_cu;
    }
    if (grid < 0) return;
    Args a{};
    for (int i = 0; i < 21; ++i) a.in[i] = (const float*)d_in[i];
    a.out = (float*)d_out; a.ws = (unsigned char*)d_ws;
    void* kargs[] = {&a};
    hipError_t e = hipLaunchCooperativeKernel((const void*)mk_fwd, dim3(grid), dim3(512), kargs, LDS_BYTES, stream);
    if (e != hipSuccess) fprintf(stderr, "cooperative launch failed: %s (grid %d)\n", hipGetErrorString(e), grid);
}
```

```cpp
#include <hip/hip_runtime.h>
#include <hip/hip_cooperative_groups.h>
#include <cstdio>
#include <cstdint>
namespace cg = cooperative_groups;

typedef unsigned short bf16_t;
typedef short bf16x8 __attribute__((ext_vector_type(8)));
typedef float f32x4 __attribute__((ext_vector_type(4)));
typedef float f32x16 __attribute__((ext_vector_type(16)));
typedef unsigned u32x4 __attribute__((ext_vector_type(4)));
typedef unsigned u32x2 __attribute__((ext_vector_type(2)));
#define LAS __attribute__((address_space(3)))

constexpr int DM = 2048, NB = 4, SEQ = 4096, NCTXT = 256, DEPTH = 4;
constexpr int NLAT = NB * SEQ, NCTX = NB * NCTXT, MROWS = NLAT + NCTX;
constexpr int NMIX = 4928, NMIXP = 5120, NGP = 3072, NMG = 6144, NINP = NMIXP + NGP + NMG, NIN = 14144;
constexpr int O_KR = 768, O_NAQ = 832, O_NAK = 1856, O_NAV = 2880, O_PX = 3904;
constexpr float EPS = 1e-6f, LOG2E = 1.4426950408889634f;
constexpr float C_MLA = 0.07216878364870322f * LOG2E;
constexpr float C_NA = 0.125f * LOG2E;
constexpr int NCHUNK = 68;

constexpr size_t al256(size_t x) { return (x + 255) / 256 * 256; }
constexpr size_t WS_WIN = 0;
constexpr size_t WS_WUQ = WS_WIN + al256((size_t)DEPTH * NINP * DM * 2);
constexpr size_t WS_WUKV = WS_WUQ + al256((size_t)DEPTH * 1536 * 512 * 2);
constexpr size_t WS_WBR = WS_WUKV + al256((size_t)DEPTH * 2048 * 256 * 2);
constexpr size_t WS_WOUT = WS_WBR + al256((size_t)DEPTH * 3 * 2048 * 1024 * 2);
constexpr size_t WS_WG = WS_WOUT + al256((size_t)DEPTH * 2048 * 2048 * 2);
constexpr size_t WS_MOD = WS_WG + al256((size_t)DEPTH * 2 * 16 * 128 * 64 * 2);
constexpr size_t WS_ROPE = WS_MOD + al256((size_t)DEPTH * 5 * 6144 * 4);
constexpr size_t WS_XCUR = WS_ROPE + al256((size_t)64 * 16 * 2 * 4);
constexpr size_t WS_H = WS_XCUR + al256((size_t)MROWS * DM * 4);
constexpr size_t WS_PMIX = WS_H + al256((size_t)MROWS * DM * 2);
constexpr size_t WS_GP = WS_PMIX + al256((size_t)MROWS * NMIXP * 2);
constexpr size_t WS_MG = WS_GP + al256((size_t)MROWS * NGP * 2);
constexpr size_t WS_RSQ = WS_MG + al256((size_t)MROWS * NMG * 2);
constexpr size_t WS_Q = WS_RSQ + al256((size_t)MROWS * 12 * 4);
constexpr size_t WS_KV = WS_Q + al256((size_t)MROWS * 1536 * 2);
constexpr size_t WS_KR = WS_KV + al256((size_t)MROWS * 2048 * 2);
constexpr size_t WS_LA = WS_KR + al256((size_t)MROWS * 64 * 2);
constexpr size_t WS_LU = WS_LA + al256((size_t)2 * MROWS * 1024 * 4);
constexpr size_t WS_AGG = WS_LU + al256((size_t)2 * MROWS * 1024 * 4);
constexpr size_t WS_O = WS_AGG + al256((size_t)2 * NB * NCHUNK * 1024 * 2 * 4);
constexpr size_t WS_END = WS_O + al256((size_t)MROWS * 3072 * 2);

constexpr int LDS_BYTES = 147456;

struct Args { const float* in[21]; float* out; unsigned char* ws; };

typedef float f32x2_t __attribute__((ext_vector_type(2))); typedef __bf16 bf16x2_t __attribute__((ext_vector_type(2)));
__device__ __forceinline__ unsigned cvt_pk(float lo, float hi) { f32x2_t v = {lo, hi}; bf16x2_t b = __builtin_convertvector(v, bf16x2_t); return __builtin_bit_cast(unsigned, b); }
__device__ __forceinline__ float bflo(unsigned u) { return __uint_as_float(u << 16); }
__device__ __forceinline__ float bfhi(unsigned u) { return __uint_as_float(u & 0xffff0000u); }
__device__ __forceinline__ float bf1(bf16_t u) { return __uint_as_float(((unsigned)u) << 16); }
__device__ __forceinline__ u32x4 pack8(f32x4 a, f32x4 b) { u32x4 w; w.x = cvt_pk(a[0], a[1]); w.y = cvt_pk(a[2], a[3]); w.z = cvt_pk(b[0], b[1]); w.w = cvt_pk(b[2], b[3]); return w; }
__device__ __forceinline__ float sigmoidf_(float x) { return __builtin_amdgcn_rcpf(1.f + __expf(-x)); }
__device__ __forceinline__ float shx(float v, int lane, int m) { return __int_as_float(__builtin_amdgcn_ds_bpermute((lane ^ m) << 2, __float_as_int(v))); }
__device__ __forceinline__ float wave_sum(float v, int lane) {
#pragma unroll
    for (int o = 1; o < 64; o <<= 1) v += shx(v, lane, o);
    return v;
}
__device__ __forceinline__ int opaque_v(int x) { asm volatile("" : "+v"(x)); return x; }
__device__ __forceinline__ int crow(int r, int hi) { return (r & 3) + 8 * (r >> 2) + 4 * hi; }

namespace pg8 {
constexpr int BM = 256, BK = 64, HALF = 128, HTB = HALF * BK * 2, NXCD = 8, WGM = 8;
__host__ __device__ __forceinline__ int lds_byte(int r, int c) { const int st = (r >> 4) * 2 + (c >> 5), rr = r & 15, cc = c & 31, ob = rr * 64 + cc * 2; return st * 1024 + (ob ^ (((ob >> 9) & 1) << 5)); }
__host__ __device__ __forceinline__ void stage_rc(int b, int& R, int& C) { const int st = b / 1024, sb = b % 1024, swz = sb ^ (((sb >> 9) & 1) << 5); R = (st >> 1) * 16 + swz / 64; C = (st & 1) * 32 + (swz % 64) / 2; }
__host__ __device__ __forceinline__ int perm32(int rho) { const int n = rho >> 4, i = rho & 15; return 8 * (i >> 2) + 4 * n + (i & 3); }

struct Unit { int pm, pn, z; };
struct Gemm { const bf16_t* A; const bf16_t* Bt; int lda, ldb, K; size_t azs, bzs; };

struct Sched {
    int nM, nN, nwg, G, c, nz;
    __device__ void init(int M, int N, int G_, int c_, int nz_) { nM = M / BM; nN = N / BM; nwg = nM * nN; G = G_; c = c_; nz = nz_; }
    __device__ bool next(int i, Unit& u) const {
        const int it = i / nz; u.z = i - it * nz;
        const long L = (long)it * G + c; if (L >= nwg) return false;
        int wgid = (int)L; { const int q = nwg / NXCD, r = nwg % NXCD, xcd = wgid % NXCD, off = wgid / NXCD; wgid = (xcd < r ? xcd * (q + 1) : r * (q + 1) + (xcd - r) * q) + off; }
        const int nig = WGM * nN, gid = wgid / nig, fm = gid * WGM, gsz = (nM - fm) < WGM ? (nM - fm) : WGM;
        u.pm = fm + ((wgid % nig) % gsz); u.pn = (wgid % nig) / gsz; return true;
    }
};

template <class Epi>
__device__ __forceinline__ void gemm_phase(LAS unsigned char* lds, const Gemm g, const Sched& S, const Epi& E) {
    const int tid = opaque_v(threadIdx.x), wid = __builtin_amdgcn_readfirstlane(tid >> 6), lane = tid & 63, wr = wid >> 2, wc = wid & 3, fr = lane & 15, fq = lane >> 4;
    const int K = g.K, nt = K / BK;
    unsigned voffA[2], voffB[2];
#pragma unroll
    for (int i = 0; i < 2; ++i) { int R, C; stage_rc(tid * 16 + i * 8192, R, C); const int Rb = (R & ~31) + perm32(R & 31);
        voffA[i] = (unsigned)(R * g.lda + C) * 2u; voffB[i] = (unsigned)(Rb * g.ldb + C) * 2u; }
    const size_t kstep = (size_t)(BK * 2);
    const size_t hstepA = (size_t)HALF * g.lda * 2, hstepB = (size_t)HALF * g.ldb * 2;
    const unsigned ldsw = (unsigned)wid * 1024u;
    const int aoff = lds_byte(wr * 64 + fr, fq * 8), boff = lds_byte(wc * 32 + fr, fq * 8);
#define PG8_SA(b, h) (((b) * 2 + (h)) * HTB)
#define PG8_SB(b, h) ((4 + (b) * 2 + (h)) * HTB)
#define PG8_STAGE(bufoff, gbase, voff) do { _Pragma("unroll") for (int _i = 0; _i < 2; ++_i) \
        __builtin_amdgcn_global_load_lds((const unsigned*)((const char*)(gbase) + (voff)[_i]), (LAS unsigned*)(lds + (bufoff) + ldsw + _i * 8192), 16, 0, 0); } while (0)
#define PG8_LDA(dst, b, h) do { _Pragma("unroll") for (int m = 0; m < 4; ++m) _Pragma("unroll") for (int k = 0; k < 2; ++k) dst[m][k] = *(const LAS bf16x8*)(lds + PG8_SA(b, h) + aoff + m * 2048 + k * 1024); } while (0)
#define PG8_LDB(dst, b, h) do { _Pragma("unroll") for (int n = 0; n < 2; ++n) _Pragma("unroll") for (int k = 0; k < 2; ++k) dst[n][k] = *(const LAS bf16x8*)(lds + PG8_SB(b, h) + boff + n * 2048 + k * 1024); } while (0)
#define PG8_MMA(ai, bj, At, Bt) do { __builtin_amdgcn_s_setprio(1); _Pragma("unroll") for (int m = 0; m < 4; ++m) _Pragma("unroll") for (int n = 0; n < 2; ++n) _Pragma("unroll") for (int k = 0; k < 2; ++k) \
        acc[ai][bj][m][n] = __builtin_amdgcn_mfma_f32_16x16x32_bf16(Bt[n][k], At[m][k], acc[ai][bj][m][n], 0, 0, 0); __builtin_amdgcn_s_setprio(0); } while (0)
#define PG8_WAIT_V(n) asm volatile("s_waitcnt vmcnt(" #n ")" ::: "memory")
#define PG8_WAIT_L(n) asm volatile("s_waitcnt lgkmcnt(" #n ")" ::: "memory")
#define PG8_BAR __builtin_amdgcn_s_barrier()
#define PG8_SCHED __builtin_amdgcn_sched_barrier(0)
    Unit cur, nxt; int ui = 0;
    if (!S.next(0, cur)) return;
    f32x4 acc[2][2][4][2];
#pragma unroll
    for (int a = 0; a < 2; ++a)
#pragma unroll
        for (int b = 0; b < 2; ++b)
#pragma unroll
            for (int m = 0; m < 4; ++m)
#pragma unroll
                for (int n = 0; n < 2; ++n) acc[a][b][m][n] = (f32x4){0.f, 0.f, 0.f, 0.f};
    bf16x8 At[4][2], B0[2][2], B1[2][2];
    const char* cA = (const char*)g.A + ((size_t)cur.z * g.azs + (size_t)cur.pm * BM * g.lda) * 2;
    const char* cB = (const char*)g.Bt + ((size_t)cur.z * g.bzs + (size_t)cur.pn * BM * g.ldb) * 2;
    PG8_STAGE(PG8_SB(0, 0), cB, voffB); PG8_STAGE(PG8_SB(0, 1), cB + hstepB, voffB); PG8_STAGE(PG8_SA(0, 0), cA, voffA); PG8_STAGE(PG8_SA(0, 1), cA + hstepA, voffA);
    if (wr == 1) PG8_BAR;
    PG8_WAIT_V(2); PG8_BAR;
    PG8_STAGE(PG8_SB(1, 0), cB + kstep, voffB); PG8_STAGE(PG8_SA(1, 0), cA + kstep, voffA); PG8_STAGE(PG8_SB(1, 1), cB + hstepB + kstep, voffB);
    PG8_WAIT_V(6); PG8_BAR;
    for (;;) {
        const bool has_next = S.next(ui + 1, nxt);
        const char* nA = has_next ? (const char*)g.A + ((size_t)nxt.z * g.azs + (size_t)nxt.pm * BM * g.lda) * 2 : cA;
        const char* nB = has_next ? (const char*)g.Bt + ((size_t)nxt.z * g.bzs + (size_t)nxt.pn * BM * g.ldb) * 2 : cB;
        for (int t = 0; t < nt; t += 2) {
            const bool last = (t == nt - 2);
            const char* a1 = cA + (size_t)(t + 1) * kstep;
            const char* a2 = last ? nA : cA + (size_t)(t + 2) * kstep; const char* b2 = last ? nB : cB + (size_t)(t + 2) * kstep;
            const char* a3 = a2 + kstep; const char* b3 = b2 + kstep;
            PG8_LDB(B0, 0, 0); PG8_LDB(B1, 0, 1); PG8_SCHED; PG8_LDA(At, 0, 0); PG8_STAGE(PG8_SA(1, 1), a1 + hstepA, voffA);
            PG8_WAIT_V(8); PG8_WAIT_L(0); PG8_BAR; PG8_MMA(0, 0, At, B0); PG8_MMA(0, 1, At, B1); PG8_BAR; PG8_SCHED;
            PG8_LDA(At, 0, 1); PG8_STAGE(PG8_SB(0, 0), b2, voffB); PG8_STAGE(PG8_SB(0, 1), b2 + hstepB, voffB); PG8_STAGE(PG8_SA(0, 0), a2, voffA);
            PG8_WAIT_V(8); PG8_WAIT_L(0); PG8_BAR; PG8_MMA(1, 0, At, B0); PG8_MMA(1, 1, At, B1); PG8_BAR; PG8_SCHED;
            PG8_LDB(B0, 1, 0); PG8_LDB(B1, 1, 1); PG8_SCHED; PG8_LDA(At, 1, 0); PG8_STAGE(PG8_SA(0, 1), a2 + hstepA, voffA);
            PG8_WAIT_V(8); PG8_WAIT_L(0); PG8_BAR; PG8_MMA(0, 0, At, B0); PG8_MMA(0, 1, At, B1); PG8_BAR; PG8_SCHED;
            PG8_LDA(At, 1, 1); PG8_STAGE(PG8_SB(1, 0), b3, voffB); PG8_STAGE(PG8_SB(1, 1), b3 + hstepB, voffB); PG8_STAGE(PG8_SA(1, 0), a3, voffA);
            PG8_WAIT_V(8); PG8_WAIT_L(0); PG8_BAR; PG8_MMA(1, 0, At, B0); PG8_MMA(1, 1, At, B1); PG8_BAR; PG8_SCHED;
        }
        if (wr == 0) PG8_BAR;
        { const int l2 = opaque_v(lane); E(acc, cur, wr, wc, l2 & 15, l2 >> 4); }
        if (!has_next) break;
#pragma unroll
        for (int a = 0; a < 2; ++a)
#pragma unroll
            for (int b = 0; b < 2; ++b)
#pragma unroll
                for (int m = 0; m < 4; ++m)
#pragma unroll
                    for (int n = 0; n < 2; ++n) acc[a][b][m][n] = (f32x4){0.f, 0.f, 0.f, 0.f};
        cur = nxt; cA = nA; cB = nB; ++ui;
        if (wr == 1) PG8_BAR;
    }
    PG8_WAIT_V(0);
    PG8_BAR;
#undef PG8_SA
#undef PG8_SB
#undef PG8_STAGE
#undef PG8_LDA
#undef PG8_LDB
#undef PG8_MMA
#undef PG8_WAIT_V
#undef PG8_WAIT_L
#undef PG8_BAR
#undef PG8_SCHED
}
}
typedef f32x4 AccT[2][2][4][2];
#define EPI_FENCE(a, b) asm volatile("" : "+v"(a), "+v"(b) :: "memory")

struct EpiIn {
    bf16_t* pmix; bf16_t* gp; bf16_t* mg; float* rsq;
    __device__ __forceinline__ void operator()(const AccT& acc, const pg8::Unit& u, int wr, int wc, int fr, int fq) const {
        const int row0 = u.pm * 256 + wr * 64 + fr, pn = u.pn;
        if (pn < 20) {
#pragma unroll
            for (int ai = 0; ai < 2; ++ai)
#pragma unroll
                for (int m = 0; m < 4; ++m) {
                    __builtin_amdgcn_sched_barrier(0); const int row = row0 + ai * 128 + m * 16; float ss = 0.f;
#pragma unroll
                    for (int bj = 0; bj < 2; ++bj) {
                        const int col0 = pn * 256 + bj * 128 + wc * 32 + 8 * fq;
                        f32x4 v0 = acc[ai][bj][m][0], v1 = acc[ai][bj][m][1]; EPI_FENCE(v0, v1);
                        ss += (v0[0] * v0[0] + v0[1] * v0[1]) + (v0[2] * v0[2] + v0[3] * v0[3]) + (v1[0] * v1[0] + v1[1] * v1[1]) + (v1[2] * v1[2] + v1[3] * v1[3]);
                        const float sc = (col0 >= O_NAQ && col0 < O_NAK) ? C_NA : 1.f;
                        *(u32x4*)(pmix + (size_t)row * NMIXP + col0) = pack8(v0 * sc, v1 * sc);
                    }
                    if (pn < 3) { ss += shx(ss, fr + 16 * fq, 16); ss += shx(ss, fr + 16 * fq, 32); if (fq == 0) rsq[(size_t)row * 12 + pn * 4 + wc] = ss; }
                }
        } else if (pn < 32) {
#pragma unroll
            for (int ai = 0; ai < 2; ++ai)
#pragma unroll
                for (int m = 0; m < 4; ++m) {
                    __builtin_amdgcn_sched_barrier(0); const int row = row0 + ai * 128 + m * 16;
#pragma unroll
                    for (int bj = 0; bj < 2; ++bj) {
                        const int col0 = (pn - 20) * 256 + bj * 128 + wc * 32 + 8 * fq;
                        f32x4 v0 = acc[ai][bj][m][0], v1 = acc[ai][bj][m][1]; EPI_FENCE(v0, v1);
#pragma unroll
                        for (int e = 0; e < 4; ++e) { v0[e] = v0[e] * sigmoidf_(v0[e]); v1[e] = v1[e] * sigmoidf_(v1[e]); }
                        *(u32x4*)(gp + (size_t)row * NGP + col0) = pack8(v0, v1);
                    }
                }
        } else {
#pragma unroll
            for (int ai = 0; ai < 2; ++ai)
#pragma unroll
                for (int m = 0; m < 4; ++m) {
                    __builtin_amdgcn_sched_barrier(0); const int row = row0 + ai * 128 + m * 16;
#pragma unroll
                    for (int bj = 0; bj < 2; ++bj) {
                        const int col0 = (pn - 32) * 256 + bj * 128 + wc * 32 + 8 * fq;
                        f32x4 v0 = acc[ai][bj][m][0], v1 = acc[ai][bj][m][1]; EPI_FENCE(v0, v1);
#pragma unroll
                        for (int e = 0; e < 4; ++e) { v0[e] = sigmoidf_(v0[e]); v1[e] = sigmoidf_(v1[e]); }
                        *(u32x4*)(mg + (size_t)row * NMG + col0) = pack8(v0, v1);
                    }
                }
        }
    }
};
struct EpiQ {
    bf16_t* q; const float* rsq; const float* cs;
    __device__ __forceinline__ void operator()(const AccT& acc, const pg8::Unit& u, int wr, int wc, int fr, int fq) const {
        const int row0 = u.pm * 256 + wr * 64 + fr, pn = u.pn; const bool lat = u.pm < 64;
#pragma unroll
        for (int ai = 0; ai < 2; ++ai)
#pragma unroll
            for (int m = 0; m < 4; ++m) {
                __builtin_amdgcn_sched_barrier(0); const int row = row0 + ai * 128 + m * 16;
                const f32x4 r0 = *(const f32x4*)(rsq + (size_t)row * 12), r1 = *(const f32x4*)(rsq + (size_t)row * 12 + 4);
                const float ssum = ((r0[0] + r0[1]) + (r0[2] + r0[3])) + ((r1[0] + r1[1]) + (r1[2] + r1[3]));
                const float rinv = rsqrtf(ssum * (1.f / 512.f) + EPS) * C_MLA;
                const int s = row & 4095;
#pragma unroll
                for (int bj = 0; bj < 2; ++bj) {
                    const int g32 = pn * 8 + bj * 4 + wc, t6 = g32 % 6, col0 = g32 * 32 + 8 * fq;
                    f32x4 v0 = acc[ai][bj][m][0], v1 = acc[ai][bj][m][1]; EPI_FENCE(v0, v1); v0 = v0 * rinv; v1 = v1 * rinv;
                    if (t6 >= 4 && lat) {
                        const int pos = (t6 == 4) ? (s >> 6) : (s & 63);
                        const float* cp = cs + (pos * 16 + 8 * (fq & 1)) * 2;
                        const f32x4 c0 = *(const f32x4*)(cp), c1 = *(const f32x4*)(cp + 4), c2 = *(const f32x4*)(cp + 8), c3 = *(const f32x4*)(cp + 12);
                        const float cosv[8] = {c0[0], c0[2], c1[0], c1[2], c2[0], c2[2], c3[0], c3[2]};
                        const float sinv[8] = {c0[1], c0[3], c1[1], c1[3], c2[1], c2[3], c3[1], c3[3]};
                        float x[8] = {v0[0], v0[1], v0[2], v0[3], v1[0], v1[1], v1[2], v1[3]};
#pragma unroll
                        for (int e = 0; e < 8; ++e) { const float p = shx(x[e], fr + 16 * fq, 32); x[e] = (fq < 2) ? (x[e] * cosv[e] - p * sinv[e]) : (p * sinv[e] + x[e] * cosv[e]); }
                        v0 = (f32x4){x[0], x[1], x[2], x[3]}; v1 = (f32x4){x[4], x[5], x[6], x[7]};
                    }
                    *(u32x4*)(q + (size_t)row * 1536 + col0) = pack8(v0, v1);
                }
            }
    }
};
struct EpiKV {
    bf16_t* kv; const float* rsq;
    __device__ __forceinline__ void operator()(const AccT& acc, const pg8::Unit& u, int wr, int wc, int fr, int fq) const {
        const int row0 = u.pm * 256 + wr * 64 + fr, pn = u.pn;
#pragma unroll
        for (int ai = 0; ai < 2; ++ai)
#pragma unroll
            for (int m = 0; m < 4; ++m) {
                __builtin_amdgcn_sched_barrier(0); const int row = row0 + ai * 128 + m * 16;
                const f32x4 r0 = *(const f32x4*)(rsq + (size_t)row * 12 + 8);
                const float rinv = rsqrtf(((r0[0] + r0[1]) + (r0[2] + r0[3])) * (1.f / 256.f) + EPS);
#pragma unroll
                for (int bj = 0; bj < 2; ++bj) {
                    const int col0 = pn * 256 + bj * 128 + wc * 32 + 8 * fq;
                    f32x4 v0 = acc[ai][bj][m][0], v1 = acc[ai][bj][m][1]; EPI_FENCE(v0, v1);
                    *(u32x4*)(kv + (size_t)row * 2048 + col0) = pack8(v0 * rinv, v1 * rinv);
                }
            }
    }
};
struct EpiMerge {
    const bf16_t* mg; float* tmp; bf16_t* merged;
    __device__ __forceinline__ void operator()(const AccT& acc, const pg8::Unit& u, int wr, int wc, int fr, int fq) const {
        const int row0 = u.pm * 256 + wr * 64 + fr, pn = u.pn, z = u.z;
#pragma unroll
        for (int ai = 0; ai < 2; ++ai)
#pragma unroll
            for (int m = 0; m < 4; ++m) {
                __builtin_amdgcn_sched_barrier(0); const int row = row0 + ai * 128 + m * 16;
#pragma unroll
                for (int bj = 0; bj < 2; ++bj) {
                    const int col0 = pn * 256 + bj * 128 + wc * 32 + 8 * fq;
                    const u32x4 gw = *(const u32x4*)(mg + (size_t)row * NMG + z * 2048 + col0);
                    f32x4 v0 = acc[ai][bj][m][0], v1 = acc[ai][bj][m][1]; EPI_FENCE(v0, v1);
                    v0[0] *= bflo(gw.x); v0[1] *= bfhi(gw.x); v0[2] *= bflo(gw.y); v0[3] *= bfhi(gw.y);
                    v1[0] *= bflo(gw.z); v1[1] *= bfhi(gw.z); v1[2] *= bflo(gw.w); v1[3] *= bfhi(gw.w);
                    float* tp = tmp + (size_t)row * 2048 + col0;
                    if (z > 0) { v0 += *(const f32x4*)tp; v1 += *(const f32x4*)(tp + 4); }
                    if (z < 2) { *(f32x4*)tp = v0; *(f32x4*)(tp + 4) = v1; }
                    else *(u32x4*)(merged + (size_t)row * 2048 + col0) = pack8(v0, v1);
                }
            }
    }
};
struct EpiOut {
    const float* xin; const float* ctxin; float* xcur; const float* mod; int layer;
    __device__ __forceinline__ void operator()(const AccT& acc, const pg8::Unit& u, int wr, int wc, int fr, int fq) const {
        const int row0 = u.pm * 256 + wr * 64 + fr, pn = u.pn; const bool lat = u.pm < 64;
        const float* gt = mod + (size_t)(lat ? (u.pm >> 4) : 4) * 6144 + 4096;
#pragma unroll
        for (int ai = 0; ai < 2; ++ai)
#pragma unroll
            for (int m = 0; m < 4; ++m) {
                __builtin_amdgcn_sched_barrier(0); const int row = row0 + ai * 128 + m * 16;
                const float* xo = (layer == 0) ? (lat ? xin + (size_t)row * 2048 : ctxin + (size_t)(row - NLAT) * 2048) : xcur + (size_t)row * 2048;
#pragma unroll
                for (int bj = 0; bj < 2; ++bj) {
                    const int col0 = pn * 256 + bj * 128 + wc * 32 + 8 * fq;
                    f32x4 v0 = acc[ai][bj][m][0], v1 = acc[ai][bj][m][1]; EPI_FENCE(v0, v1);
                    const f32x4 g0 = *(const f32x4*)(gt + col0), g1 = *(const f32x4*)(gt + col0 + 4);
                    const f32x4 x0 = *(const f32x4*)(xo + col0), x1 = *(const f32x4*)(xo + col0 + 4);
                    *(f32x4*)(xcur + (size_t)row * 2048 + col0) = x0 + g0 * v0;
                    *(f32x4*)(xcur + (size_t)row * 2048 + col0 + 4) = x1 + g1 * v1;
                }
            }
    }
};

namespace mla {
typedef short s16x4 __attribute__((ext_vector_type(4)));
constexpr int SHM_V = 16384, SHM_K = 16384, SHM_KR = 8192;
constexpr int OFF_V = 0, OFF_K = 2 * SHM_V, OFF_KR = OFF_K + 2 * SHM_K, OFF_WS = OFF_KR + 2 * SHM_KR;
constexpr float THR2 = 8.f;
#define KSWZ(row, colB) ((row) * 256 + ((colB) ^ (((row) & 7) << 4)))
#define KRSWZ(row, colB) ((row) * 128 + ((colB) ^ (((row) & 7) << 4)))
#define SBAR() __builtin_amdgcn_sched_barrier(0)
__device__ __forceinline__ void partialSM(f32x16& p0, f32x16& p1, float& m_reg, float& mn, float& alpha) {
    float pmax = p0[0];
#pragma unroll
    for (int r = 1; r < 16; ++r) pmax = fmaxf(pmax, p0[r]);
#pragma unroll
    for (int r = 0; r < 16; ++r) pmax = fmaxf(pmax, p1[r]);
    { auto rr = __builtin_amdgcn_permlane32_swap(__float_as_uint(pmax), __float_as_uint(pmax), false, false);
      pmax = fmaxf(__uint_as_float(rr[0]), __uint_as_float(rr[1])); }
    if (__builtin_expect(__all(pmax - m_reg <= THR2), 1)) { mn = m_reg; alpha = 1.f; }
    else { mn = fmaxf(m_reg, pmax); alpha = __builtin_amdgcn_exp2f(m_reg - mn); m_reg = mn; }
#pragma unroll
    for (int r = 0; r < 16; ++r) p0[r] = p0[r] - mn;
#pragma unroll
    for (int r = 0; r < 16; ++r) p1[r] = p1[r] - mn;
#pragma unroll
    for (int r = 0; r < 16; ++r) p0[r] = __builtin_amdgcn_exp2f(p0[r]);
}
__device__ __forceinline__ void finishSM(f32x16& p0, f32x16& p1, float alpha, float& l_reg, bf16x8& pa0, bf16x8& pa1, bf16x8& pa2, bf16x8& pa3) {
#pragma unroll
    for (int r = 0; r < 16; ++r) p1[r] = __builtin_amdgcn_exp2f(p1[r]);
    float ps = 0;
#pragma unroll
    for (int r = 0; r < 16; ++r) ps += p0[r];
#pragma unroll
    for (int r = 0; r < 16; ++r) ps += p1[r];
    { auto rr = __builtin_amdgcn_permlane32_swap(__float_as_uint(ps), __float_as_uint(ps), false, false);
      ps = __uint_as_float(rr[0]) + __uint_as_float(rr[1]); }
    l_reg = l_reg * alpha + ps;
#define PK4(P, BASE, OUT) do { unsigned a0 = cvt_pk(P[BASE + 0], P[BASE + 1]), a1 = cvt_pk(P[BASE + 2], P[BASE + 3]);   \
    unsigned b0 = cvt_pk(P[BASE + 4], P[BASE + 5]), b1 = cvt_pk(P[BASE + 6], P[BASE + 7]);                              \
    auto r0 = __builtin_amdgcn_permlane32_swap(a0, b0, false, false); auto r1 = __builtin_amdgcn_permlane32_swap(a1, b1, false, false); \
    u32x4 w = {r0[0], r1[0], r0[1], r1[1]}; OUT = *reinterpret_cast<bf16x8*>(&w); } while (0)
    PK4(p0, 0, pa0); PK4(p0, 8, pa1); PK4(p1, 0, pa2); PK4(p1, 8, pa3);
#undef PK4
}
__device__ __forceinline__ void qkt(f32x16& p0, f32x16& p1, const char* Ks, const char* KRs, const bf16x8* qr, int r32, int hi) {
    p0 = f32x16{}; p1 = f32x16{};
#pragma unroll
    for (int d0 = 0; d0 < 8; ++d0) { const int cb = (d0 * 16 + hi * 8) * 2;
        bf16x8 b0 = *reinterpret_cast<const bf16x8*>(Ks + KSWZ(r32, cb));
        bf16x8 b1 = *reinterpret_cast<const bf16x8*>(Ks + KSWZ(32 + r32, cb));
        p0 = __builtin_amdgcn_mfma_f32_32x32x16_bf16(b0, qr[d0], p0, 0, 0, 0);
        p1 = __builtin_amdgcn_mfma_f32_32x32x16_bf16(b1, qr[d0], p1, 0, 0, 0); }
#pragma unroll
    for (int d0 = 0; d0 < 4; ++d0) { const int cb = (d0 * 16 + hi * 8) * 2;
        bf16x8 b0 = *reinterpret_cast<const bf16x8*>(KRs + KRSWZ(r32, cb));
        bf16x8 b1 = *reinterpret_cast<const bf16x8*>(KRs + KRSWZ(32 + r32, cb));
        p0 = __builtin_amdgcn_mfma_f32_32x32x16_bf16(b0, qr[8 + d0], p0, 0, 0, 0);
        p1 = __builtin_amdgcn_mfma_f32_32x32x16_bf16(b1, qr[8 + d0], p1, 0, 0, 0); }
}
__device__ __forceinline__ int v_st(int k, int c) { const int kk = (k & ~0xC) | ((k & 4) << 1) | ((k & 8) >> 1); return ((kk >> 3) * 4 + (c >> 5)) * 512 + ((kk & 7) * 32 + (c & 31)) * 2; }
__device__ __forceinline__ int v_rd_base(int lane) { return ((lane & 3) << 3) | (((lane >> 2) & 3) << 6) | (((lane >> 4) & 1) << 5) | (((lane >> 5) & 1) << 8); }
constexpr int v_rd_off(int d0, int ks, int half) { return d0 * 512 + ks * 4096 + half * 2048; }
template <int OFF> __device__ __forceinline__ s16x4 tr_read(int vb) {
    s16x4 r; asm volatile("ds_read_b64_tr_b16 %0, %1 offset:%2" : "=&v"(r) : "v"(vb), "i"(OFF) : "memory"); return r;
}
template <int D0> __device__ __forceinline__ void pv_one(f32x16& od, int vb, bf16x8 pa0, bf16x8 pa1, bf16x8 pa2, bf16x8 pa3) {
    const s16x4 l0 = tr_read<v_rd_off(D0, 0, 0)>(vb), h0 = tr_read<v_rd_off(D0, 0, 1)>(vb), l1 = tr_read<v_rd_off(D0, 1, 0)>(vb), h1 = tr_read<v_rd_off(D0, 1, 1)>(vb);
    const s16x4 l2 = tr_read<v_rd_off(D0, 2, 0)>(vb), h2 = tr_read<v_rd_off(D0, 2, 1)>(vb), l3 = tr_read<v_rd_off(D0, 3, 0)>(vb), h3 = tr_read<v_rd_off(D0, 3, 1)>(vb);
    asm volatile("s_waitcnt lgkmcnt(0)" ::: "memory"); SBAR();
#define PK(L, H) (bf16x8){L[0], L[1], L[2], L[3], H[0], H[1], H[2], H[3]}
    od = __builtin_amdgcn_mfma_f32_32x32x16_bf16(pa0, PK(l0, h0), od, 0, 0, 0);
    od = __builtin_amdgcn_mfma_f32_32x32x16_bf16(pa1, PK(l1, h1), od, 0, 0, 0);
    od = __builtin_amdgcn_mfma_f32_32x32x16_bf16(pa2, PK(l2, h2), od, 0, 0, 0);
    od = __builtin_amdgcn_mfma_f32_32x32x16_bf16(pa3, PK(l3, h3), od, 0, 0, 0);
#undef PK
}
__device__ __forceinline__ void pv_d0(f32x16* o, int vb, bf16x8 pa0, bf16x8 pa1, bf16x8 pa2, bf16x8 pa3) {
    pv_one<0>(o[0], vb, pa0, pa1, pa2, pa3); pv_one<1>(o[1], vb, pa0, pa1, pa2, pa3); pv_one<2>(o[2], vb, pa0, pa1, pa2, pa3); pv_one<3>(o[3], vb, pa0, pa1, pa2, pa3);
}
__device__ __forceinline__ void attn_unit(const bf16_t* __restrict__ Q, const bf16_t* __restrict__ KV, const bf16_t* __restrict__ KR, const bf16_t* __restrict__ GP, bf16_t* __restrict__ O,
                                          int qrow0, int h, int latbase, int ctxbase, int nlt, int NT, char* lds) {
    const int tid = opaque_v(threadIdx.x), wid = tid >> 6, lane = tid & 63, r32 = lane & 31, hi = lane >> 5;
    char* V_lds = lds + OFF_V; char* K_lds = lds + OFF_K; char* KR_lds = lds + OFF_KR;
    float* ws = (float*)(lds + OFF_WS) + wid * 64; float* li_l = ws; float* al_l = ws + 32;
    float m_reg = -1e30f, l_reg = 0; f32x16 o[4] = {}; bf16x8 qr[12];
    const bf16_t* Qw = Q + (size_t)(qrow0 + wid * 32 + r32) * 1536 + h * 192 + hi * 8;
#pragma unroll
    for (int d0 = 0; d0 < 12; ++d0) qr[d0] = *reinterpret_cast<const bf16x8*>(Qw + d0 * 16);
    const int sr = tid >> 4, sc = (tid & 15) * 8, vst0 = v_st(sr, sc), vst1 = v_st(32 + sr, sc);
    const int krr = tid >> 3, krc = (tid & 7) * 16;
    const int vb0 = (int)(uintptr_t)V_lds + v_rd_base(lane);
    const bf16_t* Kh = KV + h * 256 + sc; const bf16_t* Vh = KV + h * 256 + 128 + sc;
    bf16x8 s_v0, s_v1, s_k0, s_k1, s_kr;
#define TROW(j) ((j) < nlt ? latbase + 64 * (j) : ctxbase + 64 * ((j) - nlt))
#define SLOAD(j) do { const int _rb = TROW(j); \
    s_v0 = *reinterpret_cast<const bf16x8*>(Vh + (size_t)(_rb + sr) * 2048); s_v1 = *reinterpret_cast<const bf16x8*>(Vh + (size_t)(_rb + 32 + sr) * 2048); \
    s_k0 = *reinterpret_cast<const bf16x8*>(Kh + (size_t)(_rb + sr) * 2048); s_k1 = *reinterpret_cast<const bf16x8*>(Kh + (size_t)(_rb + 32 + sr) * 2048); \
    s_kr = *reinterpret_cast<const bf16x8*>((const char*)KR + (size_t)(_rb + krr) * 128 + krc); } while (0)
#define SWRITE(b) do { *(bf16x8*)(V_lds + (b) * SHM_V + vst0) = s_v0; *(bf16x8*)(V_lds + (b) * SHM_V + vst1) = s_v1; const int kc = sc * 2; \
    *(bf16x8*)(K_lds + (b) * SHM_K + KSWZ(sr, kc)) = s_k0; *(bf16x8*)(K_lds + (b) * SHM_K + KSWZ(32 + sr, kc)) = s_k1; \
    *(bf16x8*)(KR_lds + (b) * SHM_KR + KRSWZ(krr, krc)) = s_kr; } while (0)
#define RESC(a) do { if (__any((a) < 1.f)) { if (hi == 0) al_l[r32] = (a); asm volatile("s_waitcnt lgkmcnt(0)" ::: "memory"); \
    _Pragma("unroll") for (int d = 0; d < 4; ++d) _Pragma("unroll") for (int r = 0; r < 16; ++r) o[d][r] *= al_l[crow(r, hi)]; } } while (0)
    f32x16 pA0, pA1, pB0, pB1; float mnA, mnB, alA, alB; bf16x8 pa0, pa1, pa2, pa3;
    SLOAD(0); asm volatile("s_waitcnt vmcnt(0)" ::: "memory"); SWRITE(0); __syncthreads();
    qkt(pA0, pA1, K_lds, KR_lds, qr, r32, hi); partialSM(pA0, pA1, m_reg, mnA, alA);
    SLOAD(1);
    asm volatile("s_waitcnt vmcnt(0)" ::: "memory"); SWRITE(1); __syncthreads();
    for (int j = 1; j + 1 < NT; j += 2) {
        SBAR(); qkt(pB0, pB1, K_lds + SHM_K, KR_lds + SHM_KR, qr, r32, hi);
        finishSM(pA0, pA1, alA, l_reg, pa0, pa1, pa2, pa3); SBAR();
        SLOAD(j + 1); SBAR();
        pv_d0(o, vb0, pa0, pa1, pa2, pa3); partialSM(pB0, pB1, m_reg, mnB, alB);
        __syncthreads(); asm volatile("s_waitcnt vmcnt(0)" ::: "memory"); SWRITE(0);
        RESC(alB); __syncthreads();
        SBAR(); qkt(pA0, pA1, K_lds, KR_lds, qr, r32, hi);
        finishSM(pB0, pB1, alB, l_reg, pa0, pa1, pa2, pa3); SBAR();
        SLOAD(j + 2); SBAR();
        pv_d0(o, vb0 + SHM_V, pa0, pa1, pa2, pa3); partialSM(pA0, pA1, m_reg, mnA, alA);
        __syncthreads(); asm volatile("s_waitcnt vmcnt(0)" ::: "memory"); SWRITE(1);
        RESC(alA); __syncthreads();
    }
    SBAR(); qkt(pB0, pB1, K_lds + SHM_K, KR_lds + SHM_KR, qr, r32, hi);
    finishSM(pA0, pA1, alA, l_reg, pa0, pa1, pa2, pa3); SBAR();
    pv_d0(o, vb0, pa0, pa1, pa2, pa3); partialSM(pB0, pB1, m_reg, mnB, alB);
    __syncthreads(); RESC(alB);
    finishSM(pB0, pB1, alB, l_reg, pa0, pa1, pa2, pa3); SBAR();
    pv_d0(o, vb0 + SHM_V, pa0, pa1, pa2, pa3);
    if (hi == 0) li_l[r32] = l_reg; asm volatile("s_waitcnt lgkmcnt(0)" ::: "memory");
    const int orow0 = qrow0 + wid * 32;
#pragma unroll
    for (int r = 0; r < 16; ++r) { const int orow = orow0 + crow(r, hi); const float rl = __builtin_amdgcn_rcpf(li_l[crow(r, hi)]);
#pragma unroll
        for (int d0 = 0; d0 < 4; ++d0) { const size_t idx = (size_t)orow * 3072 + h * 128 + d0 * 32 + r32;
            const float v = o[d0][r] * rl * bf1(GP[idx]); O[idx] = (bf16_t)(cvt_pk(v, 0.f) & 0xffffu); } }
    __syncthreads();
#undef TROW
#undef SLOAD
#undef SWRITE
#undef RESC
}
}

__device__ __forceinline__ void na_item(const bf16_t* __restrict__ PMIX, const bf16_t* __restrict__ GP, bf16_t* __restrict__ O, const float* __restrict__ bias, int item, int lane, LAS unsigned char* wl) {
    const int q = lane & 31, hi = lane >> 5;
    const bool lat = item < 8192;
    int b, h, gi = 0, jh = 0, qrow;
    if (lat) { b = item >> 11; h = (item >> 7) & 15; gi = (item >> 1) & 63; jh = item & 1; qrow = b * 4096 + gi * 64 + jh * 32 + q; }
    else { const int it = item - 8192; b = it >> 7; h = (it >> 3) & 15; qrow = NLAT + b * 256 + (it & 7) * 32 + q; }
    const int j = jh * 32 + q;
    const int c0 = min(max(j - 8, 0), 48), r0 = min(max(gi - 4, 0), 56);
    const bf16_t* qp = PMIX + (size_t)qrow * NMIXP + O_NAQ + h * 64 + hi * 8;
    bf16x8 qf[4];
#pragma unroll
    for (int ks = 0; ks < 4; ++ks) qf[ks] = *reinterpret_cast<const bf16x8*>(qp + ks * 16);
    f32x16 oT0 = {}, oT1 = {}; float m = -1e30f, l = 0.f;
    const int ntiles = lat ? 24 : 8;
    const float* bh = bias + h * (15 * 31);
    bf16x8 kf[4]; u32x4 vv[4];
#define NA_TROW(t_) ((lat && (t_) < 16) ? (b * 4096 + (r0 + ((t_) >> 1)) * 64 + ((t_) & 1) * 32) : (NLAT + b * 256 + (lat ? (t_) - 16 : (t_)) * 32))
#define NA_LOAD(KF, VV, t_) do { const int kr0_ = NA_TROW(t_); const bf16_t* kp_ = PMIX + (size_t)(kr0_ + q) * NMIXP + O_NAK + h * 64 + hi * 8; \
        _Pragma("unroll") for (int ks = 0; ks < 4; ++ks) KF[ks] = *reinterpret_cast<const bf16x8*>(kp_ + ks * 16); \
        const bf16_t* vp_ = PMIX + (size_t)(kr0_ + (lane >> 1)) * NMIXP + O_NAV + h * 64 + (lane & 1) * 32; \
        _Pragma("unroll") for (int c = 0; c < 4; ++c) VV[c] = *reinterpret_cast<const u32x4*>(vp_ + c * 8); } while (0)
    NA_LOAD(kf, vv, 0);
    for (int t = 0; t < ntiles; ++t) {
        int kr = 0, kblk = 0; const bool local = lat && t < 16;
        if (local) { kr = t >> 1; kblk = t & 1; }
        bf16x8 kfn[4]; u32x4 vvn[4];
        { const int tn = (t + 1 < ntiles) ? t + 1 : t; NA_LOAD(kfn, vvn, tn); }
        f32x16 p = {};
#pragma unroll
        for (int ks = 0; ks < 4; ++ks) p = __builtin_amdgcn_mfma_f32_32x32x16_bf16(kf[ks], qf[ks], p, 0, 0, 0);
#pragma unroll
        for (int c = 0; c < 4; ++c) *(LAS u32x4*)(wl + (lane >> 1) * 144 + (lane & 1) * 64 + c * 16) = vv[c];
        if (local) {
            const float* brow = bh + (r0 + kr - gi + 7) * 31 + 15 - j;
#pragma unroll
            for (int r = 0; r < 16; ++r) { const int kc = kblk * 32 + crow(r, hi); const bool valid = (kc >= c0) && (kc < c0 + 16);
                const float bv = valid ? brow[kc] : 0.f; p[r] = valid ? fmaf(bv, LOG2E, p[r]) : -INFINITY; }
        }
        float tmax = p[0];
#pragma unroll
        for (int r = 1; r < 16; ++r) tmax = fmaxf(tmax, p[r]);
        tmax = fmaxf(tmax, shx(tmax, lane, 32));
        const float mn = fmaxf(m, tmax), alpha = __builtin_amdgcn_exp2f(m - mn); m = mn;
        float ps = 0.f;
#pragma unroll
        for (int r = 0; r < 16; ++r) { p[r] = __builtin_amdgcn_exp2f(p[r] - mn); ps += p[r]; }
        l = l * alpha + ps;
#pragma unroll
        for (int r = 0; r < 16; ++r) { oT0[r] *= alpha; oT1[r] *= alpha; }
        asm volatile("s_waitcnt lgkmcnt(0)" ::: "memory"); __builtin_amdgcn_wave_barrier();
#pragma unroll
        for (int ks = 0; ks < 2; ++ks) {
            u32x4 pw; pw.x = cvt_pk(p[8 * ks + 0], p[8 * ks + 1]); pw.y = cvt_pk(p[8 * ks + 2], p[8 * ks + 3]); pw.z = cvt_pk(p[8 * ks + 4], p[8 * ks + 5]); pw.w = cvt_pk(p[8 * ks + 6], p[8 * ks + 7]);
            const bf16x8 pf = *reinterpret_cast<bf16x8*>(&pw);
#pragma unroll
            for (int db = 0; db < 2; ++db) {
                bf16x8 vf;
#pragma unroll
                for (int jj = 0; jj < 8; ++jj) { const int key = 16 * ks + 8 * (jj >> 2) + 4 * hi + (jj & 3); vf[jj] = *(const LAS short*)(wl + key * 144 + (32 * db + q) * 2); }
                if (db == 0) oT0 = __builtin_amdgcn_mfma_f32_32x32x16_bf16(vf, pf, oT0, 0, 0, 0);
                else oT1 = __builtin_amdgcn_mfma_f32_32x32x16_bf16(vf, pf, oT1, 0, 0, 0);
            }
        }
        asm volatile("s_waitcnt lgkmcnt(0)" ::: "memory"); __builtin_amdgcn_wave_barrier();
#pragma unroll
        for (int i4 = 0; i4 < 4; ++i4) { kf[i4] = kfn[i4]; vv[i4] = vvn[i4]; }
    }
#undef NA_TROW
#undef NA_LOAD
    const float inv = __builtin_amdgcn_rcpf(l + shx(l, lane, 32));
    const size_t ob = (size_t)qrow * 3072 + 1024 + h * 64;
#pragma unroll
    for (int db = 0; db < 2; ++db)
#pragma unroll
        for (int g = 0; g < 4; ++g) {
            const int d = 32 * db + 8 * g + 4 * hi;
            const u32x2 gw = *reinterpret_cast<const u32x2*>(GP + ob + d);
            float v0, v1, v2, v3;
            if (db == 0) { v0 = oT0[4 * g]; v1 = oT0[4 * g + 1]; v2 = oT0[4 * g + 2]; v3 = oT0[4 * g + 3]; } else { v0 = oT1[4 * g]; v1 = oT1[4 * g + 1]; v2 = oT1[4 * g + 2]; v3 = oT1[4 * g + 3]; }
            u32x2 w; w.x = cvt_pk(v0 * inv * bflo(gw.x), v1 * inv * bfhi(gw.x)); w.y = cvt_pk(v2 * inv * bflo(gw.y), v3 * inv * bfhi(gw.y));
            *reinterpret_cast<u32x2*>(O + ob + d) = w;
        }
}

__device__ __forceinline__ void lru_gate_item(const bf16_t* __restrict__ PMIX, const bf16_t* __restrict__ WG, const float* __restrict__ convw, const float* __restrict__ convb,
                                              const float* __restrict__ bg, const float* __restrict__ lam, float* __restrict__ LA, float* __restrict__ LU, int item, LAS unsigned char* lds) {
    const int tid = opaque_v(threadIdx.x), lane = tid & 63, wid = tid >> 6;
    const int tt = item >> 4, blk = item & 15, row0 = tt * 64;
    const int seg0 = row0 < NLAT ? (row0 & ~4095) : (NLAT + ((row0 - NLAT) & ~255)), seg1 = seg0 + (row0 < NLAT ? 4096 : 256);
    LAS float* xcf = (LAS float*)lds;
    LAS unsigned char* xcb = lds + 64 * 68 * 4;
    {
        const int tl = tid >> 3, cg8 = (tid & 7) * 8, row = row0 + tl, ch = blk * 64 + cg8;
        float xc[8];
        { const f32x4 b0 = *(const f32x4*)(convb + ch), b1 = *(const f32x4*)(convb + ch + 4); xc[0] = b0[0]; xc[1] = b0[1]; xc[2] = b0[2]; xc[3] = b0[3]; xc[4] = b1[0]; xc[5] = b1[1]; xc[6] = b1[2]; xc[7] = b1[3]; }
#pragma unroll
        for (int tap = 0; tap < 4; ++tap) {
            const int rr = row + tap - 2;
            if (rr >= seg0 && rr < seg1) {
                const u32x4 pv = *(const u32x4*)(PMIX + (size_t)rr * NMIXP + O_PX + ch);
                const f32x4 w0 = *(const f32x4*)(convw + tap * 1024 + ch), w1 = *(const f32x4*)(convw + tap * 1024 + ch + 4);
                xc[0] += w0[0] * bflo(pv.x); xc[1] += w0[1] * bfhi(pv.x); xc[2] += w0[2] * bflo(pv.y); xc[3] += w0[3] * bfhi(pv.y);
                xc[4] += w1[0] * bflo(pv.z); xc[5] += w1[1] * bfhi(pv.z); xc[6] += w1[2] * bflo(pv.w); xc[7] += w1[3] * bfhi(pv.w);
            }
        }
        *(LAS f32x4*)(xcf + tl * 68 + cg8) = (f32x4){xc[0], xc[1], xc[2], xc[3]}; *(LAS f32x4*)(xcf + tl * 68 + cg8 + 4) = (f32x4){xc[4], xc[5], xc[6], xc[7]};
        u32x4 w; w.x = cvt_pk(xc[0], xc[1]); w.y = cvt_pk(xc[2], xc[3]); w.z = cvt_pk(xc[4], xc[5]); w.w = cvt_pk(xc[6], xc[7]);
        *(LAS u32x4*)(xcb + tl * 144 + cg8 * 2) = w;
    }
    __syncthreads();
    {
        const int dir = wid >> 2, th = (wid >> 1) & 1, chh = wid & 1, q = lane & 31, hi = lane >> 5;
        const int cl = 32 * chh + q, ch = blk * 64 + cl;
        const bf16_t* wt = WG + (size_t)(dir * 16 + blk) * 128 * 64;
        f32x16 accR = {}, accI = {};
#pragma unroll
        for (int ks = 0; ks < 4; ++ks) {
            const bf16x8 af = *(const LAS bf16x8*)(xcb + (32 * th + q) * 144 + (16 * ks + 8 * hi) * 2);
            const bf16x8 br = *reinterpret_cast<const bf16x8*>(wt + (size_t)cl * 64 + 16 * ks + 8 * hi);
            const bf16x8 bi = *reinterpret_cast<const bf16x8*>(wt + (size_t)(64 + cl) * 64 + 16 * ks + 8 * hi);
            accR = __builtin_amdgcn_mfma_f32_32x32x16_bf16(af, br, accR, 0, 0, 0);
            accI = __builtin_amdgcn_mfma_f32_32x32x16_bf16(af, bi, accI, 0, 0, 0);
        }
        const float brv = bg[dir * 2048 + blk * 128 + cl], biv = bg[dir * 2048 + blk * 128 + 64 + cl];
        float sp; { const float xs = __expf(-lam[dir * 1024 + ch]);
            sp = xs < 0.05f ? xs * (1.f - xs * (0.5f - xs * ((1.f / 3.f) - xs * (0.25f - xs * 0.2f)))) : __logf(1.f + xs); }
#pragma unroll
        for (int r = 0; r < 16; ++r) {
            const int tl = 32 * th + crow(r, hi);
            const float rg = sigmoidf_(accR[r] + brv), ig = sigmoidf_(accI[r] + biv);
            const float log_a = -8.f * rg * sp, a = __expf(log_a), ym = -2.f * log_a;
            const float om = ym < 0.1f ? ym * (1.f - ym * (0.5f - ym * ((1.f / 6.f) - ym * ((1.f / 24.f) - ym * (1.f / 120.f))))) : 1.f - __expf(-ym);
            const float u = __builtin_sqrtf(fmaxf(om, 0.f)) * (ig * xcf[tl * 68 + cl]);
            const size_t idx = ((size_t)dir * MROWS + row0 + tl) * 1024 + ch;
            LA[idx] = a; LU[idx] = u;
        }
    }
    __syncthreads();
}
__device__ __forceinline__ int chunk_row0(int b, int c) { return c < 4 ? NLAT + b * 256 + c * 64 : b * 4096 + (c - 4) * 64; }
__device__ __forceinline__ void lru_pass1_item(const float* __restrict__ LA, const float* __restrict__ LU, float* __restrict__ AGG, int item) {
    const int g = item * 512 + opaque_v(threadIdx.x), ch = (g & 255) * 4, dir = (g >> 8) & 1, bc = g >> 9, c = bc % NCHUNK, b = bc / NCHUNK;
    const int row0 = chunk_row0(b, c);
    const float* ap = LA + ((size_t)dir * MROWS + row0) * 1024 + ch; const float* up = LU + ((size_t)dir * MROWS + row0) * 1024 + ch;
    f32x4 A = {1.f, 1.f, 1.f, 1.f}, H = {0.f, 0.f, 0.f, 0.f};
#pragma unroll 8
    for (int t = 0; t < 64; ++t) { const int tt = dir ? 63 - t : t; const f32x4 a = *(const f32x4*)(ap + (size_t)tt * 1024), u = *(const f32x4*)(up + (size_t)tt * 1024); A *= a; H = a * H + u; }
    float* o = AGG + (((size_t)(dir * NB + b) * NCHUNK + c) * 1024 + ch) * 2;
    *(f32x4*)o = (f32x4){A[0], H[0], A[1], H[1]}; *(f32x4*)(o + 4) = (f32x4){A[2], H[2], A[3], H[3]};
}
__device__ __forceinline__ void lru_pass3_item(const float* __restrict__ LA, const float* __restrict__ LU, const float* __restrict__ AGG, const bf16_t* __restrict__ GP, bf16_t* __restrict__ O, int item, LAS unsigned char* lds) {
    const int tid = opaque_v(threadIdx.x);
    const int cg = item & 7, bc = item >> 3, c = bc % NCHUNK, b = bc / NCHUNK, row0 = chunk_row0(b, c), ch0 = cg * 128;
    LAS float* S = (LAS float*)lds;
#pragma unroll 4
    for (int p = 0; p < 16; ++p) { const int e = p * 512 + tid, arr = e >> 11, rem = e & 2047, tok = rem >> 5, c4 = rem & 31;
        const float* src = ((arr & 1) ? LU : LA) + ((size_t)(arr >> 1) * MROWS + row0 + tok) * 1024 + ch0 + c4 * 4;
        *(LAS f32x4*)(S + (arr * 64 + tok) * 128 + c4 * 4) = *(const f32x4*)src; }
    __syncthreads();
    if (tid < 256) {
        const int dir = tid >> 7, ch = tid & 127;
        float h = 0.f;
        const float* ag = AGG + ((size_t)(dir * NB + b) * NCHUNK * 1024 + ch0 + ch) * 2;
#define AGG_STEP(cc) do { const f32x2_t q_ = *(const f32x2_t*)(ag + (size_t)(cc) * 2048); h = q_[0] * h + q_[1]; } while (0)
        if (dir == 0) {
#pragma unroll 4
            for (int cc = 0; cc < c; ++cc) AGG_STEP(cc);
        } else if (c < 4) { for (int cc = 3; cc > c; --cc) AGG_STEP(cc); }
        else { for (int cc = 3; cc >= 0; --cc) AGG_STEP(cc);
#pragma unroll 4
               for (int cc = NCHUNK - 1; cc > c; --cc) AGG_STEP(cc); }
#undef AGG_STEP
        LAS float* sa = S + (dir * 2) * 64 * 128 + ch; LAS float* su = sa + 64 * 128;
#pragma unroll 8
        for (int t = 0; t < 64; ++t) { const int tt = dir ? 63 - t : t; h = sa[tt * 128] * h + su[tt * 128]; su[tt * 128] = h; }
    }
    __syncthreads();
#pragma unroll
    for (int p = 0; p < 4; ++p) { const int e = p * 512 + tid, tok = e >> 5, c4 = e & 31;
        const f32x4 hf = *(const LAS f32x4*)(S + (1 * 64 + tok) * 128 + c4 * 4), hb = *(const LAS f32x4*)(S + (3 * 64 + tok) * 128 + c4 * 4);
        const size_t oi = (size_t)(row0 + tok) * 3072 + 2048 + ch0 + c4 * 4; const u32x2 gw = *(const u32x2*)(GP + oi);
        u32x2 w; w.x = cvt_pk((hf[0] + hb[0]) * bflo(gw.x), (hf[1] + hb[1]) * bfhi(gw.x)); w.y = cvt_pk((hf[2] + hb[2]) * bflo(gw.y), (hf[3] + hb[3]) * bfhi(gw.y));
        *(u32x2*)(O + oi) = w; }
    __syncthreads();
}

__device__ __forceinline__ void transpose_item(const float* __restrict__ W, int ld_src, int k0, int n0src, const float* __restrict__ kscale, bf16_t* __restrict__ WT, int ldt, int n0dst, LAS float* scr, int lane) {
#pragma unroll 8
    for (int i = 0; i < 32; ++i) { const int kk = 2 * i + (lane >> 5); float v = W[(size_t)(k0 + kk) * ld_src + n0src + (lane & 31)]; if (kscale) v *= kscale[k0 + kk]; scr[kk * 33 + (lane & 31)] = v; }
    asm volatile("s_waitcnt lgkmcnt(0)" ::: "memory"); __builtin_amdgcn_wave_barrier();
    const int c = lane & 7;
#pragma unroll
    for (int jn = 0; jn < 4; ++jn) { const int n = (lane >> 3) + 8 * jn; const LAS float* s = scr + (8 * c) * 33 + n;
        u32x4 o; o.x = cvt_pk(s[0 * 33], s[1 * 33]); o.y = cvt_pk(s[2 * 33], s[3 * 33]); o.z = cvt_pk(s[4 * 33], s[5 * 33]); o.w = cvt_pk(s[6 * 33], s[7 * 33]);
        *(u32x4*)(WT + (size_t)(n0dst + n) * ldt + k0 + 8 * c) = o; }
    asm volatile("s_waitcnt lgkmcnt(0)" ::: "memory"); __builtin_amdgcn_wave_barrier();
}

#define GRID_SYNC() do { asm volatile("s_waitcnt vmcnt(0) lgkmcnt(0)" ::: "memory"); grid.sync(); \
    if (threadIdx.x < 64) asm volatile("buffer_inv sc1\n\ts_waitcnt vmcnt(0)" ::: "memory"); __syncthreads(); } while (0)
__device__ __forceinline__ unsigned char* opaque_p(unsigned char* p) { asm volatile("" : "+s"(p)); return p; }
__device__ __forceinline__ int opaque_s(int x) { asm volatile("" : "+s"(x)); return x; }
#define x_in (args.in[0])
#define c_in (args.in[1])
#define ctx_in (args.in[2])
#define cctx_in (args.in[3])
#define ada_w (args.in[4])
#define ada_b (args.in[5])
#define norm_g (args.in[6])
#define w_in (args.in[7])
#define qng (args.in[8])
#define kvng (args.in[9])
#define w_uq (args.in[10])
#define w_ukv (args.in[11])
#define rel_bias (args.in[12])
#define conv_w (args.in[13])
#define conv_b (args.in[14])
#define w_gate (args.in[15])
#define b_gate (args.in[16])
#define lam_in (args.in[17])
#define w_branch (args.in[18])
#define w_out (args.in[19])
#define fng (args.in[20])
#define WIN ((bf16_t*)(ws + WS_WIN))
#define WUQ ((bf16_t*)(ws + WS_WUQ))
#define WUKV ((bf16_t*)(ws + WS_WUKV))
#define WBR ((bf16_t*)(ws + WS_WBR))
#define WOUT ((bf16_t*)(ws + WS_WOUT))
#define WG ((bf16_t*)(ws + WS_WG))
#define MOD ((float*)(ws + WS_MOD))
#define ROPE ((float*)(ws + WS_ROPE))
#define XCUR ((float*)(ws + WS_XCUR))
#define HB ((bf16_t*)(ws + WS_H))
#define PMIX ((bf16_t*)(ws + WS_PMIX))
#define GP ((bf16_t*)(ws + WS_GP))
#define MG ((bf16_t*)(ws + WS_MG))
#define RSQ ((float*)(ws + WS_RSQ))
#define QB ((bf16_t*)(ws + WS_Q))
#define KVB ((bf16_t*)(ws + WS_KV))
#define KRB ((bf16_t*)(ws + WS_KR))
#define LA ((float*)(ws + WS_LA))
#define LU ((float*)(ws + WS_LU))
#define AGG ((float*)(ws + WS_AGG))
#define OB ((bf16_t*)(ws + WS_O))
#define MTMP LA
__global__ void __launch_bounds__(512, 2) mk_fwd(Args args) {
    extern __shared__ __attribute__((aligned(16))) unsigned char lds_raw[];
    cg::grid_group grid = cg::this_grid();
    LAS unsigned char* lds = (LAS unsigned char*)lds_raw;
#define PHASE_IDS const int tid = opaque_v(threadIdx.x), lane = tid & 63, wid = __builtin_amdgcn_readfirstlane(tid >> 6), G = opaque_s(gridDim.x), bid = opaque_s(blockIdx.x), NGW = G * 8, gw = bid * 8 + wid; unsigned char* ws = args.ws + (size_t)(unsigned)opaque_s(0); (void)lane; (void)gw; (void)NGW; (void)ws; (void)tid;

    {
        PHASE_IDS
        LAS float* scr = (LAS float*)(lds + wid * 8448);
        constexpr int I_IN = 32 * 442, I_UQ = 8 * 48, I_UKV = 4 * 64, I_BR = 3 * 16 * 64, I_OUT = 32 * 64, I_G = 32 * 4, I_L = I_IN + I_UQ + I_UKV + I_BR + I_OUT + I_G;
        for (int it = gw; it < DEPTH * I_L; it += NGW) {
            const int L = it / I_L; int r = it - L * I_L;
            if (r < I_IN) { const int kb = r / 442, nb = r % 442, n0 = nb * 32;
                transpose_item(w_in + (size_t)L * DM * NIN, NIN, kb * 64, n0, nullptr, WIN + (size_t)L * NINP * DM, DM, n0 < NMIX ? n0 : n0 + (NMIXP - NMIX), scr, lane); continue; } r -= I_IN;
            if (r < I_UQ) { const int kb = r / 48, nb = r % 48;
                transpose_item(w_uq + (size_t)L * 512 * 1536, 1536, kb * 64, nb * 32, qng + L * 512, WUQ + (size_t)L * 1536 * 512, 512, nb * 32, scr, lane); continue; } r -= I_UQ;
            if (r < I_UKV) { const int kb = r / 64, nb = r % 64;
                transpose_item(w_ukv + (size_t)L * 256 * 2048, 2048, kb * 64, nb * 32, kvng + L * 256, WUKV + (size_t)L * 2048 * 256, 256, nb * 32, scr, lane); continue; } r -= I_UKV;
            if (r < I_BR) { const int n3 = r / 1024, rr = r % 1024, kb = rr / 64, nb = rr % 64;
                transpose_item(w_branch + ((size_t)L * 3 + n3) * 1024 * 2048, 2048, kb * 64, nb * 32, nullptr, WBR + ((size_t)L * 3 + n3) * 2048 * 1024, 1024, nb * 32, scr, lane); continue; } r -= I_BR;
            if (r < I_OUT) { const int kb = r / 64, nb = r % 64;
                transpose_item(w_out + (size_t)L * DM * DM, DM, kb * 64, nb * 32, nullptr, WOUT + (size_t)L * DM * DM, DM, nb * 32, scr, lane); continue; } r -= I_OUT;
            { const int db = r / 4, nb = r % 4;
              transpose_item(w_gate + ((size_t)L * 32 + db) * 64 * 128, 128, 0, nb * 32, nullptr, WG + ((size_t)L * 32 + db) * 128 * 64, 64, nb * 32, scr, lane); }
        }
        for (int i = bid * 512 + tid; i < DEPTH * (NMIXP - NMIX) * (DM / 8); i += G * 512) {
            const int L = i / ((NMIXP - NMIX) * (DM / 8)), r = i % ((NMIXP - NMIX) * (DM / 8));
            *(u32x4*)(WIN + ((size_t)L * NINP + NMIX) * DM + (size_t)r * 8) = (u32x4){0u, 0u, 0u, 0u};
        }
        __syncthreads();
        LAS float* sil = (LAS float*)(lds + 69632);
        LAS float* red = (LAS float*)(lds + 69632 + 40960);
        for (int i = tid; i < 5 * 2048; i += 512) { const float v = i < 4 * 2048 ? c_in[i] : cctx_in[i - 4 * 2048]; sil[i] = v * (1.f / (1.f + expf(-v))); }
        __syncthreads();
        for (int it = bid; it < DEPTH * 96; it += G) {
            const int L = it / 96, cb = it % 96, ksl = tid >> 6, col = cb * 64 + (tid & 63);
            float a5[5] = {0.f, 0.f, 0.f, 0.f, 0.f};
            const float* wp = ada_w + (size_t)L * DM * 6144 + col;
            for (int k = ksl * 256; k < ksl * 256 + 256; ++k) { const float w = wp[(size_t)k * 6144];
#pragma unroll
                for (int r = 0; r < 5; ++r) a5[r] += sil[r * 2048 + k] * w; }
#pragma unroll
            for (int r = 0; r < 5; ++r) red[(ksl * 5 + r) * 64 + (tid & 63)] = a5[r];
            __syncthreads();
            if (tid < 320) { const int r = tid >> 6, cc = tid & 63; float s = 0.f;
#pragma unroll
                for (int k = 0; k < 8; ++k) s += red[(k * 5 + r) * 64 + cc];
                MOD[((size_t)L * 5 + r) * 6144 + cb * 64 + cc] = s + ada_b[(size_t)L * 6144 + cb * 64 + cc]; }
            __syncthreads();
        }
        if (bid == G - 1) for (int i = tid; i < 1024; i += 512) { const int pos = i >> 4, k = i & 15;
            const float inv = 1.0f / powf(10000.f, (float)k * (1.f / 16.f)), ang = (float)pos * inv; ROPE[2 * i] = cosf(ang); ROPE[2 * i + 1] = sinf(ang); }
    }
    GRID_SYNC();

    for (int layer = 0; layer < DEPTH; ++layer) {
        const bool need_ctx = layer < DEPTH - 1;
        { PHASE_IDS
        for (int row = gw; row < MROWS; row += NGW) {
            const bool lat = row < NLAT;
            const float* src = (layer == 0) ? (lat ? x_in + (size_t)row * DM : ctx_in + (size_t)(row - NLAT) * DM) : XCUR + (size_t)row * DM;
            const float* mr = MOD + (size_t)layer * 5 * 6144 + (size_t)(lat ? (row >> 12) : 4) * 6144;
            f32x4 v[8]; float ss = 0.f;
#pragma unroll
            for (int jv = 0; jv < 8; ++jv) { v[jv] = *(const f32x4*)(src + 4 * (lane + 64 * jv)); ss += (v[jv][0] * v[jv][0] + v[jv][1] * v[jv][1]) + (v[jv][2] * v[jv][2] + v[jv][3] * v[jv][3]); }
            const float rinv = rsqrtf(wave_sum(ss, lane) * (1.f / DM) + EPS);
#pragma unroll
            for (int jv = 0; jv < 8; ++jv) { const int col = 4 * (lane + 64 * jv);
                const f32x4 gg = *(const f32x4*)(norm_g + layer * DM + col), sh = *(const f32x4*)(mr + col), sc = *(const f32x4*)(mr + 2048 + col);
                const f32x4 hh = (v[jv] * rinv * gg) * (sc + 1.f) + sh;
                u32x2 w; w.x = cvt_pk(hh[0], hh[1]); w.y = cvt_pk(hh[2], hh[3]); *(u32x2*)(HB + (size_t)row * DM + col) = w; }
        } }
        GRID_SYNC();
        {
            PHASE_IDS
            pg8::Gemm g{HB, WIN + (size_t)layer * NINP * DM, DM, DM, DM, 0, 0}; pg8::Sched S; S.init(MROWS, NINP, G, bid, 1);
            EpiIn E{PMIX, GP, MG, RSQ};
            pg8::gemm_phase<EpiIn>(lds, g, S, E);
        }
        GRID_SYNC();
        {
            PHASE_IDS
            { pg8::Gemm g{PMIX, WUQ + (size_t)layer * 1536 * 512, NMIXP, 512, 512, 0, 0}; pg8::Sched S; S.init(MROWS, 1536, G, bid, 1);
              EpiQ E{QB, RSQ, ROPE}; pg8::gemm_phase<EpiQ>(lds, g, S, E); }
            { pg8::Gemm g{PMIX + 512, WUKV + (size_t)layer * 2048 * 256, NMIXP, 256, 256, 0, 0}; pg8::Sched S; S.init(MROWS, 2048, G, bid, 1);
              EpiKV E{KVB, RSQ}; pg8::gemm_phase<EpiKV>(lds, g, S, E); }
            for (int i = bid * 512 + tid; i < MROWS * 4; i += G * 512) {
                const int row = i >> 2, hf = (i >> 1) & 1, sub = i & 1;
                const bf16_t* src = PMIX + (size_t)row * NMIXP + O_KR + 32 * hf + 8 * sub;
                u32x4 a = *(const u32x4*)src, b2 = *(const u32x4*)(src + 16);
                if (row < NLAT) {
                    const int s = row & 4095, pos = hf ? (s & 63) : (s >> 6);
                    const float* cp = ROPE + (pos * 16 + 8 * sub) * 2;
                    float x1[8] = {bflo(a.x), bfhi(a.x), bflo(a.y), bfhi(a.y), bflo(a.z), bfhi(a.z), bflo(a.w), bfhi(a.w)};
                    float x2[8] = {bflo(b2.x), bfhi(b2.x), bflo(b2.y), bfhi(b2.y), bflo(b2.z), bfhi(b2.z), bflo(b2.w), bfhi(b2.w)};
                    float o1[8], o2[8];
#pragma unroll
                    for (int e = 0; e < 8; ++e) { const float cv = cp[2 * e], sv = cp[2 * e + 1]; o1[e] = x1[e] * cv - x2[e] * sv; o2[e] = x1[e] * sv + x2[e] * cv; }
                    a.x = cvt_pk(o1[0], o1[1]); a.y = cvt_pk(o1[2], o1[3]); a.z = cvt_pk(o1[4], o1[5]); a.w = cvt_pk(o1[6], o1[7]);
                    b2.x = cvt_pk(o2[0], o2[1]); b2.y = cvt_pk(o2[2], o2[3]); b2.z = cvt_pk(o2[4], o2[5]); b2.w = cvt_pk(o2[6], o2[7]);
                }
                bf16_t* dst = KRB + (size_t)row * 64 + 32 * hf + 8 * sub;
                *(u32x4*)dst = a; *(u32x4*)(dst + 16) = b2;
            }
            __syncthreads();
            for (int it = bid; it < (MROWS / 64) * 16; it += G)
                lru_gate_item(PMIX, WG + (size_t)layer * 32 * 128 * 64, conv_w + (size_t)layer * 4 * 1024, conv_b + (size_t)layer * 1024, b_gate + (size_t)layer * 2 * 2048, lam_in + (size_t)layer * 2 * 1024, LA, LU, it, lds);
        }
        GRID_SYNC();
        {
            PHASE_IDS
            const int nmla = 512 + (need_ctx ? 32 : 0);
            for (int u = bid; u < nmla; u += G) {
                if (u < 512) { const int b = u >> 7, h = (u >> 4) & 7, qb = u & 15;
                    mla::attn_unit(QB, KVB, KRB, GP, OB, b * 4096 + qb * 256, h, b * 4096, NLAT + b * 256, 64, 68, (char*)lds_raw); }
                else { const int b = (u - 512) >> 3, h = (u - 512) & 7;
                    mla::attn_unit(QB, KVB, KRB, GP, OB, NLAT + b * 256, h, 0, NLAT + b * 256, 0, 4, (char*)lds_raw); }
            }
            __syncthreads();
            const int nna = 8192 + (need_ctx ? 512 : 0);
            for (int it = gw; it < nna; it += NGW) na_item(PMIX, GP, OB, rel_bias + (size_t)layer * 16 * 15 * 31, it, lane, lds + wid * 4608);
            for (int it = bid; it < (NB * NCHUNK * 2 * 256) / 512; it += G) lru_pass1_item(LA, LU, AGG, it);
        }
        GRID_SYNC();
        { PHASE_IDS
        for (int it = bid; it < NB * NCHUNK * 8; it += G) lru_pass3_item(LA, LU, AGG, GP, OB, it, lds); }
        GRID_SYNC();
        {
            PHASE_IDS
            const int Mrows = need_ctx ? MROWS : NLAT;
            pg8::Gemm g{OB, WBR + (size_t)layer * 3 * 2048 * 1024, 3072, 1024, 1024, 1024, (size_t)2048 * 1024}; pg8::Sched S; S.init(Mrows, DM, G, bid, 3);
            EpiMerge E{MG, MTMP, HB}; pg8::gemm_phase<EpiMerge>(lds, g, S, E);
        }
        GRID_SYNC();
        {
            PHASE_IDS
            const int Mrows = need_ctx ? MROWS : NLAT;
            pg8::Gemm g{HB, WOUT + (size_t)layer * DM * DM, DM, DM, DM, 0, 0}; pg8::Sched S; S.init(Mrows, DM, G, bid, 1);
            EpiOut E{x_in, ctx_in, XCUR, MOD + (size_t)layer * 5 * 6144, layer}; pg8::gemm_phase<EpiOut>(lds, g, S, E);
        }
        GRID_SYNC();
    }
    { PHASE_IDS
    for (int row = gw; row < NLAT; row += NGW) {
        const float* src = XCUR + (size_t)row * DM;
        f32x4 v[8]; float ss = 0.f;
#pragma unroll
        for (int jv = 0; jv < 8; ++jv) { v[jv] = *(const f32x4*)(src + 4 * (lane + 64 * jv)); ss += (v[jv][0] * v[jv][0] + v[jv][1] * v[jv][1]) + (v[jv][2] * v[jv][2] + v[jv][3] * v[jv][3]); }
        const float rinv = rsqrtf(wave_sum(ss, lane) * (1.f / DM) + EPS);
#pragma unroll
        for (int jv = 0; jv < 8; ++jv) { const int col = 4 * (lane + 64 * jv); *(f32x4*)(args.out + (size_t)row * DM + col) = v[jv] * rinv * *(const f32x4*)(fng + col); }
    } }
}

extern "C" void kernel_launch(void* const* d_in, const int* in_sizes, int n_in, void* d_out, int out_size, void* d_ws, size_t ws_size, hipStream_t stream) {
    static int grid = 0;
    if (grid == 0) {
        if (n_in != 21 || ws_size < WS_END) { fprintf(stderr, "kernel_launch: n_in %d ws %zu (need %zu): nothing launched\n", n_in, ws_size, (size_t)WS_END); grid = -1; return; }
        int dev = 0, cus = 0, per_cu = 0;
        if (hipGetDevice(&dev) != hipSuccess || hipDeviceGetAttribute(&cus, hipDeviceAttributeMultiprocessorCount, dev) != hipSuccess) { grid = -1; return; }
        if (hipFuncSetAttribute((const void*)mk_fwd, hipFuncAttributeMaxDynamicSharedMemorySize, LDS_BYTES) != hipSuccess) { fprintf(stderr, "hipFuncSetAttribute failed\n"); grid = -1; return; }
        if (hipOccupancyMaxActiveBlocksPerMultiprocessor(&per_cu, (const void*)mk_fwd, 512, LDS_BYTES) != hipSuccess || per_cu < 1) { fprintf(stderr, "occupancy query: %d\n", per_cu); per_cu = 1; }
        (void)hipGetLastError();
        grid = cus * per_cu;
    }
    if (grid < 0) return;
    Args a{};
    for (int i = 0; i < 21; ++i) a.in[i] = (const float*)d_in[i];
    a.out = (float*)d_out; a.ws = (unsigned char*)d_ws;
    void* kargs[] = {&a};
    hipError_t e = hipLaunchCooperativeKernel((const void*)mk_fwd, dim3(grid), dim3(512), kargs, LDS_BYTES, stream);
    if (e != hipSuccess) fprintf(stderr, "cooperative launch failed: %s (grid %d)\n", hipGetErrorString(e), grid);
}
```

```cpp
#include <hip/hip_runtime.h>
#include <hip/hip_cooperative_groups.h>
#include <cstdio>
#include <cstdint>
namespace cg = cooperative_groups;

typedef unsigned short bf16_t;
typedef short bf16x8 __attribute__((ext_vector_type(8)));
typedef float f32x4 __attribute__((ext_vector_type(4)));
typedef float f32x16 __attribute__((ext_vector_type(16)));
typedef unsigned u32x4 __attribute__((ext_vector_type(4)));
typedef unsigned u32x2 __attribute__((ext_vector_type(2)));
#define LAS __attribute__((address_space(3)))

constexpr int DM = 2048, NB = 4, SEQ = 4096, NCTXT = 256, DEPTH = 4;
constexpr int NLAT = NB * SEQ, NCTX = NB * NCTXT, MROWS = NLAT + NCTX;
constexpr int NMIX = 4928, NMIXP = 5120, NGP = 3072, NMG = 6144, NINP = NMIXP + NGP + NMG, NIN = 14144;
constexpr int O_KR = 768, O_NAQ = 832, O_NAK = 1856, O_NAV = 2880, O_PX = 3904;
constexpr float EPS = 1e-6f, LOG2E = 1.4426950408889634f;
constexpr float C_MLA = 0.07216878364870322f * LOG2E;
constexpr float C_NA = 0.125f * LOG2E;
constexpr int NCHUNK = 68;

constexpr size_t al256(size_t x) { return (x + 255) / 256 * 256; }
constexpr size_t WS_WIN = 0;
constexpr size_t WS_WUQ = WS_WIN + al256((size_t)DEPTH * NINP * DM * 2);
constexpr size_t WS_WUKV = WS_WUQ + al256((size_t)DEPTH * 1536 * 512 * 2);
constexpr size_t WS_WBR = WS_WUKV + al256((size_t)DEPTH * 2048 * 256 * 2);
constexpr size_t WS_WOUT = WS_WBR + al256((size_t)DEPTH * 3 * 2048 * 1024 * 2);
constexpr size_t WS_WG = WS_WOUT + al256((size_t)DEPTH * 2048 * 2048 * 2);
constexpr size_t WS_MOD = WS_WG + al256((size_t)DEPTH * 2 * 16 * 128 * 64 * 2);
constexpr size_t WS_ROPE = WS_MOD + al256((size_t)DEPTH * 5 * 6144 * 4);
constexpr size_t WS_XCUR = WS_ROPE + al256((size_t)64 * 16 * 2 * 4);
constexpr size_t WS_H = WS_XCUR + al256((size_t)MROWS * DM * 4);
constexpr size_t WS_PMIX = WS_H + al256((size_t)MROWS * DM * 2);
constexpr size_t WS_GP = WS_PMIX + al256((size_t)MROWS * NMIXP * 2);
constexpr size_t WS_MG = WS_GP + al256((size_t)MROWS * NGP * 2);
constexpr size_t WS_RSQ = WS_MG + al256((size_t)MROWS * NMG * 2);
constexpr size_t WS_Q = WS_RSQ + al256((size_t)MROWS * 12 * 4);
constexpr size_t WS_KV = WS_Q + al256((size_t)MROWS * 1536 * 2);
constexpr size_t WS_KR = WS_KV + al256((size_t)MROWS * 2048 * 2);
constexpr size_t WS_LA = WS_KR + al256((size_t)MROWS * 64 * 2);
constexpr size_t WS_LU = WS_LA + al256((size_t)2 * MROWS * 1024 * 4);
constexpr size_t WS_AGG = WS_LU + al256((size_t)2 * MROWS * 1024 * 4);
constexpr size_t WS_O = WS_AGG + al256((size_t)2 * NB * NCHUNK * 1024 * 2 * 4);
constexpr size_t WS_BAR = WS_O + al256((size_t)MROWS * 3072 * 2);
constexpr size_t WS_END = WS_BAR + 16384;

constexpr int LDS_BYTES = 147456;

struct Args { const float* in[21]; float* out; unsigned char* ws; };

typedef float f32x2_t __attribute__((ext_vector_type(2))); typedef __bf16 bf16x2_t __attribute__((ext_vector_type(2)));
__device__ __forceinline__ unsigned cvt_pk(float lo, float hi) { f32x2_t v = {lo, hi}; bf16x2_t b = __builtin_convertvector(v, bf16x2_t); return __builtin_bit_cast(unsigned, b); }
__device__ __forceinline__ float bflo(unsigned u) { return __uint_as_float(u << 16); }
__device__ __forceinline__ float bfhi(unsigned u) { return __uint_as_float(u & 0xffff0000u); }
__device__ __forceinline__ float bf1(bf16_t u) { return __uint_as_float(((unsigned)u) << 16); }
__device__ __forceinline__ u32x4 pack8(f32x4 a, f32x4 b) { u32x4 w; w.x = cvt_pk(a[0], a[1]); w.y = cvt_pk(a[2], a[3]); w.z = cvt_pk(b[0], b[1]); w.w = cvt_pk(b[2], b[3]); return w; }
__device__ __forceinline__ float sigmoidf_(float x) { return __builtin_amdgcn_rcpf(1.f + __expf(-x)); }
__device__ __forceinline__ float shx(float v, int lane, int m) { return __int_as_float(__builtin_amdgcn_ds_bpermute((lane ^ m) << 2, __float_as_int(v))); }
__device__ __forceinline__ float wave_sum(float v, int lane) {
#pragma unroll
    for (int o = 1; o < 64; o <<= 1) v += shx(v, lane, o);
    return v;
}
__device__ __forceinline__ int opaque_v(int x) { asm volatile("" : "+v"(x)); return x; }
__device__ __forceinline__ int crow(int r, int hi) { return (r & 3) + 8 * (r >> 2) + 4 * hi; }

namespace pg8 {
constexpr int BM = 256, BK = 64, HALF = 128, HTB = HALF * BK * 2, NXCD = 8, WGM = 8;
__host__ __device__ __forceinline__ int lds_byte(int r, int c) { const int st = (r >> 4) * 2 + (c >> 5), rr = r & 15, cc = c & 31, ob = rr * 64 + cc * 2; return st * 1024 + (ob ^ (((ob >> 9) & 1) << 5)); }
__host__ __device__ __forceinline__ void stage_rc(int b, int& R, int& C) { const int st = b / 1024, sb = b % 1024, swz = sb ^ (((sb >> 9) & 1) << 5); R = (st >> 1) * 16 + swz / 64; C = (st & 1) * 32 + (swz % 64) / 2; }
__host__ __device__ __forceinline__ int perm32(int rho) { const int n = rho >> 4, i = rho & 15; return 8 * (i >> 2) + 4 * n + (i & 3); }

struct Unit { int pm, pn, z; };
struct Gemm { const bf16_t* A; const bf16_t* Bt; int lda, ldb, K; size_t azs, bzs; };

struct Sched {
    int nM, nN, nwg, G, c, nz;
    __device__ void init(int M, int N, int G_, int c_, int nz_) { nM = M / BM; nN = N / BM; nwg = nM * nN; G = G_; c = c_; nz = nz_; }
    __device__ bool next(int i, Unit& u) const {
        const int it = i / nz; u.z = i - it * nz;
        const long L = (long)it * G + c; if (L >= nwg) return false;
        int wgid = (int)L; { const int q = nwg / NXCD, r = nwg % NXCD, xcd = wgid % NXCD, off = wgid / NXCD; wgid = (xcd < r ? xcd * (q + 1) : r * (q + 1) + (xcd - r) * q) + off; }
        const int nig = WGM * nN, gid = wgid / nig, fm = gid * WGM, gsz = (nM - fm) < WGM ? (nM - fm) : WGM;
        u.pm = fm + ((wgid % nig) % gsz); u.pn = (wgid % nig) / gsz; return true;
    }
};

template <class Epi>
__device__ __forceinline__ void gemm_phase(LAS unsigned char* lds, const Gemm g, const Sched& S, const Epi& E) {
    const int tid = opaque_v(threadIdx.x), wid = __builtin_amdgcn_readfirstlane(tid >> 6), lane = tid & 63, wr = wid >> 2, wc = wid & 3, fr = lane & 15, fq = lane >> 4;
    const int K = g.K, nt = K / BK;
    unsigned voffA[2], voffB[2];
#pragma unroll
    for (int i = 0; i < 2; ++i) { int R, C; stage_rc(tid * 16 + i * 8192, R, C); const int Rb = (R & ~31) + perm32(R & 31);
        voffA[i] = (unsigned)(R * g.lda + C) * 2u; voffB[i] = (unsigned)(Rb * g.ldb + C) * 2u; }
    const size_t kstep = (size_t)(BK * 2);
    const size_t hstepA = (size_t)HALF * g.lda * 2, hstepB = (size_t)HALF * g.ldb * 2;
    const unsigned ldsw = (unsigned)wid * 1024u;
    const int aoff = lds_byte(wr * 64 + fr, fq * 8), boff = lds_byte(wc * 32 + fr, fq * 8);
#define PG8_SA(b, h) (((b) * 2 + (h)) * HTB)
#define PG8_SB(b, h) ((4 + (b) * 2 + (h)) * HTB)
#define PG8_STAGE(bufoff, gbase, voff) do { _Pragma("unroll") for (int _i = 0; _i < 2; ++_i) \
        __builtin_amdgcn_global_load_lds((const unsigned*)((const char*)(gbase) + (voff)[_i]), (LAS unsigned*)(lds + (bufoff) + ldsw + _i * 8192), 16, 0, 0); } while (0)
#define PG8_LDA(dst, b, h) do { _Pragma("unroll") for (int m = 0; m < 4; ++m) _Pragma("unroll") for (int k = 0; k < 2; ++k) dst[m][k] = *(const LAS bf16x8*)(lds + PG8_SA(b, h) + aoff + m * 2048 + k * 1024); } while (0)
#define PG8_LDB(dst, b, h) do { _Pragma("unroll") for (int n = 0; n < 2; ++n) _Pragma("unroll") for (int k = 0; k < 2; ++k) dst[n][k] = *(const LAS bf16x8*)(lds + PG8_SB(b, h) + boff + n * 2048 + k * 1024); } while (0)
#define PG8_MMA(ai, bj, At, Bt) do { __builtin_amdgcn_s_setprio(1); _Pragma("unroll") for (int m = 0; m < 4; ++m) _Pragma("unroll") for (int n = 0; n < 2; ++n) _Pragma("unroll") for (int k = 0; k < 2; ++k) \
        acc[ai][bj][m][n] = __builtin_amdgcn_mfma_f32_16x16x32_bf16(Bt[n][k], At[m][k], acc[ai][bj][m][n], 0, 0, 0); __builtin_amdgcn_s_setprio(0); } while (0)
#define PG8_WAIT_V(n) asm volatile("s_waitcnt vmcnt(" #n ")" ::: "memory")
#define PG8_WAIT_L(n) asm volatile("s_waitcnt lgkmcnt(" #n ")" ::: "memory")
#define PG8_BAR __builtin_amdgcn_s_barrier()
#define PG8_SCHED __builtin_amdgcn_sched_barrier(0)
    Unit cur, nxt; int ui = 0;
    if (!S.next(0, cur)) return;
    f32x4 acc[2][2][4][2];
#pragma unroll
    for (int a = 0; a < 2; ++a)
#pragma unroll
        for (int b = 0; b < 2; ++b)
#pragma unroll
            for (int m = 0; m < 4; ++m)
#pragma unroll
                for (int n = 0; n < 2; ++n) acc[a][b][m][n] = (f32x4){0.f, 0.f, 0.f, 0.f};
    bf16x8 At[4][2], B0[2][2], B1[2][2];
    const char* cA = (const char*)g.A + ((size_t)cur.z * g.azs + (size_t)cur.pm * BM * g.lda) * 2;
    const char* cB = (const char*)g.Bt + ((size_t)cur.z * g.bzs + (size_t)cur.pn * BM * g.ldb) * 2;
    PG8_STAGE(PG8_SB(0, 0), cB, voffB); PG8_STAGE(PG8_SB(0, 1), cB + hstepB, voffB); PG8_STAGE(PG8_SA(0, 0), cA, voffA); PG8_STAGE(PG8_SA(0, 1), cA + hstepA, voffA);
    if (wr == 1) PG8_BAR;
    PG8_WAIT_V(2); PG8_BAR;
    PG8_STAGE(PG8_SB(1, 0), cB + kstep, voffB); PG8_STAGE(PG8_SA(1, 0), cA + kstep, voffA); PG8_STAGE(PG8_SB(1, 1), cB + hstepB + kstep, voffB);
    PG8_WAIT_V(6); PG8_BAR;
    for (;;) {
        const bool has_next = S.next(ui + 1, nxt);
        const char* nA = has_next ? (const char*)g.A + ((size_t)nxt.z * g.azs + (size_t)nxt.pm * BM * g.lda) * 2 : cA;
        const char* nB = has_next ? (const char*)g.Bt + ((size_t)nxt.z * g.bzs + (size_t)nxt.pn * BM * g.ldb) * 2 : cB;
        for (int t = 0; t < nt; t += 2) {
            const bool last = (t == nt - 2);
            const char* a1 = cA + (size_t)(t + 1) * kstep;
            const char* a2 = last ? nA : cA + (size_t)(t + 2) * kstep; const char* b2 = last ? nB : cB + (size_t)(t + 2) * kstep;
            const char* a3 = a2 + kstep; const char* b3 = b2 + kstep;
            PG8_LDB(B0, 0, 0); PG8_LDB(B1, 0, 1); PG8_SCHED; PG8_LDA(At, 0, 0); PG8_STAGE(PG8_SA(1, 1), a1 + hstepA, voffA);
            PG8_WAIT_V(8); PG8_WAIT_L(0); PG8_BAR; PG8_MMA(0, 0, At, B0); PG8_MMA(0, 1, At, B1); PG8_BAR; PG8_SCHED;
            PG8_LDA(At, 0, 1); PG8_STAGE(PG8_SB(0, 0), b2, voffB); PG8_STAGE(PG8_SB(0, 1), b2 + hstepB, voffB); PG8_STAGE(PG8_SA(0, 0), a2, voffA);
            PG8_WAIT_V(8); PG8_WAIT_L(0); PG8_BAR; PG8_MMA(1, 0, At, B0); PG8_MMA(1, 1, At, B1); PG8_BAR; PG8_SCHED;
            PG8_LDB(B0, 1, 0); PG8_LDB(B1, 1, 1); PG8_SCHED; PG8_LDA(At, 1, 0); PG8_STAGE(PG8_SA(0, 1), a2 + hstepA, voffA);
            PG8_WAIT_V(8); PG8_WAIT_L(0); PG8_BAR; PG8_MMA(0, 0, At, B0); PG8_MMA(0, 1, At, B1); PG8_BAR; PG8_SCHED;
            PG8_LDA(At, 1, 1); PG8_STAGE(PG8_SB(1, 0), b3, voffB); PG8_STAGE(PG8_SB(1, 1), b3 + hstepB, voffB); PG8_STAGE(PG8_SA(1, 0), a3, voffA);
            PG8_WAIT_V(8); PG8_WAIT_L(0); PG8_BAR; PG8_MMA(1, 0, At, B0); PG8_MMA(1, 1, At, B1); PG8_BAR; PG8_SCHED;
        }
        if (wr == 0) PG8_BAR;
        { const int l2 = opaque_v(lane); E(acc, cur, wr, wc, l2 & 15, l2 >> 4); }
        if (!has_next) break;
#pragma unroll
        for (int a = 0; a < 2; ++a)
#pragma unroll
            for (int b = 0; b < 2; ++b)
#pragma unroll
                for (int m = 0; m < 4; ++m)
#pragma unroll
                    for (int n = 0; n < 2; ++n) acc[a][b][m][n] = (f32x4){0.f, 0.f, 0.f, 0.f};
        cur = nxt; cA = nA; cB = nB; ++ui;
        if (wr == 1) PG8_BAR;
    }
    PG8_WAIT_V(0);
    PG8_BAR;
#undef PG8_SA
#undef PG8_SB
#undef PG8_STAGE
#undef PG8_LDA
#undef PG8_LDB
#undef PG8_MMA
#undef PG8_WAIT_V
#undef PG8_WAIT_L
#undef PG8_BAR
#undef PG8_SCHED
}
}
typedef f32x4 AccT[2][2][4][2];
#define EPI_FENCE(a, b) asm volatile("" : "+v"(a), "+v"(b) :: "memory")

struct EpiIn {
    bf16_t* pmix; bf16_t* gp; bf16_t* mg; float* rsq;
    __device__ __forceinline__ void operator()(const AccT& acc, const pg8::Unit& u, int wr, int wc, int fr, int fq) const {
        const int row0 = u.pm * 256 + wr * 64 + fr, pn = u.pn;
        if (pn < 20) {
#pragma unroll
            for (int ai = 0; ai < 2; ++ai)
#pragma unroll
                for (int m = 0; m < 4; ++m) {
                    __builtin_amdgcn_sched_barrier(0); const int row = row0 + ai * 128 + m * 16; float ss = 0.f;
#pragma unroll
                    for (int bj = 0; bj < 2; ++bj) {
                        const int col0 = pn * 256 + bj * 128 + wc * 32 + 8 * fq;
                        f32x4 v0 = acc[ai][bj][m][0], v1 = acc[ai][bj][m][1]; EPI_FENCE(v0, v1);
                        ss += (v0[0] * v0[0] + v0[1] * v0[1]) + (v0[2] * v0[2] + v0[3] * v0[3]) + (v1[0] * v1[0] + v1[1] * v1[1]) + (v1[2] * v1[2] + v1[3] * v1[3]);
                        const float sc = (col0 >= O_NAQ && col0 < O_NAK) ? C_NA : 1.f;
                        *(u32x4*)(pmix + (size_t)row * NMIXP + col0) = pack8(v0 * sc, v1 * sc);
                    }
                    if (pn < 3) { ss += shx(ss, fr + 16 * fq, 16); ss += shx(ss, fr + 16 * fq, 32); if (fq == 0) rsq[(size_t)row * 12 + pn * 4 + wc] = ss; }
                }
        } else if (pn < 32) {
#pragma unroll
            for (int ai = 0; ai < 2; ++ai)
#pragma unroll
                for (int m = 0; m < 4; ++m) {
                    __builtin_amdgcn_sched_barrier(0); const int row = row0 + ai * 128 + m * 16;
#pragma unroll
                    for (int bj = 0; bj < 2; ++bj) {
                        const int col0 = (pn - 20) * 256 + bj * 128 + wc * 32 + 8 * fq;
                        f32x4 v0 = acc[ai][bj][m][0], v1 = acc[ai][bj][m][1]; EPI_FENCE(v0, v1);
#pragma unroll
                        for (int e = 0; e < 4; ++e) { v0[e] = v0[e] * sigmoidf_(v0[e]); v1[e] = v1[e] * sigmoidf_(v1[e]); }
                        *(u32x4*)(gp + (size_t)row * NGP + col0) = pack8(v0, v1);
                    }
                }
        } else {
#pragma unroll
            for (int ai = 0; ai < 2; ++ai)
#pragma unroll
                for (int m = 0; m < 4; ++m) {
                    __builtin_amdgcn_sched_barrier(0); const int row = row0 + ai * 128 + m * 16;
#pragma unroll
                    for (int bj = 0; bj < 2; ++bj) {
                        const int col0 = (pn - 32) * 256 + bj * 128 + wc * 32 + 8 * fq;
                        f32x4 v0 = acc[ai][bj][m][0], v1 = acc[ai][bj][m][1]; EPI_FENCE(v0, v1);
#pragma unroll
                        for (int e = 0; e < 4; ++e) { v0[e] = sigmoidf_(v0[e]); v1[e] = sigmoidf_(v1[e]); }
                        *(u32x4*)(mg + (size_t)row * NMG + col0) = pack8(v0, v1);
                    }
                }
        }
    }
};
struct EpiQ {
    bf16_t* q; const float* rsq; const float* cs;
    __device__ __forceinline__ void operator()(const AccT& acc, const pg8::Unit& u, int wr, int wc, int fr, int fq) const {
        const int row0 = u.pm * 256 + wr * 64 + fr, pn = u.pn; const bool lat = u.pm < 64;
#pragma unroll
        for (int ai = 0; ai < 2; ++ai)
#pragma unroll
            for (int m = 0; m < 4; ++m) {
                __builtin_amdgcn_sched_barrier(0); const int row = row0 + ai * 128 + m * 16;
                const f32x4 r0 = *(const f32x4*)(rsq + (size_t)row * 12), r1 = *(const f32x4*)(rsq + (size_t)row * 12 + 4);
                const float ssum = ((r0[0] + r0[1]) + (r0[2] + r0[3])) + ((r1[0] + r1[1]) + (r1[2] + r1[3]));
                const float rinv = rsqrtf(ssum * (1.f / 512.f) + EPS) * C_MLA;
                const int s = row & 4095;
#pragma unroll
                for (int bj = 0; bj < 2; ++bj) {
                    const int g32 = pn * 8 + bj * 4 + wc, t6 = g32 % 6, col0 = g32 * 32 + 8 * fq;
                    f32x4 v0 = acc[ai][bj][m][0], v1 = acc[ai][bj][m][1]; EPI_FENCE(v0, v1); v0 = v0 * rinv; v1 = v1 * rinv;
                    if (t6 >= 4 && lat) {
                        const int pos = (t6 == 4) ? (s >> 6) : (s & 63);
                        const float* cp = cs + (pos * 16 + 8 * (fq & 1)) * 2;
                        const f32x4 c0 = *(const f32x4*)(cp), c1 = *(const f32x4*)(cp + 4), c2 = *(const f32x4*)(cp + 8), c3 = *(const f32x4*)(cp + 12);
                        const float cosv[8] = {c0[0], c0[2], c1[0], c1[2], c2[0], c2[2], c3[0], c3[2]};
                        const float sinv[8] = {c0[1], c0[3], c1[1], c1[3], c2[1], c2[3], c3[1], c3[3]};
                        float x[8] = {v0[0], v0[1], v0[2], v0[3], v1[0], v1[1], v1[2], v1[3]};
#pragma unroll
                        for (int e = 0; e < 8; ++e) { const float p = shx(x[e], fr + 16 * fq, 32); x[e] = (fq < 2) ? (x[e] * cosv[e] - p * sinv[e]) : (p * sinv[e] + x[e] * cosv[e]); }
                        v0 = (f32x4){x[0], x[1], x[2], x[3]}; v1 = (f32x4){x[4], x[5], x[6], x[7]};
                    }
                    *(u32x4*)(q + (size_t)row * 1536 + col0) = pack8(v0, v1);
                }
            }
    }
};
struct EpiKV {
    bf16_t* kv; const float* rsq;
    __device__ __forceinline__ void operator()(const AccT& acc, const pg8::Unit& u, int wr, int wc, int fr, int fq) const {
        const int row0 = u.pm * 256 + wr * 64 + fr, pn = u.pn;
#pragma unroll
        for (int ai = 0; ai < 2; ++ai)
#pragma unroll
            for (int m = 0; m < 4; ++m) {
                __builtin_amdgcn_sched_barrier(0); const int row = row0 + ai * 128 + m * 16;
                const f32x4 r0 = *(const f32x4*)(rsq + (size_t)row * 12 + 8);
                const float rinv = rsqrtf(((r0[0] + r0[1]) + (r0[2] + r0[3])) * (1.f / 256.f) + EPS);
#pragma unroll
                for (int bj = 0; bj < 2; ++bj) {
                    const int col0 = pn * 256 + bj * 128 + wc * 32 + 8 * fq;
                    f32x4 v0 = acc[ai][bj][m][0], v1 = acc[ai][bj][m][1]; EPI_FENCE(v0, v1);
                    *(u32x4*)(kv + (size_t)row * 2048 + col0) = pack8(v0 * rinv, v1 * rinv);
                }
            }
    }
};
struct EpiMerge {
    const bf16_t* mg; float* tmp; bf16_t* merged;
    __device__ __forceinline__ void operator()(const AccT& acc, const pg8::Unit& u, int wr, int wc, int fr, int fq) const {
        const int row0 = u.pm * 256 + wr * 64 + fr, pn = u.pn, z = u.z;
#pragma unroll
        for (int ai = 0; ai < 2; ++ai)
#pragma unroll
            for (int m = 0; m < 4; ++m) {
                __builtin_amdgcn_sched_barrier(0); const int row = row0 + ai * 128 + m * 16;
#pragma unroll
                for (int bj = 0; bj < 2; ++bj) {
                    const int col0 = pn * 256 + bj * 128 + wc * 32 + 8 * fq;
                    const u32x4 gw = *(const u32x4*)(mg + (size_t)row * NMG + z * 2048 + col0);
                    f32x4 v0 = acc[ai][bj][m][0], v1 = acc[ai][bj][m][1]; EPI_FENCE(v0, v1);
                    v0[0] *= bflo(gw.x); v0[1] *= bfhi(gw.x); v0[2] *= bflo(gw.y); v0[3] *= bfhi(gw.y);
                    v1[0] *= bflo(gw.z); v1[1] *= bfhi(gw.z); v1[2] *= bflo(gw.w); v1[3] *= bfhi(gw.w);
                    bf16_t* mp = merged + (size_t)row * 2048 + col0;
                    if (z > 0) { const u32x4 pw = *(const u32x4*)mp;
                        v0[0] += bflo(pw.x); v0[1] += bfhi(pw.x); v0[2] += bflo(pw.y); v0[3] += bfhi(pw.y); v1[0] += bflo(pw.z); v1[1] += bfhi(pw.z); v1[2] += bflo(pw.w); v1[3] += bfhi(pw.w); }
                    *(u32x4*)mp = pack8(v0, v1);
                }
            }
    }
};
struct EpiOut {
    const float* xin; const float* ctxin; float* xcur; const float* mod; int layer;
    __device__ __forceinline__ void operator()(const AccT& acc, const pg8::Unit& u, int wr, int wc, int fr, int fq) const {
        const int row0 = u.pm * 256 + wr * 64 + fr, pn = u.pn; const bool lat = u.pm < 64;
        const float* gt = mod + (size_t)(lat ? (u.pm >> 4) : 4) * 6144 + 4096;
#pragma unroll
        for (int ai = 0; ai < 2; ++ai)
#pragma unroll
            for (int m = 0; m < 4; ++m) {
                __builtin_amdgcn_sched_barrier(0); const int row = row0 + ai * 128 + m * 16;
                const float* xo = (layer == 0) ? (lat ? xin + (size_t)row * 2048 : ctxin + (size_t)(row - NLAT) * 2048) : xcur + (size_t)row * 2048;
#pragma unroll
                for (int bj = 0; bj < 2; ++bj) {
                    const int col0 = pn * 256 + bj * 128 + wc * 32 + 8 * fq;
                    f32x4 v0 = acc[ai][bj][m][0], v1 = acc[ai][bj][m][1]; EPI_FENCE(v0, v1);
                    const f32x4 g0 = *(const f32x4*)(gt + col0), g1 = *(const f32x4*)(gt + col0 + 4);
                    const f32x4 x0 = *(const f32x4*)(xo + col0), x1 = *(const f32x4*)(xo + col0 + 4);
                    *(f32x4*)(xcur + (size_t)row * 2048 + col0) = x0 + g0 * v0;
                    *(f32x4*)(xcur + (size_t)row * 2048 + col0 + 4) = x1 + g1 * v1;
                }
            }
    }
};

namespace mla {
typedef short s16x4 __attribute__((ext_vector_type(4)));
constexpr int SHM_V = 16384, SHM_K = 16384, SHM_KR = 8192;
constexpr int OFF_V = 0, OFF_K = 2 * SHM_V, OFF_KR = OFF_K + 2 * SHM_K, OFF_WS = OFF_KR + 2 * SHM_KR;
constexpr float THR2 = 8.f;
#define KSWZ(row, colB) ((row) * 256 + ((colB) ^ (((row) & 7) << 4)))
#define KRSWZ(row, colB) ((row) * 128 + ((colB) ^ (((row) & 7) << 4)))
#define SBAR() __builtin_amdgcn_sched_barrier(0)
__device__ __forceinline__ void partialSM(f32x16& p0, f32x16& p1, float& m_reg, float& mn, float& alpha) {
    float pmax = p0[0];
#pragma unroll
    for (int r = 1; r < 16; ++r) pmax = fmaxf(pmax, p0[r]);
#pragma unroll
    for (int r = 0; r < 16; ++r) pmax = fmaxf(pmax, p1[r]);
    { auto rr = __builtin_amdgcn_permlane32_swap(__float_as_uint(pmax), __float_as_uint(pmax), false, false);
      pmax = fmaxf(__uint_as_float(rr[0]), __uint_as_float(rr[1])); }
    if (__builtin_expect(__all(pmax - m_reg <= THR2), 1)) { mn = m_reg; alpha = 1.f; }
    else { mn = fmaxf(m_reg, pmax); alpha = __builtin_amdgcn_exp2f(m_reg - mn); m_reg = mn; }
#pragma unroll
    for (int r = 0; r < 16; ++r) p0[r] = p0[r] - mn;
#pragma unroll
    for (int r = 0; r < 16; ++r) p1[r] = p1[r] - mn;
#pragma unroll
    for (int r = 0; r < 16; ++r) p0[r] = __builtin_amdgcn_exp2f(p0[r]);
}
__device__ __forceinline__ void finishSM(f32x16& p0, f32x16& p1, float alpha, float& l_reg, bf16x8& pa0, bf16x8& pa1, bf16x8& pa2, bf16x8& pa3) {
#pragma unroll
    for (int r = 0; r < 16; ++r) p1[r] = __builtin_amdgcn_exp2f(p1[r]);
    float ps = 0;
#pragma unroll
    for (int r = 0; r < 16; ++r) ps += p0[r];
#pragma unroll
    for (int r = 0; r < 16; ++r) ps += p1[r];
    { auto rr = __builtin_amdgcn_permlane32_swap(__float_as_uint(ps), __float_as_uint(ps), false, false);
      ps = __uint_as_float(rr[0]) + __uint_as_float(rr[1]); }
    l_reg = l_reg * alpha + ps;
#define PK4(P, BASE, OUT) do { unsigned a0 = cvt_pk(P[BASE + 0], P[BASE + 1]), a1 = cvt_pk(P[BASE + 2], P[BASE + 3]);   \
    unsigned b0 = cvt_pk(P[BASE + 4], P[BASE + 5]), b1 = cvt_pk(P[BASE + 6], P[BASE + 7]);                              \
    auto r0 = __builtin_amdgcn_permlane32_swap(a0, b0, false, false); auto r1 = __builtin_amdgcn_permlane32_swap(a1, b1, false, false); \
    u32x4 w = {r0[0], r1[0], r0[1], r1[1]}; OUT = *reinterpret_cast<bf16x8*>(&w); } while (0)
    PK4(p0, 0, pa0); PK4(p0, 8, pa1); PK4(p1, 0, pa2); PK4(p1, 8, pa3);
#undef PK4
}
__device__ __forceinline__ void qkt(f32x16& p0, f32x16& p1, const char* Ks, const char* KRs, const bf16x8* qr, int r32, int hi) {
    p0 = f32x16{}; p1 = f32x16{};
#pragma unroll
    for (int d0 = 0; d0 < 8; ++d0) { const int cb = (d0 * 16 + hi * 8) * 2;
        bf16x8 b0 = *reinterpret_cast<const bf16x8*>(Ks + KSWZ(r32, cb));
        bf16x8 b1 = *reinterpret_cast<const bf16x8*>(Ks + KSWZ(32 + r32, cb));
        p0 = __builtin_amdgcn_mfma_f32_32x32x16_bf16(b0, qr[d0], p0, 0, 0, 0);
        p1 = __builtin_amdgcn_mfma_f32_32x32x16_bf16(b1, qr[d0], p1, 0, 0, 0); }
#pragma unroll
    for (int d0 = 0; d0 < 4; ++d0) { const int cb = (d0 * 16 + hi * 8) * 2;
        bf16x8 b0 = *reinterpret_cast<const bf16x8*>(KRs + KRSWZ(r32, cb));
        bf16x8 b1 = *reinterpret_cast<const bf16x8*>(KRs + KRSWZ(32 + r32, cb));
        p0 = __builtin_amdgcn_mfma_f32_32x32x16_bf16(b0, qr[8 + d0], p0, 0, 0, 0);
        p1 = __builtin_amdgcn_mfma_f32_32x32x16_bf16(b1, qr[8 + d0], p1, 0, 0, 0); }
}
__device__ __forceinline__ int v_st(int k, int c) { const int kk = (k & ~0xC) | ((k & 4) << 1) | ((k & 8) >> 1); return ((kk >> 3) * 4 + (c >> 5)) * 512 + ((kk & 7) * 32 + (c & 31)) * 2; }
__device__ __forceinline__ int v_rd_base(int lane) { return ((lane & 3) << 3) | (((lane >> 2) & 3) << 6) | (((lane >> 4) & 1) << 5) | (((lane >> 5) & 1) << 8); }
constexpr int v_rd_off(int d0, int ks, int half) { return d0 * 512 + ks * 4096 + half * 2048; }
template <int OFF> __device__ __forceinline__ s16x4 tr_read(int vb) {
    s16x4 r; asm volatile("ds_read_b64_tr_b16 %0, %1 offset:%2" : "=&v"(r) : "v"(vb), "i"(OFF) : "memory"); return r;
}
template <int D0> __device__ __forceinline__ void pv_one(f32x16& od, int vb, bf16x8 pa0, bf16x8 pa1, bf16x8 pa2, bf16x8 pa3) {
    const s16x4 l0 = tr_read<v_rd_off(D0, 0, 0)>(vb), h0 = tr_read<v_rd_off(D0, 0, 1)>(vb), l1 = tr_read<v_rd_off(D0, 1, 0)>(vb), h1 = tr_read<v_rd_off(D0, 1, 1)>(vb);
    const s16x4 l2 = tr_read<v_rd_off(D0, 2, 0)>(vb), h2 = tr_read<v_rd_off(D0, 2, 1)>(vb), l3 = tr_read<v_rd_off(D0, 3, 0)>(vb), h3 = tr_read<v_rd_off(D0, 3, 1)>(vb);
    asm volatile("s_waitcnt lgkmcnt(0)" ::: "memory"); SBAR();
#define PK(L, H) (bf16x8){L[0], L[1], L[2], L[3], H[0], H[1], H[2], H[3]}
    od = __builtin_amdgcn_mfma_f32_32x32x16_bf16(pa0, PK(l0, h0), od, 0, 0, 0);
    od = __builtin_amdgcn_mfma_f32_32x32x16_bf16(pa1, PK(l1, h1), od, 0, 0, 0);
    od = __builtin_amdgcn_mfma_f32_32x32x16_bf16(pa2, PK(l2, h2), od, 0, 0, 0);
    od = __builtin_amdgcn_mfma_f32_32x32x16_bf16(pa3, PK(l3, h3), od, 0, 0, 0);
#undef PK
}
__device__ __forceinline__ void pv_d0(f32x16* o, int vb, bf16x8 pa0, bf16x8 pa1, bf16x8 pa2, bf16x8 pa3) {
    pv_one<0>(o[0], vb, pa0, pa1, pa2, pa3); pv_one<1>(o[1], vb, pa0, pa1, pa2, pa3); pv_one<2>(o[2], vb, pa0, pa1, pa2, pa3); pv_one<3>(o[3], vb, pa0, pa1, pa2, pa3);
}
__device__ __forceinline__ void attn_unit(const bf16_t* __restrict__ Q, const bf16_t* __restrict__ KV, const bf16_t* __restrict__ KR, const bf16_t* __restrict__ GP, bf16_t* __restrict__ O,
                                          int qrow0, int h, int latbase, int ctxbase, int nlt, int NT, char* lds) {
    const int tid = opaque_v(threadIdx.x), wid = tid >> 6, lane = tid & 63, r32 = lane & 31, hi = lane >> 5;
    char* V_lds = lds + OFF_V; char* K_lds = lds + OFF_K; char* KR_lds = lds + OFF_KR;
    float* ws = (float*)(lds + OFF_WS) + wid * 64; float* li_l = ws; float* al_l = ws + 32;
    float m_reg = -1e30f, l_reg = 0; f32x16 o[4] = {}; bf16x8 qr[12];
    const bf16_t* Qw = Q + (size_t)(qrow0 + wid * 32 + r32) * 1536 + h * 192 + hi * 8;
#pragma unroll
    for (int d0 = 0; d0 < 12; ++d0) qr[d0] = *reinterpret_cast<const bf16x8*>(Qw + d0 * 16);
    const int sr = tid >> 4, sc = (tid & 15) * 8, vst0 = v_st(sr, sc), vst1 = v_st(32 + sr, sc);
    const int krr = tid >> 3, krc = (tid & 7) * 16;
    const int vb0 = (int)(uintptr_t)V_lds + v_rd_base(lane);
    const bf16_t* Kh = KV + h * 256 + sc; const bf16_t* Vh = KV + h * 256 + 128 + sc;
    bf16x8 s_v0, s_v1, s_k0, s_k1, s_kr;
#define TROW(j) ((j) < nlt ? latbase + 64 * (j) : ctxbase + 64 * ((j) - nlt))
#define SLOAD(j) do { const int _rb = TROW(j); \
    s_v0 = *reinterpret_cast<const bf16x8*>(Vh + (size_t)(_rb + sr) * 2048); s_v1 = *reinterpret_cast<const bf16x8*>(Vh + (size_t)(_rb + 32 + sr) * 2048); \
    s_k0 = *reinterpret_cast<const bf16x8*>(Kh + (size_t)(_rb + sr) * 2048); s_k1 = *reinterpret_cast<const bf16x8*>(Kh + (size_t)(_rb + 32 + sr) * 2048); \
    s_kr = *reinterpret_cast<const bf16x8*>((const char*)KR + (size_t)(_rb + krr) * 128 + krc); } while (0)
#define SWRITE(b) do { *(bf16x8*)(V_lds + (b) * SHM_V + vst0) = s_v0; *(bf16x8*)(V_lds + (b) * SHM_V + vst1) = s_v1; const int kc = sc * 2; \
    *(bf16x8*)(K_lds + (b) * SHM_K + KSWZ(sr, kc)) = s_k0; *(bf16x8*)(K_lds + (b) * SHM_K + KSWZ(32 + sr, kc)) = s_k1; \
    *(bf16x8*)(KR_lds + (b) * SHM_KR + KRSWZ(krr, krc)) = s_kr; } while (0)
#define RESC(a) do { if (__any((a) < 1.f)) { if (hi == 0) al_l[r32] = (a); asm volatile("s_waitcnt lgkmcnt(0)" ::: "memory"); \
    _Pragma("unroll") for (int d = 0; d < 4; ++d) _Pragma("unroll") for (int r = 0; r < 16; ++r) o[d][r] *= al_l[crow(r, hi)]; } } while (0)
    f32x16 pA0, pA1, pB0, pB1; float mnA, mnB, alA, alB; bf16x8 pa0, pa1, pa2, pa3;
    SLOAD(0); asm volatile("s_waitcnt vmcnt(0)" ::: "memory"); SWRITE(0); __syncthreads();
    qkt(pA0, pA1, K_lds, KR_lds, qr, r32, hi); partialSM(pA0, pA1, m_reg, mnA, alA);
    SLOAD(1);
    asm volatile("s_waitcnt vmcnt(0)" ::: "memory"); SWRITE(1); __syncthreads();
    for (int j = 1; j + 1 < NT; j += 2) {
        SBAR(); qkt(pB0, pB1, K_lds + SHM_K, KR_lds + SHM_KR, qr, r32, hi);
        finishSM(pA0, pA1, alA, l_reg, pa0, pa1, pa2, pa3); SBAR();
        SLOAD(j + 1); SBAR();
        pv_d0(o, vb0, pa0, pa1, pa2, pa3); partialSM(pB0, pB1, m_reg, mnB, alB);
        __syncthreads(); asm volatile("s_waitcnt vmcnt(0)" ::: "memory"); SWRITE(0);
        RESC(alB); __syncthreads();
        SBAR(); qkt(pA0, pA1, K_lds, KR_lds, qr, r32, hi);
        finishSM(pB0, pB1, alB, l_reg, pa0, pa1, pa2, pa3); SBAR();
        SLOAD(j + 2); SBAR();
        pv_d0(o, vb0 + SHM_V, pa0, pa1, pa2, pa3); partialSM(pA0, pA1, m_reg, mnA, alA);
        __syncthreads(); asm volatile("s_waitcnt vmcnt(0)" ::: "memory"); SWRITE(1);
        RESC(alA); __syncthreads();
    }
    SBAR(); qkt(pB0, pB1, K_lds + SHM_K, KR_lds + SHM_KR, qr, r32, hi);
    finishSM(pA0, pA1, alA, l_reg, pa0, pa1, pa2, pa3); SBAR();
    pv_d0(o, vb0, pa0, pa1, pa2, pa3); partialSM(pB0, pB1, m_reg, mnB, alB);
    __syncthreads(); RESC(alB);
    finishSM(pB0, pB1, alB, l_reg, pa0, pa1, pa2, pa3); SBAR();
    pv_d0(o, vb0 + SHM_V, pa0, pa1, pa2, pa3);
    if (hi == 0) li_l[r32] = l_reg; asm volatile("s_waitcnt lgkmcnt(0)" ::: "memory");
    const int orow0 = qrow0 + wid * 32;
#pragma unroll
    for (int r = 0; r < 16; ++r) { const int orow = orow0 + crow(r, hi); const float rl = __builtin_amdgcn_rcpf(li_l[crow(r, hi)]);
#pragma unroll
        for (int d0 = 0; d0 < 4; ++d0) { const size_t idx = (size_t)orow * 3072 + h * 128 + d0 * 32 + r32;
            const float v = o[d0][r] * rl * bf1(GP[idx]); O[idx] = (bf16_t)(cvt_pk(v, 0.f) & 0xffffu); } }
    __syncthreads();
#undef TROW
#undef SLOAD
#undef SWRITE
#undef RESC
}
}

__device__ __forceinline__ void na_item(const bf16_t* __restrict__ PMIX, const bf16_t* __restrict__ GP, bf16_t* __restrict__ O, const float* __restrict__ bias, int item, int lane, LAS unsigned char* wl) {
    const int q = lane & 31, hi = lane >> 5;
    const bool lat = item < 8192;
    int b, h, gi = 0, jh = 0, qrow;
    if (lat) { b = item >> 11; h = (item >> 7) & 15; gi = (item >> 1) & 63; jh = item & 1; qrow = b * 4096 + gi * 64 + jh * 32 + q; }
    else { const int it = item - 8192; b = it >> 7; h = (it >> 3) & 15; qrow = NLAT + b * 256 + (it & 7) * 32 + q; }
    const int j = jh * 32 + q;
    const int c0 = min(max(j - 8, 0), 48), r0 = min(max(gi - 4, 0), 56);
    const bf16_t* qp = PMIX + (size_t)qrow * NMIXP + O_NAQ + h * 64 + hi * 8;
    bf16x8 qf[4];
#pragma unroll
    for (int ks = 0; ks < 4; ++ks) qf[ks] = *reinterpret_cast<const bf16x8*>(qp + ks * 16);
    f32x16 oT0 = {}, oT1 = {}; float m = -1e30f, l = 0.f;
    const int ntiles = lat ? 24 : 8;
    const float* bh = bias + h * (15 * 31);
    bf16x8 kf[4]; u32x4 vv[4];
#define NA_TROW(t_) ((lat && (t_) < 16) ? (b * 4096 + (r0 + ((t_) >> 1)) * 64 + ((t_) & 1) * 32) : (NLAT + b * 256 + (lat ? (t_) - 16 : (t_)) * 32))
#define NA_LOAD(KF, VV, t_) do { const int kr0_ = NA_TROW(t_); const bf16_t* kp_ = PMIX + (size_t)(kr0_ + q) * NMIXP + O_NAK + h * 64 + hi * 8; \
        _Pragma("unroll") for (int ks = 0; ks < 4; ++ks) KF[ks] = *reinterpret_cast<const bf16x8*>(kp_ + ks * 16); \
        const bf16_t* vp_ = PMIX + (size_t)(kr0_ + (lane >> 1)) * NMIXP + O_NAV + h * 64 + (lane & 1) * 32; \
        _Pragma("unroll") for (int c = 0; c < 4; ++c) VV[c] = *reinterpret_cast<const u32x4*>(vp_ + c * 8); } while (0)
    NA_LOAD(kf, vv, 0);
    for (int t = 0; t < ntiles; ++t) {
        int kr = 0, kblk = 0; const bool local = lat && t < 16;
        if (local) { kr = t >> 1; kblk = t & 1; }
        bf16x8 kfn[4]; u32x4 vvn[4];
        { const int tn = (t + 1 < ntiles) ? t + 1 : t; NA_LOAD(kfn, vvn, tn); }
        f32x16 p = {};
#pragma unroll
        for (int ks = 0; ks < 4; ++ks) p = __builtin_amdgcn_mfma_f32_32x32x16_bf16(kf[ks], qf[ks], p, 0, 0, 0);
#pragma unroll
        for (int c = 0; c < 4; ++c) *(LAS u32x4*)(wl + (lane >> 1) * 144 + (lane & 1) * 64 + c * 16) = vv[c];
        if (local) {
            const float* brow = bh + (r0 + kr - gi + 7) * 31 + 15 - j;
#pragma unroll
            for (int r = 0; r < 16; ++r) { const int kc = kblk * 32 + crow(r, hi); const bool valid = (kc >= c0) && (kc < c0 + 16);
                const float bv = valid ? brow[kc] : 0.f; p[r] = valid ? fmaf(bv, LOG2E, p[r]) : -INFINITY; }
        }
        float tmax = p[0];
#pragma unroll
        for (int r = 1; r < 16; ++r) tmax = fmaxf(tmax, p[r]);
        tmax = fmaxf(tmax, shx(tmax, lane, 32));
        const float mn = fmaxf(m, tmax), alpha = __builtin_amdgcn_exp2f(m - mn); m = mn;
        float ps = 0.f;
#pragma unroll
        for (int r = 0; r < 16; ++r) { p[r] = __builtin_amdgcn_exp2f(p[r] - mn); ps += p[r]; }
        l = l * alpha + ps;
#pragma unroll
        for (int r = 0; r < 16; ++r) { oT0[r] *= alpha; oT1[r] *= alpha; }
        asm volatile("s_waitcnt lgkmcnt(0)" ::: "memory"); __builtin_amdgcn_wave_barrier();
#pragma unroll
        for (int ks = 0; ks < 2; ++ks) {
            u32x4 pw; pw.x = cvt_pk(p[8 * ks + 0], p[8 * ks + 1]); pw.y = cvt_pk(p[8 * ks + 2], p[8 * ks + 3]); pw.z = cvt_pk(p[8 * ks + 4], p[8 * ks + 5]); pw.w = cvt_pk(p[8 * ks + 6], p[8 * ks + 7]);
            const bf16x8 pf = *reinterpret_cast<bf16x8*>(&pw);
#pragma unroll
            for (int db = 0; db < 2; ++db) {
                bf16x8 vf;
#pragma unroll
                for (int jj = 0; jj < 8; ++jj) { const int key = 16 * ks + 8 * (jj >> 2) + 4 * hi + (jj & 3); vf[jj] = *(const LAS short*)(wl + key * 144 + (32 * db + q) * 2); }
                if (db == 0) oT0 = __builtin_amdgcn_mfma_f32_32x32x16_bf16(vf, pf, oT0, 0, 0, 0);
                else oT1 = __builtin_amdgcn_mfma_f32_32x32x16_bf16(vf, pf, oT1, 0, 0, 0);
            }
        }
        asm volatile("s_waitcnt lgkmcnt(0)" ::: "memory"); __builtin_amdgcn_wave_barrier();
#pragma unroll
        for (int i4 = 0; i4 < 4; ++i4) { kf[i4] = kfn[i4]; vv[i4] = vvn[i4]; }
    }
#undef NA_TROW
#undef NA_LOAD
    const float inv = __builtin_amdgcn_rcpf(l + shx(l, lane, 32));
    const size_t ob = (size_t)qrow * 3072 + 1024 + h * 64;
#pragma unroll
    for (int db = 0; db < 2; ++db)
#pragma unroll
        for (int g = 0; g < 4; ++g) {
            const int d = 32 * db + 8 * g + 4 * hi;
            const u32x2 gw = *reinterpret_cast<const u32x2*>(GP + ob + d);
            float v0, v1, v2, v3;
            if (db == 0) { v0 = oT0[4 * g]; v1 = oT0[4 * g + 1]; v2 = oT0[4 * g + 2]; v3 = oT0[4 * g + 3]; } else { v0 = oT1[4 * g]; v1 = oT1[4 * g + 1]; v2 = oT1[4 * g + 2]; v3 = oT1[4 * g + 3]; }
            u32x2 w; w.x = cvt_pk(v0 * inv * bflo(gw.x), v1 * inv * bfhi(gw.x)); w.y = cvt_pk(v2 * inv * bflo(gw.y), v3 * inv * bfhi(gw.y));
            *reinterpret_cast<u32x2*>(O + ob + d) = w;
        }
}

__device__ __forceinline__ void lru_gate_item(const bf16_t* __restrict__ PMIX, const bf16_t* __restrict__ WG, const float* __restrict__ convw, const float* __restrict__ convb,
                                              const float* __restrict__ bg, const float* __restrict__ lam, float* __restrict__ LA, float* __restrict__ LU, int item, LAS unsigned char* lds) {
    const int tid = opaque_v(threadIdx.x), lane = tid & 63, wid = tid >> 6;
    const int tt = item >> 4, blk = item & 15, row0 = tt * 64;
    const int seg0 = row0 < NLAT ? (row0 & ~4095) : (NLAT + ((row0 - NLAT) & ~255)), seg1 = seg0 + (row0 < NLAT ? 4096 : 256);
    LAS float* xcf = (LAS float*)lds;
    LAS unsigned char* xcb = lds + 64 * 68 * 4;
    {
        const int tl = tid >> 3, cg8 = (tid & 7) * 8, row = row0 + tl, ch = blk * 64 + cg8;
        float xc[8];
        { const f32x4 b0 = *(const f32x4*)(convb + ch), b1 = *(const f32x4*)(convb + ch + 4); xc[0] = b0[0]; xc[1] = b0[1]; xc[2] = b0[2]; xc[3] = b0[3]; xc[4] = b1[0]; xc[5] = b1[1]; xc[6] = b1[2]; xc[7] = b1[3]; }
#pragma unroll
        for (int tap = 0; tap < 4; ++tap) {
            const int rr = row + tap - 2;
            if (rr >= seg0 && rr < seg1) {
                const u32x4 pv = *(const u32x4*)(PMIX + (size_t)rr * NMIXP + O_PX + ch);
                const f32x4 w0 = *(const f32x4*)(convw + tap * 1024 + ch), w1 = *(const f32x4*)(convw + tap * 1024 + ch + 4);
                xc[0] += w0[0] * bflo(pv.x); xc[1] += w0[1] * bfhi(pv.x); xc[2] += w0[2] * bflo(pv.y); xc[3] += w0[3] * bfhi(pv.y);
                xc[4] += w1[0] * bflo(pv.z); xc[5] += w1[1] * bfhi(pv.z); xc[6] += w1[2] * bflo(pv.w); xc[7] += w1[3] * bfhi(pv.w);
            }
        }
        *(LAS f32x4*)(xcf + tl * 68 + cg8) = (f32x4){xc[0], xc[1], xc[2], xc[3]}; *(LAS f32x4*)(xcf + tl * 68 + cg8 + 4) = (f32x4){xc[4], xc[5], xc[6], xc[7]};
        u32x4 w; w.x = cvt_pk(xc[0], xc[1]); w.y = cvt_pk(xc[2], xc[3]); w.z = cvt_pk(xc[4], xc[5]); w.w = cvt_pk(xc[6], xc[7]);
        *(LAS u32x4*)(xcb + tl * 144 + cg8 * 2) = w;
    }
    __syncthreads();
    {
        const int dir = wid >> 2, th = (wid >> 1) & 1, chh = wid & 1, q = lane & 31, hi = lane >> 5;
        const int cl = 32 * chh + q, ch = blk * 64 + cl;
        const bf16_t* wt = WG + (size_t)(dir * 16 + blk) * 128 * 64;
        f32x16 accR = {}, accI = {};
#pragma unroll
        for (int ks = 0; ks < 4; ++ks) {
            const bf16x8 af = *(const LAS bf16x8*)(xcb + (32 * th + q) * 144 + (16 * ks + 8 * hi) * 2);
            const bf16x8 br = *reinterpret_cast<const bf16x8*>(wt + (size_t)cl * 64 + 16 * ks + 8 * hi);
            const bf16x8 bi = *reinterpret_cast<const bf16x8*>(wt + (size_t)(64 + cl) * 64 + 16 * ks + 8 * hi);
            accR = __builtin_amdgcn_mfma_f32_32x32x16_bf16(af, br, accR, 0, 0, 0);
            accI = __builtin_amdgcn_mfma_f32_32x32x16_bf16(af, bi, accI, 0, 0, 0);
        }
        const float brv = bg[dir * 2048 + blk * 128 + cl], biv = bg[dir * 2048 + blk * 128 + 64 + cl];
        float sp; { const float xs = __expf(-lam[dir * 1024 + ch]);
            sp = xs < 0.05f ? xs * (1.f - xs * (0.5f - xs * ((1.f / 3.f) - xs * (0.25f - xs * 0.2f)))) : __logf(1.f + xs); }
#pragma unroll
        for (int r = 0; r < 16; ++r) {
            const int tl = 32 * th + crow(r, hi);
            const float rg = sigmoidf_(accR[r] + brv), ig = sigmoidf_(accI[r] + biv);
            const float log_a = -8.f * rg * sp, a = __expf(log_a), ym = -2.f * log_a;
            const float om = ym < 0.1f ? ym * (1.f - ym * (0.5f - ym * ((1.f / 6.f) - ym * ((1.f / 24.f) - ym * (1.f / 120.f))))) : 1.f - __expf(-ym);
            const float u = __builtin_sqrtf(fmaxf(om, 0.f)) * (ig * xcf[tl * 68 + cl]);
            const size_t idx = ((size_t)dir * MROWS + row0 + tl) * 1024 + ch;
            LA[idx] = a; LU[idx] = u;
        }
    }
    __syncthreads();
}
__device__ __forceinline__ int chunk_row0(int b, int c) { return c < 4 ? NLAT + b * 256 + c * 64 : b * 4096 + (c - 4) * 64; }
__device__ __forceinline__ void lru_pass1_item(const float* __restrict__ LA, const float* __restrict__ LU, float* __restrict__ AGG, int item) {
    const int g = item * 512 + opaque_v(threadIdx.x), ch = (g & 255) * 4, dir = (g >> 8) & 1, bc = g >> 9, c = bc % NCHUNK, b = bc / NCHUNK;
    const int row0 = chunk_row0(b, c);
    const float* ap = LA + ((size_t)dir * MROWS + row0) * 1024 + ch; const float* up = LU + ((size_t)dir * MROWS + row0) * 1024 + ch;
    f32x4 A = {1.f, 1.f, 1.f, 1.f}, H = {0.f, 0.f, 0.f, 0.f};
#pragma unroll 8
    for (int t = 0; t < 64; ++t) { const int tt = dir ? 63 - t : t; const f32x4 a = *(const f32x4*)(ap + (size_t)tt * 1024), u = *(const f32x4*)(up + (size_t)tt * 1024); A *= a; H = a * H + u; }
    float* o = AGG + (((size_t)(dir * NB + b) * NCHUNK + c) * 1024 + ch) * 2;
    *(f32x4*)o = (f32x4){A[0], H[0], A[1], H[1]}; *(f32x4*)(o + 4) = (f32x4){A[2], H[2], A[3], H[3]};
}
__device__ __forceinline__ void lru_pass3_item(const float* __restrict__ LA, const float* __restrict__ LU, const float* __restrict__ AGG, const bf16_t* __restrict__ GP, bf16_t* __restrict__ O, int item, LAS unsigned char* lds) {
    const int tid = opaque_v(threadIdx.x);
    const int cg = item & 7, bc = item >> 3, c = bc % NCHUNK, b = bc / NCHUNK, row0 = chunk_row0(b, c), ch0 = cg * 128;
    LAS float* S = (LAS float*)lds;
#pragma unroll 4
    for (int p = 0; p < 16; ++p) { const int e = p * 512 + tid, arr = e >> 11, rem = e & 2047, tok = rem >> 5, c4 = rem & 31;
        const float* src = ((arr & 1) ? LU : LA) + ((size_t)(arr >> 1) * MROWS + row0 + tok) * 1024 + ch0 + c4 * 4;
        *(LAS f32x4*)(S + (arr * 64 + tok) * 128 + c4 * 4) = *(const f32x4*)src; }
    __syncthreads();
    if (tid < 256) {
        const int dir = tid >> 7, ch = tid & 127;
        float h = 0.f;
        const float* ag = AGG + ((size_t)(dir * NB + b) * NCHUNK * 1024 + ch0 + ch) * 2;
#define AGG_STEP(cc) do { const f32x2_t q_ = *(const f32x2_t*)(ag + (size_t)(cc) * 2048); h = q_[0] * h + q_[1]; } while (0)
        if (dir == 0) {
#pragma unroll 4
            for (int cc = 0; cc < c; ++cc) AGG_STEP(cc);
        } else if (c < 4) { for (int cc = 3; cc > c; --cc) AGG_STEP(cc); }
        else { for (int cc = 3; cc >= 0; --cc) AGG_STEP(cc);
#pragma unroll 4
               for (int cc = NCHUNK - 1; cc > c; --cc) AGG_STEP(cc); }
#undef AGG_STEP
        LAS float* sa = S + (dir * 2) * 64 * 128 + ch; LAS float* su = sa + 64 * 128;
#pragma unroll 8
        for (int t = 0; t < 64; ++t) { const int tt = dir ? 63 - t : t; h = sa[tt * 128] * h + su[tt * 128]; su[tt * 128] = h; }
    }
    __syncthreads();
#pragma unroll
    for (int p = 0; p < 4; ++p) { const int e = p * 512 + tid, tok = e >> 5, c4 = e & 31;
        const f32x4 hf = *(const LAS f32x4*)(S + (1 * 64 + tok) * 128 + c4 * 4), hb = *(const LAS f32x4*)(S + (3 * 64 + tok) * 128 + c4 * 4);
        const size_t oi = (size_t)(row0 + tok) * 3072 + 2048 + ch0 + c4 * 4; const u32x2 gw = *(const u32x2*)(GP + oi);
        u32x2 w; w.x = cvt_pk((hf[0] + hb[0]) * bflo(gw.x), (hf[1] + hb[1]) * bfhi(gw.x)); w.y = cvt_pk((hf[2] + hb[2]) * bflo(gw.y), (hf[3] + hb[3]) * bfhi(gw.y));
        *(u32x2*)(O + oi) = w; }
    __syncthreads();
}

__device__ __forceinline__ void transpose_item(const float* __restrict__ W, int ld_src, int k0, int n0src, const float* __restrict__ kscale, bf16_t* __restrict__ WT, int ldt, int n0dst, LAS float* scr, int lane) {
#pragma unroll 8
    for (int i = 0; i < 32; ++i) { const int kk = 2 * i + (lane >> 5); float v = W[(size_t)(k0 + kk) * ld_src + n0src + (lane & 31)]; if (kscale) v *= kscale[k0 + kk]; scr[kk * 33 + (lane & 31)] = v; }
    asm volatile("s_waitcnt lgkmcnt(0)" ::: "memory"); __builtin_amdgcn_wave_barrier();
    const int c = lane & 7;
#pragma unroll
    for (int jn = 0; jn < 4; ++jn) { const int n = (lane >> 3) + 8 * jn; const LAS float* s = scr + (8 * c) * 33 + n;
        u32x4 o; o.x = cvt_pk(s[0 * 33], s[1 * 33]); o.y = cvt_pk(s[2 * 33], s[3 * 33]); o.z = cvt_pk(s[4 * 33], s[5 * 33]); o.w = cvt_pk(s[6 * 33], s[7 * 33]);
        *(u32x4*)(WT + (size_t)(n0dst + n) * ldt + k0 + 8 * c) = o; }
    asm volatile("s_waitcnt lgkmcnt(0)" ::: "memory"); __builtin_amdgcn_wave_barrier();
}


#define XB_TMO      128
#define XB_XCNT(j)  (256  + 64 * (j))
#define XB_XSUB(j)  (1280 + 64 * (j))
#define XB_XGEN(j)  (2304 + 64 * (j))
#define XB_TOP      3328
#define XB_TOPGEN   3392
#define XCD_BAR_WORDS 3456
#define XB_SPIN_CAP (1u << 22)
__device__ __forceinline__ unsigned xb_ld(unsigned* p)              { return __hip_atomic_load(p, __ATOMIC_RELAXED, __HIP_MEMORY_SCOPE_AGENT); }
__device__ __forceinline__ unsigned xb_add(unsigned* p, unsigned v) { return __hip_atomic_fetch_add(p, v, __ATOMIC_RELAXED, __HIP_MEMORY_SCOPE_AGENT); }
__device__ __forceinline__ unsigned xb_xcc_id() { return (unsigned)__builtin_amdgcn_s_getreg((3 << 11) | 20) & 0xFu; }
#define XB_SPIN(cond, bar) do { unsigned _sp = 0; while (cond) { __builtin_amdgcn_s_sleep(1); \
    if ((++_sp & 255u) == 0u) { if (xb_ld(&(bar)[XB_TMO])) break; if (_sp > XB_SPIN_CAP) { atomicAdd(&(bar)[XB_TMO], 1u); break; } } } } while (0)
struct XcdBarrier { unsigned* bar; unsigned x; volatile LAS unsigned* st; };
__device__ __forceinline__ XcdBarrier xcd_barrier_post(unsigned* bar, volatile LAS unsigned* st) {
    XcdBarrier b; b.bar = bar; b.x = xb_xcc_id(); b.st = st;
    if (threadIdx.x == 0) (void)xb_add(&bar[XB_XCNT(b.x)], 1u);
    return b;
}
__device__ __forceinline__ void xcd_barrier_complete(unsigned* bar, unsigned x, unsigned& nloc, unsigned& nx) {
    const unsigned G = gridDim.x * gridDim.y * gridDim.z;
    unsigned sum, cnt, mine, sp = 0u;
    for (;;) {
        sum = 0u; cnt = 0u; mine = 0u;
#pragma unroll
        for (unsigned j = 0; j < 16; ++j) { const unsigned c = xb_ld(&bar[XB_XCNT(j)]); sum += c; cnt += (c > 0u) ? 1u : 0u; mine = (j == x) ? c : mine; }
        if (sum == G) break;
        __builtin_amdgcn_s_sleep(1);
        if ((++sp & 255u) == 0u) { if (xb_ld(&bar[XB_TMO])) break; if (sp > XB_SPIN_CAP) { atomicAdd(&bar[XB_TMO], 1u); break; } }
    }
    nloc = mine > 0u ? mine : 1u; nx = cnt > 0u ? cnt : 1u;
}
__device__ __forceinline__ void xcd_barrier(const XcdBarrier& b) {
    asm volatile("s_waitcnt vmcnt(0)" ::: "memory");
    __syncthreads();
    if (threadIdx.x == 0) {
        unsigned* bar = b.bar;
        __builtin_amdgcn_s_waitcnt(0);
        unsigned nloc = b.st[0], nx = b.st[1];
        if (nloc == 0u) { xcd_barrier_complete(bar, b.x, nloc, nx); b.st[0] = nloc; b.st[1] = nx; }
        const unsigned old = xb_add(&bar[XB_XSUB(b.x)], 1u);
        const unsigned gen = old / nloc;
        if (old + 1u == (gen + 1u) * nloc) {
            __builtin_amdgcn_fence(__ATOMIC_RELEASE, "agent");
            asm volatile("s_waitcnt vmcnt(0)" ::: "memory");
            const unsigned og = xb_add(&bar[XB_TOP], 1u);
            const unsigned tg = og / nx;
            if (og + 1u == (tg + 1u) * nx) xb_add(&bar[XB_TOPGEN], 1u);
            else XB_SPIN(xb_ld(&bar[XB_TOPGEN]) == tg, bar);
            __builtin_amdgcn_fence(__ATOMIC_ACQUIRE, "agent");
            xb_add(&bar[XB_XGEN(b.x)], 1u);
            asm volatile("s_waitcnt vmcnt(0)" ::: "memory");
        } else {
            XB_SPIN(xb_ld(&bar[XB_XGEN(b.x)]) == gen, bar);
            __builtin_amdgcn_fence(__ATOMIC_ACQUIRE, "agent");
            asm volatile("s_waitcnt vmcnt(0)" ::: "memory");
        }
    }
    __syncthreads();
}
#define GRID_SYNC() do { asm volatile("s_waitcnt vmcnt(0) lgkmcnt(0)" ::: "memory"); grid.sync(); \
    if (threadIdx.x < 64) asm volatile("buffer_inv sc1\n\ts_waitcnt vmcnt(0)" ::: "memory"); __syncthreads(); } while (0)
__device__ __forceinline__ unsigned char* opaque_p(unsigned char* p) { asm volatile("" : "+s"(p)); return p; }
__device__ __forceinline__ int opaque_s(int x) { asm volatile("" : "+s"(x)); return x; }
#define x_in (args.in[0])
#define c_in (args.in[1])
#define ctx_in (args.in[2])
#define cctx_in (args.in[3])
#define ada_w (args.in[4])
#define ada_b (args.in[5])
#define norm_g (args.in[6])
#define w_in (args.in[7])
#define qng (args.in[8])
#define kvng (args.in[9])
#define w_uq (args.in[10])
#define w_ukv (args.in[11])
#define rel_bias (args.in[12])
#define conv_w (args.in[13])
#define conv_b (args.in[14])
#define w_gate (args.in[15])
#define b_gate (args.in[16])
#define lam_in (args.in[17])
#define w_branch (args.in[18])
#define w_out (args.in[19])
#define fng (args.in[20])
#define WIN ((bf16_t*)(ws + WS_WIN))
#define WUQ ((bf16_t*)(ws + WS_WUQ))
#define WUKV ((bf16_t*)(ws + WS_WUKV))
#define WBR ((bf16_t*)(ws + WS_WBR))
#define WOUT ((bf16_t*)(ws + WS_WOUT))
#define WG ((bf16_t*)(ws + WS_WG))
#define MOD ((float*)(ws + WS_MOD))
#define ROPE ((float*)(ws + WS_ROPE))
#define XCUR ((float*)(ws + WS_XCUR))
#define HB ((bf16_t*)(ws + WS_H))
#define PMIX ((bf16_t*)(ws + WS_PMIX))
#define GP ((bf16_t*)(ws + WS_GP))
#define MG ((bf16_t*)(ws + WS_MG))
#define RSQ ((float*)(ws + WS_RSQ))
#define QB ((bf16_t*)(ws + WS_Q))
#define KVB ((bf16_t*)(ws + WS_KV))
#define KRB ((bf16_t*)(ws + WS_KR))
#define LA ((float*)(ws + WS_LA))
#define LU ((float*)(ws + WS_LU))
#define AGG ((float*)(ws + WS_AGG))
#define OB ((bf16_t*)(ws + WS_O))
#define MTMP LA
__global__ void __launch_bounds__(512, 2) mk_fwd(Args args) {
    extern __shared__ __attribute__((aligned(16))) unsigned char lds_raw[];
    cg::grid_group grid = cg::this_grid();
    LAS unsigned char* lds = (LAS unsigned char*)lds_raw;
    volatile LAS unsigned* xb_st = (volatile LAS unsigned*)(lds + LDS_BYTES - 64);
    if (threadIdx.x == 0) { xb_st[0] = 0u; xb_st[1] = 0u; }
    __syncthreads();
    (void)xcd_barrier_post((unsigned*)(args.ws + WS_BAR), xb_st);
#define XSYNC() do { XcdBarrier b_; b_.bar = (unsigned*)(args.ws + WS_BAR); b_.x = xb_xcc_id(); b_.st = (volatile LAS unsigned*)(lds + LDS_BYTES - 64); xcd_barrier(b_); } while (0)
#define PHASE_IDS const int tid = opaque_v(threadIdx.x), lane = tid & 63, wid = __builtin_amdgcn_readfirstlane(tid >> 6), G = opaque_s(gridDim.x), bid = opaque_s(blockIdx.x), NGW = G * 8, gw = bid * 8 + wid; unsigned char* ws = args.ws + (size_t)(unsigned)opaque_s(0); (void)lane; (void)gw; (void)NGW; (void)ws; (void)tid;

    {
        PHASE_IDS
        LAS float* scr = (LAS float*)(lds + wid * 8448);
        constexpr int I_IN = 32 * 442, I_UQ = 8 * 48, I_UKV = 4 * 64, I_BR = 3 * 16 * 64, I_OUT = 32 * 64, I_G = 32 * 4, I_L = I_IN + I_UQ + I_UKV + I_BR + I_OUT + I_G;
        for (int it = gw; it < DEPTH * I_L; it += NGW) {
            const int L = it / I_L; int r = it - L * I_L;
            if (r < I_IN) { const int kb = r / 442, nb = r % 442, n0 = nb * 32;
                transpose_item(w_in + (size_t)L * DM * NIN, NIN, kb * 64, n0, nullptr, WIN + (size_t)L * NINP * DM, DM, n0 < NMIX ? n0 : n0 + (NMIXP - NMIX), scr, lane); continue; } r -= I_IN;
            if (r < I_UQ) { const int kb = r / 48, nb = r % 48;
                transpose_item(w_uq + (size_t)L * 512 * 1536, 1536, kb * 64, nb * 32, qng + L * 512, WUQ + (size_t)L * 1536 * 512, 512, nb * 32, scr, lane); continue; } r -= I_UQ;
            if (r < I_UKV) { const int kb = r / 64, nb = r % 64;
                transpose_item(w_ukv + (size_t)L * 256 * 2048, 2048, kb * 64, nb * 32, kvng + L * 256, WUKV + (size_t)L * 2048 * 256, 256, nb * 32, scr, lane); continue; } r -= I_UKV;
            if (r < I_BR) { const int n3 = r / 1024, rr = r % 1024, kb = rr / 64, nb = rr % 64;
                transpose_item(w_branch + ((size_t)L * 3 + n3) * 1024 * 2048, 2048, kb * 64, nb * 32, nullptr, WBR + ((size_t)L * 3 + n3) * 2048 * 1024, 1024, nb * 32, scr, lane); continue; } r -= I_BR;
            if (r < I_OUT) { const int kb = r / 64, nb = r % 64;
                transpose_item(w_out + (size_t)L * DM * DM, DM, kb * 64, nb * 32, nullptr, WOUT + (size_t)L * DM * DM, DM, nb * 32, scr, lane); continue; } r -= I_OUT;
            { const int db = r / 4, nb = r % 4;
              transpose_item(w_gate + ((size_t)L * 32 + db) * 64 * 128, 128, 0, nb * 32, nullptr, WG + ((size_t)L * 32 + db) * 128 * 64, 64, nb * 32, scr, lane); }
        }
        for (int i = bid * 512 + tid; i < DEPTH * (NMIXP - NMIX) * (DM / 8); i += G * 512) {
            const int L = i / ((NMIXP - NMIX) * (DM / 8)), r = i % ((NMIXP - NMIX) * (DM / 8));
            *(u32x4*)(WIN + ((size_t)L * NINP + NMIX) * DM + (size_t)r * 8) = (u32x4){0u, 0u, 0u, 0u};
        }
        __syncthreads();
        LAS float* sil = (LAS float*)(lds + 69632);
        LAS float* red = (LAS float*)(lds + 69632 + 40960);
        for (int i = tid; i < 5 * 2048; i += 512) { const float v = i < 4 * 2048 ? c_in[i] : cctx_in[i - 4 * 2048]; sil[i] = v * (1.f / (1.f + expf(-v))); }
        __syncthreads();
        for (int it = bid; it < DEPTH * 96; it += G) {
            const int L = it / 96, cb = it % 96, ksl = tid >> 6, col = cb * 64 + (tid & 63);
            float a5[5] = {0.f, 0.f, 0.f, 0.f, 0.f};
            const float* wp = ada_w + (size_t)L * DM * 6144 + col;
            for (int k = ksl * 256; k < ksl * 256 + 256; ++k) { const float w = wp[(size_t)k * 6144];
#pragma unroll
                for (int r = 0; r < 5; ++r) a5[r] += sil[r * 2048 + k] * w; }
#pragma unroll
            for (int r = 0; r < 5; ++r) red[(ksl * 5 + r) * 64 + (tid & 63)] = a5[r];
            __syncthreads();
            if (tid < 320) { const int r = tid >> 6, cc = tid & 63; float s = 0.f;
#pragma unroll
                for (int k = 0; k < 8; ++k) s += red[(k * 5 + r) * 64 + cc];
                MOD[((size_t)L * 5 + r) * 6144 + cb * 64 + cc] = s + ada_b[(size_t)L * 6144 + cb * 64 + cc]; }
            __syncthreads();
        }
        if (bid == G - 1) for (int i = tid; i < 1024; i += 512) { const int pos = i >> 4, k = i & 15;
            const float inv = 1.0f / powf(10000.f, (float)k * (1.f / 16.f)), ang = (float)pos * inv; ROPE[2 * i] = cosf(ang); ROPE[2 * i + 1] = sinf(ang); }
    }
    GRID_SYNC();

    for (int layer = 0; layer < DEPTH; ++layer) {
        const bool need_ctx = layer < DEPTH - 1;
        { PHASE_IDS
        for (int row = gw; row < MROWS; row += NGW) {
            const bool lat = row < NLAT;
            const float* src = (layer == 0) ? (lat ? x_in + (size_t)row * DM : ctx_in + (size_t)(row - NLAT) * DM) : XCUR + (size_t)row * DM;
            const float* mr = MOD + (size_t)layer * 5 * 6144 + (size_t)(lat ? (row >> 12) : 4) * 6144;
            f32x4 v[8]; float ss = 0.f;
#pragma unroll
            for (int jv = 0; jv < 8; ++jv) { v[jv] = *(const f32x4*)(src + 4 * (lane + 64 * jv)); ss += (v[jv][0] * v[jv][0] + v[jv][1] * v[jv][1]) + (v[jv][2] * v[jv][2] + v[jv][3] * v[jv][3]); }
            const float rinv = rsqrtf(wave_sum(ss, lane) * (1.f / DM) + EPS);
#pragma unroll
            for (int jv = 0; jv < 8; ++jv) { const int col = 4 * (lane + 64 * jv);
                const f32x4 gg = *(const f32x4*)(norm_g + layer * DM + col), sh = *(const f32x4*)(mr + col), sc = *(const f32x4*)(mr + 2048 + col);
                const f32x4 hh = (v[jv] * rinv * gg) * (sc + 1.f) + sh;
                u32x2 w; w.x = cvt_pk(hh[0], hh[1]); w.y = cvt_pk(hh[2], hh[3]); *(u32x2*)(HB + (size_t)row * DM + col) = w; }
        } }
        XSYNC();
        {
            PHASE_IDS
            pg8::Gemm g{HB, WIN + (size_t)layer * NINP * DM, DM, DM, DM, 0, 0}; pg8::Sched S; S.init(MROWS, NINP, G, bid, 1);
            EpiIn E{PMIX, GP, MG, RSQ};
            pg8::gemm_phase<EpiIn>(lds, g, S, E);
        }
        XSYNC();
        {
            PHASE_IDS
            { pg8::Gemm g{PMIX, WUQ + (size_t)layer * 1536 * 512, NMIXP, 512, 512, 0, 0}; pg8::Sched S; S.init(MROWS, 1536, G, bid, 1);
              EpiQ E{QB, RSQ, ROPE}; pg8::gemm_phase<EpiQ>(lds, g, S, E); }
            { pg8::Gemm g{PMIX + 512, WUKV + (size_t)layer * 2048 * 256, NMIXP, 256, 256, 0, 0}; pg8::Sched S; S.init(MROWS, 2048, G, bid, 1);
              EpiKV E{KVB, RSQ}; pg8::gemm_phase<EpiKV>(lds, g, S, E); }
            for (int i = bid * 512 + tid; i < MROWS * 4; i += G * 512) {
                const int row = i >> 2, hf = (i >> 1) & 1, sub = i & 1;
                const bf16_t* src = PMIX + (size_t)row * NMIXP + O_KR + 32 * hf + 8 * sub;
                u32x4 a = *(const u32x4*)src, b2 = *(const u32x4*)(src + 16);
                if (row < NLAT) {
                    const int s = row & 4095, pos = hf ? (s & 63) : (s >> 6);
                    const float* cp = ROPE + (pos * 16 + 8 * sub) * 2;
                    float x1[8] = {bflo(a.x), bfhi(a.x), bflo(a.y), bfhi(a.y), bflo(a.z), bfhi(a.z), bflo(a.w), bfhi(a.w)};
                    float x2[8] = {bflo(b2.x), bfhi(b2.x), bflo(b2.y), bfhi(b2.y), bflo(b2.z), bfhi(b2.z), bflo(b2.w), bfhi(b2.w)};
                    float o1[8], o2[8];
#pragma unroll
                    for (int e = 0; e < 8; ++e) { const float cv = cp[2 * e], sv = cp[2 * e + 1]; o1[e] = x1[e] * cv - x2[e] * sv; o2[e] = x1[e] * sv + x2[e] * cv; }
                    a.x = cvt_pk(o1[0], o1[1]); a.y = cvt_pk(o1[2], o1[3]); a.z = cvt_pk(o1[4], o1[5]); a.w = cvt_pk(o1[6], o1[7]);
                    b2.x = cvt_pk(o2[0], o2[1]); b2.y = cvt_pk(o2[2], o2[3]); b2.z = cvt_pk(o2[4], o2[5]); b2.w = cvt_pk(o2[6], o2[7]);
                }
                bf16_t* dst = KRB + (size_t)row * 64 + 32 * hf + 8 * sub;
                *(u32x4*)dst = a; *(u32x4*)(dst + 16) = b2;
            }
            __syncthreads();
            for (int it = bid; it < (MROWS / 64) * 16; it += G)
                lru_gate_item(PMIX, WG + (size_t)layer * 32 * 128 * 64, conv_w + (size_t)layer * 4 * 1024, conv_b + (size_t)layer * 1024, b_gate + (size_t)layer * 2 * 2048, lam_in + (size_t)layer * 2 * 1024, LA, LU, it, lds);
        }
        XSYNC();
        {
            PHASE_IDS
            const int nmla = 512 + (need_ctx ? 32 : 0);
            for (int u = bid; u < nmla; u += G) {
                if (u < 512) { const int b = u >> 7, h = (u >> 4) & 7, qb = u & 15;
                    mla::attn_unit(QB, KVB, KRB, GP, OB, b * 4096 + qb * 256, h, b * 4096, NLAT + b * 256, 64, 68, (char*)lds_raw); }
                else { const int b = (u - 512) >> 3, h = (u - 512) & 7;
                    mla::attn_unit(QB, KVB, KRB, GP, OB, NLAT + b * 256, h, 0, NLAT + b * 256, 0, 4, (char*)lds_raw); }
            }
            __syncthreads();
            const int nna = 8192 + (need_ctx ? 512 : 0);
            for (int it = gw; it < nna; it += NGW) na_item(PMIX, GP, OB, rel_bias + (size_t)layer * 16 * 15 * 31, it, lane, lds + wid * 4608);
            for (int it = bid; it < (NB * NCHUNK * 2 * 256) / 512; it += G) lru_pass1_item(LA, LU, AGG, it);
        }
        XSYNC();
        { PHASE_IDS
        for (int it = bid; it < NB * NCHUNK * 8; it += G) lru_pass3_item(LA, LU, AGG, GP, OB, it, lds); }
        XSYNC();
        {
            PHASE_IDS
            const int Mrows = need_ctx ? MROWS : NLAT;
            pg8::Gemm g{OB, WBR + (size_t)layer * 3 * 2048 * 1024, 3072, 1024, 1024, 1024, (size_t)2048 * 1024}; pg8::Sched S; S.init(Mrows, DM, G, bid, 3);
            EpiMerge E{MG, MTMP, HB}; pg8::gemm_phase<EpiMerge>(lds, g, S, E);
        }
        XSYNC();
        {
            PHASE_IDS
            const int Mrows = need_ctx ? MROWS : NLAT;
            pg8::Gemm g{HB, WOUT + (size_t)layer * DM * DM, DM, DM, DM, 0, 0}; pg8::Sched S; S.init(Mrows, DM, G, bid, 1);
            EpiOut E{x_in, ctx_in, XCUR, MOD + (size_t)layer * 5 * 6144, layer}; pg8::gemm_phase<EpiOut>(lds, g, S, E);
        }
        XSYNC();
    }
    { PHASE_IDS
    for (int row = gw; row < NLAT; row += NGW) {
        const float* src = XCUR + (size_t)row * DM;
        f32x4 v[8]; float ss = 0.f;
#pragma unroll
        for (int jv = 0; jv < 8; ++jv) { v[jv] = *(const f32x4*)(src + 4 * (lane + 64 * jv)); ss += (v[jv][0] * v[jv][0] + v[jv][1] * v[jv][1]) + (v[jv][2] * v[jv][2] + v[jv][3] * v[jv][3]); }
        const float rinv = rsqrtf(wave_sum(ss, lane) * (1.f / DM) + EPS);
#pragma unroll
        for (int jv = 0; jv < 8; ++jv) { const int col = 4 * (lane + 64 * jv); *(f32x4*)(args.out + (size_t)row * DM + col) = v[jv] * rinv * *(const f32x4*)(fng + col); }
    } }
}

extern "C" void kernel_launch(void* const* d_in, const int* in_sizes, int n_in, void* d_out, int out_size, void* d_ws, size_t ws_size, hipStream_t stream) {
    static int grid = 0;
    if (grid == 0) {
        if (n_in != 21 || ws_size < WS_END) { fprintf(stderr, "kernel_launch: n_in %d ws %zu (need %zu): nothing launched\n", n_in, ws_size, (size_t)WS_END); grid = -1; return; }
        int dev = 0, cus = 0, per_cu = 0;
        if (hipGetDevice(&dev) != hipSuccess || hipDeviceGetAttribute(&cus, hipDeviceAttributeMultiprocessorCount, dev) != hipSuccess) { grid = -1; return; }
        if (hipFuncSetAttribute((const void*)mk_fwd, hipFuncAttributeMaxDynamicSharedMemorySize, LDS_BYTES) != hipSuccess) { fprintf(stderr, "hipFuncSetAttribute failed\n"); grid = -1; return; }
        if (hipOccupancyMaxActiveBlocksPerMultiprocessor(&per_cu, (const void*)mk_fwd, 512, LDS_BYTES) != hipSuccess || per_cu < 1) { fprintf(stderr, "occupancy query: %d\n", per_cu); per_cu = 1; }
        (void)hipGetLastError();
        grid = cus * per_cu;
    }
    if (grid < 0) return;
    if (hipMemsetAsync((char*)d_ws + WS_BAR, 0, 16384, stream) != hipSuccess) { fprintf(stderr, "memset of barrier words failed\n"); return; }
    Args a{};
    for (int i = 0; i < 21; ++i) a.in[i] = (const float*)d_in[i];
    a.out = (float*)d_out; a.ws = (unsigned char*)d_ws;
    void* kargs[] = {&a};
    hipError_t e = hipLaunchCooperativeKernel((const void*)mk_fwd, dim3(grid), dim3(512), kargs, LDS_BYTES, stream);
    if (e != hipSuccess) fprintf(stderr, "cooperative launch failed: %s (grid %d)\n", hipGetErrorString(e), grid);
}
```

```cpp
#include <hip/hip_runtime.h>
#include <hip/hip_cooperative_groups.h>
#include <cstdio>
#include <cstdint>
namespace cg = cooperative_groups;

typedef unsigned short bf16_t;
typedef short bf16x8 __attribute__((ext_vector_type(8)));
typedef float f32x4 __attribute__((ext_vector_type(4)));
typedef float f32x16 __attribute__((ext_vector_type(16)));
typedef unsigned u32x4 __attribute__((ext_vector_type(4)));
typedef unsigned u32x2 __attribute__((ext_vector_type(2)));
#define LAS __attribute__((address_space(3)))

constexpr int DM = 2048, NB = 4, SEQ = 4096, NCTXT = 256, DEPTH = 4;
constexpr int NLAT = NB * SEQ, NCTX = NB * NCTXT, MROWS = NLAT + NCTX;
constexpr int NMIX = 4928, NMIXP = 5120, NGP = 3072, NMG = 6144, NINP = NMIXP + NGP + NMG, NIN = 14144;
constexpr int O_KR = 768, O_NAQ = 832, O_NAK = 1856, O_NAV = 2880, O_PX = 3904;
constexpr float EPS = 1e-6f, LOG2E = 1.4426950408889634f;
constexpr float C_MLA = 0.07216878364870322f * LOG2E;
constexpr float C_NA = 0.125f * LOG2E;
constexpr int NCHUNK = 68;

constexpr size_t al256(size_t x) { return (x + 255) / 256 * 256; }
constexpr size_t WS_WIN = 0;
constexpr size_t WS_WUQ = WS_WIN + al256((size_t)DEPTH * NINP * DM * 2);
constexpr size_t WS_WUKV = WS_WUQ + al256((size_t)DEPTH * 1536 * 512 * 2);
constexpr size_t WS_WBR = WS_WUKV + al256((size_t)DEPTH * 2048 * 256 * 2);
constexpr size_t WS_WOUT = WS_WBR + al256((size_t)DEPTH * 3 * 2048 * 1024 * 2);
constexpr size_t WS_WG = WS_WOUT + al256((size_t)DEPTH * 2048 * 2048 * 2);
constexpr size_t WS_MOD = WS_WG + al256((size_t)DEPTH * 2 * 16 * 128 * 64 * 2);
constexpr size_t WS_ROPE = WS_MOD + al256((size_t)DEPTH * 5 * 6144 * 4);
constexpr size_t WS_XCUR = WS_ROPE + al256((size_t)64 * 16 * 2 * 4);
constexpr size_t WS_H = WS_XCUR + al256((size_t)MROWS * DM * 4);
constexpr size_t WS_PMIX = WS_H + al256((size_t)MROWS * DM * 2);
constexpr size_t WS_GP = WS_PMIX + al256((size_t)MROWS * NMIXP * 2);
constexpr size_t WS_MG = WS_GP + al256((size_t)MROWS * NGP * 2);
constexpr size_t WS_RSQ = WS_MG + al256((size_t)MROWS * NMG * 2);
constexpr size_t WS_Q = WS_RSQ + al256((size_t)MROWS * 12 * 4);
constexpr size_t WS_KV = WS_Q + al256((size_t)MROWS * 1536 * 2);
constexpr size_t WS_KR = WS_KV + al256((size_t)MROWS * 2048 * 2);
constexpr size_t WS_LA = WS_KR + al256((size_t)MROWS * 64 * 2);
constexpr size_t WS_LU = WS_LA + al256((size_t)2 * MROWS * 1024 * 4);
constexpr size_t WS_AGG = WS_LU + al256((size_t)2 * MROWS * 1024 * 4);
constexpr size_t WS_O = WS_AGG + al256((size_t)2 * NB * NCHUNK * 1024 * 2 * 4);
constexpr size_t WS_BAR = WS_O + al256((size_t)MROWS * 3072 * 2);
constexpr size_t WS_END = WS_BAR + 16384;

constexpr int LDS_BYTES = 147456;

struct Args { const float* in[21]; float* out; unsigned char* ws; };

typedef float f32x2_t __attribute__((ext_vector_type(2))); typedef __bf16 bf16x2_t __attribute__((ext_vector_type(2)));
__device__ __forceinline__ unsigned cvt_pk(float lo, float hi) { f32x2_t v = {lo, hi}; bf16x2_t b = __builtin_convertvector(v, bf16x2_t); return __builtin_bit_cast(unsigned, b); }
__device__ __forceinline__ float bflo(unsigned u) { return __uint_as_float(u << 16); }
__device__ __forceinline__ float bfhi(unsigned u) { return __uint_as_float(u & 0xffff0000u); }
__device__ __forceinline__ float bf1(bf16_t u) { return __uint_as_float(((unsigned)u) << 16); }
__device__ __forceinline__ u32x4 pack8(f32x4 a, f32x4 b) { u32x4 w; w.x = cvt_pk(a[0], a[1]); w.y = cvt_pk(a[2], a[3]); w.z = cvt_pk(b[0], b[1]); w.w = cvt_pk(b[2], b[3]); return w; }
__device__ __forceinline__ float sigmoidf_(float x) { return __builtin_amdgcn_rcpf(1.f + __expf(-x)); }
__device__ __forceinline__ float shx(float v, int lane, int m) { return __int_as_float(__builtin_amdgcn_ds_bpermute((lane ^ m) << 2, __float_as_int(v))); }
__device__ __forceinline__ float wave_sum(float v, int lane) {
#pragma unroll
    for (int o = 1; o < 64; o <<= 1) v += shx(v, lane, o);
    return v;
}
__device__ __forceinline__ int opaque_v(int x) { asm volatile("" : "+v"(x)); return x; }
__device__ __forceinline__ int crow(int r, int hi) { return (r & 3) + 8 * (r >> 2) + 4 * hi; }

namespace pg8 {
constexpr int BM = 256, BK = 64, HALF = 128, HTB = HALF * BK * 2, NXCD = 8, WGM = 8;
__host__ __device__ __forceinline__ int lds_byte(int r, int c) { const int st = (r >> 4) * 2 + (c >> 5), rr = r & 15, cc = c & 31, ob = rr * 64 + cc * 2; return st * 1024 + (ob ^ (((ob >> 9) & 1) << 5)); }
__host__ __device__ __forceinline__ void stage_rc(int b, int& R, int& C) { const int st = b / 1024, sb = b % 1024, swz = sb ^ (((sb >> 9) & 1) << 5); R = (st >> 1) * 16 + swz / 64; C = (st & 1) * 32 + (swz % 64) / 2; }
__host__ __device__ __forceinline__ int perm32(int rho) { const int n = rho >> 4, i = rho & 15; return 8 * (i >> 2) + 4 * n + (i & 3); }

struct Unit { int pm, pn, z; };
struct Gemm { const bf16_t* A; const bf16_t* Bt; int lda, ldb, K; size_t azs, bzs; };

struct Sched {
    int nM, nN, nwg, G, c, nz;
    __device__ void init(int M, int N, int G_, int c_, int nz_) { nM = M / BM; nN = N / BM; nwg = nM * nN; G = G_; c = c_; nz = nz_; }
    __device__ bool next(int i, Unit& u) const {
        const int it = i / nz; u.z = i - it * nz;
        const long L = (long)it * G + c; if (L >= nwg) return false;
        int wgid = (int)L; { const int q = nwg / NXCD, r = nwg % NXCD, xcd = wgid % NXCD, off = wgid / NXCD; wgid = (xcd < r ? xcd * (q + 1) : r * (q + 1) + (xcd - r) * q) + off; }
        const int nig = WGM * nN, gid = wgid / nig, fm = gid * WGM, gsz = (nM - fm) < WGM ? (nM - fm) : WGM;
        u.pm = fm + ((wgid % nig) % gsz); u.pn = (wgid % nig) / gsz; return true;
    }
};

template <class Epi>
__device__ __forceinline__ void gemm_phase(LAS unsigned char* lds, const Gemm g, const Sched& S, const Epi& E) {
    const int tid = opaque_v(threadIdx.x), wid = __builtin_amdgcn_readfirstlane(tid >> 6), lane = tid & 63, wr = wid >> 2, wc = wid & 3, fr = lane & 15, fq = lane >> 4;
    const int K = g.K, nt = K / BK;
    unsigned voffA[2], voffB[2];
#pragma unroll
    for (int i = 0; i < 2; ++i) { int R, C; stage_rc(tid * 16 + i * 8192, R, C); const int Rb = (R & ~31) + perm32(R & 31);
        voffA[i] = (unsigned)(R * g.lda + C) * 2u; voffB[i] = (unsigned)(Rb * g.ldb + C) * 2u; }
    const size_t kstep = (size_t)(BK * 2);
    const size_t hstepA = (size_t)HALF * g.lda * 2, hstepB = (size_t)HALF * g.ldb * 2;
    const unsigned ldsw = (unsigned)wid * 1024u;
    const int aoff = lds_byte(wr * 64 + fr, fq * 8), boff = lds_byte(wc * 32 + fr, fq * 8);
#define PG8_SA(b, h) (((b) * 2 + (h)) * HTB)
#define PG8_SB(b, h) ((4 + (b) * 2 + (h)) * HTB)
#define PG8_STAGE(bufoff, gbase, voff) do { _Pragma("unroll") for (int _i = 0; _i < 2; ++_i) \
        __builtin_amdgcn_global_load_lds((const unsigned*)((const char*)(gbase) + (voff)[_i]), (LAS unsigned*)(lds + (bufoff) + ldsw + _i * 8192), 16, 0, 0); } while (0)
#define PG8_LDA(dst, b, h) do { _Pragma("unroll") for (int m = 0; m < 4; ++m) _Pragma("unroll") for (int k = 0; k < 2; ++k) dst[m][k] = *(const LAS bf16x8*)(lds + PG8_SA(b, h) + aoff + m * 2048 + k * 1024); } while (0)
#define PG8_LDB(dst, b, h) do { _Pragma("unroll") for (int n = 0; n < 2; ++n) _Pragma("unroll") for (int k = 0; k < 2; ++k) dst[n][k] = *(const LAS bf16x8*)(lds + PG8_SB(b, h) + boff + n * 2048 + k * 1024); } while (0)
#define PG8_MMA(ai, bj, At, Bt) do { __builtin_amdgcn_s_setprio(1); _Pragma("unroll") for (int m = 0; m < 4; ++m) _Pragma("unroll") for (int n = 0; n < 2; ++n) _Pragma("unroll") for (int k = 0; k < 2; ++k) \
        acc[ai][bj][m][n] = __builtin_amdgcn_mfma_f32_16x16x32_bf16(Bt[n][k], At[m][k], acc[ai][bj][m][n], 0, 0, 0); __builtin_amdgcn_s_setprio(0); } while (0)
#define PG8_WAIT_V(n) asm volatile("s_waitcnt vmcnt(" #n ")" ::: "memory")
#define PG8_WAIT_L(n) asm volatile("s_waitcnt lgkmcnt(" #n ")" ::: "memory")
#define PG8_BAR __builtin_amdgcn_s_barrier()
#define PG8_SCHED __builtin_amdgcn_sched_barrier(0)
    Unit cur, nxt; int ui = 0;
    if (!S.next(0, cur)) return;
    f32x4 acc[2][2][4][2];
#pragma unroll
    for (int a = 0; a < 2; ++a)
#pragma unroll
        for (int b = 0; b < 2; ++b)
#pragma unroll
            for (int m = 0; m < 4; ++m)
#pragma unroll
                for (int n = 0; n < 2; ++n) acc[a][b][m][n] = (f32x4){0.f, 0.f, 0.f, 0.f};
    bf16x8 At[4][2], B0[2][2], B1[2][2];
    const char* cA = (const char*)g.A + ((size_t)cur.z * g.azs + (size_t)cur.pm * BM * g.lda) * 2;
    const char* cB = (const char*)g.Bt + ((size_t)cur.z * g.bzs + (size_t)cur.pn * BM * g.ldb) * 2;
    PG8_STAGE(PG8_SB(0, 0), cB, voffB); PG8_STAGE(PG8_SB(0, 1), cB + hstepB, voffB); PG8_STAGE(PG8_SA(0, 0), cA, voffA); PG8_STAGE(PG8_SA(0, 1), cA + hstepA, voffA);
    if (wr == 1) PG8_BAR;
    PG8_WAIT_V(2); PG8_BAR;
    PG8_STAGE(PG8_SB(1, 0), cB + kstep, voffB); PG8_STAGE(PG8_SA(1, 0), cA + kstep, voffA); PG8_STAGE(PG8_SB(1, 1), cB + hstepB + kstep, voffB);
    PG8_WAIT_V(6); PG8_BAR;
    for (;;) {
        const bool has_next = S.next(ui + 1, nxt);
        const char* nA = has_next ? (const char*)g.A + ((size_t)nxt.z * g.azs + (size_t)nxt.pm * BM * g.lda) * 2 : cA;
        const char* nB = has_next ? (const char*)g.Bt + ((size_t)nxt.z * g.bzs + (size_t)nxt.pn * BM * g.ldb) * 2 : cB;
        for (int t = 0; t < nt; t += 2) {
            const bool last = (t == nt - 2);
            const char* a1 = cA + (size_t)(t + 1) * kstep;
            const char* a2 = last ? nA : cA + (size_t)(t + 2) * kstep; const char* b2 = last ? nB : cB + (size_t)(t + 2) * kstep;
            const char* a3 = a2 + kstep; const char* b3 = b2 + kstep;
            PG8_LDB(B0, 0, 0); PG8_LDB(B1, 0, 1); PG8_SCHED; PG8_LDA(At, 0, 0); PG8_STAGE(PG8_SA(1, 1), a1 + hstepA, voffA);
            PG8_WAIT_V(8); PG8_WAIT_L(0); PG8_BAR; PG8_MMA(0, 0, At, B0); PG8_MMA(0, 1, At, B1); PG8_BAR; PG8_SCHED;
            PG8_LDA(At, 0, 1); PG8_STAGE(PG8_SB(0, 0), b2, voffB); PG8_STAGE(PG8_SB(0, 1), b2 + hstepB, voffB); PG8_STAGE(PG8_SA(0, 0), a2, voffA);
            PG8_WAIT_V(8); PG8_WAIT_L(0); PG8_BAR; PG8_MMA(1, 0, At, B0); PG8_MMA(1, 1, At, B1); PG8_BAR; PG8_SCHED;
            PG8_LDB(B0, 1, 0); PG8_LDB(B1, 1, 1); PG8_SCHED; PG8_LDA(At, 1, 0); PG8_STAGE(PG8_SA(0, 1), a2 + hstepA, voffA);
            PG8_WAIT_V(8); PG8_WAIT_L(0); PG8_BAR; PG8_MMA(0, 0, At, B0); PG8_MMA(0, 1, At, B1); PG8_BAR; PG8_SCHED;
            PG8_LDA(At, 1, 1); PG8_STAGE(PG8_SB(1, 0), b3, voffB); PG8_STAGE(PG8_SB(1, 1), b3 + hstepB, voffB); PG8_STAGE(PG8_SA(1, 0), a3, voffA);
            PG8_WAIT_V(8); PG8_WAIT_L(0); PG8_BAR; PG8_MMA(1, 0, At, B0); PG8_MMA(1, 1, At, B1); PG8_BAR; PG8_SCHED;
        }
        if (wr == 0) PG8_BAR;
        { const int l2 = opaque_v(lane); E(acc, cur, wr, wc, l2 & 15, l2 >> 4); }
        if (!has_next) break;
#pragma unroll
        for (int a = 0; a < 2; ++a)
#pragma unroll
            for (int b = 0; b < 2; ++b)
#pragma unroll
                for (int m = 0; m < 4; ++m)
#pragma unroll
                    for (int n = 0; n < 2; ++n) acc[a][b][m][n] = (f32x4){0.f, 0.f, 0.f, 0.f};
        cur = nxt; cA = nA; cB = nB; ++ui;
        if (wr == 1) PG8_BAR;
    }
    PG8_WAIT_V(0);
    PG8_BAR;
#undef PG8_SA
#undef PG8_SB
#undef PG8_STAGE
#undef PG8_LDA
#undef PG8_LDB
#undef PG8_MMA
#undef PG8_WAIT_V
#undef PG8_WAIT_L
#undef PG8_BAR
#undef PG8_SCHED
}
}
typedef f32x4 AccT[2][2][4][2];
#define EPI_FENCE(a, b) asm volatile("" : "+v"(a), "+v"(b) :: "memory")

struct EpiIn {
    bf16_t* pmix; bf16_t* gp; bf16_t* mg; float* rsq;
    __device__ __forceinline__ void operator()(const AccT& acc, const pg8::Unit& u, int wr, int wc, int fr, int fq) const {
        const int row0 = u.pm * 256 + wr * 64 + fr, pn = u.pn;
        if (pn < 20) {
#pragma unroll
            for (int ai = 0; ai < 2; ++ai)
#pragma unroll
                for (int m = 0; m < 4; ++m) {
                    __builtin_amdgcn_sched_barrier(0); const int row = row0 + ai * 128 + m * 16; float ss = 0.f;
#pragma unroll
                    for (int bj = 0; bj < 2; ++bj) {
                        const int col0 = pn * 256 + bj * 128 + wc * 32 + 8 * fq;
                        f32x4 v0 = acc[ai][bj][m][0], v1 = acc[ai][bj][m][1]; EPI_FENCE(v0, v1);
                        ss += (v0[0] * v0[0] + v0[1] * v0[1]) + (v0[2] * v0[2] + v0[3] * v0[3]) + (v1[0] * v1[0] + v1[1] * v1[1]) + (v1[2] * v1[2] + v1[3] * v1[3]);
                        const float sc = (col0 >= O_NAQ && col0 < O_NAK) ? C_NA : 1.f;
                        *(u32x4*)(pmix + (size_t)row * NMIXP + col0) = pack8(v0 * sc, v1 * sc);
                    }
                    if (pn < 3) { ss += shx(ss, fr + 16 * fq, 16); ss += shx(ss, fr + 16 * fq, 32); if (fq == 0) rsq[(size_t)row * 12 + pn * 4 + wc] = ss; }
                }
        } else if (pn < 32) {
#pragma unroll
            for (int ai = 0; ai < 2; ++ai)
#pragma unroll
                for (int m = 0; m < 4; ++m) {
                    __builtin_amdgcn_sched_barrier(0); const int row = row0 + ai * 128 + m * 16;
#pragma unroll
                    for (int bj = 0; bj < 2; ++bj) {
                        const int col0 = (pn - 20) * 256 + bj * 128 + wc * 32 + 8 * fq;
                        f32x4 v0 = acc[ai][bj][m][0], v1 = acc[ai][bj][m][1]; EPI_FENCE(v0, v1);
#pragma unroll
                        for (int e = 0; e < 4; ++e) { v0[e] = v0[e] * sigmoidf_(v0[e]); v1[e] = v1[e] * sigmoidf_(v1[e]); }
                        *(u32x4*)(gp + (size_t)row * NGP + col0) = pack8(v0, v1);
                    }
                }
        } else {
#pragma unroll
            for (int ai = 0; ai < 2; ++ai)
#pragma unroll
                for (int m = 0; m < 4; ++m) {
                    __builtin_amdgcn_sched_barrier(0); const int row = row0 + ai * 128 + m * 16;
#pragma unroll
                    for (int bj = 0; bj < 2; ++bj) {
                        const int col0 = (pn - 32) * 256 + bj * 128 + wc * 32 + 8 * fq;
                        f32x4 v0 = acc[ai][bj][m][0], v1 = acc[ai][bj][m][1]; EPI_FENCE(v0, v1);
#pragma unroll
                        for (int e = 0; e < 4; ++e) { v0[e] = sigmoidf_(v0[e]); v1[e] = sigmoidf_(v1[e]); }
                        *(u32x4*)(mg + (size_t)row * NMG + col0) = pack8(v0, v1);
                    }
                }
        }
    }
};
struct EpiQ {
    bf16_t* q; const float* rsq; const float* cs;
    __device__ __forceinline__ void operator()(const AccT& acc, const pg8::Unit& u, int wr, int wc, int fr, int fq) const {
        const int row0 = u.pm * 256 + wr * 64 + fr, pn = u.pn; const bool lat = u.pm < 64;
#pragma unroll
        for (int ai = 0; ai < 2; ++ai)
#pragma unroll
            for (int m = 0; m < 4; ++m) {
                __builtin_amdgcn_sched_barrier(0); const int row = row0 + ai * 128 + m * 16;
                const f32x4 r0 = *(const f32x4*)(rsq + (size_t)row * 12), r1 = *(const f32x4*)(rsq + (size_t)row * 12 + 4);
                const float ssum = ((r0[0] + r0[1]) + (r0[2] + r0[3])) + ((r1[0] + r1[1]) + (r1[2] + r1[3]));
                const float rinv = rsqrtf(ssum * (1.f / 512.f) + EPS) * C_MLA;
                const int s = row & 4095;
#pragma unroll
                for (int bj = 0; bj < 2; ++bj) {
                    const int g32 = pn * 8 + bj * 4 + wc, t6 = g32 % 6, col0 = g32 * 32 + 8 * fq;
                    f32x4 v0 = acc[ai][bj][m][0], v1 = acc[ai][bj][m][1]; EPI_FENCE(v0, v1); v0 = v0 * rinv; v1 = v1 * rinv;
                    if (t6 >= 4 && lat) {
                        const int pos = (t6 == 4) ? (s >> 6) : (s & 63);
                        const float* cp = cs + (pos * 16 + 8 * (fq & 1)) * 2;
                        const f32x4 c0 = *(const f32x4*)(cp), c1 = *(const f32x4*)(cp + 4), c2 = *(const f32x4*)(cp + 8), c3 = *(const f32x4*)(cp + 12);
                        const float cosv[8] = {c0[0], c0[2], c1[0], c1[2], c2[0], c2[2], c3[0], c3[2]};
                        const float sinv[8] = {c0[1], c0[3], c1[1], c1[3], c2[1], c2[3], c3[1], c3[3]};
                        float x[8] = {v0[0], v0[1], v0[2], v0[3], v1[0], v1[1], v1[2], v1[3]};
#pragma unroll
                        for (int e = 0; e < 8; ++e) { const float p = shx(x[e], fr + 16 * fq, 32); x[e] = (fq < 2) ? (x[e] * cosv[e] - p * sinv[e]) : (p * sinv[e] + x[e] * cosv[e]); }
                        v0 = (f32x4){x[0], x[1], x[2], x[3]}; v1 = (f32x4){x[4], x[5], x[6], x[7]};
                    }
                    *(u32x4*)(q + (size_t)row * 1536 + col0) = pack8(v0, v1);
                }
            }
    }
};
struct EpiKV {
    bf16_t* kv; const float* rsq;
    __device__ __forceinline__ void operator()(const AccT& acc, const pg8::Unit& u, int wr, int wc, int fr, int fq) const {
        const int row0 = u.pm * 256 + wr * 64 + fr, pn = u.pn;
#pragma unroll
        for (int ai = 0; ai < 2; ++ai)
#pragma unroll
            for (int m = 0; m < 4; ++m) {
                __builtin_amdgcn_sched_barrier(0); const int row = row0 + ai * 128 + m * 16;
                const f32x4 r0 = *(const f32x4*)(rsq + (size_t)row * 12 + 8);
                const float rinv = rsqrtf(((r0[0] + r0[1]) + (r0[2] + r0[3])) * (1.f / 256.f) + EPS);
#pragma unroll
                for (int bj = 0; bj < 2; ++bj) {
                    const int col0 = pn * 256 + bj * 128 + wc * 32 + 8 * fq;
                    f32x4 v0 = acc[ai][bj][m][0], v1 = acc[ai][bj][m][1]; EPI_FENCE(v0, v1);
                    *(u32x4*)(kv + (size_t)row * 2048 + col0) = pack8(v0 * rinv, v1 * rinv);
                }
            }
    }
};
struct EpiMerge {
    const bf16_t* mg; float* tmp; bf16_t* merged;
    __device__ __forceinline__ void operator()(const AccT& acc, const pg8::Unit& u, int wr, int wc, int fr, int fq) const {
        const int row0 = u.pm * 256 + wr * 64 + fr, pn = u.pn, z = u.z;
#pragma unroll
        for (int ai = 0; ai < 2; ++ai)
#pragma unroll
            for (int m = 0; m < 4; ++m) {
                __builtin_amdgcn_sched_barrier(0); const int row = row0 + ai * 128 + m * 16;
#pragma unroll
                for (int bj = 0; bj < 2; ++bj) {
                    const int col0 = pn * 256 + bj * 128 + wc * 32 + 8 * fq;
                    const u32x4 gw = *(const u32x4*)(mg + (size_t)row * NMG + z * 2048 + col0);
                    f32x4 v0 = acc[ai][bj][m][0], v1 = acc[ai][bj][m][1]; EPI_FENCE(v0, v1);
                    v0[0] *= bflo(gw.x); v0[1] *= bfhi(gw.x); v0[2] *= bflo(gw.y); v0[3] *= bfhi(gw.y);
                    v1[0] *= bflo(gw.z); v1[1] *= bfhi(gw.z); v1[2] *= bflo(gw.w); v1[3] *= bfhi(gw.w);
                    bf16_t* mp = merged + (size_t)row * 2048 + col0;
                    if (z > 0) { const u32x4 pw = *(const u32x4*)mp;
                        v0[0] += bflo(pw.x); v0[1] += bfhi(pw.x); v0[2] += bflo(pw.y); v0[3] += bfhi(pw.y); v1[0] += bflo(pw.z); v1[1] += bfhi(pw.z); v1[2] += bflo(pw.w); v1[3] += bfhi(pw.w); }
                    *(u32x4*)mp = pack8(v0, v1);
                }
            }
    }
};
struct EpiOut {
    const float* xin; const float* ctxin; float* xcur; const float* mod; int layer;
    __device__ __forceinline__ void operator()(const AccT& acc, const pg8::Unit& u, int wr, int wc, int fr, int fq) const {
        const int row0 = u.pm * 256 + wr * 64 + fr, pn = u.pn; const bool lat = u.pm < 64;
        const float* gt = mod + (size_t)(lat ? (u.pm >> 4) : 4) * 6144 + 4096;
#pragma unroll
        for (int ai = 0; ai < 2; ++ai)
#pragma unroll
            for (int m = 0; m < 4; ++m) {
                __builtin_amdgcn_sched_barrier(0); const int row = row0 + ai * 128 + m * 16;
                const float* xo = (layer == 0) ? (lat ? xin + (size_t)row * 2048 : ctxin + (size_t)(row - NLAT) * 2048) : xcur + (size_t)row * 2048;
#pragma unroll
                for (int bj = 0; bj < 2; ++bj) {
                    const int col0 = pn * 256 + bj * 128 + wc * 32 + 8 * fq;
                    f32x4 v0 = acc[ai][bj][m][0], v1 = acc[ai][bj][m][1]; EPI_FENCE(v0, v1);
                    const f32x4 g0 = *(const f32x4*)(gt + col0), g1 = *(const f32x4*)(gt + col0 + 4);
                    const f32x4 x0 = *(const f32x4*)(xo + col0), x1 = *(const f32x4*)(xo + col0 + 4);
                    *(f32x4*)(xcur + (size_t)row * 2048 + col0) = x0 + g0 * v0;
                    *(f32x4*)(xcur + (size_t)row * 2048 + col0 + 4) = x1 + g1 * v1;
                }
            }
    }
};

namespace mla {
typedef short s16x4 __attribute__((ext_vector_type(4)));
constexpr int SHM_V = 16384, SHM_K = 16384, SHM_KR = 8192;
constexpr int OFF_V = 0, OFF_K = 2 * SHM_V, OFF_KR = OFF_K + 2 * SHM_K, OFF_WS = OFF_KR + 2 * SHM_KR;
constexpr float THR2 = 8.f;
#define KSWZ(row, colB) ((row) * 256 + ((colB) ^ (((row) & 7) << 4)))
#define KRSWZ(row, colB) ((row) * 128 + ((colB) ^ (((row) & 7) << 4)))
#define SBAR() __builtin_amdgcn_sched_barrier(0)
__device__ __forceinline__ void partialSM(f32x16& p0, f32x16& p1, float& m_reg, float& mn, float& alpha) {
    float pmax = p0[0];
#pragma unroll
    for (int r = 1; r < 16; ++r) pmax = fmaxf(pmax, p0[r]);
#pragma unroll
    for (int r = 0; r < 16; ++r) pmax = fmaxf(pmax, p1[r]);
    { auto rr = __builtin_amdgcn_permlane32_swap(__float_as_uint(pmax), __float_as_uint(pmax), false, false);
      pmax = fmaxf(__uint_as_float(rr[0]), __uint_as_float(rr[1])); }
    if (__builtin_expect(__all(pmax - m_reg <= THR2), 1)) { mn = m_reg; alpha = 1.f; }
    else { mn = fmaxf(m_reg, pmax); alpha = __builtin_amdgcn_exp2f(m_reg - mn); m_reg = mn; }
#pragma unroll
    for (int r = 0; r < 16; ++r) p0[r] = p0[r] - mn;
#pragma unroll
    for (int r = 0; r < 16; ++r) p1[r] = p1[r] - mn;
#pragma unroll
    for (int r = 0; r < 16; ++r) p0[r] = __builtin_amdgcn_exp2f(p0[r]);
}
__device__ __forceinline__ void finishSM(f32x16& p0, f32x16& p1, float alpha, float& l_reg, bf16x8& pa0, bf16x8& pa1, bf16x8& pa2, bf16x8& pa3) {
#pragma unroll
    for (int r = 0; r < 16; ++r) p1[r] = __builtin_amdgcn_exp2f(p1[r]);
    float ps = 0;
#pragma unroll
    for (int r = 0; r < 16; ++r) ps += p0[r];
#pragma unroll
    for (int r = 0; r < 16; ++r) ps += p1[r];
    { auto rr = __builtin_amdgcn_permlane32_swap(__float_as_uint(ps), __float_as_uint(ps), false, false);
      ps = __uint_as_float(rr[0]) + __uint_as_float(rr[1]); }
    l_reg = l_reg * alpha + ps;
#define PK4(P, BASE, OUT) do { unsigned a0 = cvt_pk(P[BASE + 0], P[BASE + 1]), a1 = cvt_pk(P[BASE + 2], P[BASE + 3]);   \
    unsigned b0 = cvt_pk(P[BASE + 4], P[BASE + 5]), b1 = cvt_pk(P[BASE + 6], P[BASE + 7]);                              \
    auto r0 = __builtin_amdgcn_permlane32_swap(a0, b0, false, false); auto r1 = __builtin_amdgcn_permlane32_swap(a1, b1, false, false); \
    u32x4 w = {r0[0], r1[0], r0[1], r1[1]}; OUT = *reinterpret_cast<bf16x8*>(&w); } while (0)
    PK4(p0, 0, pa0); PK4(p0, 8, pa1); PK4(p1, 0, pa2); PK4(p1, 8, pa3);
#undef PK4
}
__device__ __forceinline__ void qkt(f32x16& p0, f32x16& p1, const char* Ks, const char* KRs, const bf16x8* qr, int r32, int hi) {
    p0 = f32x16{}; p1 = f32x16{};
#pragma unroll
    for (int d0 = 0; d0 < 8; ++d0) { const int cb = (d0 * 16 + hi * 8) * 2;
        bf16x8 b0 = *reinterpret_cast<const bf16x8*>(Ks + KSWZ(r32, cb));
        bf16x8 b1 = *reinterpret_cast<const bf16x8*>(Ks + KSWZ(32 + r32, cb));
        p0 = __builtin_amdgcn_mfma_f32_32x32x16_bf16(b0, qr[d0], p0, 0, 0, 0);
        p1 = __builtin_amdgcn_mfma_f32_32x32x16_bf16(b1, qr[d0], p1, 0, 0, 0); }
#pragma unroll
    for (int d0 = 0; d0 < 4; ++d0) { const int cb = (d0 * 16 + hi * 8) * 2;
        bf16x8 b0 = *reinterpret_cast<const bf16x8*>(KRs + KRSWZ(r32, cb));
        bf16x8 b1 = *reinterpret_cast<const bf16x8*>(KRs + KRSWZ(32 + r32, cb));
        p0 = __builtin_amdgcn_mfma_f32_32x32x16_bf16(b0, qr[8 + d0], p0, 0, 0, 0);
        p1 = __builtin_amdgcn_mfma_f32_32x32x16_bf16(b1, qr[8 + d0], p1, 0, 0, 0); }
}
__device__ __forceinline__ int v_st(int k, int c) { const int kk = (k & ~0xC) | ((k & 4) << 1) | ((k & 8) >> 1); return ((kk >> 3) * 4 + (c >> 5)) * 512 + ((kk & 7) * 32 + (c & 31)) * 2; }
__device__ __forceinline__ int v_rd_base(int lane) { return ((lane & 3) << 3) | (((lane >> 2) & 3) << 6) | (((lane >> 4) & 1) << 5) | (((lane >> 5) & 1) << 8); }
constexpr int v_rd_off(int d0, int ks, int half) { return d0 * 512 + ks * 4096 + half * 2048; }
template <int OFF> __device__ __forceinline__ s16x4 tr_read(int vb) {
    s16x4 r; asm volatile("ds_read_b64_tr_b16 %0, %1 offset:%2" : "=&v"(r) : "v"(vb), "i"(OFF) : "memory"); return r;
}
template <int D0> __device__ __forceinline__ void pv_one(f32x16& od, int vb, bf16x8 pa0, bf16x8 pa1, bf16x8 pa2, bf16x8 pa3) {
    const s16x4 l0 = tr_read<v_rd_off(D0, 0, 0)>(vb), h0 = tr_read<v_rd_off(D0, 0, 1)>(vb), l1 = tr_read<v_rd_off(D0, 1, 0)>(vb), h1 = tr_read<v_rd_off(D0, 1, 1)>(vb);
    const s16x4 l2 = tr_read<v_rd_off(D0, 2, 0)>(vb), h2 = tr_read<v_rd_off(D0, 2, 1)>(vb), l3 = tr_read<v_rd_off(D0, 3, 0)>(vb), h3 = tr_read<v_rd_off(D0, 3, 1)>(vb);
    asm volatile("s_waitcnt lgkmcnt(0)" ::: "memory"); SBAR();
#define PK(L, H) (bf16x8){L[0], L[1], L[2], L[3], H[0], H[1], H[2], H[3]}
    od = __builtin_amdgcn_mfma_f32_32x32x16_bf16(pa0, PK(l0, h0), od, 0, 0, 0);
    od = __builtin_amdgcn_mfma_f32_32x32x16_bf16(pa1, PK(l1, h1), od, 0, 0, 0);
    od = __builtin_amdgcn_mfma_f32_32x32x16_bf16(pa2, PK(l2, h2), od, 0, 0, 0);
    od = __builtin_amdgcn_mfma_f32_32x32x16_bf16(pa3, PK(l3, h3), od, 0, 0, 0);
#undef PK
}
__device__ __forceinline__ void pv_d0(f32x16* o, int vb, bf16x8 pa0, bf16x8 pa1, bf16x8 pa2, bf16x8 pa3) {
    pv_one<0>(o[0], vb, pa0, pa1, pa2, pa3); pv_one<1>(o[1], vb, pa0, pa1, pa2, pa3); pv_one<2>(o[2], vb, pa0, pa1, pa2, pa3); pv_one<3>(o[3], vb, pa0, pa1, pa2, pa3);
}
__device__ __forceinline__ void attn_unit(const bf16_t* __restrict__ Q, const bf16_t* __restrict__ KV, const bf16_t* __restrict__ KR, const bf16_t* __restrict__ GP, bf16_t* __restrict__ O,
                                          int qrow0, int h, int latbase, int ctxbase, int nlt, int NT, char* lds) {
    const int tid = opaque_v(threadIdx.x), wid = tid >> 6, lane = tid & 63, r32 = lane & 31, hi = lane >> 5;
    char* V_lds = lds + OFF_V; char* K_lds = lds + OFF_K; char* KR_lds = lds + OFF_KR;
    float* ws = (float*)(lds + OFF_WS) + wid * 64; float* li_l = ws; float* al_l = ws + 32;
    float m_reg = -1e30f, l_reg = 0; f32x16 o[4] = {}; bf16x8 qr[12];
    const bf16_t* Qw = Q + (size_t)(qrow0 + wid * 32 + r32) * 1536 + h * 192 + hi * 8;
#pragma unroll
    for (int d0 = 0; d0 < 12; ++d0) qr[d0] = *reinterpret_cast<const bf16x8*>(Qw + d0 * 16);
    const int sr = tid >> 4, sc = (tid & 15) * 8, vst0 = v_st(sr, sc), vst1 = v_st(32 + sr, sc);
    const int krr = tid >> 3, krc = (tid & 7) * 16;
    const int vb0 = (int)(uintptr_t)V_lds + v_rd_base(lane);
    const bf16_t* Kh = KV + h * 256 + sc; const bf16_t* Vh = KV + h * 256 + 128 + sc;
    bf16x8 s_v0, s_v1, s_k0, s_k1, s_kr;
#define TROW(j) ((j) < nlt ? latbase + 64 * (j) : ctxbase + 64 * ((j) - nlt))
#define SLOAD(j) do { const int _rb = TROW(j); \
    s_v0 = *reinterpret_cast<const bf16x8*>(Vh + (size_t)(_rb + sr) * 2048); s_v1 = *reinterpret_cast<const bf16x8*>(Vh + (size_t)(_rb + 32 + sr) * 2048); \
    s_k0 = *reinterpret_cast<const bf16x8*>(Kh + (size_t)(_rb + sr) * 2048); s_k1 = *reinterpret_cast<const bf16x8*>(Kh + (size_t)(_rb + 32 + sr) * 2048); \
    s_kr = *reinterpret_cast<const bf16x8*>((const char*)KR + (size_t)(_rb + krr) * 128 + krc); } while (0)
#define SWRITE(b) do { *(bf16x8*)(V_lds + (b) * SHM_V + vst0) = s_v0; *(bf16x8*)(V_lds + (b) * SHM_V + vst1) = s_v1; const int kc = sc * 2; \
    *(bf16x8*)(K_lds + (b) * SHM_K + KSWZ(sr, kc)) = s_k0; *(bf16x8*)(K_lds + (b) * SHM_K + KSWZ(32 + sr, kc)) = s_k1; \
    *(bf16x8*)(KR_lds + (b) * SHM_KR + KRSWZ(krr, krc)) = s_kr; } while (0)
#define RESC(a) do { if (__any((a) < 1.f)) { if (hi == 0) al_l[r32] = (a); asm volatile("s_waitcnt lgkmcnt(0)" ::: "memory"); \
    _Pragma("unroll") for (int d = 0; d < 4; ++d) _Pragma("unroll") for (int r = 0; r < 16; ++r) o[d][r] *= al_l[crow(r, hi)]; } } while (0)
    f32x16 pA0, pA1, pB0, pB1; float mnA, mnB, alA, alB; bf16x8 pa0, pa1, pa2, pa3;
    SLOAD(0); asm volatile("s_waitcnt vmcnt(0)" ::: "memory"); SWRITE(0); __syncthreads();
    qkt(pA0, pA1, K_lds, KR_lds, qr, r32, hi); partialSM(pA0, pA1, m_reg, mnA, alA);
    SLOAD(1);
    asm volatile("s_waitcnt vmcnt(0)" ::: "memory"); SWRITE(1); __syncthreads();
    for (int j = 1; j + 1 < NT; j += 2) {
        SBAR(); qkt(pB0, pB1, K_lds + SHM_K, KR_lds + SHM_KR, qr, r32, hi);
        finishSM(pA0, pA1, alA, l_reg, pa0, pa1, pa2, pa3); SBAR();
        SLOAD(j + 1); SBAR();
        pv_d0(o, vb0, pa0, pa1, pa2, pa3); partialSM(pB0, pB1, m_reg, mnB, alB);
        __syncthreads(); asm volatile("s_waitcnt vmcnt(0)" ::: "memory"); SWRITE(0);
        RESC(alB); __syncthreads();
        SBAR(); qkt(pA0, pA1, K_lds, KR_lds, qr, r32, hi);
        finishSM(pB0, pB1, alB, l_reg, pa0, pa1, pa2, pa3); SBAR();
        SLOAD(j + 2); SBAR();
        pv_d0(o, vb0 + SHM_V, pa0, pa1, pa2, pa3); partialSM(pA0, pA1, m_reg, mnA, alA);
        __syncthreads(); asm volatile("s_waitcnt vmcnt(0)" ::: "memory"); SWRITE(1);
        RESC(alA); __syncthreads();
    }
    SBAR(); qkt(pB0, pB1, K_lds + SHM_K, KR_lds + SHM_KR, qr, r32, hi);
    finishSM(pA0, pA1, alA, l_reg, pa0, pa1, pa2, pa3); SBAR();
    pv_d0(o, vb0, pa0, pa1, pa2, pa3); partialSM(pB0, pB1, m_reg, mnB, alB);
    __syncthreads(); RESC(alB);
    finishSM(pB0, pB1, alB, l_reg, pa0, pa1, pa2, pa3); SBAR();
    pv_d0(o, vb0 + SHM_V, pa0, pa1, pa2, pa3);
    if (hi == 0) li_l[r32] = l_reg; asm volatile("s_waitcnt lgkmcnt(0)" ::: "memory");
    const int orow0 = qrow0 + wid * 32;
#pragma unroll
    for (int r = 0; r < 16; ++r) { const int orow = orow0 + crow(r, hi); const float rl = __builtin_amdgcn_rcpf(li_l[crow(r, hi)]);
#pragma unroll
        for (int d0 = 0; d0 < 4; ++d0) { const size_t idx = (size_t)orow * 3072 + h * 128 + d0 * 32 + r32;
            const float v = o[d0][r] * rl * bf1(GP[idx]); O[idx] = (bf16_t)(cvt_pk(v, 0.f) & 0xffffu); } }
    __syncthreads();
#undef TROW
#undef SLOAD
#undef SWRITE
#undef RESC
}
}

__device__ __forceinline__ void na_item(const bf16_t* __restrict__ PMIX, const bf16_t* __restrict__ GP, bf16_t* __restrict__ O, const float* __restrict__ bias, int item, int lane, LAS unsigned char* wl) {
    const int q = lane & 31, hi = lane >> 5;
    const bool lat = item < 8192;
    int b, h, gi = 0, jh = 0, qrow;
    if (lat) { b = item >> 11; h = (item >> 7) & 15; gi = (item >> 1) & 63; jh = item & 1; qrow = b * 4096 + gi * 64 + jh * 32 + q; }
    else { const int it = item - 8192; b = it >> 7; h = (it >> 3) & 15; qrow = NLAT + b * 256 + (it & 7) * 32 + q; }
    const int j = jh * 32 + q;
    const int c0 = min(max(j - 8, 0), 48), r0 = min(max(gi - 4, 0), 56);
    const bf16_t* qp = PMIX + (size_t)qrow * NMIXP + O_NAQ + h * 64 + hi * 8;
    bf16x8 qf[4];
#pragma unroll
    for (int ks = 0; ks < 4; ++ks) qf[ks] = *reinterpret_cast<const bf16x8*>(qp + ks * 16);
    f32x16 oT0 = {}, oT1 = {}; float m = -1e30f, l = 0.f;
    const int ntiles = lat ? 24 : 8;
    const float* bh = bias + h * (15 * 31);
#define NA_TROW(t_) ((lat && (t_) < 16) ? (b * 4096 + (r0 + ((t_) >> 1)) * 64 + ((t_) & 1) * 32) : (NLAT + b * 256 + (lat ? (t_) - 16 : (t_)) * 32))
#define NA_LOAD(KF, VV, t_) do { const int kr0_ = NA_TROW(t_); const bf16_t* kp_ = PMIX + (size_t)(kr0_ + q) * NMIXP + O_NAK + h * 64 + hi * 8; \
        _Pragma("unroll") for (int ks = 0; ks < 4; ++ks) KF[ks] = *reinterpret_cast<const bf16x8*>(kp_ + ks * 16); \
        const bf16_t* vp_ = PMIX + (size_t)(kr0_ + (lane >> 1)) * NMIXP + O_NAV + h * 64 + (lane & 1) * 32; \
        _Pragma("unroll") for (int c = 0; c < 4; ++c) VV[c] = *reinterpret_cast<const u32x4*>(vp_ + c * 8); } while (0)
#define NA_TILE(KF, VV, t) do { \
        const bool local = lat && (t) < 16; const int kr = (t) >> 1, kblk = (t) & 1; \
        f32x16 p = {}; \
        _Pragma("unroll") for (int ks = 0; ks < 4; ++ks) p = __builtin_amdgcn_mfma_f32_32x32x16_bf16(KF[ks], qf[ks], p, 0, 0, 0); \
        _Pragma("unroll") for (int c = 0; c < 4; ++c) *(LAS u32x4*)(wl + (lane >> 1) * 144 + (lane & 1) * 64 + c * 16) = VV[c]; \
        if ((t) + 3 < ntiles) NA_LOAD(KF, VV, (t) + 3); \
        if (local) { \
            const float* brow = bh + (r0 + kr - gi + 7) * 31 + 15 - j; \
            _Pragma("unroll") for (int r = 0; r < 16; ++r) { const int kc = kblk * 32 + crow(r, hi); const bool valid = (kc >= c0) && (kc < c0 + 16); \
                const float bv = valid ? brow[kc] : 0.f; p[r] = valid ? fmaf(bv, LOG2E, p[r]) : -INFINITY; } \
        } \
        float tmax = p[0]; \
        _Pragma("unroll") for (int r = 1; r < 16; ++r) tmax = fmaxf(tmax, p[r]); \
        tmax = fmaxf(tmax, shx(tmax, lane, 32)); \
        const float mn = fmaxf(m, tmax), alpha = __builtin_amdgcn_exp2f(m - mn); m = mn; \
        float ps = 0.f; \
        _Pragma("unroll") for (int r = 0; r < 16; ++r) { p[r] = __builtin_amdgcn_exp2f(p[r] - mn); ps += p[r]; } \
        l = l * alpha + ps; \
        _Pragma("unroll") for (int r = 0; r < 16; ++r) { oT0[r] *= alpha; oT1[r] *= alpha; } \
        asm volatile("s_waitcnt lgkmcnt(0)" ::: "memory"); __builtin_amdgcn_wave_barrier(); \
        _Pragma("unroll") for (int ks = 0; ks < 2; ++ks) { \
            u32x4 pw; pw.x = cvt_pk(p[8 * ks + 0], p[8 * ks + 1]); pw.y = cvt_pk(p[8 * ks + 2], p[8 * ks + 3]); pw.z = cvt_pk(p[8 * ks + 4], p[8 * ks + 5]); pw.w = cvt_pk(p[8 * ks + 6], p[8 * ks + 7]); \
            const bf16x8 pf = *reinterpret_cast<bf16x8*>(&pw); \
            _Pragma("unroll") for (int db = 0; db < 2; ++db) { \
                bf16x8 vf; \
                _Pragma("unroll") for (int jj = 0; jj < 8; ++jj) { const int key = 16 * ks + 8 * (jj >> 2) + 4 * hi + (jj & 3); vf[jj] = *(const LAS short*)(wl + key * 144 + (32 * db + q) * 2); } \
                if (db == 0) oT0 = __builtin_amdgcn_mfma_f32_32x32x16_bf16(vf, pf, oT0, 0, 0, 0); \
                else oT1 = __builtin_amdgcn_mfma_f32_32x32x16_bf16(vf, pf, oT1, 0, 0, 0); \
            } \
        } \
        asm volatile("s_waitcnt lgkmcnt(0)" ::: "memory"); __builtin_amdgcn_wave_barrier(); \
    } while (0)
    bf16x8 kfa[4], kfb[4], kfc[4]; u32x4 vva[4], vvb[4], vvc[4];
    NA_LOAD(kfa, vva, 0); NA_LOAD(kfb, vvb, 1); NA_LOAD(kfc, vvc, 2);
    for (int t0 = 0; t0 < ntiles; t0 += 3) {
        NA_TILE(kfa, vva, t0);
        if (t0 + 1 < ntiles) NA_TILE(kfb, vvb, t0 + 1);
        if (t0 + 2 < ntiles) NA_TILE(kfc, vvc, t0 + 2);
    }
#undef NA_TILE
#undef NA_TROW
#undef NA_LOAD
    const float inv = __builtin_amdgcn_rcpf(l + shx(l, lane, 32));
    const size_t ob = (size_t)qrow * 3072 + 1024 + h * 64;
#pragma unroll
    for (int db = 0; db < 2; ++db)
#pragma unroll
        for (int g = 0; g < 4; ++g) {
            const int d = 32 * db + 8 * g + 4 * hi;
            const u32x2 gw = *reinterpret_cast<const u32x2*>(GP + ob + d);
            float v0, v1, v2, v3;
            if (db == 0) { v0 = oT0[4 * g]; v1 = oT0[4 * g + 1]; v2 = oT0[4 * g + 2]; v3 = oT0[4 * g + 3]; } else { v0 = oT1[4 * g]; v1 = oT1[4 * g + 1]; v2 = oT1[4 * g + 2]; v3 = oT1[4 * g + 3]; }
            u32x2 w; w.x = cvt_pk(v0 * inv * bflo(gw.x), v1 * inv * bfhi(gw.x)); w.y = cvt_pk(v2 * inv * bflo(gw.y), v3 * inv * bfhi(gw.y));
            *reinterpret_cast<u32x2*>(O + ob + d) = w;
        }
}

__device__ __forceinline__ void lru_gate_phase(const bf16_t* __restrict__ PMIX, const bf16_t* __restrict__ WG, const float* __restrict__ convw, const float* __restrict__ convb,
                                               const float* __restrict__ bg, const float* __restrict__ lam, float* __restrict__ LA, float* __restrict__ LU, int bid, int G, LAS unsigned char* lds) {
    const int tid = opaque_v(threadIdx.x), lane = tid & 63, wid = tid >> 6;
    LAS float* xcf = (LAS float*)lds;
    LAS unsigned char* xcb = lds + 64 * 68 * 4;
    const int tl_s = tid >> 3, cg8 = (tid & 7) * 8;
    const int dir = wid >> 2, th = (wid >> 1) & 1, chh = wid & 1, q = lane & 31, hi = lane >> 5, cl = 32 * chh + q;
    int cur_blk = -1;
    f32x4 cw[4][2], cb0, cb1; bf16x8 br[4], bi[4]; float brv = 0.f, biv = 0.f, sp = 0.f;
    for (int item = bid; item < (MROWS / 64) * 16; item += G) {
        const int tt = item >> 4, blk = item & 15, row0 = tt * 64;
        if (blk != cur_blk) {
            cur_blk = blk;
            const int chs = blk * 64 + cg8;
            cb0 = *(const f32x4*)(convb + chs); cb1 = *(const f32x4*)(convb + chs + 4);
#pragma unroll
            for (int tap = 0; tap < 4; ++tap) { cw[tap][0] = *(const f32x4*)(convw + tap * 1024 + chs); cw[tap][1] = *(const f32x4*)(convw + tap * 1024 + chs + 4); }
            const bf16_t* wt = WG + (size_t)(dir * 16 + blk) * 128 * 64;
#pragma unroll
            for (int ks = 0; ks < 4; ++ks) { br[ks] = *reinterpret_cast<const bf16x8*>(wt + (size_t)cl * 64 + 16 * ks + 8 * hi); bi[ks] = *reinterpret_cast<const bf16x8*>(wt + (size_t)(64 + cl) * 64 + 16 * ks + 8 * hi); }
            brv = bg[dir * 2048 + blk * 128 + cl]; biv = bg[dir * 2048 + blk * 128 + 64 + cl];
            const float xs = __expf(-lam[dir * 1024 + blk * 64 + cl]);
            sp = xs < 0.05f ? xs * (1.f - xs * (0.5f - xs * ((1.f / 3.f) - xs * (0.25f - xs * 0.2f)))) : __logf(1.f + xs);
        }
        const int seg0 = row0 < NLAT ? (row0 & ~4095) : (NLAT + ((row0 - NLAT) & ~255)), seg1 = seg0 + (row0 < NLAT ? 4096 : 256);
        {
            const int row = row0 + tl_s, chs = blk * 64 + cg8;
            f32x4 x0 = cb0, x1 = cb1;
#pragma unroll
            for (int tap = 0; tap < 4; ++tap) {
                const int rr = row + tap - 2;
                if (rr >= seg0 && rr < seg1) {
                    const u32x4 pv = *(const u32x4*)(PMIX + (size_t)rr * NMIXP + O_PX + chs);
                    x0 += cw[tap][0] * (f32x4){bflo(pv.x), bfhi(pv.x), bflo(pv.y), bfhi(pv.y)};
                    x1 += cw[tap][1] * (f32x4){bflo(pv.z), bfhi(pv.z), bflo(pv.w), bfhi(pv.w)};
                }
            }
            *(LAS f32x4*)(xcf + tl_s * 68 + cg8) = x0; *(LAS f32x4*)(xcf + tl_s * 68 + cg8 + 4) = x1;
            *(LAS u32x4*)(xcb + tl_s * 144 + cg8 * 2) = pack8(x0, x1);
        }
        __syncthreads();
        {
            const int ch = blk * 64 + cl;
            f32x16 accR = {}, accI = {};
#pragma unroll
            for (int ks = 0; ks < 4; ++ks) {
                const bf16x8 af = *(const LAS bf16x8*)(xcb + (32 * th + q) * 144 + (16 * ks + 8 * hi) * 2);
                accR = __builtin_amdgcn_mfma_f32_32x32x16_bf16(af, br[ks], accR, 0, 0, 0);
                accI = __builtin_amdgcn_mfma_f32_32x32x16_bf16(af, bi[ks], accI, 0, 0, 0);
            }
#pragma unroll
            for (int r = 0; r < 16; ++r) {
                const int tl = 32 * th + crow(r, hi);
                const float rg = sigmoidf_(accR[r] + brv), ig = sigmoidf_(accI[r] + biv);
                const float log_a = -8.f * rg * sp, av = __expf(log_a), ym = -2.f * log_a;
                const float om = ym < 0.1f ? ym * (1.f - ym * (0.5f - ym * ((1.f / 6.f) - ym * ((1.f / 24.f) - ym * (1.f / 120.f))))) : 1.f - __expf(-ym);
                const float u = __builtin_sqrtf(fmaxf(om, 0.f)) * (ig * xcf[tl * 68 + cl]);
                const size_t idx = ((size_t)dir * MROWS + row0 + tl) * 1024 + ch;
                LA[idx] = av; LU[idx] = u;
            }
        }
        __syncthreads();
    }
}
__device__ __forceinline__ int chunk_row0(int b, int c) { return c < 4 ? NLAT + b * 256 + c * 64 : b * 4096 + (c - 4) * 64; }
__device__ __forceinline__ void lru_pass1_item(const float* __restrict__ LA, const float* __restrict__ LU, float* __restrict__ AGG, int item) {
    const int g = item * 512 + opaque_v(threadIdx.x), ch = (g & 255) * 4, dir = (g >> 8) & 1, bc = g >> 9, c = bc % NCHUNK, b = bc / NCHUNK;
    const int row0 = chunk_row0(b, c);
    const float* ap = LA + ((size_t)dir * MROWS + row0) * 1024 + ch; const float* up = LU + ((size_t)dir * MROWS + row0) * 1024 + ch;
    f32x4 A = {1.f, 1.f, 1.f, 1.f}, H = {0.f, 0.f, 0.f, 0.f};
#pragma unroll 8
    for (int t = 0; t < 64; ++t) { const int tt = dir ? 63 - t : t; const f32x4 a = *(const f32x4*)(ap + (size_t)tt * 1024), u = *(const f32x4*)(up + (size_t)tt * 1024); A *= a; H = a * H + u; }
    float* o = AGG + (((size_t)(dir * NB + b) * NCHUNK + c) * 1024 + ch) * 2;
    *(f32x4*)o = (f32x4){A[0], H[0], A[1], H[1]}; *(f32x4*)(o + 4) = (f32x4){A[2], H[2], A[3], H[3]};
}
__device__ __forceinline__ void lru_pass3_item(const float* __restrict__ LA, const float* __restrict__ LU, const float* __restrict__ AGG, const bf16_t* __restrict__ GP, bf16_t* __restrict__ O, int item, LAS unsigned char* lds) {
    const int tid = opaque_v(threadIdx.x);
    const int cg = item & 7, bc = item >> 3, c = bc % NCHUNK, b = bc / NCHUNK, row0 = chunk_row0(b, c), ch0 = cg * 128;
    LAS float* S = (LAS float*)lds;
    LAS float* CX = (LAS float*)(lds + 131072);
    {
        f32x4 tv[16];
#pragma unroll
        for (int p = 0; p < 16; ++p) { const int e = p * 512 + tid, arr = e >> 11, rem = e & 2047, tok = rem >> 5, c4 = rem & 31;
            tv[p] = *(const f32x4*)(((arr & 1) ? LU : LA) + ((size_t)(arr >> 1) * MROWS + row0 + tok) * 1024 + ch0 + c4 * 4); }
#pragma unroll
        for (int p = 0; p < 16; ++p) { const int e = p * 512 + tid, arr = e >> 11, rem = e & 2047, tok = rem >> 5, c4 = rem & 31;
            *(LAS f32x4*)(S + (arr * 64 + tok) * 128 + c4 * 4) = tv[p]; }
    }
    const int dir = (tid >> 7) & 1, ch = tid & 127, half = tid >> 8;
    float cA = 1.f, cH = 0.f;
    {
        const float* ag = AGG + ((size_t)(dir * NB + b) * NCHUNK * 1024 + ch0 + ch) * 2;
        const int n = dir == 0 ? c : (c < 4 ? 3 - c : 4 + (NCHUNK - 1 - c));
        const int k0 = half ? (n >> 1) : 0, k1 = half ? n : (n >> 1);
#pragma unroll 8
        for (int k = k0; k < k1; ++k) { const int cc = dir == 0 ? k : ((c < 4 || k < 4) ? 3 - k : NCHUNK - 1 - (k - 4));
            const f32x2_t q_ = *(const f32x2_t*)(ag + (size_t)cc * 2048); cA *= q_[0]; cH = q_[0] * cH + q_[1]; }
    }
    if (half) { CX[(tid - 256) * 2] = cA; CX[(tid - 256) * 2 + 1] = cH; }
    __syncthreads();
    if (tid < 256) {
        float h = CX[tid * 2] * cH + CX[tid * 2 + 1];
        LAS float* sa = S + (dir * 2) * 64 * 128 + ch; LAS float* su = sa + 64 * 128;
#pragma unroll 8
        for (int t = 0; t < 64; ++t) { const int tt = dir ? 63 - t : t; h = sa[tt * 128] * h + su[tt * 128]; su[tt * 128] = h; }
    }
    __syncthreads();
#pragma unroll
    for (int p = 0; p < 4; ++p) { const int e = p * 512 + tid, tok = e >> 5, c4 = e & 31;
        const f32x4 hf = *(const LAS f32x4*)(S + (1 * 64 + tok) * 128 + c4 * 4), hb = *(const LAS f32x4*)(S + (3 * 64 + tok) * 128 + c4 * 4);
        const size_t oi = (size_t)(row0 + tok) * 3072 + 2048 + ch0 + c4 * 4; const u32x2 gw = *(const u32x2*)(GP + oi);
        u32x2 w; w.x = cvt_pk((hf[0] + hb[0]) * bflo(gw.x), (hf[1] + hb[1]) * bfhi(gw.x)); w.y = cvt_pk((hf[2] + hb[2]) * bflo(gw.y), (hf[3] + hb[3]) * bfhi(gw.y));
        *(u32x2*)(O + oi) = w; }
    __syncthreads();
}

__device__ __forceinline__ void transpose_item(const float* __restrict__ W, int ld_src, int k0, int n0src, const float* __restrict__ kscale, bf16_t* __restrict__ WT, int ldt, int n0dst, LAS float* scr, int lane) {
#pragma unroll 8
    for (int i = 0; i < 32; ++i) { const int kk = 2 * i + (lane >> 5); float v = W[(size_t)(k0 + kk) * ld_src + n0src + (lane & 31)]; if (kscale) v *= kscale[k0 + kk]; scr[kk * 33 + (lane & 31)] = v; }
    asm volatile("s_waitcnt lgkmcnt(0)" ::: "memory"); __builtin_amdgcn_wave_barrier();
    const int c = lane & 7;
#pragma unroll
    for (int jn = 0; jn < 4; ++jn) { const int n = (lane >> 3) + 8 * jn; const LAS float* s = scr + (8 * c) * 33 + n;
        u32x4 o; o.x = cvt_pk(s[0 * 33], s[1 * 33]); o.y = cvt_pk(s[2 * 33], s[3 * 33]); o.z = cvt_pk(s[4 * 33], s[5 * 33]); o.w = cvt_pk(s[6 * 33], s[7 * 33]);
        *(u32x4*)(WT + (size_t)(n0dst + n) * ldt + k0 + 8 * c) = o; }
    asm volatile("s_waitcnt lgkmcnt(0)" ::: "memory"); __builtin_amdgcn_wave_barrier();
}


#define XB_TMO      128
#define XB_XCNT(j)  (256  + 64 * (j))
#define XB_XSUB(j)  (1280 + 64 * (j))
#define XB_XGEN(j)  (2304 + 64 * (j))
#define XB_TOP      3328
#define XB_TOPGEN   3392
#define XCD_BAR_WORDS 3456
#define XB_SPIN_CAP (1u << 22)
__device__ __forceinline__ unsigned xb_ld(unsigned* p)              { return __hip_atomic_load(p, __ATOMIC_RELAXED, __HIP_MEMORY_SCOPE_AGENT); }
__device__ __forceinline__ unsigned xb_add(unsigned* p, unsigned v) { return __hip_atomic_fetch_add(p, v, __ATOMIC_RELAXED, __HIP_MEMORY_SCOPE_AGENT); }
__device__ __forceinline__ unsigned xb_xcc_id() { return (unsigned)__builtin_amdgcn_s_getreg((3 << 11) | 20) & 0xFu; }
#define XB_SPIN(cond, bar) do { unsigned _sp = 0; while (cond) { __builtin_amdgcn_s_sleep(1); \
    if ((++_sp & 255u) == 0u) { if (xb_ld(&(bar)[XB_TMO])) break; if (_sp > XB_SPIN_CAP) { atomicAdd(&(bar)[XB_TMO], 1u); break; } } } } while (0)
struct XcdBarrier { unsigned* bar; unsigned x; volatile LAS unsigned* st; };
__device__ __forceinline__ XcdBarrier xcd_barrier_post(unsigned* bar, volatile LAS unsigned* st) {
    XcdBarrier b; b.bar = bar; b.x = xb_xcc_id(); b.st = st;
    if (threadIdx.x == 0) (void)xb_add(&bar[XB_XCNT(b.x)], 1u);
    return b;
}
__device__ __forceinline__ void xcd_barrier_complete(unsigned* bar, unsigned x, unsigned& nloc, unsigned& nx) {
    const unsigned G = gridDim.x * gridDim.y * gridDim.z;
    unsigned sum, cnt, mine, sp = 0u;
    for (;;) {
        sum = 0u; cnt = 0u; mine = 0u;
#pragma unroll
        for (unsigned j = 0; j < 16; ++j) { const unsigned c = xb_ld(&bar[XB_XCNT(j)]); sum += c; cnt += (c > 0u) ? 1u : 0u; mine = (j == x) ? c : mine; }
        if (sum == G) break;
        __builtin_amdgcn_s_sleep(1);
        if ((++sp & 255u) == 0u) { if (xb_ld(&bar[XB_TMO])) break; if (sp > XB_SPIN_CAP) { atomicAdd(&bar[XB_TMO], 1u); break; } }
    }
    nloc = mine > 0u ? mine : 1u; nx = cnt > 0u ? cnt : 1u;
}
__device__ __forceinline__ void xcd_barrier(const XcdBarrier& b) {
    asm volatile("s_waitcnt vmcnt(0)" ::: "memory");
    __syncthreads();
    if (threadIdx.x == 0) {
        unsigned* bar = b.bar;
        __builtin_amdgcn_s_waitcnt(0);
        unsigned nloc = b.st[0], nx = b.st[1];
        if (nloc == 0u) { xcd_barrier_complete(bar, b.x, nloc, nx); b.st[0] = nloc; b.st[1] = nx; }
        const unsigned old = xb_add(&bar[XB_XSUB(b.x)], 1u);
        const unsigned gen = old / nloc;
        if (old + 1u == (gen + 1u) * nloc) {
            __builtin_amdgcn_fence(__ATOMIC_RELEASE, "agent");
            asm volatile("s_waitcnt vmcnt(0)" ::: "memory");
            const unsigned og = xb_add(&bar[XB_TOP], 1u);
            const unsigned tg = og / nx;
            if (og + 1u == (tg + 1u) * nx) xb_add(&bar[XB_TOPGEN], 1u);
            else XB_SPIN(xb_ld(&bar[XB_TOPGEN]) == tg, bar);
            __builtin_amdgcn_fence(__ATOMIC_ACQUIRE, "agent");
            xb_add(&bar[XB_XGEN(b.x)], 1u);
            asm volatile("s_waitcnt vmcnt(0)" ::: "memory");
        } else {
            XB_SPIN(xb_ld(&bar[XB_XGEN(b.x)]) == gen, bar);
            __builtin_amdgcn_fence(__ATOMIC_ACQUIRE, "agent");
            asm volatile("s_waitcnt vmcnt(0)" ::: "memory");
        }
    }
    __syncthreads();
}
#define GRID_SYNC() do { asm volatile("s_waitcnt vmcnt(0) lgkmcnt(0)" ::: "memory"); grid.sync(); \
    if (threadIdx.x < 64) asm volatile("buffer_inv sc1\n\ts_waitcnt vmcnt(0)" ::: "memory"); __syncthreads(); } while (0)
__device__ __forceinline__ unsigned char* opaque_p(unsigned char* p) { asm volatile("" : "+s"(p)); return p; }
__device__ __forceinline__ int opaque_s(int x) { asm volatile("" : "+s"(x)); return x; }
#define x_in (args.in[0])
#define c_in (args.in[1])
#define ctx_in (args.in[2])
#define cctx_in (args.in[3])
#define ada_w (args.in[4])
#define ada_b (args.in[5])
#define norm_g (args.in[6])
#define w_in (args.in[7])
#define qng (args.in[8])
#define kvng (args.in[9])
#define w_uq (args.in[10])
#define w_ukv (args.in[11])
#define rel_bias (args.in[12])
#define conv_w (args.in[13])
#define conv_b (args.in[14])
#define w_gate (args.in[15])
#define b_gate (args.in[16])
#define lam_in (args.in[17])
#define w_branch (args.in[18])
#define w_out (args.in[19])
#define fng (args.in[20])
#define WIN ((bf16_t*)(ws + WS_WIN))
#define WUQ ((bf16_t*)(ws + WS_WUQ))
#define WUKV ((bf16_t*)(ws + WS_WUKV))
#define WBR ((bf16_t*)(ws + WS_WBR))
#define WOUT ((bf16_t*)(ws + WS_WOUT))
#define WG ((bf16_t*)(ws + WS_WG))
#define MOD ((float*)(ws + WS_MOD))
#define ROPE ((float*)(ws + WS_ROPE))
#define XCUR ((float*)(ws + WS_XCUR))
#define HB ((bf16_t*)(ws + WS_H))
#define PMIX ((bf16_t*)(ws + WS_PMIX))
#define GP ((bf16_t*)(ws + WS_GP))
#define MG ((bf16_t*)(ws + WS_MG))
#define RSQ ((float*)(ws + WS_RSQ))
#define QB ((bf16_t*)(ws + WS_Q))
#define KVB ((bf16_t*)(ws + WS_KV))
#define KRB ((bf16_t*)(ws + WS_KR))
#define LA ((float*)(ws + WS_LA))
#define LU ((float*)(ws + WS_LU))
#define AGG ((float*)(ws + WS_AGG))
#define OB ((bf16_t*)(ws + WS_O))
#define MTMP LA
__global__ void __launch_bounds__(512, 2) mk_fwd(Args args) {
    extern __shared__ __attribute__((aligned(16))) unsigned char lds_raw[];
    cg::grid_group grid = cg::this_grid();
    LAS unsigned char* lds = (LAS unsigned char*)lds_raw;
    volatile LAS unsigned* xb_st = (volatile LAS unsigned*)(lds + LDS_BYTES - 64);
    if (threadIdx.x == 0) { xb_st[0] = 0u; xb_st[1] = 0u; }
    __syncthreads();
    (void)xcd_barrier_post((unsigned*)(args.ws + WS_BAR), xb_st);
#define XSYNC() do { XcdBarrier b_; b_.bar = (unsigned*)(args.ws + WS_BAR); b_.x = xb_xcc_id(); b_.st = (volatile LAS unsigned*)(lds + LDS_BYTES - 64); xcd_barrier(b_); } while (0)
#define PHASE_IDS const int tid = opaque_v(threadIdx.x), lane = tid & 63, wid = __builtin_amdgcn_readfirstlane(tid >> 6), G = opaque_s(gridDim.x), bid = opaque_s(blockIdx.x), NGW = G * 8, gw = bid * 8 + wid; unsigned char* ws = args.ws + (size_t)(unsigned)opaque_s(0); (void)lane; (void)gw; (void)NGW; (void)ws; (void)tid;

    {
        PHASE_IDS
        LAS float* scr = (LAS float*)(lds + wid * 8448);
        constexpr int I_IN = 32 * 442, I_UQ = 8 * 48, I_UKV = 4 * 64, I_BR = 3 * 16 * 64, I_OUT = 32 * 64, I_G = 32 * 4, I_L = I_IN + I_UQ + I_UKV + I_BR + I_OUT + I_G;
        for (int it = gw; it < DEPTH * I_L; it += NGW) {
            const int L = it / I_L; int r = it - L * I_L;
            if (r < I_IN) { const int kb = r / 442, nb = r % 442, n0 = nb * 32;
                transpose_item(w_in + (size_t)L * DM * NIN, NIN, kb * 64, n0, nullptr, WIN + (size_t)L * NINP * DM, DM, n0 < NMIX ? n0 : n0 + (NMIXP - NMIX), scr, lane); continue; } r -= I_IN;
            if (r < I_UQ) { const int kb = r / 48, nb = r % 48;
                transpose_item(w_uq + (size_t)L * 512 * 1536, 1536, kb * 64, nb * 32, qng + L * 512, WUQ + (size_t)L * 1536 * 512, 512, nb * 32, scr, lane); continue; } r -= I_UQ;
            if (r < I_UKV) { const int kb = r / 64, nb = r % 64;
                transpose_item(w_ukv + (size_t)L * 256 * 2048, 2048, kb * 64, nb * 32, kvng + L * 256, WUKV + (size_t)L * 2048 * 256, 256, nb * 32, scr, lane); continue; } r -= I_UKV;
            if (r < I_BR) { const int n3 = r / 1024, rr = r % 1024, kb = rr / 64, nb = rr % 64;
                transpose_item(w_branch + ((size_t)L * 3 + n3) * 1024 * 2048, 2048, kb * 64, nb * 32, nullptr, WBR + ((size_t)L * 3 + n3) * 2048 * 1024, 1024, nb * 32, scr, lane); continue; } r -= I_BR;
            if (r < I_OUT) { const int kb = r / 64, nb = r % 64;
                transpose_item(w_out + (size_t)L * DM * DM, DM, kb * 64, nb * 32, nullptr, WOUT + (size_t)L * DM * DM, DM, nb * 32, scr, lane); continue; } r -= I_OUT;
            { const int db = r / 4, nb = r % 4;
              transpose_item(w_gate + ((size_t)L * 32 + db) * 64 * 128, 128, 0, nb * 32, nullptr, WG + ((size_t)L * 32 + db) * 128 * 64, 64, nb * 32, scr, lane); }
        }
        for (int i = bid * 512 + tid; i < DEPTH * (NMIXP - NMIX) * (DM / 8); i += G * 512) {
            const int L = i / ((NMIXP - NMIX) * (DM / 8)), r = i % ((NMIXP - NMIX) * (DM / 8));
            *(u32x4*)(WIN + ((size_t)L * NINP + NMIX) * DM + (size_t)r * 8) = (u32x4){0u, 0u, 0u, 0u};
        }
        __syncthreads();
        LAS float* sil = (LAS float*)(lds + 69632);
        LAS float* red = (LAS float*)(lds + 69632 + 40960);
        for (int i = tid; i < 5 * 2048; i += 512) { const float v = i < 4 * 2048 ? c_in[i] : cctx_in[i - 4 * 2048]; sil[i] = v * (1.f / (1.f + expf(-v))); }
        __syncthreads();
        for (int it = bid; it < DEPTH * 96; it += G) {
            const int L = it / 96, cb = it % 96, ksl = tid >> 6, col = cb * 64 + (tid & 63);
            float a5[5] = {0.f, 0.f, 0.f, 0.f, 0.f};
            const float* wp = ada_w + (size_t)L * DM * 6144 + col;
            for (int k = ksl * 256; k < ksl * 256 + 256; ++k) { const float w = wp[(size_t)k * 6144];
#pragma unroll
                for (int r = 0; r < 5; ++r) a5[r] += sil[r * 2048 + k] * w; }
#pragma unroll
            for (int r = 0; r < 5; ++r) red[(ksl * 5 + r) * 64 + (tid & 63)] = a5[r];
            __syncthreads();
            if (tid < 320) { const int r = tid >> 6, cc = tid & 63; float s = 0.f;
#pragma unroll
                for (int k = 0; k < 8; ++k) s += red[(k * 5 + r) * 64 + cc];
                MOD[((size_t)L * 5 + r) * 6144 + cb * 64 + cc] = s + ada_b[(size_t)L * 6144 + cb * 64 + cc]; }
            __syncthreads();
        }
        if (bid == G - 1) for (int i = tid; i < 1024; i += 512) { const int pos = i >> 4, k = i & 15;
            const float inv = 1.0f / powf(10000.f, (float)k * (1.f / 16.f)), ang = (float)pos * inv; ROPE[2 * i] = cosf(ang); ROPE[2 * i + 1] = sinf(ang); }
    }
    GRID_SYNC();

    for (int layer = 0; layer < DEPTH; ++layer) {
        const bool need_ctx = layer < DEPTH - 1;
        { PHASE_IDS
        for (int row = gw; row < MROWS; row += NGW) {
            const bool lat = row < NLAT;
            const float* src = (layer == 0) ? (lat ? x_in + (size_t)row * DM : ctx_in + (size_t)(row - NLAT) * DM) : XCUR + (size_t)row * DM;
            const float* mr = MOD + (size_t)layer * 5 * 6144 + (size_t)(lat ? (row >> 12) : 4) * 6144;
            f32x4 v[8]; float ss = 0.f;
#pragma unroll
            for (int jv = 0; jv < 8; ++jv) { v[jv] = *(const f32x4*)(src + 4 * (lane + 64 * jv)); ss += (v[jv][0] * v[jv][0] + v[jv][1] * v[jv][1]) + (v[jv][2] * v[jv][2] + v[jv][3] * v[jv][3]); }
            const float rinv = rsqrtf(wave_sum(ss, lane) * (1.f / DM) + EPS);
#pragma unroll
            for (int jv = 0; jv < 8; ++jv) { const int col = 4 * (lane + 64 * jv);
                const f32x4 gg = *(const f32x4*)(norm_g + layer * DM + col), sh = *(const f32x4*)(mr + col), sc = *(const f32x4*)(mr + 2048 + col);
                const f32x4 hh = (v[jv] * rinv * gg) * (sc + 1.f) + sh;
                u32x2 w; w.x = cvt_pk(hh[0], hh[1]); w.y = cvt_pk(hh[2], hh[3]); *(u32x2*)(HB + (size_t)row * DM + col) = w; }
        } }
        XSYNC();
        {
            PHASE_IDS
            pg8::Gemm g{HB, WIN + (size_t)layer * NINP * DM, DM, DM, DM, 0, 0}; pg8::Sched S; S.init(MROWS, NINP, G, bid, 1);
            EpiIn E{PMIX, GP, MG, RSQ};
            pg8::gemm_phase<EpiIn>(lds, g, S, E);
        }
        XSYNC();
        {
            PHASE_IDS
            { pg8::Gemm g{PMIX, WUQ + (size_t)layer * 1536 * 512, NMIXP, 512, 512, 0, 0}; pg8::Sched S; S.init(MROWS, 1536, G, bid, 1);
              EpiQ E{QB, RSQ, ROPE}; pg8::gemm_phase<EpiQ>(lds, g, S, E); }
            { pg8::Gemm g{PMIX + 512, WUKV + (size_t)layer * 2048 * 256, NMIXP, 256, 256, 0, 0}; pg8::Sched S; S.init(MROWS, 2048, G, bid, 1);
              EpiKV E{KVB, RSQ}; pg8::gemm_phase<EpiKV>(lds, g, S, E); }
            for (int i = bid * 512 + tid; i < MROWS * 4; i += G * 512) {
                const int row = i >> 2, hf = (i >> 1) & 1, sub = i & 1;
                const bf16_t* src = PMIX + (size_t)row * NMIXP + O_KR + 32 * hf + 8 * sub;
                u32x4 a = *(const u32x4*)src, b2 = *(const u32x4*)(src + 16);
                if (row < NLAT) {
                    const int s = row & 4095, pos = hf ? (s & 63) : (s >> 6);
                    const float* cp = ROPE + (pos * 16 + 8 * sub) * 2;
                    float x1[8] = {bflo(a.x), bfhi(a.x), bflo(a.y), bfhi(a.y), bflo(a.z), bfhi(a.z), bflo(a.w), bfhi(a.w)};
                    float x2[8] = {bflo(b2.x), bfhi(b2.x), bflo(b2.y), bfhi(b2.y), bflo(b2.z), bfhi(b2.z), bflo(b2.w), bfhi(b2.w)};
                    float o1[8], o2[8];
#pragma unroll
                    for (int e = 0; e < 8; ++e) { const float cv = cp[2 * e], sv = cp[2 * e + 1]; o1[e] = x1[e] * cv - x2[e] * sv; o2[e] = x1[e] * sv + x2[e] * cv; }
                    a.x = cvt_pk(o1[0], o1[1]); a.y = cvt_pk(o1[2], o1[3]); a.z = cvt_pk(o1[4], o1[5]); a.w = cvt_pk(o1[6], o1[7]);
                    b2.x = cvt_pk(o2[0], o2[1]); b2.y = cvt_pk(o2[2], o2[3]); b2.z = cvt_pk(o2[4], o2[5]); b2.w = cvt_pk(o2[6], o2[7]);
                }
                bf16_t* dst = KRB + (size_t)row * 64 + 32 * hf + 8 * sub;
                *(u32x4*)dst = a; *(u32x4*)(dst + 16) = b2;
            }
            __syncthreads();
            lru_gate_phase(PMIX, WG + (size_t)layer * 32 * 128 * 64, conv_w + (size_t)layer * 4 * 1024, conv_b + (size_t)layer * 1024, b_gate + (size_t)layer * 2 * 2048, lam_in + (size_t)layer * 2 * 1024, LA, LU, bid, G, lds);
        }
        XSYNC();
        {
            PHASE_IDS
            const int nmla = 512 + (need_ctx ? 32 : 0);
            for (int u = bid; u < nmla; u += G) {
                if (u < 512) { const int b = u >> 7, h = (u >> 4) & 7, qb = u & 15;
                    mla::attn_unit(QB, KVB, KRB, GP, OB, b * 4096 + qb * 256, h, b * 4096, NLAT + b * 256, 64, 68, (char*)lds_raw); }
                else { const int b = (u - 512) >> 3, h = (u - 512) & 7;
                    mla::attn_unit(QB, KVB, KRB, GP, OB, NLAT + b * 256, h, 0, NLAT + b * 256, 0, 4, (char*)lds_raw); }
            }
            __syncthreads();
            const int nna = 8192 + (need_ctx ? 512 : 0);
            for (int it = gw; it < nna; it += NGW) na_item(PMIX, GP, OB, rel_bias + (size_t)layer * 16 * 15 * 31, it, lane, lds + wid * 4608);
            for (int it = bid; it < (NB * NCHUNK * 2 * 256) / 512; it += G) lru_pass1_item(LA, LU, AGG, it);
        }
        XSYNC();
        { PHASE_IDS
        for (int it = bid; it < NB * NCHUNK * 8; it += G) lru_pass3_item(LA, LU, AGG, GP, OB, it, lds); }
        XSYNC();
        {
            PHASE_IDS
            const int Mrows = need_ctx ? MROWS : NLAT;
            pg8::Gemm g{OB, WBR + (size_t)layer * 3 * 2048 * 1024, 3072, 1024, 1024, 1024, (size_t)2048 * 1024}; pg8::Sched S; S.init(Mrows, DM, G, bid, 3);
            EpiMerge E{MG, MTMP, HB}; pg8::gemm_phase<EpiMerge>(lds, g, S, E);
        }
        XSYNC();
        {
            PHASE_IDS
            const int Mrows = need_ctx ? MROWS : NLAT;
            pg8::Gemm g{HB, WOUT + (size_t)layer * DM * DM, DM, DM, DM, 0, 0}; pg8::Sched S; S.init(Mrows, DM, G, bid, 1);
            EpiOut E{x_in, ctx_in, XCUR, MOD + (size_t)layer * 5 * 6144, layer}; pg8::gemm_phase<EpiOut>(lds, g, S, E);
        }
        XSYNC();
    }
    { PHASE_IDS
    for (int row = gw; row < NLAT; row += NGW) {
        const float* src = XCUR + (size_t)row * DM;
        f32x4 v[8]; float ss = 0.f;
#pragma unroll
        for (int jv = 0; jv < 8; ++jv) { v[jv] = *(const f32x4*)(src + 4 * (lane + 64 * jv)); ss += (v[jv][0] * v[jv][0] + v[jv][1] * v[jv][1]) + (v[jv][2] * v[jv][2] + v[jv][3] * v[jv][3]); }
        const float rinv = rsqrtf(wave_sum(ss, lane) * (1.f / DM) + EPS);
#pragma unroll
        for (int jv = 0; jv < 8; ++jv) { const int col = 4 * (lane + 64 * jv); *(f32x4*)(args.out + (size_t)row * DM + col) = v[jv] * rinv * *(const f32x4*)(fng + col); }
    } }
}

extern "C" void kernel_launch(void* const* d_in, const int* in_sizes, int n_in, void* d_out, int out_size, void* d_ws, size_t ws_size, hipStream_t stream) {
    static int grid = 0;
    if (grid == 0) {
        if (n_in != 21 || ws_size < WS_END) { fprintf(stderr, "kernel_launch: n_in %d ws %zu (need %zu): nothing launched\n", n_in, ws_size, (size_t)WS_END); grid = -1; return; }
        int dev = 0, cus = 0, per_cu = 0;
        if (hipGetDevice(&dev) != hipSuccess || hipDeviceGetAttribute(&cus, hipDeviceAttributeMultiprocessorCount, dev) != hipSuccess) { grid = -1; return; }
        if (hipFuncSetAttribute((const void*)mk_fwd, hipFuncAttributeMaxDynamicSharedMemorySize, LDS_BYTES) != hipSuccess) { fprintf(stderr, "hipFuncSetAttribute failed\n"); grid = -1; return; }
        if (hipOccupancyMaxActiveBlocksPerMultiprocessor(&per_cu, (const void*)mk_fwd, 512, LDS_BYTES) != hipSuccess || per_cu < 1) { fprintf(stderr, "occupancy query: %d\n", per_cu); per_cu = 1; }
        (void)hipGetLastError();
        grid = cus * per_cu;
    }
    if (grid < 0) return;
    if (hipMemsetAsync((char*)d_ws + WS_BAR, 0, 16384, stream) != hipSuccess) { fprintf(stderr, "memset of barrier words failed\n"); return; }
    Args a{};
    for (int i = 0; i < 21; ++i) a.in[i] = (const float*)d_in[i];
    a.out = (float*)d_out; a.ws = (unsigned char*)d_ws;
    void* kargs[] = {&a};
    hipError_t e = hipLaunchCooperativeKernel((const void*)mk_fwd, dim3(grid), dim3(512), kargs, LDS_BYTES, stream);
    if (e != hipSuccess) fprintf(stderr, "cooperative launch failed: %s (grid %d)\n", hipGetErrorString(e), grid);
}
```

```cpp
#include <hip/hip_runtime.h>
#include <hip/hip_cooperative_groups.h>
#include <cstdio>
#include <cstdint>
namespace cg = cooperative_groups;

typedef unsigned short bf16_t;
typedef short bf16x8 __attribute__((ext_vector_type(8)));
typedef float f32x4 __attribute__((ext_vector_type(4)));
typedef float f32x16 __attribute__((ext_vector_type(16)));
typedef unsigned u32x4 __attribute__((ext_vector_type(4)));
typedef unsigned u32x2 __attribute__((ext_vector_type(2)));
#define LAS __attribute__((address_space(3)))

constexpr int DM = 2048, NB = 4, SEQ = 4096, NCTXT = 256, DEPTH = 4;
constexpr int NLAT = NB * SEQ, NCTX = NB * NCTXT, MROWS = NLAT + NCTX;
constexpr int NMIX = 4928, NMIXP = 5120, NGP = 3072, NMG = 6144, NINP = NMIXP + NGP + NMG, NIN = 14144;
constexpr int O_KR = 768, O_NAQ = 832, O_NAK = 1856, O_NAV = 2880, O_PX = 3904;
constexpr float EPS = 1e-6f, LOG2E = 1.4426950408889634f;
constexpr float C_MLA = 0.07216878364870322f * LOG2E;
constexpr float C_NA = 0.125f * LOG2E;
constexpr int NCHUNK = 68;

constexpr size_t al256(size_t x) { return (x + 255) / 256 * 256; }
constexpr size_t WS_WIN = 0;
constexpr size_t WS_WUQ = WS_WIN + al256((size_t)DEPTH * NINP * DM * 2);
constexpr size_t WS_WUKV = WS_WUQ + al256((size_t)DEPTH * 1536 * 512 * 2);
constexpr size_t WS_WBR = WS_WUKV + al256((size_t)DEPTH * 2048 * 256 * 2);
constexpr size_t WS_WOUT = WS_WBR + al256((size_t)DEPTH * 3 * 2048 * 1024 * 2);
constexpr size_t WS_WG = WS_WOUT + al256((size_t)DEPTH * 2048 * 2048 * 2);
constexpr size_t WS_MOD = WS_WG + al256((size_t)DEPTH * 2 * 16 * 128 * 64 * 2);
constexpr size_t WS_ROPE = WS_MOD + al256((size_t)DEPTH * 5 * 6144 * 4);
constexpr size_t WS_XCUR = WS_ROPE + al256((size_t)64 * 16 * 2 * 4);
constexpr size_t WS_H = WS_XCUR + al256((size_t)MROWS * DM * 4);
constexpr size_t WS_PMIX = WS_H + al256((size_t)MROWS * DM * 2);
constexpr size_t WS_GP = WS_PMIX + al256((size_t)MROWS * NMIXP * 2);
constexpr size_t WS_MG = WS_GP + al256((size_t)MROWS * NGP * 2);
constexpr size_t WS_RSQ = WS_MG + al256((size_t)MROWS * NMG * 2);
constexpr size_t WS_Q = WS_RSQ + al256((size_t)MROWS * 12 * 4);
constexpr size_t WS_KV = WS_Q + al256((size_t)MROWS * 1536 * 2);
constexpr size_t WS_KR = WS_KV + al256((size_t)MROWS * 2048 * 2);
constexpr size_t WS_LA = WS_KR + al256((size_t)MROWS * 64 * 2);
constexpr size_t WS_LU = WS_LA + al256((size_t)2 * MROWS * 1024 * 4);
constexpr size_t WS_AGG = WS_LU + al256((size_t)2 * MROWS * 1024 * 4);
constexpr size_t WS_O = WS_AGG + al256((size_t)2 * NB * NCHUNK * 1024 * 2 * 4);
constexpr size_t WS_BAR = WS_O + al256((size_t)MROWS * 3072 * 2);
constexpr size_t WS_END = WS_BAR + 16384;

constexpr int LDS_BYTES = 147456;

struct Args { const float* in[21]; float* out; unsigned char* ws; };

typedef float f32x2_t __attribute__((ext_vector_type(2))); typedef __bf16 bf16x2_t __attribute__((ext_vector_type(2)));
__device__ __forceinline__ unsigned cvt_pk(float lo, float hi) { f32x2_t v = {lo, hi}; bf16x2_t b = __builtin_convertvector(v, bf16x2_t); return __builtin_bit_cast(unsigned, b); }
__device__ __forceinline__ float bflo(unsigned u) { return __uint_as_float(u << 16); }
__device__ __forceinline__ float bfhi(unsigned u) { return __uint_as_float(u & 0xffff0000u); }
__device__ __forceinline__ float bf1(bf16_t u) { return __uint_as_float(((unsigned)u) << 16); }
__device__ __forceinline__ u32x4 pack8(f32x4 a, f32x4 b) { u32x4 w; w.x = cvt_pk(a[0], a[1]); w.y = cvt_pk(a[2], a[3]); w.z = cvt_pk(b[0], b[1]); w.w = cvt_pk(b[2], b[3]); return w; }
__device__ __forceinline__ float sigmoidf_(float x) { return __builtin_amdgcn_rcpf(1.f + __expf(-x)); }
__device__ __forceinline__ float shx(float v, int lane, int m) { return __int_as_float(__builtin_amdgcn_ds_bpermute((lane ^ m) << 2, __float_as_int(v))); }
__device__ __forceinline__ float wave_sum(float v, int lane) {
#pragma unroll
    for (int o = 1; o < 64; o <<= 1) v += shx(v, lane, o);
    return v;
}
__device__ __forceinline__ int opaque_v(int x) { asm volatile("" : "+v"(x)); return x; }
__device__ __forceinline__ int crow(int r, int hi) { return (r & 3) + 8 * (r >> 2) + 4 * hi; }

namespace pg8 {
constexpr int BM = 256, BK = 64, HALF = 128, HTB = HALF * BK * 2, NXCD = 8, WGM = 8;
__host__ __device__ __forceinline__ int lds_byte(int r, int c) { const int st = (r >> 4) * 2 + (c >> 5), rr = r & 15, cc = c & 31, ob = rr * 64 + cc * 2; return st * 1024 + (ob ^ (((ob >> 9) & 1) << 5)); }
__host__ __device__ __forceinline__ void stage_rc(int b, int& R, int& C) { const int st = b / 1024, sb = b % 1024, swz = sb ^ (((sb >> 9) & 1) << 5); R = (st >> 1) * 16 + swz / 64; C = (st & 1) * 32 + (swz % 64) / 2; }
__host__ __device__ __forceinline__ int perm32(int rho) { const int n = rho >> 4, i = rho & 15; return 8 * (i >> 2) + 4 * n + (i & 3); }

struct Unit { int pm, pn, z; };
struct Gemm { const bf16_t* A; const bf16_t* Bt; int lda, ldb, K; size_t azs, bzs; };

struct Sched {
    int nM, nN, nwg, G, c, nz;
    __device__ void init(int M, int N, int G_, int c_, int nz_) { nM = M / BM; nN = N / BM; nwg = nM * nN; G = G_; c = c_; nz = nz_; }
    __device__ bool next(int i, Unit& u) const {
        const int it = i / nz; u.z = i - it * nz;
        const long L = (long)it * G + c; if (L >= nwg) return false;
        int wgid = (int)L; { const int q = nwg / NXCD, r = nwg % NXCD, xcd = wgid % NXCD, off = wgid / NXCD; wgid = (xcd < r ? xcd * (q + 1) : r * (q + 1) + (xcd - r) * q) + off; }
        const int nig = WGM * nN, gid = wgid / nig, fm = gid * WGM, gsz = (nM - fm) < WGM ? (nM - fm) : WGM;
        u.pm = fm + ((wgid % nig) % gsz); u.pn = (wgid % nig) / gsz; return true;
    }
};

template <class Epi>
__device__ __forceinline__ void gemm_phase(LAS unsigned char* lds, const Gemm g, const Sched& S, const Epi& E) {
    const int tid = opaque_v(threadIdx.x), wid = __builtin_amdgcn_readfirstlane(tid >> 6), lane = tid & 63, wr = wid >> 2, wc = wid & 3, fr = lane & 15, fq = lane >> 4;
    const int K = g.K, nt = K / BK;
    unsigned voffA[2], voffB[2];
#pragma unroll
    for (int i = 0; i < 2; ++i) { int R, C; stage_rc(tid * 16 + i * 8192, R, C); const int Rb = (R & ~31) + perm32(R & 31);
        voffA[i] = (unsigned)(R * g.lda + C) * 2u; voffB[i] = (unsigned)(Rb * g.ldb + C) * 2u; }
    const size_t kstep = (size_t)(BK * 2);
    const size_t hstepA = (size_t)HALF * g.lda * 2, hstepB = (size_t)HALF * g.ldb * 2;
    const unsigned ldsw = (unsigned)wid * 1024u;
    const int aoff = lds_byte(wr * 64 + fr, fq * 8), boff = lds_byte(wc * 32 + fr, fq * 8);
#define PG8_SA(b, h) (((b) * 2 + (h)) * HTB)
#define PG8_SB(b, h) ((4 + (b) * 2 + (h)) * HTB)
#define PG8_STAGE(bufoff, gbase, voff) do { _Pragma("unroll") for (int _i = 0; _i < 2; ++_i) \
        __builtin_amdgcn_global_load_lds((const unsigned*)((const char*)(gbase) + (voff)[_i]), (LAS unsigned*)(lds + (bufoff) + ldsw + _i * 8192), 16, 0, 0); } while (0)
#define PG8_LDA(dst, b, h) do { _Pragma("unroll") for (int m = 0; m < 4; ++m) _Pragma("unroll") for (int k = 0; k < 2; ++k) dst[m][k] = *(const LAS bf16x8*)(lds + PG8_SA(b, h) + aoff + m * 2048 + k * 1024); } while (0)
#define PG8_LDB(dst, b, h) do { _Pragma("unroll") for (int n = 0; n < 2; ++n) _Pragma("unroll") for (int k = 0; k < 2; ++k) dst[n][k] = *(const LAS bf16x8*)(lds + PG8_SB(b, h) + boff + n * 2048 + k * 1024); } while (0)
#define PG8_MMA(ai, bj, At, Bt) do { __builtin_amdgcn_s_setprio(1); _Pragma("unroll") for (int m = 0; m < 4; ++m) _Pragma("unroll") for (int n = 0; n < 2; ++n) _Pragma("unroll") for (int k = 0; k < 2; ++k) \
        acc[ai][bj][m][n] = __builtin_amdgcn_mfma_f32_16x16x32_bf16(Bt[n][k], At[m][k], acc[ai][bj][m][n], 0, 0, 0); __builtin_amdgcn_s_setprio(0); } while (0)
#define PG8_WAIT_V(n) asm volatile("s_waitcnt vmcnt(" #n ")" ::: "memory")
#define PG8_WAIT_L(n) asm volatile("s_waitcnt lgkmcnt(" #n ")" ::: "memory")
#define PG8_BAR __builtin_amdgcn_s_barrier()
#define PG8_SCHED __builtin_amdgcn_sched_barrier(0)
    Unit cur, nxt; int ui = 0;
    if (!S.next(0, cur)) return;
    f32x4 acc[2][2][4][2];
#pragma unroll
    for (int a = 0; a < 2; ++a)
#pragma unroll
        for (int b = 0; b < 2; ++b)
#pragma unroll
            for (int m = 0; m < 4; ++m)
#pragma unroll
                for (int n = 0; n < 2; ++n) acc[a][b][m][n] = (f32x4){0.f, 0.f, 0.f, 0.f};
    bf16x8 At[4][2], B0[2][2], B1[2][2];
    const char* cA = (const char*)g.A + ((size_t)cur.z * g.azs + (size_t)cur.pm * BM * g.lda) * 2;
    const char* cB = (const char*)g.Bt + ((size_t)cur.z * g.bzs + (size_t)cur.pn * BM * g.ldb) * 2;
    PG8_STAGE(PG8_SB(0, 0), cB, voffB); PG8_STAGE(PG8_SB(0, 1), cB + hstepB, voffB); PG8_STAGE(PG8_SA(0, 0), cA, voffA); PG8_STAGE(PG8_SA(0, 1), cA + hstepA, voffA);
    if (wr == 1) PG8_BAR;
    PG8_WAIT_V(2); PG8_BAR;
    PG8_STAGE(PG8_SB(1, 0), cB + kstep, voffB); PG8_STAGE(PG8_SA(1, 0), cA + kstep, voffA); PG8_STAGE(PG8_SB(1, 1), cB + hstepB + kstep, voffB);
    PG8_WAIT_V(6); PG8_BAR;
    for (;;) {
        const bool has_next = S.next(ui + 1, nxt);
        const char* nA = has_next ? (const char*)g.A + ((size_t)nxt.z * g.azs + (size_t)nxt.pm * BM * g.lda) * 2 : cA;
        const char* nB = has_next ? (const char*)g.Bt + ((size_t)nxt.z * g.bzs + (size_t)nxt.pn * BM * g.ldb) * 2 : cB;
        for (int t = 0; t < nt; t += 2) {
            const bool last = (t == nt - 2);
            const char* a1 = cA + (size_t)(t + 1) * kstep;
            const char* a2 = last ? nA : cA + (size_t)(t + 2) * kstep; const char* b2 = last ? nB : cB + (size_t)(t + 2) * kstep;
            const char* a3 = a2 + kstep; const char* b3 = b2 + kstep;
            PG8_LDB(B0, 0, 0); PG8_LDB(B1, 0, 1); PG8_SCHED; PG8_LDA(At, 0, 0); PG8_STAGE(PG8_SA(1, 1), a1 + hstepA, voffA);
            PG8_WAIT_V(8); PG8_WAIT_L(0); PG8_BAR; PG8_MMA(0, 0, At, B0); PG8_MMA(0, 1, At, B1); PG8_BAR; PG8_SCHED;
            PG8_LDA(At, 0, 1); PG8_STAGE(PG8_SB(0, 0), b2, voffB); PG8_STAGE(PG8_SB(0, 1), b2 + hstepB, voffB); PG8_STAGE(PG8_SA(0, 0), a2, voffA);
            PG8_WAIT_V(8); PG8_WAIT_L(0); PG8_BAR; PG8_MMA(1, 0, At, B0); PG8_MMA(1, 1, At, B1); PG8_BAR; PG8_SCHED;
            PG8_LDB(B0, 1, 0); PG8_LDB(B1, 1, 1); PG8_SCHED; PG8_LDA(At, 1, 0); PG8_STAGE(PG8_SA(0, 1), a2 + hstepA, voffA);
            PG8_WAIT_V(8); PG8_WAIT_L(0); PG8_BAR; PG8_MMA(0, 0, At, B0); PG8_MMA(0, 1, At, B1); PG8_BAR; PG8_SCHED;
            PG8_LDA(At, 1, 1); PG8_STAGE(PG8_SB(1, 0), b3, voffB); PG8_STAGE(PG8_SB(1, 1), b3 + hstepB, voffB); PG8_STAGE(PG8_SA(1, 0), a3, voffA);
            PG8_WAIT_V(8); PG8_WAIT_L(0); PG8_BAR; PG8_MMA(1, 0, At, B0); PG8_MMA(1, 1, At, B1); PG8_BAR; PG8_SCHED;
        }
        if (wr == 0) PG8_BAR;
        { const int l2 = opaque_v(lane); E(acc, cur, wr, wc, l2 & 15, l2 >> 4); }
        if (!has_next) break;
#pragma unroll
        for (int a = 0; a < 2; ++a)
#pragma unroll
            for (int b = 0; b < 2; ++b)
#pragma unroll
                for (int m = 0; m < 4; ++m)
#pragma unroll
                    for (int n = 0; n < 2; ++n) acc[a][b][m][n] = (f32x4){0.f, 0.f, 0.f, 0.f};
        cur = nxt; cA = nA; cB = nB; ++ui;
        if (wr == 1) PG8_BAR;
    }
    PG8_WAIT_V(0);
    PG8_BAR;
#undef PG8_SA
#undef PG8_SB
#undef PG8_STAGE
#undef PG8_LDA
#undef PG8_LDB
#undef PG8_MMA
#undef PG8_WAIT_V
#undef PG8_WAIT_L
#undef PG8_BAR
#undef PG8_SCHED
}
}
typedef f32x4 AccT[2][2][4][2];
#define EPI_FENCE(a, b) asm volatile("" : "+v"(a), "+v"(b) :: "memory")

struct EpiIn {
    bf16_t* pmix; bf16_t* gp; bf16_t* mg; float* rsq;
    __device__ __forceinline__ void operator()(const AccT& acc, const pg8::Unit& u, int wr, int wc, int fr, int fq) const {
        const int row0 = u.pm * 256 + wr * 64 + fr, pn = u.pn;
        if (pn < 20) {
#pragma unroll
            for (int ai = 0; ai < 2; ++ai)
#pragma unroll
                for (int m = 0; m < 4; ++m) {
                    __builtin_amdgcn_sched_barrier(0); const int row = row0 + ai * 128 + m * 16; float ss = 0.f;
#pragma unroll
                    for (int bj = 0; bj < 2; ++bj) {
                        const int col0 = pn * 256 + bj * 128 + wc * 32 + 8 * fq;
                        f32x4 v0 = acc[ai][bj][m][0], v1 = acc[ai][bj][m][1]; EPI_FENCE(v0, v1);
                        ss += (v0[0] * v0[0] + v0[1] * v0[1]) + (v0[2] * v0[2] + v0[3] * v0[3]) + (v1[0] * v1[0] + v1[1] * v1[1]) + (v1[2] * v1[2] + v1[3] * v1[3]);
                        const float sc = (col0 >= O_NAQ && col0 < O_NAK) ? C_NA : 1.f;
                        *(u32x4*)(pmix + (size_t)row * NMIXP + col0) = pack8(v0 * sc, v1 * sc);
                    }
                    if (pn < 3) { ss += shx(ss, fr + 16 * fq, 16); ss += shx(ss, fr + 16 * fq, 32); if (fq == 0) rsq[(size_t)row * 12 + pn * 4 + wc] = ss; }
                }
        } else if (pn < 32) {
#pragma unroll
            for (int ai = 0; ai < 2; ++ai)
#pragma unroll
                for (int m = 0; m < 4; ++m) {
                    __builtin_amdgcn_sched_barrier(0); const int row = row0 + ai * 128 + m * 16;
#pragma unroll
                    for (int bj = 0; bj < 2; ++bj) {
                        const int col0 = (pn - 20) * 256 + bj * 128 + wc * 32 + 8 * fq;
                        f32x4 v0 = acc[ai][bj][m][0], v1 = acc[ai][bj][m][1]; EPI_FENCE(v0, v1);
#pragma unroll
                        for (int e = 0; e < 4; ++e) { v0[e] = v0[e] * sigmoidf_(v0[e]); v1[e] = v1[e] * sigmoidf_(v1[e]); }
                        *(u32x4*)(gp + (size_t)row * NGP + col0) = pack8(v0, v1);
                    }
                }
        } else {
#pragma unroll
            for (int ai = 0; ai < 2; ++ai)
#pragma unroll
                for (int m = 0; m < 4; ++m) {
                    __builtin_amdgcn_sched_barrier(0); const int row = row0 + ai * 128 + m * 16;
#pragma unroll
                    for (int bj = 0; bj < 2; ++bj) {
                        const int col0 = (pn - 32) * 256 + bj * 128 + wc * 32 + 8 * fq;
                        f32x4 v0 = acc[ai][bj][m][0], v1 = acc[ai][bj][m][1]; EPI_FENCE(v0, v1);
#pragma unroll
                        for (int e = 0; e < 4; ++e) { v0[e] = sigmoidf_(v0[e]); v1[e] = sigmoidf_(v1[e]); }
                        *(u32x4*)(mg + (size_t)row * NMG + col0) = pack8(v0, v1);
                    }
                }
        }
    }
};
struct EpiQ {
    bf16_t* q; const float* rsq; const float* cs;
    __device__ __forceinline__ void operator()(const AccT& acc, const pg8::Unit& u, int wr, int wc, int fr, int fq) const {
        const int row0 = u.pm * 256 + wr * 64 + fr, pn = u.pn; const bool lat = u.pm < 64;
#pragma unroll
        for (int ai = 0; ai < 2; ++ai) {
          float rinv4[4];
          { f32x4 ra[4], rb[4];
#pragma unroll
            for (int i = 0; i < 4; ++i) { const int row = row0 + ai * 128 + i * 16; ra[i] = *(const f32x4*)(rsq + (size_t)row * 12); rb[i] = *(const f32x4*)(rsq + (size_t)row * 12 + 4); }
#pragma unroll
            for (int i = 0; i < 4; ++i) rinv4[i] = rsqrtf((((ra[i][0] + ra[i][1]) + (ra[i][2] + ra[i][3])) + ((rb[i][0] + rb[i][1]) + (rb[i][2] + rb[i][3]))) * (1.f / 512.f) + EPS) * C_MLA; }
#pragma unroll
            for (int m = 0; m < 4; ++m) {
                __builtin_amdgcn_sched_barrier(0); const int row = row0 + ai * 128 + m * 16;
                const float rinv = rinv4[m];
                const int s = row & 4095;
#pragma unroll
                for (int bj = 0; bj < 2; ++bj) {
                    const int g32 = pn * 8 + bj * 4 + wc, t6 = g32 % 6, col0 = g32 * 32 + 8 * fq;
                    f32x4 v0 = acc[ai][bj][m][0], v1 = acc[ai][bj][m][1]; EPI_FENCE(v0, v1); v0 = v0 * rinv; v1 = v1 * rinv;
                    if (t6 >= 4 && lat) {
                        const int pos = (t6 == 4) ? (s >> 6) : (s & 63);
                        const float* cp = cs + (pos * 16 + 8 * (fq & 1)) * 2;
                        const f32x4 c0 = *(const f32x4*)(cp), c1 = *(const f32x4*)(cp + 4), c2 = *(const f32x4*)(cp + 8), c3 = *(const f32x4*)(cp + 12);
                        const float cosv[8] = {c0[0], c0[2], c1[0], c1[2], c2[0], c2[2], c3[0], c3[2]};
                        const float sinv[8] = {c0[1], c0[3], c1[1], c1[3], c2[1], c2[3], c3[1], c3[3]};
                        float x[8] = {v0[0], v0[1], v0[2], v0[3], v1[0], v1[1], v1[2], v1[3]};
#pragma unroll
                        for (int e = 0; e < 8; ++e) { const float p = shx(x[e], fr + 16 * fq, 32); x[e] = (fq < 2) ? (x[e] * cosv[e] - p * sinv[e]) : (p * sinv[e] + x[e] * cosv[e]); }
                        v0 = (f32x4){x[0], x[1], x[2], x[3]}; v1 = (f32x4){x[4], x[5], x[6], x[7]};
                    }
                    *(u32x4*)(q + (size_t)row * 1536 + col0) = pack8(v0, v1);
                }
            }
        }
    }
};
struct EpiKV {
    bf16_t* kv; const float* rsq;
    __device__ __forceinline__ void operator()(const AccT& acc, const pg8::Unit& u, int wr, int wc, int fr, int fq) const {
        const int row0 = u.pm * 256 + wr * 64 + fr, pn = u.pn;
#pragma unroll
        for (int ai = 0; ai < 2; ++ai) {
          float rinv4[4];
          { f32x4 ra[4];
#pragma unroll
            for (int i = 0; i < 4; ++i) { const int row = row0 + ai * 128 + i * 16; ra[i] = *(const f32x4*)(rsq + (size_t)row * 12 + 8); }
#pragma unroll
            for (int i = 0; i < 4; ++i) rinv4[i] = rsqrtf(((ra[i][0] + ra[i][1]) + (ra[i][2] + ra[i][3])) * (1.f / 256.f) + EPS); }
#pragma unroll
            for (int m = 0; m < 4; ++m) {
                __builtin_amdgcn_sched_barrier(0); const int row = row0 + ai * 128 + m * 16;
                const float rinv = rinv4[m];
#pragma unroll
                for (int bj = 0; bj < 2; ++bj) {
                    const int col0 = pn * 256 + bj * 128 + wc * 32 + 8 * fq;
                    f32x4 v0 = acc[ai][bj][m][0], v1 = acc[ai][bj][m][1]; EPI_FENCE(v0, v1);
                    *(u32x4*)(kv + (size_t)row * 2048 + col0) = pack8(v0 * rinv, v1 * rinv);
                }
            }
        }
    }
};
struct EpiMerge {
    const bf16_t* mg; float* tmp; bf16_t* merged;
    __device__ __forceinline__ void operator()(const AccT& acc, const pg8::Unit& u, int wr, int wc, int fr, int fq) const {
        const int row0 = u.pm * 256 + wr * 64 + fr, pn = u.pn, z = u.z;
#pragma unroll
        for (int ai = 0; ai < 2; ++ai) {
            u32x4 gw8[8], pw8[8];
#pragma unroll
            for (int i = 0; i < 8; ++i) { const int row = row0 + ai * 128 + (i >> 1) * 16, col0 = pn * 256 + (i & 1) * 128 + wc * 32 + 8 * fq;
                gw8[i] = *(const u32x4*)(mg + (size_t)row * NMG + z * 2048 + col0);
                pw8[i] = (z > 0) ? *(const u32x4*)(merged + (size_t)row * 2048 + col0) : (u32x4){0u, 0u, 0u, 0u}; }
#pragma unroll
            for (int i = 0; i < 8; ++i) { const int m = i >> 1, bj = i & 1; const int row = row0 + ai * 128 + m * 16, col0 = pn * 256 + bj * 128 + wc * 32 + 8 * fq;
                f32x4 v0 = acc[ai][bj][m][0], v1 = acc[ai][bj][m][1]; EPI_FENCE(v0, v1);
                const u32x4 gw = gw8[i], pw = pw8[i];
                v0[0] = v0[0] * bflo(gw.x) + bflo(pw.x); v0[1] = v0[1] * bfhi(gw.x) + bfhi(pw.x); v0[2] = v0[2] * bflo(gw.y) + bflo(pw.y); v0[3] = v0[3] * bfhi(gw.y) + bfhi(pw.y);
                v1[0] = v1[0] * bflo(gw.z) + bflo(pw.z); v1[1] = v1[1] * bfhi(gw.z) + bfhi(pw.z); v1[2] = v1[2] * bflo(gw.w) + bflo(pw.w); v1[3] = v1[3] * bfhi(gw.w) + bfhi(pw.w);
                *(u32x4*)(merged + (size_t)row * 2048 + col0) = pack8(v0, v1); }
        }
    }
};
struct EpiOut {
    const float* xin; const float* ctxin; float* xcur; const float* mod; int layer;
    __device__ __forceinline__ void operator()(const AccT& acc, const pg8::Unit& u, int wr, int wc, int fr, int fq) const {
        const int row0 = u.pm * 256 + wr * 64 + fr, pn = u.pn; const bool lat = u.pm < 64;
        const float* gt = mod + (size_t)(lat ? (u.pm >> 4) : 4) * 6144 + 4096;
#pragma unroll
        for (int hq = 0; hq < 4; ++hq) {
            const int ai = hq >> 1, m0 = (hq & 1) * 2;
            f32x4 xa[4], xb[4];
#pragma unroll
            for (int i = 0; i < 4; ++i) { const int row = row0 + ai * 128 + (m0 + (i >> 1)) * 16, col0 = pn * 256 + (i & 1) * 128 + wc * 32 + 8 * fq;
                const float* xo = (layer == 0) ? (lat ? xin + (size_t)row * 2048 : ctxin + (size_t)(row - NLAT) * 2048) : xcur + (size_t)row * 2048;
                xa[i] = *(const f32x4*)(xo + col0); xb[i] = *(const f32x4*)(xo + col0 + 4); }
#pragma unroll
            for (int i = 0; i < 4; ++i) { const int m = m0 + (i >> 1), bj = i & 1; const int row = row0 + ai * 128 + m * 16, col0 = pn * 256 + bj * 128 + wc * 32 + 8 * fq;
                f32x4 v0 = acc[ai][bj][m][0], v1 = acc[ai][bj][m][1]; EPI_FENCE(v0, v1);
                const f32x4 g0 = *(const f32x4*)(gt + col0), g1 = *(const f32x4*)(gt + col0 + 4);
                *(f32x4*)(xcur + (size_t)row * 2048 + col0) = xa[i] + g0 * v0;
                *(f32x4*)(xcur + (size_t)row * 2048 + col0 + 4) = xb[i] + g1 * v1; }
        }
    }
};

namespace mla {
typedef short s16x4 __attribute__((ext_vector_type(4)));
constexpr int SHM_V = 16384, SHM_K = 16384, SHM_KR = 8192;
constexpr int OFF_V = 0, OFF_K = 2 * SHM_V, OFF_KR = OFF_K + 2 * SHM_K, OFF_WS = OFF_KR + 2 * SHM_KR;
constexpr float THR2 = 8.f;
#define KSWZ(row, colB) ((row) * 256 + ((colB) ^ (((row) & 7) << 4)))
#define KRSWZ(row, colB) ((row) * 128 + ((colB) ^ (((row) & 7) << 4)))
#define SBAR() __builtin_amdgcn_sched_barrier(0)
__device__ __forceinline__ void partialSM(f32x16& p0, f32x16& p1, float& m_reg, float& mn, float& alpha) {
    float pmax = p0[0];
#pragma unroll
    for (int r = 1; r < 16; ++r) pmax = fmaxf(pmax, p0[r]);
#pragma unroll
    for (int r = 0; r < 16; ++r) pmax = fmaxf(pmax, p1[r]);
    { auto rr = __builtin_amdgcn_permlane32_swap(__float_as_uint(pmax), __float_as_uint(pmax), false, false);
      pmax = fmaxf(__uint_as_float(rr[0]), __uint_as_float(rr[1])); }
    if (__builtin_expect(__all(pmax - m_reg <= THR2), 1)) { mn = m_reg; alpha = 1.f; }
    else { mn = fmaxf(m_reg, pmax); alpha = __builtin_amdgcn_exp2f(m_reg - mn); m_reg = mn; }
#pragma unroll
    for (int r = 0; r < 16; ++r) p0[r] = p0[r] - mn;
#pragma unroll
    for (int r = 0; r < 16; ++r) p1[r] = p1[r] - mn;
#pragma unroll
    for (int r = 0; r < 16; ++r) p0[r] = __builtin_amdgcn_exp2f(p0[r]);
}
__device__ __forceinline__ void finishSM(f32x16& p0, f32x16& p1, float alpha, float& l_reg, bf16x8& pa0, bf16x8& pa1, bf16x8& pa2, bf16x8& pa3) {
#pragma unroll
    for (int r = 0; r < 16; ++r) p1[r] = __builtin_amdgcn_exp2f(p1[r]);
    float ps = 0;
#pragma unroll
    for (int r = 0; r < 16; ++r) ps += p0[r];
#pragma unroll
    for (int r = 0; r < 16; ++r) ps += p1[r];
    { auto rr = __builtin_amdgcn_permlane32_swap(__float_as_uint(ps), __float_as_uint(ps), false, false);
      ps = __uint_as_float(rr[0]) + __uint_as_float(rr[1]); }
    l_reg = l_reg * alpha + ps;
#define PK4(P, BASE, OUT) do { unsigned a0 = cvt_pk(P[BASE + 0], P[BASE + 1]), a1 = cvt_pk(P[BASE + 2], P[BASE + 3]);   \
    unsigned b0 = cvt_pk(P[BASE + 4], P[BASE + 5]), b1 = cvt_pk(P[BASE + 6], P[BASE + 7]);                              \
    auto r0 = __builtin_amdgcn_permlane32_swap(a0, b0, false, false); auto r1 = __builtin_amdgcn_permlane32_swap(a1, b1, false, false); \
    u32x4 w = {r0[0], r1[0], r0[1], r1[1]}; OUT = *reinterpret_cast<bf16x8*>(&w); } while (0)
    PK4(p0, 0, pa0); PK4(p0, 8, pa1); PK4(p1, 0, pa2); PK4(p1, 8, pa3);
#undef PK4
}
__device__ __forceinline__ void qkt(f32x16& p0, f32x16& p1, const char* Ks, const char* KRs, const bf16x8* qr, int r32, int hi) {
    p0 = f32x16{}; p1 = f32x16{};
#pragma unroll
    for (int d0 = 0; d0 < 8; ++d0) { const int cb = (d0 * 16 + hi * 8) * 2;
        bf16x8 b0 = *reinterpret_cast<const bf16x8*>(Ks + KSWZ(r32, cb));
        bf16x8 b1 = *reinterpret_cast<const bf16x8*>(Ks + KSWZ(32 + r32, cb));
        p0 = __builtin_amdgcn_mfma_f32_32x32x16_bf16(b0, qr[d0], p0, 0, 0, 0);
        p1 = __builtin_amdgcn_mfma_f32_32x32x16_bf16(b1, qr[d0], p1, 0, 0, 0); }
#pragma unroll
    for (int d0 = 0; d0 < 4; ++d0) { const int cb = (d0 * 16 + hi * 8) * 2;
        bf16x8 b0 = *reinterpret_cast<const bf16x8*>(KRs + KRSWZ(r32, cb));
        bf16x8 b1 = *reinterpret_cast<const bf16x8*>(KRs + KRSWZ(32 + r32, cb));
        p0 = __builtin_amdgcn_mfma_f32_32x32x16_bf16(b0, qr[8 + d0], p0, 0, 0, 0);
        p1 = __builtin_amdgcn_mfma_f32_32x32x16_bf16(b1, qr[8 + d0], p1, 0, 0, 0); }
}
__device__ __forceinline__ int v_st(int k, int c) { const int kk = (k & ~0xC) | ((k & 4) << 1) | ((k & 8) >> 1); return ((kk >> 3) * 4 + (c >> 5)) * 512 + ((kk & 7) * 32 + (c & 31)) * 2; }
__device__ __forceinline__ int v_rd_base(int lane) { return ((lane & 3) << 3) | (((lane >> 2) & 3) << 6) | (((lane >> 4) & 1) << 5) | (((lane >> 5) & 1) << 8); }
constexpr int v_rd_off(int d0, int ks, int half) { return d0 * 512 + ks * 4096 + half * 2048; }
template <int OFF> __device__ __forceinline__ s16x4 tr_read(int vb) {
    s16x4 r; asm volatile("ds_read_b64_tr_b16 %0, %1 offset:%2" : "=&v"(r) : "v"(vb), "i"(OFF) : "memory"); return r;
}
template <int D0> __device__ __forceinline__ void pv_one(f32x16& od, int vb, bf16x8 pa0, bf16x8 pa1, bf16x8 pa2, bf16x8 pa3) {
    const s16x4 l0 = tr_read<v_rd_off(D0, 0, 0)>(vb), h0 = tr_read<v_rd_off(D0, 0, 1)>(vb), l1 = tr_read<v_rd_off(D0, 1, 0)>(vb), h1 = tr_read<v_rd_off(D0, 1, 1)>(vb);
    const s16x4 l2 = tr_read<v_rd_off(D0, 2, 0)>(vb), h2 = tr_read<v_rd_off(D0, 2, 1)>(vb), l3 = tr_read<v_rd_off(D0, 3, 0)>(vb), h3 = tr_read<v_rd_off(D0, 3, 1)>(vb);
    asm volatile("s_waitcnt lgkmcnt(0)" ::: "memory"); SBAR();
#define PK(L, H) (bf16x8){L[0], L[1], L[2], L[3], H[0], H[1], H[2], H[3]}
    od = __builtin_amdgcn_mfma_f32_32x32x16_bf16(pa0, PK(l0, h0), od, 0, 0, 0);
    od = __builtin_amdgcn_mfma_f32_32x32x16_bf16(pa1, PK(l1, h1), od, 0, 0, 0);
    od = __builtin_amdgcn_mfma_f32_32x32x16_bf16(pa2, PK(l2, h2), od, 0, 0, 0);
    od = __builtin_amdgcn_mfma_f32_32x32x16_bf16(pa3, PK(l3, h3), od, 0, 0, 0);
#undef PK
}
__device__ __forceinline__ void pv_d0(f32x16* o, int vb, bf16x8 pa0, bf16x8 pa1, bf16x8 pa2, bf16x8 pa3) {
    pv_one<0>(o[0], vb, pa0, pa1, pa2, pa3); pv_one<1>(o[1], vb, pa0, pa1, pa2, pa3); pv_one<2>(o[2], vb, pa0, pa1, pa2, pa3); pv_one<3>(o[3], vb, pa0, pa1, pa2, pa3);
}
__device__ __forceinline__ void attn_unit(const bf16_t* __restrict__ Q, const bf16_t* __restrict__ KV, const bf16_t* __restrict__ KR, const bf16_t* __restrict__ GP, bf16_t* __restrict__ O,
                                          int qrow0, int h, int latbase, int ctxbase, int nlt, int NT, char* lds) {
    const int tid = opaque_v(threadIdx.x), wid = tid >> 6, lane = tid & 63, r32 = lane & 31, hi = lane >> 5;
    char* V_lds = lds + OFF_V; char* K_lds = lds + OFF_K; char* KR_lds = lds + OFF_KR;
    float* ws = (float*)(lds + OFF_WS) + wid * 64; float* li_l = ws; float* al_l = ws + 32;
    float m_reg = -1e30f, l_reg = 0; f32x16 o[4] = {}; bf16x8 qr[12];
    const bf16_t* Qw = Q + (size_t)(qrow0 + wid * 32 + r32) * 1536 + h * 192 + hi * 8;
#pragma unroll
    for (int d0 = 0; d0 < 12; ++d0) qr[d0] = *reinterpret_cast<const bf16x8*>(Qw + d0 * 16);
    const int sr = tid >> 4, sc = (tid & 15) * 8, vst0 = v_st(sr, sc), vst1 = v_st(32 + sr, sc);
    const int krr = tid >> 3, krc = (tid & 7) * 16;
    const int vb0 = (int)(uintptr_t)V_lds + v_rd_base(lane);
    const bf16_t* Kh = KV + h * 256 + sc; const bf16_t* Vh = KV + h * 256 + 128 + sc;
    bf16x8 s_v0, s_v1, s_k0, s_k1, s_kr;
#define TROW(j) ((j) < nlt ? latbase + 64 * (j) : ctxbase + 64 * ((j) - nlt))
#define SLOAD(j) do { const int _rb = TROW(j); \
    s_v0 = *reinterpret_cast<const bf16x8*>(Vh + (size_t)(_rb + sr) * 2048); s_v1 = *reinterpret_cast<const bf16x8*>(Vh + (size_t)(_rb + 32 + sr) * 2048); \
    s_k0 = *reinterpret_cast<const bf16x8*>(Kh + (size_t)(_rb + sr) * 2048); s_k1 = *reinterpret_cast<const bf16x8*>(Kh + (size_t)(_rb + 32 + sr) * 2048); \
    s_kr = *reinterpret_cast<const bf16x8*>((const char*)KR + (size_t)(_rb + krr) * 128 + krc); } while (0)
#define SWRITE(b) do { *(bf16x8*)(V_lds + (b) * SHM_V + vst0) = s_v0; *(bf16x8*)(V_lds + (b) * SHM_V + vst1) = s_v1; const int kc = sc * 2; \
    *(bf16x8*)(K_lds + (b) * SHM_K + KSWZ(sr, kc)) = s_k0; *(bf16x8*)(K_lds + (b) * SHM_K + KSWZ(32 + sr, kc)) = s_k1; \
    *(bf16x8*)(KR_lds + (b) * SHM_KR + KRSWZ(krr, krc)) = s_kr; } while (0)
#define RESC(a) do { if (__any((a) < 1.f)) { if (hi == 0) al_l[r32] = (a); asm volatile("s_waitcnt lgkmcnt(0)" ::: "memory"); \
    _Pragma("unroll") for (int d = 0; d < 4; ++d) _Pragma("unroll") for (int r = 0; r < 16; ++r) o[d][r] *= al_l[crow(r, hi)]; } } while (0)
    f32x16 pA0, pA1, pB0, pB1; float mnA, mnB, alA, alB; bf16x8 pa0, pa1, pa2, pa3;
    SLOAD(0); asm volatile("s_waitcnt vmcnt(0)" ::: "memory"); SWRITE(0); __syncthreads();
    qkt(pA0, pA1, K_lds, KR_lds, qr, r32, hi); partialSM(pA0, pA1, m_reg, mnA, alA);
    SLOAD(1);
    asm volatile("s_waitcnt vmcnt(0)" ::: "memory"); SWRITE(1); __syncthreads();
    for (int j = 1; j + 1 < NT; j += 2) {
        SBAR(); qkt(pB0, pB1, K_lds + SHM_K, KR_lds + SHM_KR, qr, r32, hi);
        finishSM(pA0, pA1, alA, l_reg, pa0, pa1, pa2, pa3); SBAR();
        SLOAD(j + 1); SBAR();
        pv_d0(o, vb0, pa0, pa1, pa2, pa3); partialSM(pB0, pB1, m_reg, mnB, alB);
        __syncthreads(); asm volatile("s_waitcnt vmcnt(0)" ::: "memory"); SWRITE(0);
        RESC(alB); __syncthreads();
        SBAR(); qkt(pA0, pA1, K_lds, KR_lds, qr, r32, hi);
        finishSM(pB0, pB1, alB, l_reg, pa0, pa1, pa2, pa3); SBAR();
        SLOAD(j + 2); SBAR();
        pv_d0(o, vb0 + SHM_V, pa0, pa1, pa2, pa3); partialSM(pA0, pA1, m_reg, mnA, alA);
        __syncthreads(); asm volatile("s_waitcnt vmcnt(0)" ::: "memory"); SWRITE(1);
        RESC(alA); __syncthreads();
    }
    SBAR(); qkt(pB0, pB1, K_lds + SHM_K, KR_lds + SHM_KR, qr, r32, hi);
    finishSM(pA0, pA1, alA, l_reg, pa0, pa1, pa2, pa3); SBAR();
    pv_d0(o, vb0, pa0, pa1, pa2, pa3); partialSM(pB0, pB1, m_reg, mnB, alB);
    __syncthreads(); RESC(alB);
    finishSM(pB0, pB1, alB, l_reg, pa0, pa1, pa2, pa3); SBAR();
    pv_d0(o, vb0 + SHM_V, pa0, pa1, pa2, pa3);
    if (hi == 0) li_l[r32] = l_reg; asm volatile("s_waitcnt lgkmcnt(0)" ::: "memory");
    const int orow0 = qrow0 + wid * 32;
#pragma unroll
    for (int r = 0; r < 16; ++r) { const int orow = orow0 + crow(r, hi); const float rl = __builtin_amdgcn_rcpf(li_l[crow(r, hi)]);
#pragma unroll
        for (int d0 = 0; d0 < 4; ++d0) { const size_t idx = (size_t)orow * 3072 + h * 128 + d0 * 32 + r32;
            const float v = o[d0][r] * rl * bf1(GP[idx]); O[idx] = (bf16_t)(cvt_pk(v, 0.f) & 0xffffu); } }
    __syncthreads();
#undef TROW
#undef SLOAD
#undef SWRITE
#undef RESC
}
}

__device__ __forceinline__ void na_item(const bf16_t* __restrict__ PMIX, const bf16_t* __restrict__ GP, bf16_t* __restrict__ O, const float* __restrict__ bias, int item, int lane, LAS unsigned char* wl) {
    const int q = lane & 31, hi = lane >> 5;
    const bool lat = item < 8192;
    int b, h, gi = 0, jh = 0, qrow;
    if (lat) { b = item >> 11; h = (item >> 7) & 15; gi = (item >> 1) & 63; jh = item & 1; qrow = b * 4096 + gi * 64 + jh * 32 + q; }
    else { const int it = item - 8192; b = it >> 7; h = (it >> 3) & 15; qrow = NLAT + b * 256 + (it & 7) * 32 + q; }
    const int j = jh * 32 + q;
    const int c0 = min(max(j - 8, 0), 48), r0 = min(max(gi - 4, 0), 56);
    const bf16_t* qp = PMIX + (size_t)qrow * NMIXP + O_NAQ + h * 64 + hi * 8;
    bf16x8 qf[4];
#pragma unroll
    for (int ks = 0; ks < 4; ++ks) qf[ks] = *reinterpret_cast<const bf16x8*>(qp + ks * 16);
    f32x16 oT0 = {}, oT1 = {}; float m = -1e30f, l = 0.f;
    const int ntiles = lat ? 24 : 8;
    const float* bh = bias + h * (15 * 31);
    LAS float* lbias = (LAS float*)(wl + 4608);
    if (lat) {
#pragma unroll
        for (int i = 0; i < 4; ++i) { const int e = lane * 4 + i, krr = e >> 5, dc = e & 31; lbias[e] = bh[(r0 + krr - gi + 7) * 31 + min(dc, 30)] * LOG2E; }
        asm volatile("s_waitcnt vmcnt(0) lgkmcnt(0)" ::: "memory"); __builtin_amdgcn_wave_barrier();
    }
#define NA_TROW(t_) ((lat && (t_) < 16) ? (b * 4096 + (r0 + ((t_) >> 1)) * 64 + ((t_) & 1) * 32) : (NLAT + b * 256 + (lat ? (t_) - 16 : (t_)) * 32))
#define NA_LOAD(KF, VV, t_) do { const int kr0_ = NA_TROW(t_); const bf16_t* kp_ = PMIX + (size_t)(kr0_ + q) * NMIXP + O_NAK + h * 64 + hi * 8; \
        _Pragma("unroll") for (int ks = 0; ks < 4; ++ks) KF[ks] = *reinterpret_cast<const bf16x8*>(kp_ + ks * 16); \
        const bf16_t* vp_ = PMIX + (size_t)(kr0_ + (lane >> 1)) * NMIXP + O_NAV + h * 64 + (lane & 1) * 32; \
        _Pragma("unroll") for (int c = 0; c < 4; ++c) VV[c] = *reinterpret_cast<const u32x4*>(vp_ + c * 8); } while (0)
#define NA_TILE(KF, VV, t) do { \
        const bool local = lat && (t) < 16; const int kr = (t) >> 1, kblk = (t) & 1; \
        f32x16 p = {}; \
        _Pragma("unroll") for (int ks = 0; ks < 4; ++ks) p = __builtin_amdgcn_mfma_f32_32x32x16_bf16(KF[ks], qf[ks], p, 0, 0, 0); \
        _Pragma("unroll") for (int c = 0; c < 4; ++c) *(LAS u32x4*)(wl + (lane >> 1) * 144 + (lane & 1) * 64 + c * 16) = VV[c]; \
        if ((t) + 2 < ntiles) NA_LOAD(KF, VV, (t) + 2); \
        if (local) { \
            const LAS float* brow = lbias + kr * 32; \
            _Pragma("unroll") for (int r8 = 0; r8 < 16; r8 += 4) { float bv8[4]; \
                _Pragma("unroll") for (int r = 0; r < 4; ++r) { const int kc = kblk * 32 + crow(r8 + r, hi); bv8[r] = brow[min(max(kc - j + 15, 0), 30)]; } \
                _Pragma("unroll") for (int r = 0; r < 4; ++r) asm volatile("" : "+v"(bv8[r]));     \
                _Pragma("unroll") for (int r = 0; r < 4; ++r) { const int kc = kblk * 32 + crow(r8 + r, hi); const bool valid = (kc >= c0) && (kc < c0 + 16); p[r8 + r] = valid ? p[r8 + r] + bv8[r] : -INFINITY; } } \
        } \
        float tmax = p[0]; \
        _Pragma("unroll") for (int r = 1; r < 16; ++r) tmax = fmaxf(tmax, p[r]); \
        tmax = fmaxf(tmax, shx(tmax, lane, 32)); \
        const float mn = fmaxf(m, tmax), alpha = __builtin_amdgcn_exp2f(m - mn); m = mn; \
        float ps = 0.f; \
        _Pragma("unroll") for (int r = 0; r < 16; ++r) { p[r] = __builtin_amdgcn_exp2f(p[r] - mn); ps += p[r]; } \
        l = l * alpha + ps; \
        _Pragma("unroll") for (int r = 0; r < 16; ++r) { oT0[r] *= alpha; oT1[r] *= alpha; } \
        asm volatile("s_waitcnt lgkmcnt(0)" ::: "memory"); __builtin_amdgcn_wave_barrier(); \
        _Pragma("unroll") for (int ks = 0; ks < 2; ++ks) { \
            u32x4 pw; pw.x = cvt_pk(p[8 * ks + 0], p[8 * ks + 1]); pw.y = cvt_pk(p[8 * ks + 2], p[8 * ks + 3]); pw.z = cvt_pk(p[8 * ks + 4], p[8 * ks + 5]); pw.w = cvt_pk(p[8 * ks + 6], p[8 * ks + 7]); \
            const bf16x8 pf = *reinterpret_cast<bf16x8*>(&pw); \
            _Pragma("unroll") for (int db = 0; db < 2; ++db) { \
                bf16x8 vf; \
                _Pragma("unroll") for (int jj = 0; jj < 8; ++jj) { const int key = 16 * ks + 8 * (jj >> 2) + 4 * hi + (jj & 3); vf[jj] = *(const LAS short*)(wl + key * 144 + (32 * db + q) * 2); } \
                if (db == 0) oT0 = __builtin_amdgcn_mfma_f32_32x32x16_bf16(vf, pf, oT0, 0, 0, 0); \
                else oT1 = __builtin_amdgcn_mfma_f32_32x32x16_bf16(vf, pf, oT1, 0, 0, 0); \
            } \
        } \
        asm volatile("s_waitcnt lgkmcnt(0)" ::: "memory"); __builtin_amdgcn_wave_barrier(); \
    } while (0)
    bf16x8 kfa[4], kfb[4]; u32x4 vva[4], vvb[4];
    NA_LOAD(kfa, vva, 0); NA_LOAD(kfb, vvb, 1);
    for (int t0 = 0; t0 < ntiles; t0 += 2) {
        NA_TILE(kfa, vva, t0);
        NA_TILE(kfb, vvb, t0 + 1);
    }
#undef NA_TILE
#undef NA_TROW
#undef NA_LOAD
    const float inv = __builtin_amdgcn_rcpf(l + shx(l, lane, 32));
    const size_t ob = (size_t)qrow * 3072 + 1024 + h * 64;
#pragma unroll
    for (int db = 0; db < 2; ++db)
#pragma unroll
        for (int g = 0; g < 4; ++g) {
            const int d = 32 * db + 8 * g + 4 * hi;
            const u32x2 gw = *reinterpret_cast<const u32x2*>(GP + ob + d);
            float v0, v1, v2, v3;
            if (db == 0) { v0 = oT0[4 * g]; v1 = oT0[4 * g + 1]; v2 = oT0[4 * g + 2]; v3 = oT0[4 * g + 3]; } else { v0 = oT1[4 * g]; v1 = oT1[4 * g + 1]; v2 = oT1[4 * g + 2]; v3 = oT1[4 * g + 3]; }
            u32x2 w; w.x = cvt_pk(v0 * inv * bflo(gw.x), v1 * inv * bfhi(gw.x)); w.y = cvt_pk(v2 * inv * bflo(gw.y), v3 * inv * bfhi(gw.y));
            *reinterpret_cast<u32x2*>(O + ob + d) = w;
        }
}

__device__ __forceinline__ void lru_gate_phase(const bf16_t* __restrict__ PMIX, const bf16_t* __restrict__ WG, const float* __restrict__ convw, const float* __restrict__ convb,
                                               const float* __restrict__ bg, const float* __restrict__ lam, float* __restrict__ LA, float* __restrict__ LU, int bid, int G, LAS unsigned char* lds) {
    const int tid = opaque_v(threadIdx.x), lane = tid & 63, wid = tid >> 6;
    LAS float* xcf = (LAS float*)lds;
    LAS unsigned char* xcb = lds + 64 * 68 * 4;
    const int tl_s = tid >> 3, cg8 = (tid & 7) * 8;
    const int dir = wid >> 2, th = (wid >> 1) & 1, chh = wid & 1, q = lane & 31, hi = lane >> 5, cl = 32 * chh + q;
    int cur_blk = -1;
    f32x4 cw[4][2], cb0, cb1; bf16x8 br[4], bi[4]; float brv = 0.f, biv = 0.f, sp = 0.f;
    for (int item = bid; item < (MROWS / 64) * 16; item += G) {
        const int tt = item >> 4, blk = item & 15, row0 = tt * 64;
        if (blk != cur_blk) {
            cur_blk = blk;
            const int chs = blk * 64 + cg8;
            cb0 = *(const f32x4*)(convb + chs); cb1 = *(const f32x4*)(convb + chs + 4);
#pragma unroll
            for (int tap = 0; tap < 4; ++tap) { cw[tap][0] = *(const f32x4*)(convw + tap * 1024 + chs); cw[tap][1] = *(const f32x4*)(convw + tap * 1024 + chs + 4); }
            const bf16_t* wt = WG + (size_t)(dir * 16 + blk) * 128 * 64;
#pragma unroll
            for (int ks = 0; ks < 4; ++ks) { br[ks] = *reinterpret_cast<const bf16x8*>(wt + (size_t)cl * 64 + 16 * ks + 8 * hi); bi[ks] = *reinterpret_cast<const bf16x8*>(wt + (size_t)(64 + cl) * 64 + 16 * ks + 8 * hi); }
            brv = bg[dir * 2048 + blk * 128 + cl]; biv = bg[dir * 2048 + blk * 128 + 64 + cl];
            const float xs = __expf(-lam[dir * 1024 + blk * 64 + cl]);
            sp = xs < 0.05f ? xs * (1.f - xs * (0.5f - xs * ((1.f / 3.f) - xs * (0.25f - xs * 0.2f)))) : __logf(1.f + xs);
        }
        const int seg0 = row0 < NLAT ? (row0 & ~4095) : (NLAT + ((row0 - NLAT) & ~255)), seg1 = seg0 + (row0 < NLAT ? 4096 : 256);
        {
            const int row = row0 + tl_s, chs = blk * 64 + cg8;
            f32x4 x0 = cb0, x1 = cb1;
            u32x4 pv4[4];
#pragma unroll
            for (int tap = 0; tap < 4; ++tap) { const int rr = min(max(row + tap - 2, seg0), seg1 - 1); pv4[tap] = *(const u32x4*)(PMIX + (size_t)rr * NMIXP + O_PX + chs); }
#pragma unroll
            for (int tap = 0; tap < 4; ++tap) {
                const int rr = row + tap - 2; const float ok = (rr >= seg0 && rr < seg1) ? 1.f : 0.f; const u32x4 pv = pv4[tap];
                x0 += (cw[tap][0] * ok) * (f32x4){bflo(pv.x), bfhi(pv.x), bflo(pv.y), bfhi(pv.y)};
                x1 += (cw[tap][1] * ok) * (f32x4){bflo(pv.z), bfhi(pv.z), bflo(pv.w), bfhi(pv.w)};
            }
            *(LAS f32x4*)(xcf + tl_s * 68 + cg8) = x0; *(LAS f32x4*)(xcf + tl_s * 68 + cg8 + 4) = x1;
            *(LAS u32x4*)(xcb + tl_s * 144 + cg8 * 2) = pack8(x0, x1);
        }
        __syncthreads();
        {
            const int ch = blk * 64 + cl;
            f32x16 accR = {}, accI = {};
#pragma unroll
            for (int ks = 0; ks < 4; ++ks) {
                const bf16x8 af = *(const LAS bf16x8*)(xcb + (32 * th + q) * 144 + (16 * ks + 8 * hi) * 2);
                accR = __builtin_amdgcn_mfma_f32_32x32x16_bf16(af, br[ks], accR, 0, 0, 0);
                accI = __builtin_amdgcn_mfma_f32_32x32x16_bf16(af, bi[ks], accI, 0, 0, 0);
            }
#pragma unroll
            for (int r = 0; r < 16; ++r) {
                const int tl = 32 * th + crow(r, hi);
                const float rg = sigmoidf_(accR[r] + brv), ig = sigmoidf_(accI[r] + biv);
                const float log_a = -8.f * rg * sp, ym = -2.f * log_a, y1 = -log_a;
                const float om = ym < 0.1f ? ym * (1.f - ym * (0.5f - ym * ((1.f / 6.f) - ym * ((1.f / 24.f) - ym * (1.f / 120.f))))) : 1.f - __expf(-ym);
                const float oma = y1 < 0.1f ? y1 * (1.f - y1 * (0.5f - y1 * ((1.f / 6.f) - y1 * ((1.f / 24.f) - y1 * (1.f / 120.f))))) : 1.f - __expf(-y1);
                const float u = __builtin_sqrtf(fmaxf(om, 0.f)) * (ig * xcf[tl * 68 + cl]);
                const size_t idx = ((size_t)dir * MROWS + row0 + tl) * 1024 + ch;
                ((unsigned*)LA)[idx] = cvt_pk(oma, u);
            }
        }
        __syncthreads();
    }
}
__device__ __forceinline__ int chunk_row0(int b, int c) { return c < 4 ? NLAT + b * 256 + c * 64 : b * 4096 + (c - 4) * 64; }
__device__ __forceinline__ void lru_pass1_item(const float* __restrict__ LA, const float* __restrict__ LU, float* __restrict__ AGG, int item) {
    const int g = item * 512 + opaque_v(threadIdx.x), ch = (g & 255) * 4, dir = (g >> 8) & 1, bc = g >> 9, c = bc % NCHUNK, b = bc / NCHUNK;
    const int row0 = chunk_row0(b, c);
    const unsigned* ap = (const unsigned*)LA + ((size_t)dir * MROWS + row0) * 1024 + ch; (void)LU;
    f32x4 A = {1.f, 1.f, 1.f, 1.f}, H = {0.f, 0.f, 0.f, 0.f};
#pragma unroll 8
    for (int t = 0; t < 64; ++t) { const int tt = dir ? 63 - t : t; const u32x4 w = *(const u32x4*)(ap + (size_t)tt * 1024);
        const f32x4 a = {1.f - bflo(w.x), 1.f - bflo(w.y), 1.f - bflo(w.z), 1.f - bflo(w.w)}, u = {bfhi(w.x), bfhi(w.y), bfhi(w.z), bfhi(w.w)}; A *= a; H = a * H + u; }
    float* o = AGG + (((size_t)(dir * NB + b) * NCHUNK + c) * 1024 + ch) * 2;
    *(f32x4*)o = (f32x4){A[0], H[0], A[1], H[1]}; *(f32x4*)(o + 4) = (f32x4){A[2], H[2], A[3], H[3]};
}
__device__ __forceinline__ void lru_pass3_item(const float* __restrict__ LA, const float* __restrict__ LU, const float* __restrict__ AGG, const bf16_t* __restrict__ GP, bf16_t* __restrict__ O, int item, LAS unsigned char* lds) {
    const int tid = opaque_v(threadIdx.x);
    const int cg = item & 7, bc = item >> 3, c = bc % NCHUNK, b = bc / NCHUNK, row0 = chunk_row0(b, c), ch0 = cg * 128;
    LAS unsigned* S = (LAS unsigned*)lds;
    LAS float* CX = (LAS float*)(lds + 65536);
    {
        u32x4 tv[8];
#pragma unroll
        for (int p = 0; p < 8; ++p) { const int e = p * 512 + tid, arr = e >> 11, rem = e & 2047, tok = rem >> 5, c4 = rem & 31;
            tv[p] = *(const u32x4*)((const unsigned*)LA + ((size_t)arr * MROWS + row0 + tok) * 1024 + ch0 + c4 * 4); }
#pragma unroll
        for (int p = 0; p < 8; ++p) { const int e = p * 512 + tid, arr = e >> 11, rem = e & 2047, tok = rem >> 5, c4 = rem & 31;
            *(LAS u32x4*)(S + (arr * 64 + tok) * 128 + c4 * 4) = tv[p]; }
    }
    const int dir = (tid >> 7) & 1, ch = tid & 127, half = tid >> 8;
    float cA = 1.f, cH = 0.f;
    {
        const float* ag = AGG + ((size_t)(dir * NB + b) * NCHUNK * 1024 + ch0 + ch) * 2;
        const int n = dir == 0 ? c : (c < 4 ? 3 - c : 4 + (NCHUNK - 1 - c));
        const int k0 = half ? (n >> 1) : 0, k1 = half ? n : (n >> 1);
#pragma unroll 8
        for (int k = k0; k < k1; ++k) { const int cc = dir == 0 ? k : ((c < 4 || k < 4) ? 3 - k : NCHUNK - 1 - (k - 4));
            const f32x2_t q_ = *(const f32x2_t*)(ag + (size_t)cc * 2048); cA *= q_[0]; cH = q_[0] * cH + q_[1]; }
    }
    if (half) { CX[(tid - 256) * 2] = cA; CX[(tid - 256) * 2 + 1] = cH; }
    __syncthreads();
    if (tid < 256) {
        float h = CX[tid * 2] * cH + CX[tid * 2 + 1];
        LAS unsigned* su = S + dir * 64 * 128 + ch;
#pragma unroll 8
        for (int t = 0; t < 64; ++t) { const int tt = dir ? 63 - t : t; const unsigned w = su[tt * 128]; h = (1.f - bflo(w)) * h + bfhi(w); su[tt * 128] = __float_as_uint(h); }
    }
    __syncthreads();
#pragma unroll
    for (int p = 0; p < 4; ++p) { const int e = p * 512 + tid, tok = e >> 5, c4 = e & 31;
        const f32x4 hf = *(const LAS f32x4*)(S + (0 * 64 + tok) * 128 + c4 * 4), hb = *(const LAS f32x4*)(S + (1 * 64 + tok) * 128 + c4 * 4);
        const size_t oi = (size_t)(row0 + tok) * 3072 + 2048 + ch0 + c4 * 4; const u32x2 gw = *(const u32x2*)(GP + oi);
        u32x2 w; w.x = cvt_pk((hf[0] + hb[0]) * bflo(gw.x), (hf[1] + hb[1]) * bfhi(gw.x)); w.y = cvt_pk((hf[2] + hb[2]) * bflo(gw.y), (hf[3] + hb[3]) * bfhi(gw.y));
        *(u32x2*)(O + oi) = w; }
    __syncthreads();
}

__device__ __forceinline__ void transpose_item(const float* __restrict__ W, int ld_src, int k0, int n0src, const float* __restrict__ kscale, bf16_t* __restrict__ WT, int ldt, int n0dst, LAS float* scr, int lane) {
#pragma unroll 8
    for (int i = 0; i < 32; ++i) { const int kk = 2 * i + (lane >> 5); float v = W[(size_t)(k0 + kk) * ld_src + n0src + (lane & 31)]; if (kscale) v *= kscale[k0 + kk]; scr[kk * 33 + (lane & 31)] = v; }
    asm volatile("s_waitcnt lgkmcnt(0)" ::: "memory"); __builtin_amdgcn_wave_barrier();
    const int c = lane & 7;
#pragma unroll
    for (int jn = 0; jn < 4; ++jn) { const int n = (lane >> 3) + 8 * jn; const LAS float* s = scr + (8 * c) * 33 + n;
        u32x4 o; o.x = cvt_pk(s[0 * 33], s[1 * 33]); o.y = cvt_pk(s[2 * 33], s[3 * 33]); o.z = cvt_pk(s[4 * 33], s[5 * 33]); o.w = cvt_pk(s[6 * 33], s[7 * 33]);
        *(u32x4*)(WT + (size_t)(n0dst + n) * ldt + k0 + 8 * c) = o; }
    asm volatile("s_waitcnt lgkmcnt(0)" ::: "memory"); __builtin_amdgcn_wave_barrier();
}


#define XB_TMO      128
#define XB_XCNT(j)  (256  + 64 * (j))
#define XB_XSUB(j)  (1280 + 64 * (j))
#define XB_XGEN(j)  (2304 + 64 * (j))
#define XB_TOP      3328
#define XB_TOPGEN   3392
#define XCD_BAR_WORDS 3456
#define XB_SPIN_CAP (1u << 22)
__device__ __forceinline__ unsigned xb_ld(unsigned* p)              { return __hip_atomic_load(p, __ATOMIC_RELAXED, __HIP_MEMORY_SCOPE_AGENT); }
__device__ __forceinline__ unsigned xb_add(unsigned* p, unsigned v) { return __hip_atomic_fetch_add(p, v, __ATOMIC_RELAXED, __HIP_MEMORY_SCOPE_AGENT); }
__device__ __forceinline__ unsigned xb_xcc_id() { return (unsigned)__builtin_amdgcn_s_getreg((3 << 11) | 20) & 0xFu; }
#define XB_SPIN(cond, bar) do { unsigned _sp = 0; while (cond) { __builtin_amdgcn_s_sleep(1); \
    if ((++_sp & 255u) == 0u) { if (xb_ld(&(bar)[XB_TMO])) break; if (_sp > XB_SPIN_CAP) { atomicAdd(&(bar)[XB_TMO], 1u); break; } } } } while (0)
struct XcdBarrier { unsigned* bar; unsigned x; volatile LAS unsigned* st; };
__device__ __forceinline__ XcdBarrier xcd_barrier_post(unsigned* bar, volatile LAS unsigned* st) {
    XcdBarrier b; b.bar = bar; b.x = xb_xcc_id(); b.st = st;
    if (threadIdx.x == 0) (void)xb_add(&bar[XB_XCNT(b.x)], 1u);
    return b;
}
__device__ __forceinline__ void xcd_barrier_complete(unsigned* bar, unsigned x, unsigned& nloc, unsigned& nx) {
    const unsigned G = gridDim.x * gridDim.y * gridDim.z;
    unsigned sum, cnt, mine, sp = 0u;
    for (;;) {
        sum = 0u; cnt = 0u; mine = 0u;
#pragma unroll
        for (unsigned j = 0; j < 16; ++j) { const unsigned c = xb_ld(&bar[XB_XCNT(j)]); sum += c; cnt += (c > 0u) ? 1u : 0u; mine = (j == x) ? c : mine; }
        if (sum == G) break;
        __builtin_amdgcn_s_sleep(1);
        if ((++sp & 255u) == 0u) { if (xb_ld(&bar[XB_TMO])) break; if (sp > XB_SPIN_CAP) { atomicAdd(&bar[XB_TMO], 1u); break; } }
    }
    nloc = mine > 0u ? mine : 1u; nx = cnt > 0u ? cnt : 1u;
}
__device__ __forceinline__ void xcd_barrier(const XcdBarrier& b) {
    asm volatile("s_waitcnt vmcnt(0)" ::: "memory");
    __syncthreads();
    if (threadIdx.x == 0) {
        unsigned* bar = b.bar;
        __builtin_amdgcn_s_waitcnt(0);
        unsigned nloc = b.st[0], nx = b.st[1];
        if (nloc == 0u) { xcd_barrier_complete(bar, b.x, nloc, nx); b.st[0] = nloc; b.st[1] = nx; }
        const unsigned old = xb_add(&bar[XB_XSUB(b.x)], 1u);
        const unsigned gen = old / nloc;
        if (old + 1u == (gen + 1u) * nloc) {
            __builtin_amdgcn_fence(__ATOMIC_RELEASE, "agent");
            asm volatile("s_waitcnt vmcnt(0)" ::: "memory");
            const unsigned og = xb_add(&bar[XB_TOP], 1u);
            const unsigned tg = og / nx;
            if (og + 1u == (tg + 1u) * nx) xb_add(&bar[XB_TOPGEN], 1u);
            else XB_SPIN(xb_ld(&bar[XB_TOPGEN]) == tg, bar);
            __builtin_amdgcn_fence(__ATOMIC_ACQUIRE, "agent");
            xb_add(&bar[XB_XGEN(b.x)], 1u);
            asm volatile("s_waitcnt vmcnt(0)" ::: "memory");
        } else {
            XB_SPIN(xb_ld(&bar[XB_XGEN(b.x)]) == gen, bar);
            __builtin_amdgcn_fence(__ATOMIC_ACQUIRE, "agent");
            asm volatile("s_waitcnt vmcnt(0)" ::: "memory");
        }
    }
    __syncthreads();
}
#define GRID_SYNC() do { asm volatile("s_waitcnt vmcnt(0) lgkmcnt(0)" ::: "memory"); grid.sync(); \
    if (threadIdx.x < 64) asm volatile("buffer_inv sc1\n\ts_waitcnt vmcnt(0)" ::: "memory"); __syncthreads(); } while (0)
__device__ __forceinline__ unsigned char* opaque_p(unsigned char* p) { asm volatile("" : "+s"(p)); return p; }
__device__ __forceinline__ int opaque_s(int x) { asm volatile("" : "+s"(x)); return x; }
#define x_in (args.in[0])
#define c_in (args.in[1])
#define ctx_in (args.in[2])
#define cctx_in (args.in[3])
#define ada_w (args.in[4])
#define ada_b (args.in[5])
#define norm_g (args.in[6])
#define w_in (args.in[7])
#define qng (args.in[8])
#define kvng (args.in[9])
#define w_uq (args.in[10])
#define w_ukv (args.in[11])
#define rel_bias (args.in[12])
#define conv_w (args.in[13])
#define conv_b (args.in[14])
#define w_gate (args.in[15])
#define b_gate (args.in[16])
#define lam_in (args.in[17])
#define w_branch (args.in[18])
#define w_out (args.in[19])
#define fng (args.in[20])
#define WIN ((bf16_t*)(ws + WS_WIN))
#define WUQ ((bf16_t*)(ws + WS_WUQ))
#define WUKV ((bf16_t*)(ws + WS_WUKV))
#define WBR ((bf16_t*)(ws + WS_WBR))
#define WOUT ((bf16_t*)(ws + WS_WOUT))
#define WG ((bf16_t*)(ws + WS_WG))
#define MOD ((float*)(ws + WS_MOD))
#define ROPE ((float*)(ws + WS_ROPE))
#define XCUR ((float*)(ws + WS_XCUR))
#define HB ((bf16_t*)(ws + WS_H))
#define PMIX ((bf16_t*)(ws + WS_PMIX))
#define GP ((bf16_t*)(ws + WS_GP))
#define MG ((bf16_t*)(ws + WS_MG))
#define RSQ ((float*)(ws + WS_RSQ))
#define QB ((bf16_t*)(ws + WS_Q))
#define KVB ((bf16_t*)(ws + WS_KV))
#define KRB ((bf16_t*)(ws + WS_KR))
#define LA ((float*)(ws + WS_LA))
#define LU ((float*)(ws + WS_LU))
#define AGG ((float*)(ws + WS_AGG))
#define OB ((bf16_t*)(ws + WS_O))
#define MTMP LA
__global__ void __launch_bounds__(512, 2) mk_fwd(Args args) {
    extern __shared__ __attribute__((aligned(16))) unsigned char lds_raw[];
    cg::grid_group grid = cg::this_grid();
    LAS unsigned char* lds = (LAS unsigned char*)lds_raw;
    volatile LAS unsigned* xb_st = (volatile LAS unsigned*)(lds + LDS_BYTES - 64);
    if (threadIdx.x == 0) { xb_st[0] = 0u; xb_st[1] = 0u; }
    __syncthreads();
    (void)xcd_barrier_post((unsigned*)(args.ws + WS_BAR), xb_st);
#define XSYNC() do { XcdBarrier b_; b_.bar = (unsigned*)(args.ws + WS_BAR); b_.x = xb_xcc_id(); b_.st = (volatile LAS unsigned*)(lds + LDS_BYTES - 64); xcd_barrier(b_); } while (0)
#define PHASE_IDS const int tid = opaque_v(threadIdx.x), lane = tid & 63, wid = __builtin_amdgcn_readfirstlane(tid >> 6), G = opaque_s(gridDim.x), bid = opaque_s(blockIdx.x), NGW = G * 8, gw = bid * 8 + wid; unsigned char* ws = args.ws + (size_t)(unsigned)opaque_s(0); (void)lane; (void)gw; (void)NGW; (void)ws; (void)tid;

    {
        PHASE_IDS
        LAS float* scr = (LAS float*)(lds + wid * 8448);
        constexpr int I_IN = 32 * 442, I_UQ = 8 * 48, I_UKV = 4 * 64, I_BR = 3 * 16 * 64, I_OUT = 32 * 64, I_G = 32 * 4, I_L = I_IN + I_UQ + I_UKV + I_BR + I_OUT + I_G;
        for (int it = gw; it < DEPTH * I_L; it += NGW) {
            const int L = it / I_L; int r = it - L * I_L;
            if (r < I_IN) { const int kb = r / 442, nb = r % 442, n0 = nb * 32;
                transpose_item(w_in + (size_t)L * DM * NIN, NIN, kb * 64, n0, nullptr, WIN + (size_t)L * NINP * DM, DM, n0 < NMIX ? n0 : n0 + (NMIXP - NMIX), scr, lane); continue; } r -= I_IN;
            if (r < I_UQ) { const int kb = r / 48, nb = r % 48;
                transpose_item(w_uq + (size_t)L * 512 * 1536, 1536, kb * 64, nb * 32, qng + L * 512, WUQ + (size_t)L * 1536 * 512, 512, nb * 32, scr, lane); continue; } r -= I_UQ;
            if (r < I_UKV) { const int kb = r / 64, nb = r % 64;
                transpose_item(w_ukv + (size_t)L * 256 * 2048, 2048, kb * 64, nb * 32, kvng + L * 256, WUKV + (size_t)L * 2048 * 256, 256, nb * 32, scr, lane); continue; } r -= I_UKV;
            if (r < I_BR) { const int n3 = r / 1024, rr = r % 1024, kb = rr / 64, nb = rr % 64;
                transpose_item(w_branch + ((size_t)L * 3 + n3) * 1024 * 2048, 2048, kb * 64, nb * 32, nullptr, WBR + ((size_t)L * 3 + n3) * 2048 * 1024, 1024, nb * 32, scr, lane); continue; } r -= I_BR;
            if (r < I_OUT) { const int kb = r / 64, nb = r % 64;
                transpose_item(w_out + (size_t)L * DM * DM, DM, kb * 64, nb * 32, nullptr, WOUT + (size_t)L * DM * DM, DM, nb * 32, scr, lane); continue; } r -= I_OUT;
            { const int db = r / 4, nb = r % 4;
              transpose_item(w_gate + ((size_t)L * 32 + db) * 64 * 128, 128, 0, nb * 32, nullptr, WG + ((size_t)L * 32 + db) * 128 * 64, 64, nb * 32, scr, lane); }
        }
        for (int i = bid * 512 + tid; i < DEPTH * (NMIXP - NMIX) * (DM / 8); i += G * 512) {
            const int L = i / ((NMIXP - NMIX) * (DM / 8)), r = i % ((NMIXP - NMIX) * (DM / 8));
            *(u32x4*)(WIN + ((size_t)L * NINP + NMIX) * DM + (size_t)r * 8) = (u32x4){0u, 0u, 0u, 0u};
        }
        __syncthreads();
        LAS float* sil = (LAS float*)(lds + 69632);
        LAS float* red = (LAS float*)(lds + 69632 + 40960);
        for (int i = tid; i < 5 * 2048; i += 512) { const float v = i < 4 * 2048 ? c_in[i] : cctx_in[i - 4 * 2048]; sil[i] = v * (1.f / (1.f + expf(-v))); }
        __syncthreads();
        for (int it = bid; it < DEPTH * 96; it += G) {
            const int L = it / 96, cb = it % 96, ksl = tid >> 6, col = cb * 64 + (tid & 63);
            float a5[5] = {0.f, 0.f, 0.f, 0.f, 0.f};
            const float* wp = ada_w + (size_t)L * DM * 6144 + col;
            for (int k = ksl * 256; k < ksl * 256 + 256; ++k) { const float w = wp[(size_t)k * 6144];
#pragma unroll
                for (int r = 0; r < 5; ++r) a5[r] += sil[r * 2048 + k] * w; }
#pragma unroll
            for (int r = 0; r < 5; ++r) red[(ksl * 5 + r) * 64 + (tid & 63)] = a5[r];
            __syncthreads();
            if (tid < 320) { const int r = tid >> 6, cc = tid & 63; float s = 0.f;
#pragma unroll
                for (int k = 0; k < 8; ++k) s += red[(k * 5 + r) * 64 + cc];
                MOD[((size_t)L * 5 + r) * 6144 + cb * 64 + cc] = s + ada_b[(size_t)L * 6144 + cb * 64 + cc]; }
            __syncthreads();
        }
        if (bid == G - 1) for (int i = tid; i < 1024; i += 512) { const int pos = i >> 4, k = i & 15;
            const float inv = 1.0f / powf(10000.f, (float)k * (1.f / 16.f)), ang = (float)pos * inv; ROPE[2 * i] = cosf(ang); ROPE[2 * i + 1] = sinf(ang); }
    }
    GRID_SYNC();

    for (int layer = 0; layer < DEPTH; ++layer) {
        const bool need_ctx = layer < DEPTH - 1;
        { PHASE_IDS
        for (int row = gw; row < MROWS; row += NGW) {
            const bool lat = row < NLAT;
            const float* src = (layer == 0) ? (lat ? x_in + (size_t)row * DM : ctx_in + (size_t)(row - NLAT) * DM) : XCUR + (size_t)row * DM;
            const float* mr = MOD + (size_t)layer * 5 * 6144 + (size_t)(lat ? (row >> 12) : 4) * 6144;
            f32x4 v[8]; float ss = 0.f;
#pragma unroll
            for (int jv = 0; jv < 8; ++jv) { v[jv] = *(const f32x4*)(src + 4 * (lane + 64 * jv)); ss += (v[jv][0] * v[jv][0] + v[jv][1] * v[jv][1]) + (v[jv][2] * v[jv][2] + v[jv][3] * v[jv][3]); }
            const float rinv = rsqrtf(wave_sum(ss, lane) * (1.f / DM) + EPS);
#pragma unroll
            for (int jv = 0; jv < 8; ++jv) { const int col = 4 * (lane + 64 * jv);
                const f32x4 gg = *(const f32x4*)(norm_g + layer * DM + col), sh = *(const f32x4*)(mr + col), sc = *(const f32x4*)(mr + 2048 + col);
                const f32x4 hh = (v[jv] * rinv * gg) * (sc + 1.f) + sh;
                u32x2 w; w.x = cvt_pk(hh[0], hh[1]); w.y = cvt_pk(hh[2], hh[3]); *(u32x2*)(HB + (size_t)row * DM + col) = w; }
        } }
        XSYNC();
        {
            PHASE_IDS
            pg8::Gemm g{HB, WIN + (size_t)layer * NINP * DM, DM, DM, DM, 0, 0}; pg8::Sched S; S.init(MROWS, NINP, G, bid, 1);
            EpiIn E{PMIX, GP, MG, RSQ};
            pg8::gemm_phase<EpiIn>(lds, g, S, E);
        }
        XSYNC();
        {
            {
            PHASE_IDS
            { pg8::Gemm g{PMIX, WUQ + (size_t)layer * 1536 * 512, NMIXP, 512, 512, 0, 0}; pg8::Sched S; S.init(MROWS, 1536, G, bid, 1);
              EpiQ E{QB, RSQ, ROPE}; pg8::gemm_phase<EpiQ>(lds, g, S, E); }
            { pg8::Gemm g{PMIX + 512, WUKV + (size_t)layer * 2048 * 256, NMIXP, 256, 256, 0, 0}; pg8::Sched S; S.init(MROWS, 2048, G, bid, 1);
              EpiKV E{KVB, RSQ}; pg8::gemm_phase<EpiKV>(lds, g, S, E); }
            }
            {
            PHASE_IDS
            for (int i = bid * 512 + tid; i < MROWS * 4; i += G * 512) {
                const int row = i >> 2, hf = (i >> 1) & 1, sub = i & 1;
                const bf16_t* src = PMIX + (size_t)row * NMIXP + O_KR + 32 * hf + 8 * sub;
                u32x4 a = *(const u32x4*)src, b2 = *(const u32x4*)(src + 16);
                if (row < NLAT) {
                    const int s = row & 4095, pos = hf ? (s & 63) : (s >> 6);
                    const float* cp = ROPE + (pos * 16 + 8 * sub) * 2;
                    float x1[8] = {bflo(a.x), bfhi(a.x), bflo(a.y), bfhi(a.y), bflo(a.z), bfhi(a.z), bflo(a.w), bfhi(a.w)};
                    float x2[8] = {bflo(b2.x), bfhi(b2.x), bflo(b2.y), bfhi(b2.y), bflo(b2.z), bfhi(b2.z), bflo(b2.w), bfhi(b2.w)};
                    float o1[8], o2[8];
#pragma unroll
                    for (int e = 0; e < 8; ++e) { const float cv = cp[2 * e], sv = cp[2 * e + 1]; o1[e] = x1[e] * cv - x2[e] * sv; o2[e] = x1[e] * sv + x2[e] * cv; }
                    a.x = cvt_pk(o1[0], o1[1]); a.y = cvt_pk(o1[2], o1[3]); a.z = cvt_pk(o1[4], o1[5]); a.w = cvt_pk(o1[6], o1[7]);
                    b2.x = cvt_pk(o2[0], o2[1]); b2.y = cvt_pk(o2[2], o2[3]); b2.z = cvt_pk(o2[4], o2[5]); b2.w = cvt_pk(o2[6], o2[7]);
                }
                bf16_t* dst = KRB + (size_t)row * 64 + 32 * hf + 8 * sub;
                *(u32x4*)dst = a; *(u32x4*)(dst + 16) = b2;
            }
            __syncthreads();
            lru_gate_phase(PMIX, WG + (size_t)layer * 32 * 128 * 64, conv_w + (size_t)layer * 4 * 1024, conv_b + (size_t)layer * 1024, b_gate + (size_t)layer * 2 * 2048, lam_in + (size_t)layer * 2 * 1024, LA, LU, bid, G, lds);
            }
        }
        XSYNC();
        {
            PHASE_IDS
            const int nmla = 512 + (need_ctx ? 32 : 0);
            for (int u = bid; u < nmla; u += G) {
                if (u < 512) { const int b = u >> 7, h = (u >> 4) & 7, qb = u & 15;
                    mla::attn_unit(QB, KVB, KRB, GP, OB, b * 4096 + qb * 256, h, b * 4096, NLAT + b * 256, 64, 68, (char*)lds_raw); }
                else { const int b = (u - 512) >> 3, h = (u - 512) & 7;
                    mla::attn_unit(QB, KVB, KRB, GP, OB, NLAT + b * 256, h, 0, NLAT + b * 256, 0, 4, (char*)lds_raw); }
            }
            __syncthreads();
            const int nna = 8192 + (need_ctx ? 512 : 0);
            for (int it = gw; it < nna; it += NGW) na_item(PMIX, GP, OB, rel_bias + (size_t)layer * 16 * 15 * 31, it, lane, lds + wid * 5632);
            for (int it = bid; it < (NB * NCHUNK * 2 * 256) / 512; it += G) lru_pass1_item(LA, LU, AGG, it);
        }
        XSYNC();
        { PHASE_IDS
        for (int it = bid; it < NB * NCHUNK * 8; it += G) lru_pass3_item(LA, LU, AGG, GP, OB, it, lds); }
        XSYNC();
        {
            PHASE_IDS
            const int Mrows = need_ctx ? MROWS : NLAT;
            pg8::Gemm g{OB, WBR + (size_t)layer * 3 * 2048 * 1024, 3072, 1024, 1024, 1024, (size_t)2048 * 1024}; pg8::Sched S; S.init(Mrows, DM, G, bid, 3);
            EpiMerge E{MG, MTMP, HB}; pg8::gemm_phase<EpiMerge>(lds, g, S, E);
        }
        XSYNC();
        {
            PHASE_IDS
            const int Mrows = need_ctx ? MROWS : NLAT;
            pg8::Gemm g{HB, WOUT + (size_t)layer * DM * DM, DM, DM, DM, 0, 0}; pg8::Sched S; S.init(Mrows, DM, G, bid, 1);
            EpiOut E{x_in, ctx_in, XCUR, MOD + (size_t)layer * 5 * 6144, layer}; pg8::gemm_phase<EpiOut>(lds, g, S, E);
        }
        XSYNC();
    }
    { PHASE_IDS
    for (int row = gw; row < NLAT; row += NGW) {
        const float* src = XCUR + (size_t)row * DM;
        f32x4 v[8]; float ss = 0.f;
#pragma unroll
        for (int jv = 0; jv < 8; ++jv) { v[jv] = *(const f32x4*)(src + 4 * (lane + 64 * jv)); ss += (v[jv][0] * v[jv][0] + v[jv][1] * v[jv][1]) + (v[jv][2] * v[jv][2] + v[jv][3] * v[jv][3]); }
        const float rinv = rsqrtf(wave_sum(ss, lane) * (1.f / DM) + EPS);
#pragma unroll
        for (int jv = 0; jv < 8; ++jv) { const int col = 4 * (lane + 64 * jv); *(f32x4*)(args.out + (size_t)row * DM + col) = v[jv] * rinv * *(const f32x4*)(fng + col); }
    } }
}

extern "C" void kernel_launch(void* const* d_in, const int* in_sizes, int n_in, void* d_out, int out_size, void* d_ws, size_t ws_size, hipStream_t stream) {
    static int grid = 0;
    if (grid == 0) {
        if (n_in != 21 || ws_size < WS_END) { fprintf(stderr, "kernel_launch: n_in %d ws %zu (need %zu): nothing launched\n", n_in, ws_size, (size_t)WS_END); grid = -1; return; }
        int dev = 0, cus = 0, per_cu = 0;
        if (hipGetDevice(&dev) != hipSuccess || hipDeviceGetAttribute(&cus, hipDeviceAttributeMultiprocessorCount, dev) != hipSuccess) { grid = -1; return; }
        if (hipFuncSetAttribute((const void*)mk_fwd, hipFuncAttributeMaxDynamicSharedMemorySize, LDS_BYTES) != hipSuccess) { fprintf(stderr, "hipFuncSetAttribute failed\n"); grid = -1; return; }
        if (hipOccupancyMaxActiveBlocksPerMultiprocessor(&per_cu, (const void*)mk_fwd, 512, LDS_BYTES) != hipSuccess || per_cu < 1) { fprintf(stderr, "occupancy query: %d\n", per_cu); per_cu = 1; }
        (void)hipGetLastError();
        grid = cus * per_cu;
    }
    if (grid < 0) return;
    if (hipMemsetAsync((char*)d_ws + WS_BAR, 0, 16384, stream) != hipSuccess) { fprintf(stderr, "memset of barrier words failed\n"); return; }
    Args a{};
    for (int i = 0; i < 21; ++i) a.in[i] = (const float*)d_in[i];
    a.out = (float*)d_out; a.ws = (unsigned char*)d_ws;
    void* kargs[] = {&a};
    hipError_t e = hipLaunchCooperativeKernel((const void*)mk_fwd, dim3(grid), dim3(512), kargs, LDS_BYTES, stream);
    if (e != hipSuccess) fprintf(stderr, "cooperative launch failed: %s (grid %d)\n", hipGetErrorString(e), grid);
}
```

```cpp
#include <hip/hip_runtime.h>
#include <hip/hip_cooperative_groups.h>
#include <cstdio>
#include <cstdint>
namespace cg = cooperative_groups;

typedef unsigned short bf16_t;
typedef short bf16x8 __attribute__((ext_vector_type(8)));
typedef float f32x4 __attribute__((ext_vector_type(4)));
typedef float f32x16 __attribute__((ext_vector_type(16)));
typedef unsigned u32x4 __attribute__((ext_vector_type(4)));
typedef unsigned u32x2 __attribute__((ext_vector_type(2)));
#define LAS __attribute__((address_space(3)))

constexpr int DM = 2048, NB = 4, SEQ = 4096, NCTXT = 256, DEPTH = 4;
constexpr int NLAT = NB * SEQ, NCTX = NB * NCTXT, MROWS = NLAT + NCTX;
constexpr int NMIX = 4928, NMIXP = 5120, NGP = 3072, NMG = 6144, NINP = NMIXP + NGP + NMG, NIN = 14144;
constexpr int O_KR = 768, O_NAQ = 832, O_NAK = 1856, O_NAV = 2880, O_PX = 3904;
constexpr float EPS = 1e-6f, LOG2E = 1.4426950408889634f;
constexpr float C_MLA = 0.07216878364870322f * LOG2E;
constexpr float C_NA = 0.125f * LOG2E;
constexpr int NCHUNK = 68;

constexpr size_t al256(size_t x) { return (x + 255) / 256 * 256; }
constexpr size_t WS_WIN = 0;
constexpr size_t WS_WUQ = WS_WIN + al256((size_t)DEPTH * NINP * DM * 2);
constexpr size_t WS_WUKV = WS_WUQ + al256((size_t)DEPTH * 1536 * 512 * 2);
constexpr size_t WS_WBR = WS_WUKV + al256((size_t)DEPTH * 2048 * 256 * 2);
constexpr size_t WS_WOUT = WS_WBR + al256((size_t)DEPTH * 3 * 2048 * 1024 * 2);
constexpr size_t WS_WG = WS_WOUT + al256((size_t)DEPTH * 2048 * 2048 * 2);
constexpr size_t WS_MOD = WS_WG + al256((size_t)DEPTH * 2 * 16 * 128 * 64 * 2);
constexpr size_t WS_ROPE = WS_MOD + al256((size_t)DEPTH * 5 * 6144 * 4);
constexpr size_t WS_XCUR = WS_ROPE + al256((size_t)64 * 16 * 2 * 4);
constexpr size_t WS_H = WS_XCUR + al256((size_t)MROWS * DM * 4);
constexpr size_t WS_PMIX = WS_H + al256((size_t)MROWS * DM * 2);
constexpr size_t WS_GP = WS_PMIX + al256((size_t)MROWS * NMIXP * 2);
constexpr size_t WS_MG = WS_GP + al256((size_t)MROWS * NGP * 2);
constexpr size_t WS_RSQ = WS_MG + al256((size_t)MROWS * NMG * 2);
constexpr size_t WS_Q = WS_RSQ + al256((size_t)MROWS * 12 * 4);
constexpr size_t WS_KV = WS_Q + al256((size_t)MROWS * 1536 * 2);
constexpr size_t WS_KR = WS_KV + al256((size_t)MROWS * 2048 * 2);
constexpr size_t WS_LA = WS_KR + al256((size_t)MROWS * 64 * 2);
constexpr size_t WS_LU = WS_LA + al256((size_t)2 * MROWS * 1024 * 4);
constexpr size_t WS_AGG = WS_LU + al256((size_t)2 * MROWS * 1024 * 4);
constexpr size_t WS_O = WS_AGG + al256((size_t)2 * NB * NCHUNK * 1024 * 2 * 4);
constexpr size_t WS_BAR = WS_O + al256((size_t)MROWS * 3072 * 2);
constexpr size_t WS_END = WS_BAR + 16384;

constexpr int LDS_BYTES = 147456;

struct Args { const float* in[21]; float* out; unsigned char* ws; };

typedef float f32x2_t __attribute__((ext_vector_type(2))); typedef __bf16 bf16x2_t __attribute__((ext_vector_type(2)));
__device__ __forceinline__ unsigned cvt_pk(float lo, float hi) { f32x2_t v = {lo, hi}; bf16x2_t b = __builtin_convertvector(v, bf16x2_t); return __builtin_bit_cast(unsigned, b); }
__device__ __forceinline__ float bflo(unsigned u) { return __uint_as_float(u << 16); }
__device__ __forceinline__ float bfhi(unsigned u) { return __uint_as_float(u & 0xffff0000u); }
__device__ __forceinline__ float bf1(bf16_t u) { return __uint_as_float(((unsigned)u) << 16); }
__device__ __forceinline__ u32x4 pack8(f32x4 a, f32x4 b) { u32x4 w; w.x = cvt_pk(a[0], a[1]); w.y = cvt_pk(a[2], a[3]); w.z = cvt_pk(b[0], b[1]); w.w = cvt_pk(b[2], b[3]); return w; }
__device__ __forceinline__ float sigmoidf_(float x) { return __builtin_amdgcn_rcpf(1.f + __expf(-x)); }
__device__ __forceinline__ float shx(float v, int lane, int m) { return __int_as_float(__builtin_amdgcn_ds_bpermute((lane ^ m) << 2, __float_as_int(v))); }
__device__ __forceinline__ float wave_sum(float v, int lane) {
#pragma unroll
    for (int o = 1; o < 64; o <<= 1) v += shx(v, lane, o);
    return v;
}
__device__ __forceinline__ int opaque_v(int x) { asm volatile("" : "+v"(x)); return x; }
__device__ __forceinline__ int crow(int r, int hi) { return (r & 3) + 8 * (r >> 2) + 4 * hi; }

namespace pg8 {
constexpr int BM = 256, BK = 64, HALF = 128, HTB = HALF * BK * 2, NXCD = 8, WGM = 4;
__host__ __device__ __forceinline__ int lds_byte(int r, int c) { const int st = (r >> 4) * 2 + (c >> 5), rr = r & 15, cc = c & 31, ob = rr * 64 + cc * 2; return st * 1024 + (ob ^ (((ob >> 9) & 1) << 5)); }
__host__ __device__ __forceinline__ void stage_rc(int b, int& R, int& C) { const int st = b / 1024, sb = b % 1024, swz = sb ^ (((sb >> 9) & 1) << 5); R = (st >> 1) * 16 + swz / 64; C = (st & 1) * 32 + (swz % 64) / 2; }
__host__ __device__ __forceinline__ int perm32(int rho) { const int n = rho >> 4, i = rho & 15; return 8 * (i >> 2) + 4 * n + (i & 3); }

struct Unit { int pm, pn, z; };
struct Gemm { const bf16_t* A; const bf16_t* Bt; int lda, ldb, K; size_t azs, bzs; };

struct Sched {
    int nM, nN, nwg, G, c, nz;
    __device__ void init(int M, int N, int G_, int c_, int nz_) { nM = M / BM; nN = N / BM; nwg = nM * nN; G = G_; c = c_; nz = nz_; }
    __device__ bool next(int i, Unit& u) const {
        const int it = i / nz; u.z = i - it * nz;
        const long L = (long)it * G + c; if (L >= nwg) return false;
        int wgid = (int)L; { const int q = nwg / NXCD, r = nwg % NXCD, xcd = wgid % NXCD, off = wgid / NXCD; wgid = (xcd < r ? xcd * (q + 1) : r * (q + 1) + (xcd - r) * q) + off; }
        const int nig = WGM * nN, gid = wgid / nig, fm = gid * WGM, gsz = (nM - fm) < WGM ? (nM - fm) : WGM;
        u.pm = fm + ((wgid % nig) % gsz); u.pn = (wgid % nig) / gsz; return true;
    }
};

template <class Epi>
__device__ __forceinline__ void gemm_phase(LAS unsigned char* lds, const Gemm g, const Sched& S, const Epi& E) {
    const int tid = opaque_v(threadIdx.x), wid = __builtin_amdgcn_readfirstlane(tid >> 6), lane = tid & 63, wr = wid >> 2, wc = wid & 3, fr = lane & 15, fq = lane >> 4;
    const int K = g.K, nt = K / BK;
    unsigned voffA[2], voffB[2];
#pragma unroll
    for (int i = 0; i < 2; ++i) { int R, C; stage_rc(tid * 16 + i * 8192, R, C); const int Rb = (R & ~31) + perm32(R & 31);
        voffA[i] = (unsigned)(R * g.lda + C) * 2u; voffB[i] = (unsigned)(Rb * g.ldb + C) * 2u; }
    const size_t kstep = (size_t)(BK * 2);
    const size_t hstepA = (size_t)HALF * g.lda * 2, hstepB = (size_t)HALF * g.ldb * 2;
    const unsigned ldsw = (unsigned)wid * 1024u;
    const int aoff = lds_byte(wr * 64 + fr, fq * 8), boff = lds_byte(wc * 32 + fr, fq * 8);
#define PG8_SA(b, h) (((b) * 2 + (h)) * HTB)
#define PG8_SB(b, h) ((4 + (b) * 2 + (h)) * HTB)
#define PG8_STAGE(bufoff, gbase, voff) do { _Pragma("unroll") for (int _i = 0; _i < 2; ++_i) \
        __builtin_amdgcn_global_load_lds((const unsigned*)((const char*)(gbase) + (voff)[_i]), (LAS unsigned*)(lds + (bufoff) + ldsw + _i * 8192), 16, 0, 0); } while (0)
#define PG8_LDA(dst, b, h) do { _Pragma("unroll") for (int m = 0; m < 4; ++m) _Pragma("unroll") for (int k = 0; k < 2; ++k) dst[m][k] = *(const LAS bf16x8*)(lds + PG8_SA(b, h) + aoff + m * 2048 + k * 1024); } while (0)
#define PG8_LDB(dst, b, h) do { _Pragma("unroll") for (int n = 0; n < 2; ++n) _Pragma("unroll") for (int k = 0; k < 2; ++k) dst[n][k] = *(const LAS bf16x8*)(lds + PG8_SB(b, h) + boff + n * 2048 + k * 1024); } while (0)
#define PG8_MMA(ai, bj, At, Bt) do { __builtin_amdgcn_s_setprio(1); _Pragma("unroll") for (int m = 0; m < 4; ++m) _Pragma("unroll") for (int n = 0; n < 2; ++n) _Pragma("unroll") for (int k = 0; k < 2; ++k) \
        acc[ai][bj][m][n] = __builtin_amdgcn_mfma_f32_16x16x32_bf16(Bt[n][k], At[m][k], acc[ai][bj][m][n], 0, 0, 0); __builtin_amdgcn_s_setprio(0); } while (0)
#define PG8_WAIT_V(n) asm volatile("s_waitcnt vmcnt(" #n ")" ::: "memory")
#define PG8_WAIT_L(n) asm volatile("s_waitcnt lgkmcnt(" #n ")" ::: "memory")
#define PG8_BAR __builtin_amdgcn_s_barrier()
#define PG8_SCHED __builtin_amdgcn_sched_barrier(0)
    Unit cur, nxt; int ui = 0;
    if (!S.next(0, cur)) return;
    f32x4 acc[2][2][4][2];
#pragma unroll
    for (int a = 0; a < 2; ++a)
#pragma unroll
        for (int b = 0; b < 2; ++b)
#pragma unroll
            for (int m = 0; m < 4; ++m)
#pragma unroll
                for (int n = 0; n < 2; ++n) acc[a][b][m][n] = (f32x4){0.f, 0.f, 0.f, 0.f};
    bf16x8 At[4][2], B0[2][2], B1[2][2];
    const char* cA = (const char*)g.A + ((size_t)cur.z * g.azs + (size_t)cur.pm * BM * g.lda) * 2;
    const char* cB = (const char*)g.Bt + ((size_t)cur.z * g.bzs + (size_t)cur.pn * BM * g.ldb) * 2;
    PG8_STAGE(PG8_SB(0, 0), cB, voffB); PG8_STAGE(PG8_SB(0, 1), cB + hstepB, voffB); PG8_STAGE(PG8_SA(0, 0), cA, voffA); PG8_STAGE(PG8_SA(0, 1), cA + hstepA, voffA);
    if (wr == 1) PG8_BAR;
    PG8_WAIT_V(2); PG8_BAR;
    PG8_STAGE(PG8_SB(1, 0), cB + kstep, voffB); PG8_STAGE(PG8_SA(1, 0), cA + kstep, voffA); PG8_STAGE(PG8_SB(1, 1), cB + hstepB + kstep, voffB);
    PG8_WAIT_V(6); PG8_BAR;
    for (;;) {
        const bool has_next = S.next(ui + 1, nxt);
        const char* nA = has_next ? (const char*)g.A + ((size_t)nxt.z * g.azs + (size_t)nxt.pm * BM * g.lda) * 2 : cA;
        const char* nB = has_next ? (const char*)g.Bt + ((size_t)nxt.z * g.bzs + (size_t)nxt.pn * BM * g.ldb) * 2 : cB;
        for (int t = 0; t < nt; t += 2) {
            const bool last = (t == nt - 2);
            const char* a1 = cA + (size_t)(t + 1) * kstep;
            const char* a2 = last ? nA : cA + (size_t)(t + 2) * kstep; const char* b2 = last ? nB : cB + (size_t)(t + 2) * kstep;
            const char* a3 = a2 + kstep; const char* b3 = b2 + kstep;
            PG8_LDB(B0, 0, 0); PG8_LDB(B1, 0, 1); PG8_SCHED; PG8_LDA(At, 0, 0); PG8_STAGE(PG8_SA(1, 1), a1 + hstepA, voffA);
            PG8_WAIT_V(8); PG8_WAIT_L(0); PG8_BAR; PG8_MMA(0, 0, At, B0); PG8_MMA(0, 1, At, B1); PG8_BAR; PG8_SCHED;
            PG8_LDA(At, 0, 1); PG8_STAGE(PG8_SB(0, 0), b2, voffB); PG8_STAGE(PG8_SB(0, 1), b2 + hstepB, voffB); PG8_STAGE(PG8_SA(0, 0), a2, voffA);
            PG8_WAIT_V(8); PG8_WAIT_L(0); PG8_BAR; PG8_MMA(1, 0, At, B0); PG8_MMA(1, 1, At, B1); PG8_BAR; PG8_SCHED;
            PG8_LDB(B0, 1, 0); PG8_LDB(B1, 1, 1); PG8_SCHED; PG8_LDA(At, 1, 0); PG8_STAGE(PG8_SA(0, 1), a2 + hstepA, voffA);
            PG8_WAIT_V(8); PG8_WAIT_L(0); PG8_BAR; PG8_MMA(0, 0, At, B0); PG8_MMA(0, 1, At, B1); PG8_BAR; PG8_SCHED;
            PG8_LDA(At, 1, 1); PG8_STAGE(PG8_SB(1, 0), b3, voffB); PG8_STAGE(PG8_SB(1, 1), b3 + hstepB, voffB); PG8_STAGE(PG8_SA(1, 0), a3, voffA);
            PG8_WAIT_V(8); PG8_WAIT_L(0); PG8_BAR; PG8_MMA(1, 0, At, B0); PG8_MMA(1, 1, At, B1); PG8_BAR; PG8_SCHED;
        }
        if (wr == 0) PG8_BAR;
        { const int l2 = opaque_v(lane); E(acc, cur, wr, wc, l2 & 15, l2 >> 4); }
        if (!has_next) break;
#pragma unroll
        for (int a = 0; a < 2; ++a)
#pragma unroll
            for (int b = 0; b < 2; ++b)
#pragma unroll
                for (int m = 0; m < 4; ++m)
#pragma unroll
                    for (int n = 0; n < 2; ++n) acc[a][b][m][n] = (f32x4){0.f, 0.f, 0.f, 0.f};
        cur = nxt; cA = nA; cB = nB; ++ui;
        if (wr == 1) PG8_BAR;
    }
    PG8_WAIT_V(0);
    PG8_BAR;
#undef PG8_SA
#undef PG8_SB
#undef PG8_STAGE
#undef PG8_LDA
#undef PG8_LDB
#undef PG8_MMA
#undef PG8_WAIT_V
#undef PG8_WAIT_L
#undef PG8_BAR
#undef PG8_SCHED
}
}
typedef f32x4 AccT[2][2][4][2];
#define EPI_FENCE(a, b) asm volatile("" : "+v"(a), "+v"(b) :: "memory")

struct EpiIn {
    bf16_t* pmix; bf16_t* gp; bf16_t* mg; float* rsq;
    __device__ __forceinline__ void operator()(const AccT& acc, const pg8::Unit& u, int wr, int wc, int fr, int fq) const {
        const int row0 = u.pm * 256 + wr * 64 + fr, pn = u.pn;
        if (pn < 20) {
#pragma unroll
            for (int ai = 0; ai < 2; ++ai)
#pragma unroll
                for (int m = 0; m < 4; ++m) {
                    __builtin_amdgcn_sched_barrier(0); const int row = row0 + ai * 128 + m * 16; float ss = 0.f;
#pragma unroll
                    for (int bj = 0; bj < 2; ++bj) {
                        const int col0 = pn * 256 + bj * 128 + wc * 32 + 8 * fq;
                        f32x4 v0 = acc[ai][bj][m][0], v1 = acc[ai][bj][m][1]; EPI_FENCE(v0, v1);
                        ss += (v0[0] * v0[0] + v0[1] * v0[1]) + (v0[2] * v0[2] + v0[3] * v0[3]) + (v1[0] * v1[0] + v1[1] * v1[1]) + (v1[2] * v1[2] + v1[3] * v1[3]);
                        const float sc = (col0 >= O_NAQ && col0 < O_NAK) ? C_NA : 1.f;
                        *(u32x4*)(pmix + (size_t)row * NMIXP + col0) = pack8(v0 * sc, v1 * sc);
                    }
                    if (pn < 3) { ss += shx(ss, fr + 16 * fq, 16); ss += shx(ss, fr + 16 * fq, 32); if (fq == 0) rsq[(size_t)row * 12 + pn * 4 + wc] = ss; }
                }
        } else if (pn < 32) {
#pragma unroll
            for (int ai = 0; ai < 2; ++ai)
#pragma unroll
                for (int m = 0; m < 4; ++m) {
                    __builtin_amdgcn_sched_barrier(0); const int row = row0 + ai * 128 + m * 16;
#pragma unroll
                    for (int bj = 0; bj < 2; ++bj) {
                        const int col0 = (pn - 20) * 256 + bj * 128 + wc * 32 + 8 * fq;
                        f32x4 v0 = acc[ai][bj][m][0], v1 = acc[ai][bj][m][1]; EPI_FENCE(v0, v1);
#pragma unroll
                        for (int e = 0; e < 4; ++e) { v0[e] = v0[e] * sigmoidf_(v0[e]); v1[e] = v1[e] * sigmoidf_(v1[e]); }
                        *(u32x4*)(gp + (size_t)row * NGP + col0) = pack8(v0, v1);
                    }
                }
        } else {
#pragma unroll
            for (int ai = 0; ai < 2; ++ai)
#pragma unroll
                for (int m = 0; m < 4; ++m) {
                    __builtin_amdgcn_sched_barrier(0); const int row = row0 + ai * 128 + m * 16;
#pragma unroll
                    for (int bj = 0; bj < 2; ++bj) {
                        const int col0 = (pn - 32) * 256 + bj * 128 + wc * 32 + 8 * fq;
                        f32x4 v0 = acc[ai][bj][m][0], v1 = acc[ai][bj][m][1]; EPI_FENCE(v0, v1);
#pragma unroll
                        for (int e = 0; e < 4; ++e) { v0[e] = sigmoidf_(v0[e]); v1[e] = sigmoidf_(v1[e]); }
                        *(u32x4*)(mg + (size_t)row * NMG + col0) = pack8(v0, v1);
                    }
                }
        }
    }
};
struct EpiQ {
    bf16_t* q; const float* rsq; const float* cs;
    __device__ __forceinline__ void operator()(const AccT& acc, const pg8::Unit& u, int wr, int wc, int fr, int fq) const {
        const int row0 = u.pm * 256 + wr * 64 + fr, pn = u.pn; const bool lat = u.pm < 64;
#pragma unroll
        for (int ai = 0; ai < 2; ++ai) {
          float rinv4[4];
          { f32x4 ra[4], rb[4];
#pragma unroll
            for (int i = 0; i < 4; ++i) { const int row = row0 + ai * 128 + i * 16; ra[i] = *(const f32x4*)(rsq + (size_t)row * 12); rb[i] = *(const f32x4*)(rsq + (size_t)row * 12 + 4); }
#pragma unroll
            for (int i = 0; i < 4; ++i) rinv4[i] = rsqrtf((((ra[i][0] + ra[i][1]) + (ra[i][2] + ra[i][3])) + ((rb[i][0] + rb[i][1]) + (rb[i][2] + rb[i][3]))) * (1.f / 512.f) + EPS) * C_MLA; }
#pragma unroll
            for (int m = 0; m < 4; ++m) {
                __builtin_amdgcn_sched_barrier(0); const int row = row0 + ai * 128 + m * 16;
                const float rinv = rinv4[m];
                const int s = row & 4095;
#pragma unroll
                for (int bj = 0; bj < 2; ++bj) {
                    const int g32 = pn * 8 + bj * 4 + wc, t6 = g32 % 6, col0 = g32 * 32 + 8 * fq;
                    f32x4 v0 = acc[ai][bj][m][0], v1 = acc[ai][bj][m][1]; EPI_FENCE(v0, v1); v0 = v0 * rinv; v1 = v1 * rinv;
                    if (t6 >= 4 && lat) {
                        const int pos = (t6 == 4) ? (s >> 6) : (s & 63);
                        const float* cp = cs + (pos * 16 + 8 * (fq & 1)) * 2;
                        const f32x4 c0 = *(const f32x4*)(cp), c1 = *(const f32x4*)(cp + 4), c2 = *(const f32x4*)(cp + 8), c3 = *(const f32x4*)(cp + 12);
                        const float cosv[8] = {c0[0], c0[2], c1[0], c1[2], c2[0], c2[2], c3[0], c3[2]};
                        const float sinv[8] = {c0[1], c0[3], c1[1], c1[3], c2[1], c2[3], c3[1], c3[3]};
                        float x[8] = {v0[0], v0[1], v0[2], v0[3], v1[0], v1[1], v1[2], v1[3]};
#pragma unroll
                        for (int e = 0; e < 8; ++e) { const float p = shx(x[e], fr + 16 * fq, 32); x[e] = (fq < 2) ? (x[e] * cosv[e] - p * sinv[e]) : (p * sinv[e] + x[e] * cosv[e]); }
                        v0 = (f32x4){x[0], x[1], x[2], x[3]}; v1 = (f32x4){x[4], x[5], x[6], x[7]};
                    }
                    *(u32x4*)(q + (size_t)row * 1536 + col0) = pack8(v0, v1);
                }
            }
        }
    }
};
struct EpiKV {
    bf16_t* kv; const float* rsq;
    __device__ __forceinline__ void operator()(const AccT& acc, const pg8::Unit& u, int wr, int wc, int fr, int fq) const {
        const int row0 = u.pm * 256 + wr * 64 + fr, pn = u.pn;
#pragma unroll
        for (int ai = 0; ai < 2; ++ai) {
          float rinv4[4];
          { f32x4 ra[4];
#pragma unroll
            for (int i = 0; i < 4; ++i) { const int row = row0 + ai * 128 + i * 16; ra[i] = *(const f32x4*)(rsq + (size_t)row * 12 + 8); }
#pragma unroll
            for (int i = 0; i < 4; ++i) rinv4[i] = rsqrtf(((ra[i][0] + ra[i][1]) + (ra[i][2] + ra[i][3])) * (1.f / 256.f) + EPS); }
#pragma unroll
            for (int m = 0; m < 4; ++m) {
                __builtin_amdgcn_sched_barrier(0); const int row = row0 + ai * 128 + m * 16;
                const float rinv = rinv4[m];
#pragma unroll
                for (int bj = 0; bj < 2; ++bj) {
                    const int col0 = pn * 256 + bj * 128 + wc * 32 + 8 * fq;
                    f32x4 v0 = acc[ai][bj][m][0], v1 = acc[ai][bj][m][1]; EPI_FENCE(v0, v1);
                    *(u32x4*)(kv + (size_t)row * 2048 + col0) = pack8(v0 * rinv, v1 * rinv);
                }
            }
        }
    }
};
struct EpiMerge {
    const bf16_t* mg; float* tmp; bf16_t* merged;
    __device__ __forceinline__ void operator()(const AccT& acc, const pg8::Unit& u, int wr, int wc, int fr, int fq) const {
        const int row0 = u.pm * 256 + wr * 64 + fr, pn = u.pn, z = u.z;
#pragma unroll
        for (int ai = 0; ai < 2; ++ai) {
            u32x4 gw8[8], pw8[8];
#pragma unroll
            for (int i = 0; i < 8; ++i) { const int row = row0 + ai * 128 + (i >> 1) * 16, col0 = pn * 256 + (i & 1) * 128 + wc * 32 + 8 * fq;
                gw8[i] = *(const u32x4*)(mg + (size_t)row * NMG + z * 2048 + col0);
                pw8[i] = (z > 0) ? *(const u32x4*)(merged + (size_t)row * 2048 + col0) : (u32x4){0u, 0u, 0u, 0u}; }
#pragma unroll
            for (int i = 0; i < 8; ++i) { const int m = i >> 1, bj = i & 1; const int row = row0 + ai * 128 + m * 16, col0 = pn * 256 + bj * 128 + wc * 32 + 8 * fq;
                f32x4 v0 = acc[ai][bj][m][0], v1 = acc[ai][bj][m][1]; EPI_FENCE(v0, v1);
                const u32x4 gw = gw8[i], pw = pw8[i];
                v0[0] = v0[0] * bflo(gw.x) + bflo(pw.x); v0[1] = v0[1] * bfhi(gw.x) + bfhi(pw.x); v0[2] = v0[2] * bflo(gw.y) + bflo(pw.y); v0[3] = v0[3] * bfhi(gw.y) + bfhi(pw.y);
                v1[0] = v1[0] * bflo(gw.z) + bflo(pw.z); v1[1] = v1[1] * bfhi(gw.z) + bfhi(pw.z); v1[2] = v1[2] * bflo(gw.w) + bflo(pw.w); v1[3] = v1[3] * bfhi(gw.w) + bfhi(pw.w);
                *(u32x4*)(merged + (size_t)row * 2048 + col0) = pack8(v0, v1); }
        }
    }
};
struct EpiOut {
    const float* xin; const float* ctxin; float* xcur; const float* mod; int layer;
    __device__ __forceinline__ void operator()(const AccT& acc, const pg8::Unit& u, int wr, int wc, int fr, int fq) const {
        const int row0 = u.pm * 256 + wr * 64 + fr, pn = u.pn; const bool lat = u.pm < 64;
        const float* gt = mod + (size_t)(lat ? (u.pm >> 4) : 4) * 6144 + 4096;
#pragma unroll
        for (int hq = 0; hq < 4; ++hq) {
            const int ai = hq >> 1, m0 = (hq & 1) * 2;
            f32x4 xa[4], xb[4];
#pragma unroll
            for (int i = 0; i < 4; ++i) { const int row = row0 + ai * 128 + (m0 + (i >> 1)) * 16, col0 = pn * 256 + (i & 1) * 128 + wc * 32 + 8 * fq;
                const float* xo = (layer == 0) ? (lat ? xin + (size_t)row * 2048 : ctxin + (size_t)(row - NLAT) * 2048) : xcur + (size_t)row * 2048;
                xa[i] = *(const f32x4*)(xo + col0); xb[i] = *(const f32x4*)(xo + col0 + 4); }
#pragma unroll
            for (int i = 0; i < 4; ++i) { const int m = m0 + (i >> 1), bj = i & 1; const int row = row0 + ai * 128 + m * 16, col0 = pn * 256 + bj * 128 + wc * 32 + 8 * fq;
                f32x4 v0 = acc[ai][bj][m][0], v1 = acc[ai][bj][m][1]; EPI_FENCE(v0, v1);
                const f32x4 g0 = *(const f32x4*)(gt + col0), g1 = *(const f32x4*)(gt + col0 + 4);
                *(f32x4*)(xcur + (size_t)row * 2048 + col0) = xa[i] + g0 * v0;
                *(f32x4*)(xcur + (size_t)row * 2048 + col0 + 4) = xb[i] + g1 * v1; }
        }
    }
};

namespace mla {
typedef short s16x4 __attribute__((ext_vector_type(4)));
constexpr int SHM_V = 16384, SHM_K = 16384, SHM_KR = 8192;
constexpr int OFF_V = 0, OFF_K = 2 * SHM_V, OFF_KR = OFF_K + 2 * SHM_K, OFF_WS = OFF_KR + 2 * SHM_KR;
constexpr float THR2 = 8.f;
#define KSWZ(row, colB) ((row) * 256 + ((colB) ^ (((row) & 7) << 4)))
#define KRSWZ(row, colB) ((row) * 128 + ((colB) ^ (((row) & 7) << 4)))
#define SBAR() __builtin_amdgcn_sched_barrier(0)
__device__ __forceinline__ void partialSM(f32x16& p0, f32x16& p1, float& m_reg, float& mn, float& alpha) {
    float pmax = p0[0];
#pragma unroll
    for (int r = 1; r < 16; ++r) pmax = fmaxf(pmax, p0[r]);
#pragma unroll
    for (int r = 0; r < 16; ++r) pmax = fmaxf(pmax, p1[r]);
    { auto rr = __builtin_amdgcn_permlane32_swap(__float_as_uint(pmax), __float_as_uint(pmax), false, false);
      pmax = fmaxf(__uint_as_float(rr[0]), __uint_as_float(rr[1])); }
    if (__builtin_expect(__all(pmax - m_reg <= THR2), 1)) { mn = m_reg; alpha = 1.f; }
    else { mn = fmaxf(m_reg, pmax); alpha = __builtin_amdgcn_exp2f(m_reg - mn); m_reg = mn; }
#pragma unroll
    for (int r = 0; r < 16; ++r) p0[r] = p0[r] - mn;
#pragma unroll
    for (int r = 0; r < 16; ++r) p1[r] = p1[r] - mn;
#pragma unroll
    for (int r = 0; r < 16; ++r) p0[r] = __builtin_amdgcn_exp2f(p0[r]);
}
__device__ __forceinline__ void finishSM(f32x16& p0, f32x16& p1, float alpha, float& l_reg, bf16x8& pa0, bf16x8& pa1, bf16x8& pa2, bf16x8& pa3) {
#pragma unroll
    for (int r = 0; r < 16; ++r) p1[r] = __builtin_amdgcn_exp2f(p1[r]);
    float ps = 0;
#pragma unroll
    for (int r = 0; r < 16; ++r) ps += p0[r];
#pragma unroll
    for (int r = 0; r < 16; ++r) ps += p1[r];
    { auto rr = __builtin_amdgcn_permlane32_swap(__float_as_uint(ps), __float_as_uint(ps), false, false);
      ps = __uint_as_float(rr[0]) + __uint_as_float(rr[1]); }
    l_reg = l_reg * alpha + ps;
#define PK4(P, BASE, OUT) do { unsigned a0 = cvt_pk(P[BASE + 0], P[BASE + 1]), a1 = cvt_pk(P[BASE + 2], P[BASE + 3]);   \
    unsigned b0 = cvt_pk(P[BASE + 4], P[BASE + 5]), b1 = cvt_pk(P[BASE + 6], P[BASE + 7]);                              \
    auto r0 = __builtin_amdgcn_permlane32_swap(a0, b0, false, false); auto r1 = __builtin_amdgcn_permlane32_swap(a1, b1, false, false); \
    u32x4 w = {r0[0], r1[0], r0[1], r1[1]}; OUT = *reinterpret_cast<bf16x8*>(&w); } while (0)
    PK4(p0, 0, pa0); PK4(p0, 8, pa1); PK4(p1, 0, pa2); PK4(p1, 8, pa3);
#undef PK4
}
__device__ __forceinline__ void qkt(f32x16& p0, f32x16& p1, const char* Ks, const char* KRs, const bf16x8* qr, int r32, int hi) {
    p0 = f32x16{}; p1 = f32x16{};
#pragma unroll
    for (int d0 = 0; d0 < 8; ++d0) { const int cb = (d0 * 16 + hi * 8) * 2;
        bf16x8 b0 = *reinterpret_cast<const bf16x8*>(Ks + KSWZ(r32, cb));
        bf16x8 b1 = *reinterpret_cast<const bf16x8*>(Ks + KSWZ(32 + r32, cb));
        p0 = __builtin_amdgcn_mfma_f32_32x32x16_bf16(b0, qr[d0], p0, 0, 0, 0);
        p1 = __builtin_amdgcn_mfma_f32_32x32x16_bf16(b1, qr[d0], p1, 0, 0, 0); }
#pragma unroll
    for (int d0 = 0; d0 < 4; ++d0) { const int cb = (d0 * 16 + hi * 8) * 2;
        bf16x8 b0 = *reinterpret_cast<const bf16x8*>(KRs + KRSWZ(r32, cb));
        bf16x8 b1 = *reinterpret_cast<const bf16x8*>(KRs + KRSWZ(32 + r32, cb));
        p0 = __builtin_amdgcn_mfma_f32_32x32x16_bf16(b0, qr[8 + d0], p0, 0, 0, 0);
        p1 = __builtin_amdgcn_mfma_f32_32x32x16_bf16(b1, qr[8 + d0], p1, 0, 0, 0); }
}
__device__ __forceinline__ int v_st(int k, int c) { const int kk = (k & ~0xC) | ((k & 4) << 1) | ((k & 8) >> 1); return ((kk >> 3) * 4 + (c >> 5)) * 512 + ((kk & 7) * 32 + (c & 31)) * 2; }
__device__ __forceinline__ int v_rd_base(int lane) { return ((lane & 3) << 3) | (((lane >> 2) & 3) << 6) | (((lane >> 4) & 1) << 5) | (((lane >> 5) & 1) << 8); }
constexpr int v_rd_off(int d0, int ks, int half) { return d0 * 512 + ks * 4096 + half * 2048; }
template <int OFF> __device__ __forceinline__ s16x4 tr_read(int vb) {
    s16x4 r; asm volatile("ds_read_b64_tr_b16 %0, %1 offset:%2" : "=&v"(r) : "v"(vb), "i"(OFF) : "memory"); return r;
}
template <int D0> __device__ __forceinline__ void pv_one(f32x16& od, int vb, bf16x8 pa0, bf16x8 pa1, bf16x8 pa2, bf16x8 pa3) {
    const s16x4 l0 = tr_read<v_rd_off(D0, 0, 0)>(vb), h0 = tr_read<v_rd_off(D0, 0, 1)>(vb), l1 = tr_read<v_rd_off(D0, 1, 0)>(vb), h1 = tr_read<v_rd_off(D0, 1, 1)>(vb);
    const s16x4 l2 = tr_read<v_rd_off(D0, 2, 0)>(vb), h2 = tr_read<v_rd_off(D0, 2, 1)>(vb), l3 = tr_read<v_rd_off(D0, 3, 0)>(vb), h3 = tr_read<v_rd_off(D0, 3, 1)>(vb);
    asm volatile("s_waitcnt lgkmcnt(0)" ::: "memory"); SBAR();
#define PK(L, H) (bf16x8){L[0], L[1], L[2], L[3], H[0], H[1], H[2], H[3]}
    od = __builtin_amdgcn_mfma_f32_32x32x16_bf16(pa0, PK(l0, h0), od, 0, 0, 0);
    od = __builtin_amdgcn_mfma_f32_32x32x16_bf16(pa1, PK(l1, h1), od, 0, 0, 0);
    od = __builtin_amdgcn_mfma_f32_32x32x16_bf16(pa2, PK(l2, h2), od, 0, 0, 0);
    od = __builtin_amdgcn_mfma_f32_32x32x16_bf16(pa3, PK(l3, h3), od, 0, 0, 0);
#undef PK
}
__device__ __forceinline__ void pv_d0(f32x16* o, int vb, bf16x8 pa0, bf16x8 pa1, bf16x8 pa2, bf16x8 pa3) {
    pv_one<0>(o[0], vb, pa0, pa1, pa2, pa3); pv_one<1>(o[1], vb, pa0, pa1, pa2, pa3); pv_one<2>(o[2], vb, pa0, pa1, pa2, pa3); pv_one<3>(o[3], vb, pa0, pa1, pa2, pa3);
}
__device__ __forceinline__ void attn_unit(const bf16_t* __restrict__ Q, const bf16_t* __restrict__ KV, const bf16_t* __restrict__ KR, const bf16_t* __restrict__ GP, bf16_t* __restrict__ O,
                                          int qrow0, int h, int latbase, int ctxbase, int nlt, int NT, char* lds) {
    const int tid = opaque_v(threadIdx.x), wid = tid >> 6, lane = tid & 63, r32 = lane & 31, hi = lane >> 5;
    char* V_lds = lds + OFF_V; char* K_lds = lds + OFF_K; char* KR_lds = lds + OFF_KR;
    float* ws = (float*)(lds + OFF_WS) + wid * 64; float* li_l = ws; float* al_l = ws + 32;
    float m_reg = -1e30f, l_reg = 0; f32x16 o[4] = {}; bf16x8 qr[12];
    const bf16_t* Qw = Q + (size_t)(qrow0 + wid * 32 + r32) * 1536 + h * 192 + hi * 8;
#pragma unroll
    for (int d0 = 0; d0 < 12; ++d0) qr[d0] = *reinterpret_cast<const bf16x8*>(Qw + d0 * 16);
    const int sr = tid >> 4, sc = (tid & 15) * 8, vst0 = v_st(sr, sc), vst1 = v_st(32 + sr, sc);
    const int krr = tid >> 3, krc = (tid & 7) * 16;
    const int vb0 = (int)(uintptr_t)V_lds + v_rd_base(lane);
    const bf16_t* Kh = KV + h * 256 + sc; const bf16_t* Vh = KV + h * 256 + 128 + sc;
    bf16x8 s_v0, s_v1, s_k0, s_k1, s_kr;
#define TROW(j) ((j) < nlt ? latbase + 64 * (j) : ctxbase + 64 * ((j) - nlt))
#define SLOAD(j) do { const int _rb = TROW(j); \
    s_v0 = *reinterpret_cast<const bf16x8*>(Vh + (size_t)(_rb + sr) * 2048); s_v1 = *reinterpret_cast<const bf16x8*>(Vh + (size_t)(_rb + 32 + sr) * 2048); \
    s_k0 = *reinterpret_cast<const bf16x8*>(Kh + (size_t)(_rb + sr) * 2048); s_k1 = *reinterpret_cast<const bf16x8*>(Kh + (size_t)(_rb + 32 + sr) * 2048); \
    s_kr = *reinterpret_cast<const bf16x8*>((const char*)KR + (size_t)(_rb + krr) * 128 + krc); } while (0)
#define SWRITE(b) do { *(bf16x8*)(V_lds + (b) * SHM_V + vst0) = s_v0; *(bf16x8*)(V_lds + (b) * SHM_V + vst1) = s_v1; const int kc = sc * 2; \
    *(bf16x8*)(K_lds + (b) * SHM_K + KSWZ(sr, kc)) = s_k0; *(bf16x8*)(K_lds + (b) * SHM_K + KSWZ(32 + sr, kc)) = s_k1; \
    *(bf16x8*)(KR_lds + (b) * SHM_KR + KRSWZ(krr, krc)) = s_kr; } while (0)
#define RESC(a) do { if (__any((a) < 1.f)) { if (hi == 0) al_l[r32] = (a); asm volatile("s_waitcnt lgkmcnt(0)" ::: "memory"); \
    _Pragma("unroll") for (int d = 0; d < 4; ++d) _Pragma("unroll") for (int r = 0; r < 16; ++r) o[d][r] *= al_l[crow(r, hi)]; } } while (0)
    f32x16 pA0, pA1, pB0, pB1; float mnA, mnB, alA, alB; bf16x8 pa0, pa1, pa2, pa3;
    SLOAD(0); asm volatile("s_waitcnt vmcnt(0)" ::: "memory"); SWRITE(0); __syncthreads();
    qkt(pA0, pA1, K_lds, KR_lds, qr, r32, hi); partialSM(pA0, pA1, m_reg, mnA, alA);
    SLOAD(1);
    asm volatile("s_waitcnt vmcnt(0)" ::: "memory"); SWRITE(1); __syncthreads();
    for (int j = 1; j + 1 < NT; j += 2) {
        SBAR(); qkt(pB0, pB1, K_lds + SHM_K, KR_lds + SHM_KR, qr, r32, hi);
        finishSM(pA0, pA1, alA, l_reg, pa0, pa1, pa2, pa3); SBAR();
        SLOAD(j + 1); SBAR();
        pv_d0(o, vb0, pa0, pa1, pa2, pa3); partialSM(pB0, pB1, m_reg, mnB, alB);
        __syncthreads(); asm volatile("s_waitcnt vmcnt(0)" ::: "memory"); SWRITE(0);
        RESC(alB); __syncthreads();
        SBAR(); qkt(pA0, pA1, K_lds, KR_lds, qr, r32, hi);
        finishSM(pB0, pB1, alB, l_reg, pa0, pa1, pa2, pa3); SBAR();
        SLOAD(j + 2); SBAR();
        pv_d0(o, vb0 + SHM_V, pa0, pa1, pa2, pa3); partialSM(pA0, pA1, m_reg, mnA, alA);
        __syncthreads(); asm volatile("s_waitcnt vmcnt(0)" ::: "memory"); SWRITE(1);
        RESC(alA); __syncthreads();
    }
    SBAR(); qkt(pB0, pB1, K_lds + SHM_K, KR_lds + SHM_KR, qr, r32, hi);
    finishSM(pA0, pA1, alA, l_reg, pa0, pa1, pa2, pa3); SBAR();
    pv_d0(o, vb0, pa0, pa1, pa2, pa3); partialSM(pB0, pB1, m_reg, mnB, alB);
    __syncthreads(); RESC(alB);
    finishSM(pB0, pB1, alB, l_reg, pa0, pa1, pa2, pa3); SBAR();
    pv_d0(o, vb0 + SHM_V, pa0, pa1, pa2, pa3);
    if (hi == 0) li_l[r32] = l_reg; asm volatile("s_waitcnt lgkmcnt(0)" ::: "memory");
    const int orow0 = qrow0 + wid * 32;
#pragma unroll
    for (int r = 0; r < 16; ++r) { const int orow = orow0 + crow(r, hi); const float rl = __builtin_amdgcn_rcpf(li_l[crow(r, hi)]);
#pragma unroll
        for (int d0 = 0; d0 < 4; ++d0) { const size_t idx = (size_t)orow * 3072 + h * 128 + d0 * 32 + r32;
            const float v = o[d0][r] * rl * bf1(GP[idx]); O[idx] = (bf16_t)(cvt_pk(v, 0.f) & 0xffffu); } }
    __syncthreads();
#undef TROW
#undef SLOAD
#undef SWRITE
#undef RESC
}
}

__device__ __forceinline__ void na_item(const bf16_t* __restrict__ PMIX, const bf16_t* __restrict__ GP, bf16_t* __restrict__ O, const float* __restrict__ bias, int item, int lane, LAS unsigned char* wl) {
    const int q = lane & 31, hi = lane >> 5;
    const bool lat = item < 8192;
    int b, h, gi = 0, jh = 0, qrow;
    if (lat) { b = item >> 11; h = (item >> 7) & 15; gi = (item >> 1) & 63; jh = item & 1; qrow = b * 4096 + gi * 64 + jh * 32 + q; }
    else { const int it = item - 8192; b = it >> 7; h = (it >> 3) & 15; qrow = NLAT + b * 256 + (it & 7) * 32 + q; }
    const int j = jh * 32 + q;
    const int c0 = min(max(j - 8, 0), 48), r0 = min(max(gi - 4, 0), 56);
    const bf16_t* qp = PMIX + (size_t)qrow * NMIXP + O_NAQ + h * 64 + hi * 8;
    bf16x8 qf[4];
#pragma unroll
    for (int ks = 0; ks < 4; ++ks) qf[ks] = *reinterpret_cast<const bf16x8*>(qp + ks * 16);
    f32x16 oT0 = {}, oT1 = {}; float m = -1e30f, l = 0.f;
    const int ntiles = lat ? 24 : 8;
    const float* bh = bias + h * (15 * 31);
    LAS float* lbias = (LAS float*)(wl + 4608);
    if (lat) {
#pragma unroll
        for (int i = 0; i < 4; ++i) { const int e = lane * 4 + i, krr = e >> 5, dc = e & 31; lbias[e] = bh[(r0 + krr - gi + 7) * 31 + min(dc, 30)] * LOG2E; }
        asm volatile("s_waitcnt vmcnt(0) lgkmcnt(0)" ::: "memory"); __builtin_amdgcn_wave_barrier();
    }
#define NA_TROW(t_) ((lat && (t_) < 16) ? (b * 4096 + (r0 + ((t_) >> 1)) * 64 + ((t_) & 1) * 32) : (NLAT + b * 256 + (lat ? (t_) - 16 : (t_)) * 32))
#define NA_LOAD(KF, VV, t_) do { const int kr0_ = NA_TROW(t_); const bf16_t* kp_ = PMIX + (size_t)(kr0_ + q) * NMIXP + O_NAK + h * 64 + hi * 8; \
        _Pragma("unroll") for (int ks = 0; ks < 4; ++ks) KF[ks] = *reinterpret_cast<const bf16x8*>(kp_ + ks * 16); \
        const bf16_t* vp_ = PMIX + (size_t)(kr0_ + (lane >> 1)) * NMIXP + O_NAV + h * 64 + (lane & 1) * 32; \
        _Pragma("unroll") for (int c = 0; c < 4; ++c) VV[c] = *reinterpret_cast<const u32x4*>(vp_ + c * 8); } while (0)
#define NA_TILE(KF, VV, t) do { \
        const bool local = lat && (t) < 16; const int kr = (t) >> 1, kblk = (t) & 1; \
        f32x16 p = {}; \
        _Pragma("unroll") for (int ks = 0; ks < 4; ++ks) p = __builtin_amdgcn_mfma_f32_32x32x16_bf16(KF[ks], qf[ks], p, 0, 0, 0); \
        _Pragma("unroll") for (int c = 0; c < 4; ++c) *(LAS u32x4*)(wl + (lane >> 1) * 144 + (lane & 1) * 64 + c * 16) = VV[c]; \
        if ((t) + 2 < ntiles) NA_LOAD(KF, VV, (t) + 2); \
        if (local) { \
            const LAS float* brow = lbias + kr * 32; \
            _Pragma("unroll") for (int r8 = 0; r8 < 16; r8 += 4) { float bv8[4]; \
                _Pragma("unroll") for (int r = 0; r < 4; ++r) { const int kc = kblk * 32 + crow(r8 + r, hi); bv8[r] = brow[min(max(kc - j + 15, 0), 30)]; } \
                _Pragma("unroll") for (int r = 0; r < 4; ++r) asm volatile("" : "+v"(bv8[r]));     \
                _Pragma("unroll") for (int r = 0; r < 4; ++r) { const int kc = kblk * 32 + crow(r8 + r, hi); const bool valid = (kc >= c0) && (kc < c0 + 16); p[r8 + r] = valid ? p[r8 + r] + bv8[r] : -INFINITY; } } \
        } \
        float tmax = p[0]; \
        _Pragma("unroll") for (int r = 1; r < 16; ++r) tmax = fmaxf(tmax, p[r]); \
        tmax = fmaxf(tmax, shx(tmax, lane, 32)); \
        const float mn = fmaxf(m, tmax), alpha = __builtin_amdgcn_exp2f(m - mn); m = mn; \
        float ps = 0.f; \
        _Pragma("unroll") for (int r = 0; r < 16; ++r) { p[r] = __builtin_amdgcn_exp2f(p[r] - mn); ps += p[r]; } \
        l = l * alpha + ps; \
        _Pragma("unroll") for (int r = 0; r < 16; ++r) { oT0[r] *= alpha; oT1[r] *= alpha; } \
        asm volatile("s_waitcnt lgkmcnt(0)" ::: "memory"); __builtin_amdgcn_wave_barrier(); \
        _Pragma("unroll") for (int ks = 0; ks < 2; ++ks) { \
            u32x4 pw; pw.x = cvt_pk(p[8 * ks + 0], p[8 * ks + 1]); pw.y = cvt_pk(p[8 * ks + 2], p[8 * ks + 3]); pw.z = cvt_pk(p[8 * ks + 4], p[8 * ks + 5]); pw.w = cvt_pk(p[8 * ks + 6], p[8 * ks + 7]); \
            const bf16x8 pf = *reinterpret_cast<bf16x8*>(&pw); \
            _Pragma("unroll") for (int db = 0; db < 2; ++db) { \
                bf16x8 vf; \
                _Pragma("unroll") for (int jj = 0; jj < 8; ++jj) { const int key = 16 * ks + 8 * (jj >> 2) + 4 * hi + (jj & 3); vf[jj] = *(const LAS short*)(wl + key * 144 + (32 * db + q) * 2); } \
                if (db == 0) oT0 = __builtin_amdgcn_mfma_f32_32x32x16_bf16(vf, pf, oT0, 0, 0, 0); \
                else oT1 = __builtin_amdgcn_mfma_f32_32x32x16_bf16(vf, pf, oT1, 0, 0, 0); \
            } \
        } \
        asm volatile("s_waitcnt lgkmcnt(0)" ::: "memory"); __builtin_amdgcn_wave_barrier(); \
    } while (0)
    bf16x8 kfa[4], kfb[4]; u32x4 vva[4], vvb[4];
    NA_LOAD(kfa, vva, 0); NA_LOAD(kfb, vvb, 1);
    for (int t0 = 0; t0 < ntiles; t0 += 2) {
        NA_TILE(kfa, vva, t0);
        NA_TILE(kfb, vvb, t0 + 1);
    }
#undef NA_TILE
#undef NA_TROW
#undef NA_LOAD
    const float inv = __builtin_amdgcn_rcpf(l + shx(l, lane, 32));
    const size_t ob = (size_t)qrow * 3072 + 1024 + h * 64;
#pragma unroll
    for (int db = 0; db < 2; ++db)
#pragma unroll
        for (int g = 0; g < 4; ++g) {
            const int d = 32 * db + 8 * g + 4 * hi;
            const u32x2 gw = *reinterpret_cast<const u32x2*>(GP + ob + d);
            float v0, v1, v2, v3;
            if (db == 0) { v0 = oT0[4 * g]; v1 = oT0[4 * g + 1]; v2 = oT0[4 * g + 2]; v3 = oT0[4 * g + 3]; } else { v0 = oT1[4 * g]; v1 = oT1[4 * g + 1]; v2 = oT1[4 * g + 2]; v3 = oT1[4 * g + 3]; }
            u32x2 w; w.x = cvt_pk(v0 * inv * bflo(gw.x), v1 * inv * bfhi(gw.x)); w.y = cvt_pk(v2 * inv * bflo(gw.y), v3 * inv * bfhi(gw.y));
            *reinterpret_cast<u32x2*>(O + ob + d) = w;
        }
}

__device__ __forceinline__ void lru_gate_phase(const bf16_t* __restrict__ PMIX, const bf16_t* __restrict__ WG, const float* __restrict__ convw, const float* __restrict__ convb,
                                               const float* __restrict__ bg, const float* __restrict__ lam, float* __restrict__ LA, float* __restrict__ LU, int bid, int G, LAS unsigned char* lds) {
    const int tid = opaque_v(threadIdx.x), lane = tid & 63, wid = tid >> 6;
    LAS float* xcf = (LAS float*)lds;
    LAS unsigned char* xcb = lds + 64 * 68 * 4;
    const int tl_s = tid >> 3, cg8 = (tid & 7) * 8;
    const int dir = wid >> 2, th = (wid >> 1) & 1, chh = wid & 1, q = lane & 31, hi = lane >> 5, cl = 32 * chh + q;
    int cur_blk = -1;
    f32x4 cw[4][2], cb0, cb1; bf16x8 br[4], bi[4]; float brv = 0.f, biv = 0.f, sp = 0.f;
    for (int item = bid; item < (MROWS / 64) * 16; item += G) {
        const int tt = item >> 4, blk = item & 15, row0 = tt * 64;
        if (blk != cur_blk) {
            cur_blk = blk;
            const int chs = blk * 64 + cg8;
            cb0 = *(const f32x4*)(convb + chs); cb1 = *(const f32x4*)(convb + chs + 4);
#pragma unroll
            for (int tap = 0; tap < 4; ++tap) { cw[tap][0] = *(const f32x4*)(convw + tap * 1024 + chs); cw[tap][1] = *(const f32x4*)(convw + tap * 1024 + chs + 4); }
            const bf16_t* wt = WG + (size_t)(dir * 16 + blk) * 128 * 64;
#pragma unroll
            for (int ks = 0; ks < 4; ++ks) { br[ks] = *reinterpret_cast<const bf16x8*>(wt + (size_t)cl * 64 + 16 * ks + 8 * hi); bi[ks] = *reinterpret_cast<const bf16x8*>(wt + (size_t)(64 + cl) * 64 + 16 * ks + 8 * hi); }
            brv = bg[dir * 2048 + blk * 128 + cl]; biv = bg[dir * 2048 + blk * 128 + 64 + cl];
            const float xs = __expf(-lam[dir * 1024 + blk * 64 + cl]);
            sp = xs < 0.05f ? xs * (1.f - xs * (0.5f - xs * ((1.f / 3.f) - xs * (0.25f - xs * 0.2f)))) : __logf(1.f + xs);
        }
        const int seg0 = row0 < NLAT ? (row0 & ~4095) : (NLAT + ((row0 - NLAT) & ~255)), seg1 = seg0 + (row0 < NLAT ? 4096 : 256);
        {
            const int row = row0 + tl_s, chs = blk * 64 + cg8;
            f32x4 x0 = cb0, x1 = cb1;
            u32x4 pv4[4];
#pragma unroll
            for (int tap = 0; tap < 4; ++tap) { const int rr = min(max(row + tap - 2, seg0), seg1 - 1); pv4[tap] = *(const u32x4*)(PMIX + (size_t)rr * NMIXP + O_PX + chs); }
#pragma unroll
            for (int tap = 0; tap < 4; ++tap) {
                const int rr = row + tap - 2; const float ok = (rr >= seg0 && rr < seg1) ? 1.f : 0.f; const u32x4 pv = pv4[tap];
                x0 += (cw[tap][0] * ok) * (f32x4){bflo(pv.x), bfhi(pv.x), bflo(pv.y), bfhi(pv.y)};
                x1 += (cw[tap][1] * ok) * (f32x4){bflo(pv.z), bfhi(pv.z), bflo(pv.w), bfhi(pv.w)};
            }
            *(LAS f32x4*)(xcf + tl_s * 68 + cg8) = x0; *(LAS f32x4*)(xcf + tl_s * 68 + cg8 + 4) = x1;
            *(LAS u32x4*)(xcb + tl_s * 144 + cg8 * 2) = pack8(x0, x1);
        }
        __syncthreads();
        {
            const int ch = blk * 64 + cl;
            f32x16 accR = {}, accI = {};
#pragma unroll
            for (int ks = 0; ks < 4; ++ks) {
                const bf16x8 af = *(const LAS bf16x8*)(xcb + (32 * th + q) * 144 + (16 * ks + 8 * hi) * 2);
                accR = __builtin_amdgcn_mfma_f32_32x32x16_bf16(af, br[ks], accR, 0, 0, 0);
                accI = __builtin_amdgcn_mfma_f32_32x32x16_bf16(af, bi[ks], accI, 0, 0, 0);
            }
#pragma unroll
            for (int r = 0; r < 16; ++r) {
                const int tl = 32 * th + crow(r, hi);
                const float rg = sigmoidf_(accR[r] + brv), ig = sigmoidf_(accI[r] + biv);
                const float log_a = -8.f * rg * sp, ym = -2.f * log_a, y1 = -log_a;
                const float om = ym < 0.1f ? ym * (1.f - ym * (0.5f - ym * ((1.f / 6.f) - ym * ((1.f / 24.f) - ym * (1.f / 120.f))))) : 1.f - __expf(-ym);
                const float oma = y1 < 0.1f ? y1 * (1.f - y1 * (0.5f - y1 * ((1.f / 6.f) - y1 * ((1.f / 24.f) - y1 * (1.f / 120.f))))) : 1.f - __expf(-y1);
                const float u = __builtin_sqrtf(fmaxf(om, 0.f)) * (ig * xcf[tl * 68 + cl]);
                const size_t idx = ((size_t)dir * MROWS + row0 + tl) * 1024 + ch;
                ((unsigned*)LA)[idx] = cvt_pk(oma, u);
            }
        }
        __syncthreads();
    }
}
__device__ __forceinline__ int chunk_row0(int b, int c) { return c < 4 ? NLAT + b * 256 + c * 64 : b * 4096 + (c - 4) * 64; }
__device__ __forceinline__ void lru_pass1_item(const float* __restrict__ LA, const float* __restrict__ LU, float* __restrict__ AGG, int item) {
    const int g = item * 512 + opaque_v(threadIdx.x), ch = (g & 255) * 4, dir = (g >> 8) & 1, bc = g >> 9, c = bc % NCHUNK, b = bc / NCHUNK;
    const int row0 = chunk_row0(b, c);
    const unsigned* ap = (const unsigned*)LA + ((size_t)dir * MROWS + row0) * 1024 + ch; (void)LU;
    f32x4 A = {1.f, 1.f, 1.f, 1.f}, H = {0.f, 0.f, 0.f, 0.f};
#pragma unroll 8
    for (int t = 0; t < 64; ++t) { const int tt = dir ? 63 - t : t; const u32x4 w = *(const u32x4*)(ap + (size_t)tt * 1024);
        const f32x4 a = {1.f - bflo(w.x), 1.f - bflo(w.y), 1.f - bflo(w.z), 1.f - bflo(w.w)}, u = {bfhi(w.x), bfhi(w.y), bfhi(w.z), bfhi(w.w)}; A *= a; H = a * H + u; }
    float* o = AGG + (((size_t)(dir * NB + b) * NCHUNK + c) * 1024 + ch) * 2;
    *(f32x4*)o = (f32x4){A[0], H[0], A[1], H[1]}; *(f32x4*)(o + 4) = (f32x4){A[2], H[2], A[3], H[3]};
}
__device__ __forceinline__ void lru_pass3_item(const float* __restrict__ LA, const float* __restrict__ LU, const float* __restrict__ AGG, const bf16_t* __restrict__ GP, bf16_t* __restrict__ O, int item, LAS unsigned char* lds) {
    const int tid = opaque_v(threadIdx.x);
    const int cg = item & 7, bc = item >> 3, c = bc % NCHUNK, b = bc / NCHUNK, row0 = chunk_row0(b, c), ch0 = cg * 128;
    LAS unsigned* S = (LAS unsigned*)lds;
    LAS float* CX = (LAS float*)(lds + 65536);
    {
        u32x4 tv[8];
#pragma unroll
        for (int p = 0; p < 8; ++p) { const int e = p * 512 + tid, arr = e >> 11, rem = e & 2047, tok = rem >> 5, c4 = rem & 31;
            tv[p] = *(const u32x4*)((const unsigned*)LA + ((size_t)arr * MROWS + row0 + tok) * 1024 + ch0 + c4 * 4); }
#pragma unroll
        for (int p = 0; p < 8; ++p) { const int e = p * 512 + tid, arr = e >> 11, rem = e & 2047, tok = rem >> 5, c4 = rem & 31;
            *(LAS u32x4*)(S + (arr * 64 + tok) * 128 + c4 * 4) = tv[p]; }
    }
    const int dir = (tid >> 7) & 1, ch = tid & 127, half = tid >> 8;
    float cA = 1.f, cH = 0.f;
    {
        const float* ag = AGG + ((size_t)(dir * NB + b) * NCHUNK * 1024 + ch0 + ch) * 2;
        const int n = dir == 0 ? c : (c < 4 ? 3 - c : 4 + (NCHUNK - 1 - c));
        const int k0 = half ? (n >> 1) : 0, k1 = half ? n : (n >> 1);
#pragma unroll 8
        for (int k = k0; k < k1; ++k) { const int cc = dir == 0 ? k : ((c < 4 || k < 4) ? 3 - k : NCHUNK - 1 - (k - 4));
            const f32x2_t q_ = *(const f32x2_t*)(ag + (size_t)cc * 2048); cA *= q_[0]; cH = q_[0] * cH + q_[1]; }
    }
    if (half) { CX[(tid - 256) * 2] = cA; CX[(tid - 256) * 2 + 1] = cH; }
    __syncthreads();
    if (tid < 256) {
        float h = CX[tid * 2] * cH + CX[tid * 2 + 1];
        LAS unsigned* su = S + dir * 64 * 128 + ch;
#pragma unroll 8
        for (int t = 0; t < 64; ++t) { const int tt = dir ? 63 - t : t; const unsigned w = su[tt * 128]; h = (1.f - bflo(w)) * h + bfhi(w); su[tt * 128] = __float_as_uint(h); }
    }
    __syncthreads();
#pragma unroll
    for (int p = 0; p < 4; ++p) { const int e = p * 512 + tid, tok = e >> 5, c4 = e & 31;
        const f32x4 hf = *(const LAS f32x4*)(S + (0 * 64 + tok) * 128 + c4 * 4), hb = *(const LAS f32x4*)(S + (1 * 64 + tok) * 128 + c4 * 4);
        const size_t oi = (size_t)(row0 + tok) * 3072 + 2048 + ch0 + c4 * 4; const u32x2 gw = *(const u32x2*)(GP + oi);
        u32x2 w; w.x = cvt_pk((hf[0] + hb[0]) * bflo(gw.x), (hf[1] + hb[1]) * bfhi(gw.x)); w.y = cvt_pk((hf[2] + hb[2]) * bflo(gw.y), (hf[3] + hb[3]) * bfhi(gw.y));
        *(u32x2*)(O + oi) = w; }
    __syncthreads();
}

__device__ __forceinline__ void transpose_item(const float* __restrict__ W, int ld_src, int k0, int n0src, const float* __restrict__ kscale, bf16_t* __restrict__ WT, int ldt, int n0dst, LAS float* scr, int lane) {
#pragma unroll 8
    for (int i = 0; i < 32; ++i) { const int kk = 2 * i + (lane >> 5); float v = W[(size_t)(k0 + kk) * ld_src + n0src + (lane & 31)]; if (kscale) v *= kscale[k0 + kk]; scr[kk * 33 + (lane & 31)] = v; }
    asm volatile("s_waitcnt lgkmcnt(0)" ::: "memory"); __builtin_amdgcn_wave_barrier();
    const int c = lane & 7;
#pragma unroll
    for (int jn = 0; jn < 4; ++jn) { const int n = (lane >> 3) + 8 * jn; const LAS float* s = scr + (8 * c) * 33 + n;
        u32x4 o; o.x = cvt_pk(s[0 * 33], s[1 * 33]); o.y = cvt_pk(s[2 * 33], s[3 * 33]); o.z = cvt_pk(s[4 * 33], s[5 * 33]); o.w = cvt_pk(s[6 * 33], s[7 * 33]);
        *(u32x4*)(WT + (size_t)(n0dst + n) * ldt + k0 + 8 * c) = o; }
    asm volatile("s_waitcnt lgkmcnt(0)" ::: "memory"); __builtin_amdgcn_wave_barrier();
}


#define XB_TMO      128
#define XB_XCNT(j)  (256  + 64 * (j))
#define XB_XSUB(j)  (1280 + 64 * (j))
#define XB_XGEN(j)  (2304 + 64 * (j))
#define XB_TOP      3328
#define XB_TOPGEN   3392
#define XCD_BAR_WORDS 3456
#define XB_SPIN_CAP (1u << 22)
__device__ __forceinline__ unsigned xb_ld(unsigned* p)              { return __hip_atomic_load(p, __ATOMIC_RELAXED, __HIP_MEMORY_SCOPE_AGENT); }
__device__ __forceinline__ unsigned xb_add(unsigned* p, unsigned v) { return __hip_atomic_fetch_add(p, v, __ATOMIC_RELAXED, __HIP_MEMORY_SCOPE_AGENT); }
__device__ __forceinline__ unsigned xb_xcc_id() { return (unsigned)__builtin_amdgcn_s_getreg((3 << 11) | 20) & 0xFu; }
#define XB_SPIN(cond, bar) do { unsigned _sp = 0; while (cond) { __builtin_amdgcn_s_sleep(1); \
    if ((++_sp & 255u) == 0u) { if (xb_ld(&(bar)[XB_TMO])) break; if (_sp > XB_SPIN_CAP) { atomicAdd(&(bar)[XB_TMO], 1u); break; } } } } while (0)
struct XcdBarrier { unsigned* bar; unsigned x; volatile LAS unsigned* st; };
__device__ __forceinline__ XcdBarrier xcd_barrier_post(unsigned* bar, volatile LAS unsigned* st) {
    XcdBarrier b; b.bar = bar; b.x = xb_xcc_id(); b.st = st;
    if (threadIdx.x == 0) (void)xb_add(&bar[XB_XCNT(b.x)], 1u);
    return b;
}
__device__ __forceinline__ void xcd_barrier_complete(unsigned* bar, unsigned x, unsigned& nloc, unsigned& nx) {
    const unsigned G = gridDim.x * gridDim.y * gridDim.z;
    unsigned sum, cnt, mine, sp = 0u;
    for (;;) {
        sum = 0u; cnt = 0u; mine = 0u;
#pragma unroll
        for (unsigned j = 0; j < 16; ++j) { const unsigned c = xb_ld(&bar[XB_XCNT(j)]); sum += c; cnt += (c > 0u) ? 1u : 0u; mine = (j == x) ? c : mine; }
        if (sum == G) break;
        __builtin_amdgcn_s_sleep(1);
        if ((++sp & 255u) == 0u) { if (xb_ld(&bar[XB_TMO])) break; if (sp > XB_SPIN_CAP) { atomicAdd(&bar[XB_TMO], 1u); break; } }
    }
    nloc = mine > 0u ? mine : 1u; nx = cnt > 0u ? cnt : 1u;
}
__device__ __forceinline__ void xcd_barrier(const XcdBarrier& b) {
    asm volatile("s_waitcnt vmcnt(0)" ::: "memory");
    __syncthreads();
    if (threadIdx.x == 0) {
        unsigned* bar = b.bar;
        __builtin_amdgcn_s_waitcnt(0);
        unsigned nloc = b.st[0], nx = b.st[1];
        if (nloc == 0u) { xcd_barrier_complete(bar, b.x, nloc, nx); b.st[0] = nloc; b.st[1] = nx; }
        const unsigned old = xb_add(&bar[XB_XSUB(b.x)], 1u);
        const unsigned gen = old / nloc;
        if (old + 1u == (gen + 1u) * nloc) {
            __builtin_amdgcn_fence(__ATOMIC_RELEASE, "agent");
            asm volatile("s_waitcnt vmcnt(0)" ::: "memory");
            const unsigned og = xb_add(&bar[XB_TOP], 1u);
            const unsigned tg = og / nx;
            if (og + 1u == (tg + 1u) * nx) xb_add(&bar[XB_TOPGEN], 1u);
            else XB_SPIN(xb_ld(&bar[XB_TOPGEN]) == tg, bar);
            __builtin_amdgcn_fence(__ATOMIC_ACQUIRE, "agent");
            xb_add(&bar[XB_XGEN(b.x)], 1u);
            asm volatile("s_waitcnt vmcnt(0)" ::: "memory");
        } else {
            XB_SPIN(xb_ld(&bar[XB_XGEN(b.x)]) == gen, bar);
            __builtin_amdgcn_fence(__ATOMIC_ACQUIRE, "agent");
            asm volatile("s_waitcnt vmcnt(0)" ::: "memory");
        }
    }
    __syncthreads();
}
#define GRID_SYNC() do { asm volatile("s_waitcnt vmcnt(0) lgkmcnt(0)" ::: "memory"); grid.sync(); \
    if (threadIdx.x < 64) asm volatile("buffer_inv sc1\n\ts_waitcnt vmcnt(0)" ::: "memory"); __syncthreads(); } while (0)
__device__ __forceinline__ unsigned char* opaque_p(unsigned char* p) { asm volatile("" : "+s"(p)); return p; }
__device__ __forceinline__ int opaque_s(int x) { asm volatile("" : "+s"(x)); return x; }
#define x_in (args.in[0])
#define c_in (args.in[1])
#define ctx_in (args.in[2])
#define cctx_in (args.in[3])
#define ada_w (args.in[4])
#define ada_b (args.in[5])
#define norm_g (args.in[6])
#define w_in (args.in[7])
#define qng (args.in[8])
#define kvng (args.in[9])
#define w_uq (args.in[10])
#define w_ukv (args.in[11])
#define rel_bias (args.in[12])
#define conv_w (args.in[13])
#define conv_b (args.in[14])
#define w_gate (args.in[15])
#define b_gate (args.in[16])
#define lam_in (args.in[17])
#define w_branch (args.in[18])
#define w_out (args.in[19])
#define fng (args.in[20])
#define WIN ((bf16_t*)(ws + WS_WIN))
#define WUQ ((bf16_t*)(ws + WS_WUQ))
#define WUKV ((bf16_t*)(ws + WS_WUKV))
#define WBR ((bf16_t*)(ws + WS_WBR))
#define WOUT ((bf16_t*)(ws + WS_WOUT))
#define WG ((bf16_t*)(ws + WS_WG))
#define MOD ((float*)(ws + WS_MOD))
#define ROPE ((float*)(ws + WS_ROPE))
#define XCUR ((float*)(ws + WS_XCUR))
#define HB ((bf16_t*)(ws + WS_H))
#define PMIX ((bf16_t*)(ws + WS_PMIX))
#define GP ((bf16_t*)(ws + WS_GP))
#define MG ((bf16_t*)(ws + WS_MG))
#define RSQ ((float*)(ws + WS_RSQ))
#define QB ((bf16_t*)(ws + WS_Q))
#define KVB ((bf16_t*)(ws + WS_KV))
#define KRB ((bf16_t*)(ws + WS_KR))
#define LA ((float*)(ws + WS_LA))
#define LU ((float*)(ws + WS_LU))
#define AGG ((float*)(ws + WS_AGG))
#define OB ((bf16_t*)(ws + WS_O))
#define MTMP LA
__global__ void __launch_bounds__(512, 2) mk_fwd(Args args) {
    extern __shared__ __attribute__((aligned(16))) unsigned char lds_raw[];
    cg::grid_group grid = cg::this_grid();
    LAS unsigned char* lds = (LAS unsigned char*)lds_raw;
    volatile LAS unsigned* xb_st = (volatile LAS unsigned*)(lds + LDS_BYTES - 64);
    if (threadIdx.x == 0) { xb_st[0] = 0u; xb_st[1] = 0u; }
    __syncthreads();
    (void)xcd_barrier_post((unsigned*)(args.ws + WS_BAR), xb_st);
#define XSYNC() do { XcdBarrier b_; b_.bar = (unsigned*)(args.ws + WS_BAR); b_.x = xb_xcc_id(); b_.st = (volatile LAS unsigned*)(lds + LDS_BYTES - 64); xcd_barrier(b_); } while (0)
#define PHASE_IDS const int tid = opaque_v(threadIdx.x), lane = tid & 63, wid = __builtin_amdgcn_readfirstlane(tid >> 6), G = opaque_s(gridDim.x), bid = opaque_s(blockIdx.x), NGW = G * 8, gw = bid * 8 + wid; unsigned char* ws = args.ws + (size_t)(unsigned)opaque_s(0); (void)lane; (void)gw; (void)NGW; (void)ws; (void)tid;

    {
        PHASE_IDS
        LAS float* scr = (LAS float*)(lds + wid * 8448);
        constexpr int I_IN = 32 * 442, I_UQ = 8 * 48, I_UKV = 4 * 64, I_BR = 3 * 16 * 64, I_OUT = 32 * 64, I_G = 32 * 4, I_L = I_IN + I_UQ + I_UKV + I_BR + I_OUT + I_G;
        for (int it = gw; it < DEPTH * I_L; it += NGW) {
            const int L = it / I_L; int r = it - L * I_L;
            if (r < I_IN) { const int kb = r / 442, nb = r % 442, n0 = nb * 32;
                transpose_item(w_in + (size_t)L * DM * NIN, NIN, kb * 64, n0, nullptr, WIN + (size_t)L * NINP * DM, DM, n0 < NMIX ? n0 : n0 + (NMIXP - NMIX), scr, lane); continue; } r -= I_IN;
            if (r < I_UQ) { const int kb = r / 48, nb = r % 48;
                transpose_item(w_uq + (size_t)L * 512 * 1536, 1536, kb * 64, nb * 32, qng + L * 512, WUQ + (size_t)L * 1536 * 512, 512, nb * 32, scr, lane); continue; } r -= I_UQ;
            if (r < I_UKV) { const int kb = r / 64, nb = r % 64;
                transpose_item(w_ukv + (size_t)L * 256 * 2048, 2048, kb * 64, nb * 32, kvng + L * 256, WUKV + (size_t)L * 2048 * 256, 256, nb * 32, scr, lane); continue; } r -= I_UKV;
            if (r < I_BR) { const int n3 = r / 1024, rr = r % 1024, kb = rr / 64, nb = rr % 64;
                transpose_item(w_branch + ((size_t)L * 3 + n3) * 1024 * 2048, 2048, kb * 64, nb * 32, nullptr, WBR + ((size_t)L * 3 + n3) * 2048 * 1024, 1024, nb * 32, scr, lane); continue; } r -= I_BR;
            if (r < I_OUT) { const int kb = r / 64, nb = r % 64;
                transpose_item(w_out + (size_t)L * DM * DM, DM, kb * 64, nb * 32, nullptr, WOUT + (size_t)L * DM * DM, DM, nb * 32, scr, lane); continue; } r -= I_OUT;
            { const int db = r / 4, nb = r % 4;
              transpose_item(w_gate + ((size_t)L * 32 + db) * 64 * 128, 128, 0, nb * 32, nullptr, WG + ((size_t)L * 32 + db) * 128 * 64, 64, nb * 32, scr, lane); }
        }
        for (int i = bid * 512 + tid; i < DEPTH * (NMIXP - NMIX) * (DM / 8); i += G * 512) {
            const int L = i / ((NMIXP - NMIX) * (DM / 8)), r = i % ((NMIXP - NMIX) * (DM / 8));
            *(u32x4*)(WIN + ((size_t)L * NINP + NMIX) * DM + (size_t)r * 8) = (u32x4){0u, 0u, 0u, 0u};
        }
        __syncthreads();
        LAS float* sil = (LAS float*)(lds + 69632);
        LAS float* red = (LAS float*)(lds + 69632 + 40960);
        for (int i = tid; i < 5 * 2048; i += 512) { const float v = i < 4 * 2048 ? c_in[i] : cctx_in[i - 4 * 2048]; sil[i] = v * (1.f / (1.f + expf(-v))); }
        __syncthreads();
        for (int it = bid; it < DEPTH * 96; it += G) {
            const int L = it / 96, cb = it % 96, ksl = tid >> 6, col = cb * 64 + (tid & 63);
            float a5[5] = {0.f, 0.f, 0.f, 0.f, 0.f};
            const float* wp = ada_w + (size_t)L * DM * 6144 + col;
            for (int k = ksl * 256; k < ksl * 256 + 256; ++k) { const float w = wp[(size_t)k * 6144];
#pragma unroll
                for (int r = 0; r < 5; ++r) a5[r] += sil[r * 2048 + k] * w; }
#pragma unroll
            for (int r = 0; r < 5; ++r) red[(ksl * 5 + r) * 64 + (tid & 63)] = a5[r];
            __syncthreads();
            if (tid < 320) { const int r = tid >> 6, cc = tid & 63; float s = 0.f;
#pragma unroll
                for (int k = 0; k < 8; ++k) s += red[(k * 5 + r) * 64 + cc];
                MOD[((size_t)L * 5 + r) * 6144 + cb * 64 + cc] = s + ada_b[(size_t)L * 6144 + cb * 64 + cc]; }
            __syncthreads();
        }
        if (bid == G - 1) for (int i = tid; i < 1024; i += 512) { const int pos = i >> 4, k = i & 15;
            const float inv = 1.0f / powf(10000.f, (float)k * (1.f / 16.f)), ang = (float)pos * inv; ROPE[2 * i] = cosf(ang); ROPE[2 * i + 1] = sinf(ang); }
    }
    GRID_SYNC();

    for (int layer = 0; layer < DEPTH; ++layer) {
        const bool need_ctx = layer < DEPTH - 1;
        { PHASE_IDS
        for (int row = gw; row < MROWS; row += NGW) {
            const bool lat = row < NLAT;
            const float* src = (layer == 0) ? (lat ? x_in + (size_t)row * DM : ctx_in + (size_t)(row - NLAT) * DM) : XCUR + (size_t)row * DM;
            const float* mr = MOD + (size_t)layer * 5 * 6144 + (size_t)(lat ? (row >> 12) : 4) * 6144;
            f32x4 v[8]; float ss = 0.f;
#pragma unroll
            for (int jv = 0; jv < 8; ++jv) { v[jv] = *(const f32x4*)(src + 4 * (lane + 64 * jv)); ss += (v[jv][0] * v[jv][0] + v[jv][1] * v[jv][1]) + (v[jv][2] * v[jv][2] + v[jv][3] * v[jv][3]); }
            const float rinv = rsqrtf(wave_sum(ss, lane) * (1.f / DM) + EPS);
#pragma unroll
            for (int jv = 0; jv < 8; ++jv) { const int col = 4 * (lane + 64 * jv);
                const f32x4 gg = *(const f32x4*)(norm_g + layer * DM + col), sh = *(const f32x4*)(mr + col), sc = *(const f32x4*)(mr + 2048 + col);
                const f32x4 hh = (v[jv] * rinv * gg) * (sc + 1.f) + sh;
                u32x2 w; w.x = cvt_pk(hh[0], hh[1]); w.y = cvt_pk(hh[2], hh[3]); *(u32x2*)(HB + (size_t)row * DM + col) = w; }
        } }
        XSYNC();
        {
            PHASE_IDS
            pg8::Gemm g{HB, WIN + (size_t)layer * NINP * DM, DM, DM, DM, 0, 0}; pg8::Sched S; S.init(MROWS, NINP, G, bid, 1);
            EpiIn E{PMIX, GP, MG, RSQ};
            pg8::gemm_phase<EpiIn>(lds, g, S, E);
        }
        XSYNC();
        {
            {
            PHASE_IDS
            { pg8::Gemm g{PMIX, WUQ + (size_t)layer * 1536 * 512, NMIXP, 512, 512, 0, 0}; pg8::Sched S; S.init(MROWS, 1536, G, bid, 1);
              EpiQ E{QB, RSQ, ROPE}; pg8::gemm_phase<EpiQ>(lds, g, S, E); }
            { pg8::Gemm g{PMIX + 512, WUKV + (size_t)layer * 2048 * 256, NMIXP, 256, 256, 0, 0}; pg8::Sched S; S.init(MROWS, 2048, G, bid, 1);
              EpiKV E{KVB, RSQ}; pg8::gemm_phase<EpiKV>(lds, g, S, E); }
            }
            {
            PHASE_IDS
            for (int i = bid * 512 + tid; i < MROWS * 4; i += G * 512) {
                const int row = i >> 2, hf = (i >> 1) & 1, sub = i & 1;
                const bf16_t* src = PMIX + (size_t)row * NMIXP + O_KR + 32 * hf + 8 * sub;
                u32x4 a = *(const u32x4*)src, b2 = *(const u32x4*)(src + 16);
                if (row < NLAT) {
                    const int s = row & 4095, pos = hf ? (s & 63) : (s >> 6);
                    const float* cp = ROPE + (pos * 16 + 8 * sub) * 2;
                    float x1[8] = {bflo(a.x), bfhi(a.x), bflo(a.y), bfhi(a.y), bflo(a.z), bfhi(a.z), bflo(a.w), bfhi(a.w)};
                    float x2[8] = {bflo(b2.x), bfhi(b2.x), bflo(b2.y), bfhi(b2.y), bflo(b2.z), bfhi(b2.z), bflo(b2.w), bfhi(b2.w)};
                    float o1[8], o2[8];
#pragma unroll
                    for (int e = 0; e < 8; ++e) { const float cv = cp[2 * e], sv = cp[2 * e + 1]; o1[e] = x1[e] * cv - x2[e] * sv; o2[e] = x1[e] * sv + x2[e] * cv; }
                    a.x = cvt_pk(o1[0], o1[1]); a.y = cvt_pk(o1[2], o1[3]); a.z = cvt_pk(o1[4], o1[5]); a.w = cvt_pk(o1[6], o1[7]);
                    b2.x = cvt_pk(o2[0], o2[1]); b2.y = cvt_pk(o2[2], o2[3]); b2.z = cvt_pk(o2[4], o2[5]); b2.w = cvt_pk(o2[6], o2[7]);
                }
                bf16_t* dst = KRB + (size_t)row * 64 + 32 * hf + 8 * sub;
                *(u32x4*)dst = a; *(u32x4*)(dst + 16) = b2;
            }
            __syncthreads();
            lru_gate_phase(PMIX, WG + (size_t)layer * 32 * 128 * 64, conv_w + (size_t)layer * 4 * 1024, conv_b + (size_t)layer * 1024, b_gate + (size_t)layer * 2 * 2048, lam_in + (size_t)layer * 2 * 1024, LA, LU, bid, G, lds);
            }
        }
        XSYNC();
        {
            PHASE_IDS
            const int nmla = 512 + (need_ctx ? 32 : 0);
            for (int u0 = bid; u0 < nmla; u0 += G) {
                int u = u0;
                if (G == 256 && u0 < 512) { const int x = bid & 7, i = bid >> 3, r = u0 >> 8; u = ((r * 16 + x * 2 + (i >> 4)) << 4) | (i & 15); }
                if (u < 512) { const int b = u >> 7, h = (u >> 4) & 7, qb = u & 15;
                    mla::attn_unit(QB, KVB, KRB, GP, OB, b * 4096 + qb * 256, h, b * 4096, NLAT + b * 256, 64, 68, (char*)lds_raw); }
                else { const int b = (u - 512) >> 3, h = (u - 512) & 7;
                    mla::attn_unit(QB, KVB, KRB, GP, OB, NLAT + b * 256, h, 0, NLAT + b * 256, 0, 4, (char*)lds_raw); }
            }
            __syncthreads();
            const int nna = 8192 + (need_ctx ? 512 : 0);
            for (int it = gw; it < nna; it += NGW) na_item(PMIX, GP, OB, rel_bias + (size_t)layer * 16 * 15 * 31, it, lane, lds + wid * 5632);
            for (int it = bid; it < (NB * NCHUNK * 2 * 256) / 512; it += G) lru_pass1_item(LA, LU, AGG, it);
        }
        XSYNC();
        { PHASE_IDS
        for (int it = bid; it < NB * NCHUNK * 8; it += G) lru_pass3_item(LA, LU, AGG, GP, OB, it, lds); }
        XSYNC();
        {
            PHASE_IDS
            const int Mrows = need_ctx ? MROWS : NLAT;
            pg8::Gemm g{OB, WBR + (size_t)layer * 3 * 2048 * 1024, 3072, 1024, 1024, 1024, (size_t)2048 * 1024}; pg8::Sched S; S.init(Mrows, DM, G, bid, 3);
            EpiMerge E{MG, MTMP, HB}; pg8::gemm_phase<EpiMerge>(lds, g, S, E);
        }
        XSYNC();
        {
            PHASE_IDS
            const int Mrows = need_ctx ? MROWS : NLAT;
            pg8::Gemm g{HB, WOUT + (size_t)layer * DM * DM, DM, DM, DM, 0, 0}; pg8::Sched S; S.init(Mrows, DM, G, bid, 1);
            EpiOut E{x_in, ctx_in, XCUR, MOD + (size_t)layer * 5 * 6144, layer}; pg8::gemm_phase<EpiOut>(lds, g, S, E);
        }
        XSYNC();
    }
    { PHASE_IDS
    for (int row = gw; row < NLAT; row += NGW) {
        const float* src = XCUR + (size_t)row * DM;
        f32x4 v[8]; float ss = 0.f;
#pragma unroll
        for (int jv = 0; jv < 8; ++jv) { v[jv] = *(const f32x4*)(src + 4 * (lane + 64 * jv)); ss += (v[jv][0] * v[jv][0] + v[jv][1] * v[jv][1]) + (v[jv][2] * v[jv][2] + v[jv][3] * v[jv][3]); }
        const float rinv = rsqrtf(wave_sum(ss, lane) * (1.f / DM) + EPS);
#pragma unroll
        for (int jv = 0; jv < 8; ++jv) { const int col = 4 * (lane + 64 * jv); *(f32x4*)(args.out + (size_t)row * DM + col) = v[jv] * rinv * *(const f32x4*)(fng + col); }
    } }
}

extern "C" void kernel_launch(void* const* d_in, const int* in_sizes, int n_in, void* d_out, int out_size, void* d_ws, size_t ws_size, hipStream_t stream) {
    static int grid = 0;
    if (grid == 0) {
        if (n_in != 21 || ws_size < WS_END) { fprintf(stderr, "kernel_launch: n_in %d ws %zu (need %zu): nothing launched\n", n_in, ws_size, (size_t)WS_END); grid = -1; return; }
        int dev = 0, cus = 0, per_cu = 0;
        if (hipGetDevice(&dev) != hipSuccess || hipDeviceGetAttribute(&cus, hipDeviceAttributeMultiprocessorCount, dev) != hipSuccess) { grid = -1; return; }
        if (hipFuncSetAttribute((const void*)mk_fwd, hipFuncAttributeMaxDynamicSharedMemorySize, LDS_BYTES) != hipSuccess) { fprintf(stderr, "hipFuncSetAttribute failed\n"); grid = -1; return; }
        if (hipOccupancyMaxActiveBlocksPerMultiprocessor(&per_cu, (const void*)mk_fwd, 512, LDS_BYTES) != hipSuccess || per_cu < 1) { fprintf(stderr, "occupancy query: %d\n", per_cu); per_cu = 1; }
        (void)hipGetLastError();
        grid = cus * per_cu;
    }
    if (grid < 0) return;
    if (hipMemsetAsync((char*)d_ws + WS_BAR, 0, 16384, stream) != hipSuccess) { fprintf(stderr, "memset of barrier words failed\n"); return; }
    Args a{};
    for (int i = 0; i < 21; ++i) a.in[i] = (const float*)d_in[i];
    a.out = (float*)d_out; a.ws = (unsigned char*)d_ws;
    void* kargs[] = {&a};
    hipError_t e = hipLaunchCooperativeKernel((const void*)mk_fwd, dim3(grid), dim3(512), kargs, LDS_BYTES, stream);
    if (e != hipSuccess) fprintf(stderr, "cooperative launch failed: %s (grid %d)\n", hipGetErrorString(e), grid);
}
```

```cpp
#include <hip/hip_runtime.h>
#include <hip/hip_cooperative_groups.h>
#include <cstdio>
#include <cstdint>
namespace cg = cooperative_groups;

typedef unsigned short bf16_t;
typedef short bf16x8 __attribute__((ext_vector_type(8)));
typedef float f32x4 __attribute__((ext_vector_type(4)));
typedef float f32x16 __attribute__((ext_vector_type(16)));
typedef unsigned u32x4 __attribute__((ext_vector_type(4)));
typedef unsigned u32x2 __attribute__((ext_vector_type(2)));
#define LAS __attribute__((address_space(3)))

constexpr int DM = 2048, NB = 4, SEQ = 4096, NCTXT = 256, DEPTH = 4;
constexpr int NLAT = NB * SEQ, NCTX = NB * NCTXT, MROWS = NLAT + NCTX;
constexpr int NMIX = 4928, NMIXP = 5120, NGP = 3072, NMG = 6144, NINP = NMIXP + NGP + NMG, NIN = 14144;
constexpr int O_KR = 768, O_NAQ = 832, O_NAK = 1856, O_NAV = 2880, O_PX = 3904;
constexpr float EPS = 1e-6f, LOG2E = 1.4426950408889634f;
constexpr float C_MLA = 0.07216878364870322f * LOG2E;
constexpr float C_NA = 0.125f * LOG2E;
constexpr int NCHUNK = 68;

constexpr size_t al256(size_t x) { return (x + 255) / 256 * 256; }
constexpr size_t WS_WIN = 0;
constexpr size_t WS_WUQ = WS_WIN + al256((size_t)DEPTH * NINP * DM * 2);
constexpr size_t WS_WUKV = WS_WUQ + al256((size_t)DEPTH * 1536 * 512 * 2);
constexpr size_t WS_WBR = WS_WUKV + al256((size_t)DEPTH * 2048 * 256 * 2);
constexpr size_t WS_WOUT = WS_WBR + al256((size_t)DEPTH * 3 * 2048 * 1024 * 2);
constexpr size_t WS_WG = WS_WOUT + al256((size_t)DEPTH * 2048 * 2048 * 2);
constexpr size_t WS_MOD = WS_WG + al256((size_t)DEPTH * 2 * 16 * 128 * 64 * 2);
constexpr size_t WS_ROPE = WS_MOD + al256((size_t)DEPTH * 5 * 6144 * 4);
constexpr size_t WS_XCUR = WS_ROPE + al256((size_t)64 * 16 * 2 * 4);
constexpr size_t WS_H = WS_XCUR + al256((size_t)MROWS * DM * 4);
constexpr size_t WS_PMIX = WS_H + al256((size_t)MROWS * DM * 2);
constexpr size_t WS_GP = WS_PMIX + al256((size_t)MROWS * NMIXP * 2);
constexpr size_t WS_MG = WS_GP + al256((size_t)MROWS * NGP * 2);
constexpr size_t WS_RSQ = WS_MG + al256((size_t)MROWS * NMG * 2);
constexpr size_t WS_Q = WS_RSQ + al256((size_t)MROWS * 12 * 4);
constexpr size_t WS_KV = WS_Q + al256((size_t)MROWS * 1536 * 2);
constexpr size_t WS_KR = WS_KV + al256((size_t)MROWS * 2048 * 2);
constexpr size_t WS_LA = WS_KR + al256((size_t)MROWS * 64 * 2);
constexpr size_t WS_LU = WS_LA + al256((size_t)2 * MROWS * 1024 * 4);
constexpr size_t WS_AGG = WS_LU + al256((size_t)2 * MROWS * 1024 * 4);
constexpr size_t WS_O = WS_AGG + al256((size_t)2 * NB * NCHUNK * 1024 * 2 * 4);
constexpr size_t WS_BAR = WS_O + al256((size_t)MROWS * 3072 * 2);
constexpr size_t WS_END = WS_BAR + 16384;

constexpr int LDS_BYTES = 147456;

struct Args { const float* in[21]; float* out; unsigned char* ws; };

typedef float f32x2_t __attribute__((ext_vector_type(2))); typedef __bf16 bf16x2_t __attribute__((ext_vector_type(2)));
__device__ __forceinline__ unsigned cvt_pk(float lo, float hi) { f32x2_t v = {lo, hi}; bf16x2_t b = __builtin_convertvector(v, bf16x2_t); return __builtin_bit_cast(unsigned, b); }
__device__ __forceinline__ float bflo(unsigned u) { return __uint_as_float(u << 16); }
__device__ __forceinline__ float bfhi(unsigned u) { return __uint_as_float(u & 0xffff0000u); }
__device__ __forceinline__ float bf1(bf16_t u) { return __uint_as_float(((unsigned)u) << 16); }
__device__ __forceinline__ u32x4 pack8(f32x4 a, f32x4 b) { u32x4 w; w.x = cvt_pk(a[0], a[1]); w.y = cvt_pk(a[2], a[3]); w.z = cvt_pk(b[0], b[1]); w.w = cvt_pk(b[2], b[3]); return w; }
__device__ __forceinline__ float sigmoidf_(float x) { return __builtin_amdgcn_rcpf(1.f + __expf(-x)); }
__device__ __forceinline__ float shx(float v, int lane, int m) { return __int_as_float(__builtin_amdgcn_ds_bpermute((lane ^ m) << 2, __float_as_int(v))); }
__device__ __forceinline__ float wave_sum(float v, int lane) {
#pragma unroll
    for (int o = 1; o < 64; o <<= 1) v += shx(v, lane, o);
    return v;
}
__device__ __forceinline__ int opaque_v(int x) { asm volatile("" : "+v"(x)); return x; }
__device__ __forceinline__ int crow(int r, int hi) { return (r & 3) + 8 * (r >> 2) + 4 * hi; }

namespace pg8 {
constexpr int BM = 256, BK = 64, HALF = 128, HTB = HALF * BK * 2, NXCD = 8, WGM = 4;
__host__ __device__ __forceinline__ int lds_byte(int r, int c) { const int st = (r >> 4) * 2 + (c >> 5), rr = r & 15, cc = c & 31, ob = rr * 64 + cc * 2; return st * 1024 + (ob ^ (((ob >> 9) & 1) << 5)); }
__host__ __device__ __forceinline__ void stage_rc(int b, int& R, int& C) { const int st = b / 1024, sb = b % 1024, swz = sb ^ (((sb >> 9) & 1) << 5); R = (st >> 1) * 16 + swz / 64; C = (st & 1) * 32 + (swz % 64) / 2; }
__host__ __device__ __forceinline__ int perm32(int rho) { const int n = rho >> 4, i = rho & 15; return 8 * (i >> 2) + 4 * n + (i & 3); }

struct Unit { int pm, pn, z; };
struct Gemm { const bf16_t* A; const bf16_t* Bt; int lda, ldb, K; size_t azs, bzs; };

struct Sched {
    int nM, nN, nwg, G, c, nz, rot = 0, pm0 = 0;
    __device__ void init(int M, int N, int G_, int c_, int nz_) { nM = M / BM; nN = N / BM; nwg = nM * nN; G = G_; c = c_; nz = nz_; }
    __device__ bool next(int i, Unit& u) const {
        const int it = i / nz; u.z = i - it * nz;
        const long L = (long)it * G + c; if (L >= nwg) return false;
        int wgid = (int)L; { const int q = nwg / NXCD, r = nwg % NXCD, xcd = wgid % NXCD, off = wgid / NXCD; wgid = (xcd < r ? xcd * (q + 1) : r * (q + 1) + (xcd - r) * q) + off; }
        const int nig = WGM * nN, gid = wgid / nig, fm = gid * WGM, gsz = (nM - fm) < WGM ? (nM - fm) : WGM;
        u.pm = fm + ((wgid % nig) % gsz); u.pn = (wgid % nig) / gsz;
        if (rot) u.pm = (u.pm < 4) ? nM - 4 + u.pm : u.pm - 4;
        u.pm += pm0; return true;
    }
};

template <class Epi>
__device__ __forceinline__ void gemm_phase(LAS unsigned char* lds, const Gemm g, const Sched& S, const Epi& E) {
    const int tid = opaque_v(threadIdx.x), wid = __builtin_amdgcn_readfirstlane(tid >> 6), lane = tid & 63, wr = wid >> 2, wc = wid & 3, fr = lane & 15, fq = lane >> 4;
    const int K = g.K, nt = K / BK;
    unsigned voffA[2], voffB[2];
#pragma unroll
    for (int i = 0; i < 2; ++i) { int R, C; stage_rc(tid * 16 + i * 8192, R, C); const int Rb = (R & ~31) + perm32(R & 31);
        voffA[i] = (unsigned)(R * g.lda + C) * 2u; voffB[i] = (unsigned)(Rb * g.ldb + C) * 2u; }
    const size_t kstep = (size_t)(BK * 2);
    const size_t hstepA = (size_t)HALF * g.lda * 2, hstepB = (size_t)HALF * g.ldb * 2;
    const unsigned ldsw = (unsigned)wid * 1024u;
    const int aoff = lds_byte(wr * 64 + fr, fq * 8), boff = lds_byte(wc * 32 + fr, fq * 8);
#define PG8_SA(b, h) (((b) * 2 + (h)) * HTB)
#define PG8_SB(b, h) ((4 + (b) * 2 + (h)) * HTB)
#define PG8_STAGE(bufoff, gbase, voff) do { _Pragma("unroll") for (int _i = 0; _i < 2; ++_i) \
        __builtin_amdgcn_global_load_lds((const unsigned*)((const char*)(gbase) + (voff)[_i]), (LAS unsigned*)(lds + (bufoff) + ldsw + _i * 8192), 16, 0, 0); } while (0)
#define PG8_LDA(dst, b, h) do { _Pragma("unroll") for (int m = 0; m < 4; ++m) _Pragma("unroll") for (int k = 0; k < 2; ++k) dst[m][k] = *(const LAS bf16x8*)(lds + PG8_SA(b, h) + aoff + m * 2048 + k * 1024); } while (0)
#define PG8_LDB(dst, b, h) do { _Pragma("unroll") for (int n = 0; n < 2; ++n) _Pragma("unroll") for (int k = 0; k < 2; ++k) dst[n][k] = *(const LAS bf16x8*)(lds + PG8_SB(b, h) + boff + n * 2048 + k * 1024); } while (0)
#define PG8_MMA(ai, bj, At, Bt) do { __builtin_amdgcn_s_setprio(1); _Pragma("unroll") for (int m = 0; m < 4; ++m) _Pragma("unroll") for (int n = 0; n < 2; ++n) _Pragma("unroll") for (int k = 0; k < 2; ++k) \
        acc[ai][bj][m][n] = __builtin_amdgcn_mfma_f32_16x16x32_bf16(Bt[n][k], At[m][k], acc[ai][bj][m][n], 0, 0, 0); __builtin_amdgcn_s_setprio(0); } while (0)
#define PG8_WAIT_V(n) asm volatile("s_waitcnt vmcnt(" #n ")" ::: "memory")
#define PG8_WAIT_L(n) asm volatile("s_waitcnt lgkmcnt(" #n ")" ::: "memory")
#define PG8_BAR __builtin_amdgcn_s_barrier()
#define PG8_SCHED __builtin_amdgcn_sched_barrier(0)
    Unit cur, nxt; int ui = 0;
    if (!S.next(0, cur)) return;
    f32x4 acc[2][2][4][2];
#pragma unroll
    for (int a = 0; a < 2; ++a)
#pragma unroll
        for (int b = 0; b < 2; ++b)
#pragma unroll
            for (int m = 0; m < 4; ++m)
#pragma unroll
                for (int n = 0; n < 2; ++n) acc[a][b][m][n] = (f32x4){0.f, 0.f, 0.f, 0.f};
    bf16x8 At[4][2], B0[2][2], B1[2][2];
    const char* cA = (const char*)g.A + ((size_t)cur.z * g.azs + (size_t)cur.pm * BM * g.lda) * 2;
    const char* cB = (const char*)g.Bt + ((size_t)cur.z * g.bzs + (size_t)cur.pn * BM * g.ldb) * 2;
    PG8_STAGE(PG8_SB(0, 0), cB, voffB); PG8_STAGE(PG8_SB(0, 1), cB + hstepB, voffB); PG8_STAGE(PG8_SA(0, 0), cA, voffA); PG8_STAGE(PG8_SA(0, 1), cA + hstepA, voffA);
    if (wr == 1) PG8_BAR;
    PG8_WAIT_V(2); PG8_BAR;
    PG8_STAGE(PG8_SB(1, 0), cB + kstep, voffB); PG8_STAGE(PG8_SA(1, 0), cA + kstep, voffA); PG8_STAGE(PG8_SB(1, 1), cB + hstepB + kstep, voffB);
    PG8_WAIT_V(6); PG8_BAR;
    for (;;) {
        const bool has_next = S.next(ui + 1, nxt);
        const char* nA = has_next ? (const char*)g.A + ((size_t)nxt.z * g.azs + (size_t)nxt.pm * BM * g.lda) * 2 : cA;
        const char* nB = has_next ? (const char*)g.Bt + ((size_t)nxt.z * g.bzs + (size_t)nxt.pn * BM * g.ldb) * 2 : cB;
        for (int t = 0; t < nt; t += 2) {
            const bool last = (t == nt - 2);
            const char* a1 = cA + (size_t)(t + 1) * kstep;
            const char* a2 = last ? nA : cA + (size_t)(t + 2) * kstep; const char* b2 = last ? nB : cB + (size_t)(t + 2) * kstep;
            const char* a3 = a2 + kstep; const char* b3 = b2 + kstep;
            PG8_LDB(B0, 0, 0); PG8_LDB(B1, 0, 1); PG8_SCHED; PG8_LDA(At, 0, 0); PG8_STAGE(PG8_SA(1, 1), a1 + hstepA, voffA);
            PG8_WAIT_V(8); PG8_WAIT_L(0); PG8_BAR; PG8_MMA(0, 0, At, B0); PG8_MMA(0, 1, At, B1); PG8_BAR; PG8_SCHED;
            PG8_LDA(At, 0, 1); PG8_STAGE(PG8_SB(0, 0), b2, voffB); PG8_STAGE(PG8_SB(0, 1), b2 + hstepB, voffB); PG8_STAGE(PG8_SA(0, 0), a2, voffA);
            PG8_WAIT_V(8); PG8_WAIT_L(0); PG8_BAR; PG8_MMA(1, 0, At, B0); PG8_MMA(1, 1, At, B1); PG8_BAR; PG8_SCHED;
            PG8_LDB(B0, 1, 0); PG8_LDB(B1, 1, 1); PG8_SCHED; PG8_LDA(At, 1, 0); PG8_STAGE(PG8_SA(0, 1), a2 + hstepA, voffA);
            PG8_WAIT_V(8); PG8_WAIT_L(0); PG8_BAR; PG8_MMA(0, 0, At, B0); PG8_MMA(0, 1, At, B1); PG8_BAR; PG8_SCHED;
            PG8_LDA(At, 1, 1); PG8_STAGE(PG8_SB(1, 0), b3, voffB); PG8_STAGE(PG8_SB(1, 1), b3 + hstepB, voffB); PG8_STAGE(PG8_SA(1, 0), a3, voffA);
            PG8_WAIT_V(8); PG8_WAIT_L(0); PG8_BAR; PG8_MMA(1, 0, At, B0); PG8_MMA(1, 1, At, B1); PG8_BAR; PG8_SCHED;
        }
        if (wr == 0) PG8_BAR;
        { const int l2 = opaque_v(lane); E(acc, cur, wr, wc, l2 & 15, l2 >> 4); }
        if (!has_next) break;
#pragma unroll
        for (int a = 0; a < 2; ++a)
#pragma unroll
            for (int b = 0; b < 2; ++b)
#pragma unroll
                for (int m = 0; m < 4; ++m)
#pragma unroll
                    for (int n = 0; n < 2; ++n) acc[a][b][m][n] = (f32x4){0.f, 0.f, 0.f, 0.f};
        cur = nxt; cA = nA; cB = nB; ++ui;
        if (wr == 1) PG8_BAR;
    }
    PG8_WAIT_V(0);
    PG8_BAR;
#undef PG8_SA
#undef PG8_SB
#undef PG8_STAGE
#undef PG8_LDA
#undef PG8_LDB
#undef PG8_MMA
#undef PG8_WAIT_V
#undef PG8_WAIT_L
#undef PG8_BAR
#undef PG8_SCHED
}
}
typedef f32x4 AccT[2][2][4][2];
#define EPI_FENCE(a, b) asm volatile("" : "+v"(a), "+v"(b) :: "memory")

struct EpiIn {
    bf16_t* pmix; bf16_t* gp; bf16_t* mg; float* rsq;
    __device__ __forceinline__ void operator()(const AccT& acc, const pg8::Unit& u, int wr, int wc, int fr, int fq) const {
        const int row0 = u.pm * 256 + wr * 64 + fr, pn = u.pn;
        if (pn < 20) {
#pragma unroll
            for (int ai = 0; ai < 2; ++ai)
#pragma unroll
                for (int m = 0; m < 4; ++m) {
                    __builtin_amdgcn_sched_barrier(0); const int row = row0 + ai * 128 + m * 16; float ss = 0.f;
#pragma unroll
                    for (int bj = 0; bj < 2; ++bj) {
                        const int col0 = pn * 256 + bj * 128 + wc * 32 + 8 * fq;
                        f32x4 v0 = acc[ai][bj][m][0], v1 = acc[ai][bj][m][1]; EPI_FENCE(v0, v1);
                        ss += (v0[0] * v0[0] + v0[1] * v0[1]) + (v0[2] * v0[2] + v0[3] * v0[3]) + (v1[0] * v1[0] + v1[1] * v1[1]) + (v1[2] * v1[2] + v1[3] * v1[3]);
                        const float sc = (col0 >= O_NAQ && col0 < O_NAK) ? C_NA : 1.f;
                        *(u32x4*)(pmix + (size_t)row * NMIXP + col0) = pack8(v0 * sc, v1 * sc);
                    }
                    if (pn < 3) { ss += shx(ss, fr + 16 * fq, 16); ss += shx(ss, fr + 16 * fq, 32); if (fq == 0) rsq[(size_t)row * 12 + pn * 4 + wc] = ss; }
                }
        } else if (pn < 32) {
#pragma unroll
            for (int ai = 0; ai < 2; ++ai)
#pragma unroll
                for (int m = 0; m < 4; ++m) {
                    __builtin_amdgcn_sched_barrier(0); const int row = row0 + ai * 128 + m * 16;
#pragma unroll
                    for (int bj = 0; bj < 2; ++bj) {
                        const int col0 = (pn - 20) * 256 + bj * 128 + wc * 32 + 8 * fq;
                        f32x4 v0 = acc[ai][bj][m][0], v1 = acc[ai][bj][m][1]; EPI_FENCE(v0, v1);
#pragma unroll
                        for (int e = 0; e < 4; ++e) { v0[e] = v0[e] * sigmoidf_(v0[e]); v1[e] = v1[e] * sigmoidf_(v1[e]); }
                        *(u32x4*)(gp + (size_t)row * NGP + col0) = pack8(v0, v1);
                    }
                }
        } else {
#pragma unroll
            for (int ai = 0; ai < 2; ++ai)
#pragma unroll
                for (int m = 0; m < 4; ++m) {
                    __builtin_amdgcn_sched_barrier(0); const int row = row0 + ai * 128 + m * 16;
#pragma unroll
                    for (int bj = 0; bj < 2; ++bj) {
                        const int col0 = (pn - 32) * 256 + bj * 128 + wc * 32 + 8 * fq;
                        f32x4 v0 = acc[ai][bj][m][0], v1 = acc[ai][bj][m][1]; EPI_FENCE(v0, v1);
#pragma unroll
                        for (int e = 0; e < 4; ++e) { v0[e] = sigmoidf_(v0[e]); v1[e] = sigmoidf_(v1[e]); }
                        *(u32x4*)(mg + (size_t)row * NMG + col0) = pack8(v0, v1);
                    }
                }
        }
    }
};
struct EpiQ {
    bf16_t* q; const float* rsq; const float* cs;
    __device__ __forceinline__ void operator()(const AccT& acc, const pg8::Unit& u, int wr, int wc, int fr, int fq) const {
        const int row0 = u.pm * 256 + wr * 64 + fr, pn = u.pn; const bool lat = u.pm < 64;
#pragma unroll
        for (int ai = 0; ai < 2; ++ai) {
          float rinv4[4];
          { f32x4 ra[4], rb[4];
#pragma unroll
            for (int i = 0; i < 4; ++i) { const int row = row0 + ai * 128 + i * 16; ra[i] = *(const f32x4*)(rsq + (size_t)row * 12); rb[i] = *(const f32x4*)(rsq + (size_t)row * 12 + 4); }
#pragma unroll
            for (int i = 0; i < 4; ++i) rinv4[i] = rsqrtf((((ra[i][0] + ra[i][1]) + (ra[i][2] + ra[i][3])) + ((rb[i][0] + rb[i][1]) + (rb[i][2] + rb[i][3]))) * (1.f / 512.f) + EPS) * C_MLA; }
#pragma unroll
            for (int m = 0; m < 4; ++m) {
                __builtin_amdgcn_sched_barrier(0); const int row = row0 + ai * 128 + m * 16;
                const float rinv = rinv4[m];
                const int s = row & 4095;
#pragma unroll
                for (int bj = 0; bj < 2; ++bj) {
                    const int g32 = pn * 8 + bj * 4 + wc, t6 = g32 % 6, col0 = g32 * 32 + 8 * fq;
                    f32x4 v0 = acc[ai][bj][m][0], v1 = acc[ai][bj][m][1]; EPI_FENCE(v0, v1); v0 = v0 * rinv; v1 = v1 * rinv;
                    if (t6 >= 4 && lat) {
                        const int pos = (t6 == 4) ? (s >> 6) : (s & 63);
                        const float* cp = cs + (pos * 16 + 8 * (fq & 1)) * 2;
                        const f32x4 c0 = *(const f32x4*)(cp), c1 = *(const f32x4*)(cp + 4), c2 = *(const f32x4*)(cp + 8), c3 = *(const f32x4*)(cp + 12);
                        const float cosv[8] = {c0[0], c0[2], c1[0], c1[2], c2[0], c2[2], c3[0], c3[2]};
                        const float sinv[8] = {c0[1], c0[3], c1[1], c1[3], c2[1], c2[3], c3[1], c3[3]};
                        float x[8] = {v0[0], v0[1], v0[2], v0[3], v1[0], v1[1], v1[2], v1[3]};
#pragma unroll
                        for (int e = 0; e < 8; ++e) { const float p = shx(x[e], fr + 16 * fq, 32); x[e] = (fq < 2) ? (x[e] * cosv[e] - p * sinv[e]) : (p * sinv[e] + x[e] * cosv[e]); }
                        v0 = (f32x4){x[0], x[1], x[2], x[3]}; v1 = (f32x4){x[4], x[5], x[6], x[7]};
                    }
                    *(u32x4*)(q + (size_t)row * 1536 + col0) = pack8(v0, v1);
                }
            }
        }
    }
};
struct EpiKV {
    bf16_t* kv; const float* rsq;
    __device__ __forceinline__ void operator()(const AccT& acc, const pg8::Unit& u, int wr, int wc, int fr, int fq) const {
        const int row0 = u.pm * 256 + wr * 64 + fr, pn = u.pn;
#pragma unroll
        for (int ai = 0; ai < 2; ++ai) {
          float rinv4[4];
          { f32x4 ra[4];
#pragma unroll
            for (int i = 0; i < 4; ++i) { const int row = row0 + ai * 128 + i * 16; ra[i] = *(const f32x4*)(rsq + (size_t)row * 12 + 8); }
#pragma unroll
            for (int i = 0; i < 4; ++i) rinv4[i] = rsqrtf(((ra[i][0] + ra[i][1]) + (ra[i][2] + ra[i][3])) * (1.f / 256.f) + EPS); }
#pragma unroll
            for (int m = 0; m < 4; ++m) {
                __builtin_amdgcn_sched_barrier(0); const int row = row0 + ai * 128 + m * 16;
                const float rinv = rinv4[m];
#pragma unroll
                for (int bj = 0; bj < 2; ++bj) {
                    const int col0 = pn * 256 + bj * 128 + wc * 32 + 8 * fq;
                    f32x4 v0 = acc[ai][bj][m][0], v1 = acc[ai][bj][m][1]; EPI_FENCE(v0, v1);
                    *(u32x4*)(kv + (size_t)row * 2048 + col0) = pack8(v0 * rinv, v1 * rinv);
                }
            }
        }
    }
};
struct EpiMerge {
    const bf16_t* mg; float* tmp; bf16_t* merged; unsigned* ctr;
    __device__ __forceinline__ void operator()(const AccT& acc, const pg8::Unit& u, int wr, int wc, int fr, int fq) const {
        const int row0 = u.pm * 256 + wr * 64 + fr, pn = u.pn, z = u.z;
#pragma unroll
        for (int ai = 0; ai < 2; ++ai) {
            u32x4 gw8[8], pw8[8];
#pragma unroll
            for (int i = 0; i < 8; ++i) { const int row = row0 + ai * 128 + (i >> 1) * 16, col0 = pn * 256 + (i & 1) * 128 + wc * 32 + 8 * fq;
                gw8[i] = *(const u32x4*)(mg + (size_t)row * NMG + z * 2048 + col0);
                pw8[i] = (z > 0) ? *(const u32x4*)(merged + (size_t)row * 2048 + col0) : (u32x4){0u, 0u, 0u, 0u}; }
#pragma unroll
            for (int i = 0; i < 8; ++i) { const int m = i >> 1, bj = i & 1; const int row = row0 + ai * 128 + m * 16, col0 = pn * 256 + bj * 128 + wc * 32 + 8 * fq;
                f32x4 v0 = acc[ai][bj][m][0], v1 = acc[ai][bj][m][1]; EPI_FENCE(v0, v1);
                const u32x4 gw = gw8[i], pw = pw8[i];
                v0[0] = v0[0] * bflo(gw.x) + bflo(pw.x); v0[1] = v0[1] * bfhi(gw.x) + bfhi(pw.x); v0[2] = v0[2] * bflo(gw.y) + bflo(pw.y); v0[3] = v0[3] * bfhi(gw.y) + bfhi(pw.y);
                v1[0] = v1[0] * bflo(gw.z) + bflo(pw.z); v1[1] = v1[1] * bfhi(gw.z) + bfhi(pw.z); v1[2] = v1[2] * bflo(gw.w) + bflo(pw.w); v1[3] = v1[3] * bfhi(gw.w) + bfhi(pw.w);
                *(u32x4*)(merged + (size_t)row * 2048 + col0) = pack8(v0, v1); }
        }
        if (ctr && z == 2 && u.pm >= 64) {
            asm volatile("s_waitcnt vmcnt(0)" ::: "memory"); __builtin_amdgcn_s_barrier();
            if (threadIdx.x == 0) { __builtin_amdgcn_fence(__ATOMIC_RELEASE, "agent"); asm volatile("s_waitcnt vmcnt(0)" ::: "memory");
                (void)__hip_atomic_fetch_add(ctr + (u.pm - 64), 1u, __ATOMIC_RELAXED, __HIP_MEMORY_SCOPE_AGENT); }
        }
    }
};
struct EpiOut {
    const float* xin; const float* ctxin; float* xcur; const float* mod; int layer;
    __device__ __forceinline__ void operator()(const AccT& acc, const pg8::Unit& u, int wr, int wc, int fr, int fq) const {
        const int row0 = u.pm * 256 + wr * 64 + fr, pn = u.pn; const bool lat = u.pm < 64;
        const float* gt = mod + (size_t)(lat ? (u.pm >> 4) : 4) * 6144 + 4096;
#pragma unroll
        for (int hq = 0; hq < 4; ++hq) {
            const int ai = hq >> 1, m0 = (hq & 1) * 2;
            f32x4 xa[4], xb[4];
#pragma unroll
            for (int i = 0; i < 4; ++i) { const int row = row0 + ai * 128 + (m0 + (i >> 1)) * 16, col0 = pn * 256 + (i & 1) * 128 + wc * 32 + 8 * fq;
                const float* xo = (layer == 0) ? (lat ? xin + (size_t)row * 2048 : ctxin + (size_t)(row - NLAT) * 2048) : xcur + (size_t)row * 2048;
                xa[i] = *(const f32x4*)(xo + col0); xb[i] = *(const f32x4*)(xo + col0 + 4); }
#pragma unroll
            for (int i = 0; i < 4; ++i) { const int m = m0 + (i >> 1), bj = i & 1; const int row = row0 + ai * 128 + m * 16, col0 = pn * 256 + bj * 128 + wc * 32 + 8 * fq;
                f32x4 v0 = acc[ai][bj][m][0], v1 = acc[ai][bj][m][1]; EPI_FENCE(v0, v1);
                const f32x4 g0 = *(const f32x4*)(gt + col0), g1 = *(const f32x4*)(gt + col0 + 4);
                *(f32x4*)(xcur + (size_t)row * 2048 + col0) = xa[i] + g0 * v0;
                *(f32x4*)(xcur + (size_t)row * 2048 + col0 + 4) = xb[i] + g1 * v1; }
        }
    }
};

namespace mla {
typedef short s16x4 __attribute__((ext_vector_type(4)));
constexpr int SHM_V = 16384, SHM_K = 16384, SHM_KR = 8192;
constexpr int OFF_V = 0, OFF_K = 2 * SHM_V, OFF_KR = OFF_K + 2 * SHM_K, OFF_WS = OFF_KR + 2 * SHM_KR;
constexpr float THR2 = 8.f;
#define KSWZ(row, colB) ((row) * 256 + ((colB) ^ (((row) & 7) << 4)))
#define KRSWZ(row, colB) ((row) * 128 + ((colB) ^ (((row) & 7) << 4)))
#define SBAR() __builtin_amdgcn_sched_barrier(0)
__device__ __forceinline__ void partialSM(f32x16& p0, f32x16& p1, float& m_reg, float& mn, float& alpha) {
    float pmax = p0[0];
#pragma unroll
    for (int r = 1; r < 16; ++r) pmax = fmaxf(pmax, p0[r]);
#pragma unroll
    for (int r = 0; r < 16; ++r) pmax = fmaxf(pmax, p1[r]);
    { auto rr = __builtin_amdgcn_permlane32_swap(__float_as_uint(pmax), __float_as_uint(pmax), false, false);
      pmax = fmaxf(__uint_as_float(rr[0]), __uint_as_float(rr[1])); }
    if (__builtin_expect(__all(pmax - m_reg <= THR2), 1)) { mn = m_reg; alpha = 1.f; }
    else { mn = fmaxf(m_reg, pmax); alpha = __builtin_amdgcn_exp2f(m_reg - mn); m_reg = mn; }
#pragma unroll
    for (int r = 0; r < 16; ++r) p0[r] = p0[r] - mn;
#pragma unroll
    for (int r = 0; r < 16; ++r) p1[r] = p1[r] - mn;
#pragma unroll
    for (int r = 0; r < 16; ++r) p0[r] = __builtin_amdgcn_exp2f(p0[r]);
}
__device__ __forceinline__ void finishSM(f32x16& p0, f32x16& p1, float alpha, float& l_reg, bf16x8& pa0, bf16x8& pa1, bf16x8& pa2, bf16x8& pa3) {
#pragma unroll
    for (int r = 0; r < 16; ++r) p1[r] = __builtin_amdgcn_exp2f(p1[r]);
    float ps = 0;
#pragma unroll
    for (int r = 0; r < 16; ++r) ps += p0[r];
#pragma unroll
    for (int r = 0; r < 16; ++r) ps += p1[r];
    { auto rr = __builtin_amdgcn_permlane32_swap(__float_as_uint(ps), __float_as_uint(ps), false, false);
      ps = __uint_as_float(rr[0]) + __uint_as_float(rr[1]); }
    l_reg = l_reg * alpha + ps;
#define PK4(P, BASE, OUT) do { unsigned a0 = cvt_pk(P[BASE + 0], P[BASE + 1]), a1 = cvt_pk(P[BASE + 2], P[BASE + 3]);   \
    unsigned b0 = cvt_pk(P[BASE + 4], P[BASE + 5]), b1 = cvt_pk(P[BASE + 6], P[BASE + 7]);                              \
    auto r0 = __builtin_amdgcn_permlane32_swap(a0, b0, false, false); auto r1 = __builtin_amdgcn_permlane32_swap(a1, b1, false, false); \
    u32x4 w = {r0[0], r1[0], r0[1], r1[1]}; OUT = *reinterpret_cast<bf16x8*>(&w); } while (0)
    PK4(p0, 0, pa0); PK4(p0, 8, pa1); PK4(p1, 0, pa2); PK4(p1, 8, pa3);
#undef PK4
}
__device__ __forceinline__ void qkt(f32x16& p0, f32x16& p1, const char* Ks, const char* KRs, const bf16x8* qr, int r32, int hi) {
    p0 = f32x16{}; p1 = f32x16{};
#pragma unroll
    for (int d0 = 0; d0 < 8; ++d0) { const int cb = (d0 * 16 + hi * 8) * 2;
        bf16x8 b0 = *reinterpret_cast<const bf16x8*>(Ks + KSWZ(r32, cb));
        bf16x8 b1 = *reinterpret_cast<const bf16x8*>(Ks + KSWZ(32 + r32, cb));
        p0 = __builtin_amdgcn_mfma_f32_32x32x16_bf16(b0, qr[d0], p0, 0, 0, 0);
        p1 = __builtin_amdgcn_mfma_f32_32x32x16_bf16(b1, qr[d0], p1, 0, 0, 0); }
#pragma unroll
    for (int d0 = 0; d0 < 4; ++d0) { const int cb = (d0 * 16 + hi * 8) * 2;
        bf16x8 b0 = *reinterpret_cast<const bf16x8*>(KRs + KRSWZ(r32, cb));
        bf16x8 b1 = *reinterpret_cast<const bf16x8*>(KRs + KRSWZ(32 + r32, cb));
        p0 = __builtin_amdgcn_mfma_f32_32x32x16_bf16(b0, qr[8 + d0], p0, 0, 0, 0);
        p1 = __builtin_amdgcn_mfma_f32_32x32x16_bf16(b1, qr[8 + d0], p1, 0, 0, 0); }
}
__device__ __forceinline__ int v_st(int k, int c) { const int kk = (k & ~0xC) | ((k & 4) << 1) | ((k & 8) >> 1); return ((kk >> 3) * 4 + (c >> 5)) * 512 + ((kk & 7) * 32 + (c & 31)) * 2; }
__device__ __forceinline__ int v_rd_base(int lane) { return ((lane & 3) << 3) | (((lane >> 2) & 3) << 6) | (((lane >> 4) & 1) << 5) | (((lane >> 5) & 1) << 8); }
constexpr int v_rd_off(int d0, int ks, int half) { return d0 * 512 + ks * 4096 + half * 2048; }
template <int OFF> __device__ __forceinline__ s16x4 tr_read(int vb) {
    s16x4 r; asm volatile("ds_read_b64_tr_b16 %0, %1 offset:%2" : "=&v"(r) : "v"(vb), "i"(OFF) : "memory"); return r;
}
template <int D0> __device__ __forceinline__ void pv_one(f32x16& od, int vb, bf16x8 pa0, bf16x8 pa1, bf16x8 pa2, bf16x8 pa3) {
    const s16x4 l0 = tr_read<v_rd_off(D0, 0, 0)>(vb), h0 = tr_read<v_rd_off(D0, 0, 1)>(vb), l1 = tr_read<v_rd_off(D0, 1, 0)>(vb), h1 = tr_read<v_rd_off(D0, 1, 1)>(vb);
    const s16x4 l2 = tr_read<v_rd_off(D0, 2, 0)>(vb), h2 = tr_read<v_rd_off(D0, 2, 1)>(vb), l3 = tr_read<v_rd_off(D0, 3, 0)>(vb), h3 = tr_read<v_rd_off(D0, 3, 1)>(vb);
    asm volatile("s_waitcnt lgkmcnt(0)" ::: "memory"); SBAR();
#define PK(L, H) (bf16x8){L[0], L[1], L[2], L[3], H[0], H[1], H[2], H[3]}
    od = __builtin_amdgcn_mfma_f32_32x32x16_bf16(pa0, PK(l0, h0), od, 0, 0, 0);
    od = __builtin_amdgcn_mfma_f32_32x32x16_bf16(pa1, PK(l1, h1), od, 0, 0, 0);
    od = __builtin_amdgcn_mfma_f32_32x32x16_bf16(pa2, PK(l2, h2), od, 0, 0, 0);
    od = __builtin_amdgcn_mfma_f32_32x32x16_bf16(pa3, PK(l3, h3), od, 0, 0, 0);
#undef PK
}
__device__ __forceinline__ void pv_d0(f32x16* o, int vb, bf16x8 pa0, bf16x8 pa1, bf16x8 pa2, bf16x8 pa3) {
    pv_one<0>(o[0], vb, pa0, pa1, pa2, pa3); pv_one<1>(o[1], vb, pa0, pa1, pa2, pa3); pv_one<2>(o[2], vb, pa0, pa1, pa2, pa3); pv_one<3>(o[3], vb, pa0, pa1, pa2, pa3);
}
__device__ __forceinline__ void attn_unit(const bf16_t* __restrict__ Q, const bf16_t* __restrict__ KV, const bf16_t* __restrict__ KR, const bf16_t* __restrict__ GP, bf16_t* __restrict__ O,
                                          int qrow0, int h, int latbase, int ctxbase, int nlt, int NT, char* lds) {
    const int tid = opaque_v(threadIdx.x), wid = tid >> 6, lane = tid & 63, r32 = lane & 31, hi = lane >> 5;
    char* V_lds = lds + OFF_V; char* K_lds = lds + OFF_K; char* KR_lds = lds + OFF_KR;
    float* ws = (float*)(lds + OFF_WS) + wid * 64; float* li_l = ws; float* al_l = ws + 32;
    float m_reg = -1e30f, l_reg = 0; f32x16 o[4] = {}; bf16x8 qr[12];
    const bf16_t* Qw = Q + (size_t)(qrow0 + wid * 32 + r32) * 1536 + h * 192 + hi * 8;
#pragma unroll
    for (int d0 = 0; d0 < 12; ++d0) qr[d0] = *reinterpret_cast<const bf16x8*>(Qw + d0 * 16);
    const int sr = tid >> 4, sc = (tid & 15) * 8, vst0 = v_st(sr, sc), vst1 = v_st(32 + sr, sc);
    const int krr = tid >> 3, krc = (tid & 7) * 16;
    const int vb0 = (int)(uintptr_t)V_lds + v_rd_base(lane);
    const bf16_t* Kh = KV + h * 256 + sc; const bf16_t* Vh = KV + h * 256 + 128 + sc;
    bf16x8 s_v0, s_v1, s_k0, s_k1, s_kr;
#define TROW(j) ((j) < nlt ? latbase + 64 * (j) : ctxbase + 64 * ((j) - nlt))
#define SLOAD(j) do { const int _rb = TROW(j); \
    s_v0 = *reinterpret_cast<const bf16x8*>(Vh + (size_t)(_rb + sr) * 2048); s_v1 = *reinterpret_cast<const bf16x8*>(Vh + (size_t)(_rb + 32 + sr) * 2048); \
    s_k0 = *reinterpret_cast<const bf16x8*>(Kh + (size_t)(_rb + sr) * 2048); s_k1 = *reinterpret_cast<const bf16x8*>(Kh + (size_t)(_rb + 32 + sr) * 2048); \
    s_kr = *reinterpret_cast<const bf16x8*>((const char*)KR + (size_t)(_rb + krr) * 128 + krc); } while (0)
#define SWRITE(b) do { *(bf16x8*)(V_lds + (b) * SHM_V + vst0) = s_v0; *(bf16x8*)(V_lds + (b) * SHM_V + vst1) = s_v1; const int kc = sc * 2; \
    *(bf16x8*)(K_lds + (b) * SHM_K + KSWZ(sr, kc)) = s_k0; *(bf16x8*)(K_lds + (b) * SHM_K + KSWZ(32 + sr, kc)) = s_k1; \
    *(bf16x8*)(KR_lds + (b) * SHM_KR + KRSWZ(krr, krc)) = s_kr; } while (0)
#define RESC(a) do { if (__any((a) < 1.f)) { if (hi == 0) al_l[r32] = (a); asm volatile("s_waitcnt lgkmcnt(0)" ::: "memory"); \
    _Pragma("unroll") for (int d = 0; d < 4; ++d) _Pragma("unroll") for (int r = 0; r < 16; ++r) o[d][r] *= al_l[crow(r, hi)]; } } while (0)
    f32x16 pA0, pA1, pB0, pB1; float mnA, mnB, alA, alB; bf16x8 pa0, pa1, pa2, pa3;
    SLOAD(0); asm volatile("s_waitcnt vmcnt(0)" ::: "memory"); SWRITE(0); __syncthreads();
    qkt(pA0, pA1, K_lds, KR_lds, qr, r32, hi); partialSM(pA0, pA1, m_reg, mnA, alA);
    SLOAD(1);
    asm volatile("s_waitcnt vmcnt(0)" ::: "memory"); SWRITE(1); __syncthreads();
    for (int j = 1; j + 1 < NT; j += 2) {
        SBAR(); qkt(pB0, pB1, K_lds + SHM_K, KR_lds + SHM_KR, qr, r32, hi);
        finishSM(pA0, pA1, alA, l_reg, pa0, pa1, pa2, pa3); SBAR();
        SLOAD(j + 1); SBAR();
        pv_d0(o, vb0, pa0, pa1, pa2, pa3); partialSM(pB0, pB1, m_reg, mnB, alB);
        __syncthreads(); asm volatile("s_waitcnt vmcnt(0)" ::: "memory"); SWRITE(0);
        RESC(alB); __syncthreads();
        SBAR(); qkt(pA0, pA1, K_lds, KR_lds, qr, r32, hi);
        finishSM(pB0, pB1, alB, l_reg, pa0, pa1, pa2, pa3); SBAR();
        SLOAD(j + 2); SBAR();
        pv_d0(o, vb0 + SHM_V, pa0, pa1, pa2, pa3); partialSM(pA0, pA1, m_reg, mnA, alA);
        __syncthreads(); asm volatile("s_waitcnt vmcnt(0)" ::: "memory"); SWRITE(1);
        RESC(alA); __syncthreads();
    }
    SBAR(); qkt(pB0, pB1, K_lds + SHM_K, KR_lds + SHM_KR, qr, r32, hi);
    finishSM(pA0, pA1, alA, l_reg, pa0, pa1, pa2, pa3); SBAR();
    pv_d0(o, vb0, pa0, pa1, pa2, pa3); partialSM(pB0, pB1, m_reg, mnB, alB);
    __syncthreads(); RESC(alB);
    finishSM(pB0, pB1, alB, l_reg, pa0, pa1, pa2, pa3); SBAR();
    pv_d0(o, vb0 + SHM_V, pa0, pa1, pa2, pa3);
    if (hi == 0) li_l[r32] = l_reg; asm volatile("s_waitcnt lgkmcnt(0)" ::: "memory");
    const int orow0 = qrow0 + wid * 32;
#pragma unroll
    for (int r = 0; r < 16; ++r) { const int orow = orow0 + crow(r, hi); const float rl = __builtin_amdgcn_rcpf(li_l[crow(r, hi)]);
#pragma unroll
        for (int d0 = 0; d0 < 4; ++d0) { const size_t idx = (size_t)orow * 3072 + h * 128 + d0 * 32 + r32;
            const float v = o[d0][r] * rl * bf1(GP[idx]); O[idx] = (bf16_t)(cvt_pk(v, 0.f) & 0xffffu); } }
    __syncthreads();
#undef TROW
#undef SLOAD
#undef SWRITE
#undef RESC
}
}

__device__ __forceinline__ void na_item(const bf16_t* __restrict__ PMIX, const bf16_t* __restrict__ GP, bf16_t* __restrict__ O, const float* __restrict__ bias, int item, int lane, LAS unsigned char* wl) {
    const int q = lane & 31, hi = lane >> 5;
    const bool lat = item < 8192;
    int b, h, gi = 0, jh = 0, qrow;
    if (lat) { b = item >> 11; h = (item >> 7) & 15; gi = (item >> 1) & 63; jh = item & 1; qrow = b * 4096 + gi * 64 + jh * 32 + q; }
    else { const int it = item - 8192; b = it >> 7; h = (it >> 3) & 15; qrow = NLAT + b * 256 + (it & 7) * 32 + q; }
    const int j = jh * 32 + q;
    const int c0 = min(max(j - 8, 0), 48), r0 = min(max(gi - 4, 0), 56);
    const bf16_t* qp = PMIX + (size_t)qrow * NMIXP + O_NAQ + h * 64 + hi * 8;
    bf16x8 qf[4];
#pragma unroll
    for (int ks = 0; ks < 4; ++ks) qf[ks] = *reinterpret_cast<const bf16x8*>(qp + ks * 16);
    f32x16 oT0 = {}, oT1 = {}; float m = -1e30f, l = 0.f;
    const int ntiles = lat ? 24 : 8;
    const float* bh = bias + h * (15 * 31);
    LAS float* lbias = (LAS float*)(wl + 4608);
    if (lat) {
#pragma unroll
        for (int i = 0; i < 4; ++i) { const int e = lane * 4 + i, krr = e >> 5, dc = e & 31; lbias[e] = bh[(r0 + krr - gi + 7) * 31 + min(dc, 30)] * LOG2E; }
        asm volatile("s_waitcnt vmcnt(0) lgkmcnt(0)" ::: "memory"); __builtin_amdgcn_wave_barrier();
    }
#define NA_TROW(t_) ((lat && (t_) < 16) ? (b * 4096 + (r0 + ((t_) >> 1)) * 64 + ((t_) & 1) * 32) : (NLAT + b * 256 + (lat ? (t_) - 16 : (t_)) * 32))
#define NA_LOAD(KF, VV, t_) do { const int kr0_ = NA_TROW(t_); const bf16_t* kp_ = PMIX + (size_t)(kr0_ + q) * NMIXP + O_NAK + h * 64 + hi * 8; \
        _Pragma("unroll") for (int ks = 0; ks < 4; ++ks) KF[ks] = *reinterpret_cast<const bf16x8*>(kp_ + ks * 16); \
        const bf16_t* vp_ = PMIX + (size_t)(kr0_ + (lane >> 1)) * NMIXP + O_NAV + h * 64 + (lane & 1) * 32; \
        _Pragma("unroll") for (int c = 0; c < 4; ++c) VV[c] = *reinterpret_cast<const u32x4*>(vp_ + c * 8); } while (0)
#define NA_TILE(KF, VV, t) do { \
        const bool local = lat && (t) < 16; const int kr = (t) >> 1, kblk = (t) & 1; \
        f32x16 p = {}; \
        _Pragma("unroll") for (int ks = 0; ks < 4; ++ks) p = __builtin_amdgcn_mfma_f32_32x32x16_bf16(KF[ks], qf[ks], p, 0, 0, 0); \
        _Pragma("unroll") for (int c = 0; c < 4; ++c) *(LAS u32x4*)(wl + (lane >> 1) * 144 + (lane & 1) * 64 + c * 16) = VV[c]; \
        if ((t) + 2 < ntiles) NA_LOAD(KF, VV, (t) + 2); \
        if (local) { \
            const LAS float* brow = lbias + kr * 32; \
            _Pragma("unroll") for (int r8 = 0; r8 < 16; r8 += 4) { float bv8[4]; \
                _Pragma("unroll") for (int r = 0; r < 4; ++r) { const int kc = kblk * 32 + crow(r8 + r, hi); bv8[r] = brow[min(max(kc - j + 15, 0), 30)]; } \
                _Pragma("unroll") for (int r = 0; r < 4; ++r) asm volatile("" : "+v"(bv8[r]));     \
                _Pragma("unroll") for (int r = 0; r < 4; ++r) { const int kc = kblk * 32 + crow(r8 + r, hi); const bool valid = (kc >= c0) && (kc < c0 + 16); p[r8 + r] = valid ? p[r8 + r] + bv8[r] : -INFINITY; } } \
        } \
        float tmax = p[0]; \
        _Pragma("unroll") for (int r = 1; r < 16; ++r) tmax = fmaxf(tmax, p[r]); \
        tmax = fmaxf(tmax, shx(tmax, lane, 32)); \
        const float mn = fmaxf(m, tmax), alpha = __builtin_amdgcn_exp2f(m - mn); m = mn; \
        float ps = 0.f; \
        _Pragma("unroll") for (int r = 0; r < 16; ++r) { p[r] = __builtin_amdgcn_exp2f(p[r] - mn); ps += p[r]; } \
        l = l * alpha + ps; \
        _Pragma("unroll") for (int r = 0; r < 16; ++r) { oT0[r] *= alpha; oT1[r] *= alpha; } \
        asm volatile("s_waitcnt lgkmcnt(0)" ::: "memory"); __builtin_amdgcn_wave_barrier(); \
        _Pragma("unroll") for (int ks = 0; ks < 2; ++ks) { \
            u32x4 pw; pw.x = cvt_pk(p[8 * ks + 0], p[8 * ks + 1]); pw.y = cvt_pk(p[8 * ks + 2], p[8 * ks + 3]); pw.z = cvt_pk(p[8 * ks + 4], p[8 * ks + 5]); pw.w = cvt_pk(p[8 * ks + 6], p[8 * ks + 7]); \
            const bf16x8 pf = *reinterpret_cast<bf16x8*>(&pw); \
            _Pragma("unroll") for (int db = 0; db < 2; ++db) { \
                bf16x8 vf; \
                _Pragma("unroll") for (int jj = 0; jj < 8; ++jj) { const int key = 16 * ks + 8 * (jj >> 2) + 4 * hi + (jj & 3); vf[jj] = *(const LAS short*)(wl + key * 144 + (32 * db + q) * 2); } \
                if (db == 0) oT0 = __builtin_amdgcn_mfma_f32_32x32x16_bf16(vf, pf, oT0, 0, 0, 0); \
                else oT1 = __builtin_amdgcn_mfma_f32_32x32x16_bf16(vf, pf, oT1, 0, 0, 0); \
            } \
        } \
        asm volatile("s_waitcnt lgkmcnt(0)" ::: "memory"); __builtin_amdgcn_wave_barrier(); \
    } while (0)
    bf16x8 kfa[4], kfb[4]; u32x4 vva[4], vvb[4];
    NA_LOAD(kfa, vva, 0); NA_LOAD(kfb, vvb, 1);
    for (int t0 = 0; t0 < ntiles; t0 += 2) {
        NA_TILE(kfa, vva, t0);
        NA_TILE(kfb, vvb, t0 + 1);
    }
#undef NA_TILE
#undef NA_TROW
#undef NA_LOAD
    const float inv = __builtin_amdgcn_rcpf(l + shx(l, lane, 32));
    const size_t ob = (size_t)qrow * 3072 + 1024 + h * 64;
#pragma unroll
    for (int db = 0; db < 2; ++db)
#pragma unroll
        for (int g = 0; g < 4; ++g) {
            const int d = 32 * db + 8 * g + 4 * hi;
            const u32x2 gw = *reinterpret_cast<const u32x2*>(GP + ob + d);
            float v0, v1, v2, v3;
            if (db == 0) { v0 = oT0[4 * g]; v1 = oT0[4 * g + 1]; v2 = oT0[4 * g + 2]; v3 = oT0[4 * g + 3]; } else { v0 = oT1[4 * g]; v1 = oT1[4 * g + 1]; v2 = oT1[4 * g + 2]; v3 = oT1[4 * g + 3]; }
            u32x2 w; w.x = cvt_pk(v0 * inv * bflo(gw.x), v1 * inv * bfhi(gw.x)); w.y = cvt_pk(v2 * inv * bflo(gw.y), v3 * inv * bfhi(gw.y));
            *reinterpret_cast<u32x2*>(O + ob + d) = w;
        }
}

__device__ __forceinline__ void lru_gate_phase(const bf16_t* __restrict__ PMIX, const bf16_t* __restrict__ WG, const float* __restrict__ convw, const float* __restrict__ convb,
                                               const float* __restrict__ bg, const float* __restrict__ lam, float* __restrict__ LA, float* __restrict__ LU, int bid, int G, LAS unsigned char* lds) {
    const int tid = opaque_v(threadIdx.x), lane = tid & 63, wid = tid >> 6;
    LAS float* xcf = (LAS float*)lds;
    LAS unsigned char* xcb = lds + 64 * 68 * 4;
    const int tl_s = tid >> 3, cg8 = (tid & 7) * 8;
    const int dir = wid >> 2, th = (wid >> 1) & 1, chh = wid & 1, q = lane & 31, hi = lane >> 5, cl = 32 * chh + q;
    int cur_blk = -1;
    f32x4 cw[4][2], cb0, cb1; bf16x8 br[4], bi[4]; float brv = 0.f, biv = 0.f, sp = 0.f;
    for (int item = bid; item < (MROWS / 64) * 16; item += G) {
        const int tt = item >> 4, blk = item & 15, row0 = tt * 64;
        if (blk != cur_blk) {
            cur_blk = blk;
            const int chs = blk * 64 + cg8;
            cb0 = *(const f32x4*)(convb + chs); cb1 = *(const f32x4*)(convb + chs + 4);
#pragma unroll
            for (int tap = 0; tap < 4; ++tap) { cw[tap][0] = *(const f32x4*)(convw + tap * 1024 + chs); cw[tap][1] = *(const f32x4*)(convw + tap * 1024 + chs + 4); }
            const bf16_t* wt = WG + (size_t)(dir * 16 + blk) * 128 * 64;
#pragma unroll
            for (int ks = 0; ks < 4; ++ks) { br[ks] = *reinterpret_cast<const bf16x8*>(wt + (size_t)cl * 64 + 16 * ks + 8 * hi); bi[ks] = *reinterpret_cast<const bf16x8*>(wt + (size_t)(64 + cl) * 64 + 16 * ks + 8 * hi); }
            brv = bg[dir * 2048 + blk * 128 + cl]; biv = bg[dir * 2048 + blk * 128 + 64 + cl];
            const float xs = __expf(-lam[dir * 1024 + blk * 64 + cl]);
            sp = xs < 0.05f ? xs * (1.f - xs * (0.5f - xs * ((1.f / 3.f) - xs * (0.25f - xs * 0.2f)))) : __logf(1.f + xs);
        }
        const int seg0 = row0 < NLAT ? (row0 & ~4095) : (NLAT + ((row0 - NLAT) & ~255)), seg1 = seg0 + (row0 < NLAT ? 4096 : 256);
        {
            const int row = row0 + tl_s, chs = blk * 64 + cg8;
            f32x4 x0 = cb0, x1 = cb1;
            u32x4 pv4[4];
#pragma unroll
            for (int tap = 0; tap < 4; ++tap) { const int rr = min(max(row + tap - 2, seg0), seg1 - 1); pv4[tap] = *(const u32x4*)(PMIX + (size_t)rr * NMIXP + O_PX + chs); }
#pragma unroll
            for (int tap = 0; tap < 4; ++tap) {
                const int rr = row + tap - 2; const float ok = (rr >= seg0 && rr < seg1) ? 1.f : 0.f; const u32x4 pv = pv4[tap];
                x0 += (cw[tap][0] * ok) * (f32x4){bflo(pv.x), bfhi(pv.x), bflo(pv.y), bfhi(pv.y)};
                x1 += (cw[tap][1] * ok) * (f32x4){bflo(pv.z), bfhi(pv.z), bflo(pv.w), bfhi(pv.w)};
            }
            *(LAS f32x4*)(xcf + tl_s * 68 + cg8) = x0; *(LAS f32x4*)(xcf + tl_s * 68 + cg8 + 4) = x1;
            *(LAS u32x4*)(xcb + tl_s * 144 + cg8 * 2) = pack8(x0, x1);
        }
        __syncthreads();
        {
            const int ch = blk * 64 + cl;
            f32x16 accR = {}, accI = {};
#pragma unroll
            for (int ks = 0; ks < 4; ++ks) {
                const bf16x8 af = *(const LAS bf16x8*)(xcb + (32 * th + q) * 144 + (16 * ks + 8 * hi) * 2);
                accR = __builtin_amdgcn_mfma_f32_32x32x16_bf16(af, br[ks], accR, 0, 0, 0);
                accI = __builtin_amdgcn_mfma_f32_32x32x16_bf16(af, bi[ks], accI, 0, 0, 0);
            }
#pragma unroll
            for (int r = 0; r < 16; ++r) {
                const int tl = 32 * th + crow(r, hi);
                const float rg = sigmoidf_(accR[r] + brv), ig = sigmoidf_(accI[r] + biv);
                const float log_a = -8.f * rg * sp, ym = -2.f * log_a, y1 = -log_a;
                const float om = ym < 0.1f ? ym * (1.f - ym * (0.5f - ym * ((1.f / 6.f) - ym * ((1.f / 24.f) - ym * (1.f / 120.f))))) : 1.f - __expf(-ym);
                const float oma = y1 < 0.1f ? y1 * (1.f - y1 * (0.5f - y1 * ((1.f / 6.f) - y1 * ((1.f / 24.f) - y1 * (1.f / 120.f))))) : 1.f - __expf(-y1);
                const float u = __builtin_sqrtf(fmaxf(om, 0.f)) * (ig * xcf[tl * 68 + cl]);
                const size_t idx = ((size_t)dir * MROWS + row0 + tl) * 1024 + ch;
                ((unsigned*)LA)[idx] = cvt_pk(oma, u);
            }
        }
        __syncthreads();
    }
}
__device__ __forceinline__ int chunk_row0(int b, int c) { return c < 4 ? NLAT + b * 256 + c * 64 : b * 4096 + (c - 4) * 64; }
__device__ __forceinline__ void lru_pass1_item(const float* __restrict__ LA, const float* __restrict__ LU, float* __restrict__ AGG, int item) {
    const int g = item * 512 + opaque_v(threadIdx.x), ch = (g & 255) * 4, dir = (g >> 8) & 1, bc = g >> 9, c = bc % NCHUNK, b = bc / NCHUNK;
    const int row0 = chunk_row0(b, c);
    const unsigned* ap = (const unsigned*)LA + ((size_t)dir * MROWS + row0) * 1024 + ch; (void)LU;
    f32x4 A = {1.f, 1.f, 1.f, 1.f}, H = {0.f, 0.f, 0.f, 0.f};
#pragma unroll 8
    for (int t = 0; t < 64; ++t) { const int tt = dir ? 63 - t : t; const u32x4 w = *(const u32x4*)(ap + (size_t)tt * 1024);
        const f32x4 a = {1.f - bflo(w.x), 1.f - bflo(w.y), 1.f - bflo(w.z), 1.f - bflo(w.w)}, u = {bfhi(w.x), bfhi(w.y), bfhi(w.z), bfhi(w.w)}; A *= a; H = a * H + u; }
    float* o = AGG + (((size_t)(dir * NB + b) * NCHUNK + c) * 1024 + ch) * 2;
    *(f32x4*)o = (f32x4){A[0], H[0], A[1], H[1]}; *(f32x4*)(o + 4) = (f32x4){A[2], H[2], A[3], H[3]};
}
__device__ __forceinline__ void lru_pass3_item(const float* __restrict__ LA, const float* __restrict__ LU, const float* __restrict__ AGG, const bf16_t* __restrict__ GP, bf16_t* __restrict__ O, int item, LAS unsigned char* lds) {
    const int tid = opaque_v(threadIdx.x);
    const int cg = item & 7, bc = item >> 3, c = bc % NCHUNK, b = bc / NCHUNK, row0 = chunk_row0(b, c), ch0 = cg * 128;
    LAS unsigned* S = (LAS unsigned*)lds;
    LAS float* CX = (LAS float*)(lds + 65536);
    {
        u32x4 tv[8];
#pragma unroll
        for (int p = 0; p < 8; ++p) { const int e = p * 512 + tid, arr = e >> 11, rem = e & 2047, tok = rem >> 5, c4 = rem & 31;
            tv[p] = *(const u32x4*)((const unsigned*)LA + ((size_t)arr * MROWS + row0 + tok) * 1024 + ch0 + c4 * 4); }
#pragma unroll
        for (int p = 0; p < 8; ++p) { const int e = p * 512 + tid, arr = e >> 11, rem = e & 2047, tok = rem >> 5, c4 = rem & 31;
            *(LAS u32x4*)(S + (arr * 64 + tok) * 128 + c4 * 4) = tv[p]; }
    }
    const int dir = (tid >> 7) & 1, ch = tid & 127, half = tid >> 8;
    float cA = 1.f, cH = 0.f;
    {
        const float* ag = AGG + ((size_t)(dir * NB + b) * NCHUNK * 1024 + ch0 + ch) * 2;
        const int n = dir == 0 ? c : (c < 4 ? 3 - c : 4 + (NCHUNK - 1 - c));
        const int k0 = half ? (n >> 1) : 0, k1 = half ? n : (n >> 1);
#pragma unroll 8
        for (int k = k0; k < k1; ++k) { const int cc = dir == 0 ? k : ((c < 4 || k < 4) ? 3 - k : NCHUNK - 1 - (k - 4));
            const f32x2_t q_ = *(const f32x2_t*)(ag + (size_t)cc * 2048); cA *= q_[0]; cH = q_[0] * cH + q_[1]; }
    }
    if (half) { CX[(tid - 256) * 2] = cA; CX[(tid - 256) * 2 + 1] = cH; }
    __syncthreads();
    if (tid < 256) {
        float h = CX[tid * 2] * cH + CX[tid * 2 + 1];
        LAS unsigned* su = S + dir * 64 * 128 + ch;
#pragma unroll 8
        for (int t = 0; t < 64; ++t) { const int tt = dir ? 63 - t : t; const unsigned w = su[tt * 128]; h = (1.f - bflo(w)) * h + bfhi(w); su[tt * 128] = __float_as_uint(h); }
    }
    __syncthreads();
#pragma unroll
    for (int p = 0; p < 4; ++p) { const int e = p * 512 + tid, tok = e >> 5, c4 = e & 31;
        const f32x4 hf = *(const LAS f32x4*)(S + (0 * 64 + tok) * 128 + c4 * 4), hb = *(const LAS f32x4*)(S + (1 * 64 + tok) * 128 + c4 * 4);
        const size_t oi = (size_t)(row0 + tok) * 3072 + 2048 + ch0 + c4 * 4; const u32x2 gw = *(const u32x2*)(GP + oi);
        u32x2 w; w.x = cvt_pk((hf[0] + hb[0]) * bflo(gw.x), (hf[1] + hb[1]) * bfhi(gw.x)); w.y = cvt_pk((hf[2] + hb[2]) * bflo(gw.y), (hf[3] + hb[3]) * bfhi(gw.y));
        *(u32x2*)(O + oi) = w; }
    __syncthreads();
}

__device__ __forceinline__ void transpose_item(const float* __restrict__ W, int ld_src, int k0, int n0src, const float* __restrict__ kscale, bf16_t* __restrict__ WT, int ldt, int n0dst, LAS float* scr, int lane) {
#pragma unroll 8
    for (int i = 0; i < 32; ++i) { const int kk = 2 * i + (lane >> 5); float v = W[(size_t)(k0 + kk) * ld_src + n0src + (lane & 31)]; if (kscale) v *= kscale[k0 + kk]; scr[kk * 33 + (lane & 31)] = v; }
    asm volatile("s_waitcnt lgkmcnt(0)" ::: "memory"); __builtin_amdgcn_wave_barrier();
    const int c = lane & 7;
#pragma unroll
    for (int jn = 0; jn < 4; ++jn) { const int n = (lane >> 3) + 8 * jn; const LAS float* s = scr + (8 * c) * 33 + n;
        u32x4 o; o.x = cvt_pk(s[0 * 33], s[1 * 33]); o.y = cvt_pk(s[2 * 33], s[3 * 33]); o.z = cvt_pk(s[4 * 33], s[5 * 33]); o.w = cvt_pk(s[6 * 33], s[7 * 33]);
        *(u32x4*)(WT + (size_t)(n0dst + n) * ldt + k0 + 8 * c) = o; }
    asm volatile("s_waitcnt lgkmcnt(0)" ::: "memory"); __builtin_amdgcn_wave_barrier();
}


#define XB_TMO      128
#define XB_XCNT(j)  (256  + 64 * (j))
#define XB_XSUB(j)  (1280 + 64 * (j))
#define XB_XGEN(j)  (2304 + 64 * (j))
#define XB_TOP      3328
#define XB_TOPGEN   3392
#define XCD_BAR_WORDS 3456
#define XB_SPIN_CAP (1u << 22)
__device__ __forceinline__ unsigned xb_ld(unsigned* p)              { return __hip_atomic_load(p, __ATOMIC_RELAXED, __HIP_MEMORY_SCOPE_AGENT); }
__device__ __forceinline__ unsigned xb_add(unsigned* p, unsigned v) { return __hip_atomic_fetch_add(p, v, __ATOMIC_RELAXED, __HIP_MEMORY_SCOPE_AGENT); }
__device__ __forceinline__ unsigned xb_xcc_id() { return (unsigned)__builtin_amdgcn_s_getreg((3 << 11) | 20) & 0xFu; }
#define XB_SPIN(cond, bar) do { unsigned _sp = 0; while (cond) { __builtin_amdgcn_s_sleep(1); \
    if ((++_sp & 255u) == 0u) { if (xb_ld(&(bar)[XB_TMO])) break; if (_sp > XB_SPIN_CAP) { atomicAdd(&(bar)[XB_TMO], 1u); break; } } } } while (0)
struct XcdBarrier { unsigned* bar; unsigned x; volatile LAS unsigned* st; };
__device__ __forceinline__ XcdBarrier xcd_barrier_post(unsigned* bar, volatile LAS unsigned* st) {
    XcdBarrier b; b.bar = bar; b.x = xb_xcc_id(); b.st = st;
    if (threadIdx.x == 0) (void)xb_add(&bar[XB_XCNT(b.x)], 1u);
    return b;
}
__device__ __forceinline__ void xcd_barrier_complete(unsigned* bar, unsigned x, unsigned& nloc, unsigned& nx) {
    const unsigned G = gridDim.x * gridDim.y * gridDim.z;
    unsigned sum, cnt, mine, sp = 0u;
    for (;;) {
        sum = 0u; cnt = 0u; mine = 0u;
#pragma unroll
        for (unsigned j = 0; j < 16; ++j) { const unsigned c = xb_ld(&bar[XB_XCNT(j)]); sum += c; cnt += (c > 0u) ? 1u : 0u; mine = (j == x) ? c : mine; }
        if (sum == G) break;
        __builtin_amdgcn_s_sleep(1);
        if ((++sp & 255u) == 0u) { if (xb_ld(&bar[XB_TMO])) break; if (sp > XB_SPIN_CAP) { atomicAdd(&bar[XB_TMO], 1u); break; } }
    }
    nloc = mine > 0u ? mine : 1u; nx = cnt > 0u ? cnt : 1u;
}
__device__ __forceinline__ void xcd_barrier(const XcdBarrier& b) {
    asm volatile("s_waitcnt vmcnt(0)" ::: "memory");
    __syncthreads();
    if (threadIdx.x == 0) {
        unsigned* bar = b.bar;
        __builtin_amdgcn_s_waitcnt(0);
        unsigned nloc = b.st[0], nx = b.st[1];
        if (nloc == 0u) { xcd_barrier_complete(bar, b.x, nloc, nx); b.st[0] = nloc; b.st[1] = nx; }
        const unsigned old = xb_add(&bar[XB_XSUB(b.x)], 1u);
        const unsigned gen = old / nloc;
        if (old + 1u == (gen + 1u) * nloc) {
            __builtin_amdgcn_fence(__ATOMIC_RELEASE, "agent");
            asm volatile("s_waitcnt vmcnt(0)" ::: "memory");
            const unsigned og = xb_add(&bar[XB_TOP], 1u);
            const unsigned tg = og / nx;
            if (og + 1u == (tg + 1u) * nx) xb_add(&bar[XB_TOPGEN], 1u);
            else XB_SPIN(xb_ld(&bar[XB_TOPGEN]) == tg, bar);
            __builtin_amdgcn_fence(__ATOMIC_ACQUIRE, "agent");
            xb_add(&bar[XB_XGEN(b.x)], 1u);
            asm volatile("s_waitcnt vmcnt(0)" ::: "memory");
        } else {
            XB_SPIN(xb_ld(&bar[XB_XGEN(b.x)]) == gen, bar);
            __builtin_amdgcn_fence(__ATOMIC_ACQUIRE, "agent");
            asm volatile("s_waitcnt vmcnt(0)" ::: "memory");
        }
    }
    __syncthreads();
}
#define GRID_SYNC() do { asm volatile("s_waitcnt vmcnt(0) lgkmcnt(0)" ::: "memory"); grid.sync(); \
    if (threadIdx.x < 64) asm volatile("buffer_inv sc1\n\ts_waitcnt vmcnt(0)" ::: "memory"); __syncthreads(); } while (0)
__device__ __forceinline__ unsigned char* opaque_p(unsigned char* p) { asm volatile("" : "+s"(p)); return p; }
__device__ __forceinline__ int opaque_s(int x) { asm volatile("" : "+s"(x)); return x; }
#define x_in (args.in[0])
#define c_in (args.in[1])
#define ctx_in (args.in[2])
#define cctx_in (args.in[3])
#define ada_w (args.in[4])
#define ada_b (args.in[5])
#define norm_g (args.in[6])
#define w_in (args.in[7])
#define qng (args.in[8])
#define kvng (args.in[9])
#define w_uq (args.in[10])
#define w_ukv (args.in[11])
#define rel_bias (args.in[12])
#define conv_w (args.in[13])
#define conv_b (args.in[14])
#define w_gate (args.in[15])
#define b_gate (args.in[16])
#define lam_in (args.in[17])
#define w_branch (args.in[18])
#define w_out (args.in[19])
#define fng (args.in[20])
#define WIN ((bf16_t*)(ws + WS_WIN))
#define WUQ ((bf16_t*)(ws + WS_WUQ))
#define WUKV ((bf16_t*)(ws + WS_WUKV))
#define WBR ((bf16_t*)(ws + WS_WBR))
#define WOUT ((bf16_t*)(ws + WS_WOUT))
#define WG ((bf16_t*)(ws + WS_WG))
#define MOD ((float*)(ws + WS_MOD))
#define ROPE ((float*)(ws + WS_ROPE))
#define XCUR ((float*)(ws + WS_XCUR))
#define HB ((bf16_t*)(ws + WS_H))
#define PMIX ((bf16_t*)(ws + WS_PMIX))
#define GP ((bf16_t*)(ws + WS_GP))
#define MG ((bf16_t*)(ws + WS_MG))
#define RSQ ((float*)(ws + WS_RSQ))
#define QB ((bf16_t*)(ws + WS_Q))
#define KVB ((bf16_t*)(ws + WS_KV))
#define KRB ((bf16_t*)(ws + WS_KR))
#define LA ((float*)(ws + WS_LA))
#define LU ((float*)(ws + WS_LU))
#define AGG ((float*)(ws + WS_AGG))
#define OB ((bf16_t*)(ws + WS_O))
#define MTMP LA
__global__ void __launch_bounds__(512, 2) mk_fwd(Args args) {
    extern __shared__ __attribute__((aligned(16))) unsigned char lds_raw[];
    cg::grid_group grid = cg::this_grid();
    LAS unsigned char* lds = (LAS unsigned char*)lds_raw;
    volatile LAS unsigned* xb_st = (volatile LAS unsigned*)(lds + LDS_BYTES - 64);
    if (threadIdx.x == 0) { xb_st[0] = 0u; xb_st[1] = 0u; }
    __syncthreads();
    (void)xcd_barrier_post((unsigned*)(args.ws + WS_BAR), xb_st);
#define XSYNC() do { XcdBarrier b_; b_.bar = (unsigned*)(args.ws + WS_BAR); b_.x = xb_xcc_id(); b_.st = (volatile LAS unsigned*)(lds + LDS_BYTES - 64); xcd_barrier(b_); } while (0)
#define PHASE_IDS const int tid = opaque_v(threadIdx.x), lane = tid & 63, wid = __builtin_amdgcn_readfirstlane(tid >> 6), G = opaque_s(gridDim.x), bid = opaque_s(blockIdx.x), NGW = G * 8, gw = bid * 8 + wid; unsigned char* ws = args.ws + (size_t)(unsigned)opaque_s(0); (void)lane; (void)gw; (void)NGW; (void)ws; (void)tid;

    {
        PHASE_IDS
        LAS float* scr = (LAS float*)(lds + wid * 8448);
        constexpr int I_IN = 32 * 442, I_UQ = 8 * 48, I_UKV = 4 * 64, I_BR = 3 * 16 * 64, I_OUT = 32 * 64, I_G = 32 * 4, I_L = I_IN + I_UQ + I_UKV + I_BR + I_OUT + I_G;
        for (int it = gw; it < DEPTH * I_L; it += NGW) {
            const int L = it / I_L; int r = it - L * I_L;
            if (r < I_IN) { const int kb = r / 442, nb = r % 442, n0 = nb * 32;
                transpose_item(w_in + (size_t)L * DM * NIN, NIN, kb * 64, n0, nullptr, WIN + (size_t)L * NINP * DM, DM, n0 < NMIX ? n0 : n0 + (NMIXP - NMIX), scr, lane); continue; } r -= I_IN;
            if (r < I_UQ) { const int kb = r / 48, nb = r % 48;
                transpose_item(w_uq + (size_t)L * 512 * 1536, 1536, kb * 64, nb * 32, qng + L * 512, WUQ + (size_t)L * 1536 * 512, 512, nb * 32, scr, lane); continue; } r -= I_UQ;
            if (r < I_UKV) { const int kb = r / 64, nb = r % 64;
                transpose_item(w_ukv + (size_t)L * 256 * 2048, 2048, kb * 64, nb * 32, kvng + L * 256, WUKV + (size_t)L * 2048 * 256, 256, nb * 32, scr, lane); continue; } r -= I_UKV;
            if (r < I_BR) { const int n3 = r / 1024, rr = r % 1024, kb = rr / 64, nb = rr % 64;
                transpose_item(w_branch + ((size_t)L * 3 + n3) * 1024 * 2048, 2048, kb * 64, nb * 32, nullptr, WBR + ((size_t)L * 3 + n3) * 2048 * 1024, 1024, nb * 32, scr, lane); continue; } r -= I_BR;
            if (r < I_OUT) { const int kb = r / 64, nb = r % 64;
                transpose_item(w_out + (size_t)L * DM * DM, DM, kb * 64, nb * 32, nullptr, WOUT + (size_t)L * DM * DM, DM, nb * 32, scr, lane); continue; } r -= I_OUT;
            { const int db = r / 4, nb = r % 4;
              transpose_item(w_gate + ((size_t)L * 32 + db) * 64 * 128, 128, 0, nb * 32, nullptr, WG + ((size_t)L * 32 + db) * 128 * 64, 64, nb * 32, scr, lane); }
        }
        for (int i = bid * 512 + tid; i < DEPTH * (NMIXP - NMIX) * (DM / 8); i += G * 512) {
            const int L = i / ((NMIXP - NMIX) * (DM / 8)), r = i % ((NMIXP - NMIX) * (DM / 8));
            *(u32x4*)(WIN + ((size_t)L * NINP + NMIX) * DM + (size_t)r * 8) = (u32x4){0u, 0u, 0u, 0u};
        }
        __syncthreads();
        LAS float* sil = (LAS float*)(lds + 69632);
        LAS float* red = (LAS float*)(lds + 69632 + 40960);
        for (int i = tid; i < 5 * 2048; i += 512) { const float v = i < 4 * 2048 ? c_in[i] : cctx_in[i - 4 * 2048]; sil[i] = v * (1.f / (1.f + expf(-v))); }
        __syncthreads();
        for (int it = bid; it < DEPTH * 96; it += G) {
            const int L = it / 96, cb = it % 96, ksl = tid >> 6, col = cb * 64 + (tid & 63);
            float a5[5] = {0.f, 0.f, 0.f, 0.f, 0.f};
            const float* wp = ada_w + (size_t)L * DM * 6144 + col;
            for (int k = ksl * 256; k < ksl * 256 + 256; ++k) { const float w = wp[(size_t)k * 6144];
#pragma unroll
                for (int r = 0; r < 5; ++r) a5[r] += sil[r * 2048 + k] * w; }
#pragma unroll
            for (int r = 0; r < 5; ++r) red[(ksl * 5 + r) * 64 + (tid & 63)] = a5[r];
            __syncthreads();
            if (tid < 320) { const int r = tid >> 6, cc = tid & 63; float s = 0.f;
#pragma unroll
                for (int k = 0; k < 8; ++k) s += red[(k * 5 + r) * 64 + cc];
                MOD[((size_t)L * 5 + r) * 6144 + cb * 64 + cc] = s + ada_b[(size_t)L * 6144 + cb * 64 + cc]; }
            __syncthreads();
        }
        if (bid == G - 1) for (int i = tid; i < 1024; i += 512) { const int pos = i >> 4, k = i & 15;
            const float inv = 1.0f / powf(10000.f, (float)k * (1.f / 16.f)), ang = (float)pos * inv; ROPE[2 * i] = cosf(ang); ROPE[2 * i + 1] = sinf(ang); }
    }
    GRID_SYNC();

    for (int layer = 0; layer < DEPTH; ++layer) {
        const bool need_ctx = layer < DEPTH - 1;
        { PHASE_IDS
        for (int row = gw; row < MROWS; row += NGW) {
            const bool lat = row < NLAT;
            const float* src = (layer == 0) ? (lat ? x_in + (size_t)row * DM : ctx_in + (size_t)(row - NLAT) * DM) : XCUR + (size_t)row * DM;
            const float* mr = MOD + (size_t)layer * 5 * 6144 + (size_t)(lat ? (row >> 12) : 4) * 6144;
            f32x4 v[8]; float ss = 0.f;
#pragma unroll
            for (int jv = 0; jv < 8; ++jv) { v[jv] = *(const f32x4*)(src + 4 * (lane + 64 * jv)); ss += (v[jv][0] * v[jv][0] + v[jv][1] * v[jv][1]) + (v[jv][2] * v[jv][2] + v[jv][3] * v[jv][3]); }
            const float rinv = rsqrtf(wave_sum(ss, lane) * (1.f / DM) + EPS);
#pragma unroll
            for (int jv = 0; jv < 8; ++jv) { const int col = 4 * (lane + 64 * jv);
                const f32x4 gg = *(const f32x4*)(norm_g + layer * DM + col), sh = *(const f32x4*)(mr + col), sc = *(const f32x4*)(mr + 2048 + col);
                const f32x4 hh = (v[jv] * rinv * gg) * (sc + 1.f) + sh;
                u32x2 w; w.x = cvt_pk(hh[0], hh[1]); w.y = cvt_pk(hh[2], hh[3]); *(u32x2*)(HB + (size_t)row * DM + col) = w; }
        } }
        XSYNC();
        {
            PHASE_IDS
            pg8::Gemm g{HB, WIN + (size_t)layer * NINP * DM, DM, DM, DM, 0, 0}; pg8::Sched S; S.init(MROWS, NINP, G, bid, 1);
            EpiIn E{PMIX, GP, MG, RSQ};
            pg8::gemm_phase<EpiIn>(lds, g, S, E);
        }
        XSYNC();
        {
            {
            PHASE_IDS
            { pg8::Gemm g{PMIX, WUQ + (size_t)layer * 1536 * 512, NMIXP, 512, 512, 0, 0}; pg8::Sched S; S.init(MROWS, 1536, G, bid, 1);
              EpiQ E{QB, RSQ, ROPE}; pg8::gemm_phase<EpiQ>(lds, g, S, E); }
            { pg8::Gemm g{PMIX + 512, WUKV + (size_t)layer * 2048 * 256, NMIXP, 256, 256, 0, 0}; pg8::Sched S; S.init(MROWS, 2048, G, bid, 1);
              EpiKV E{KVB, RSQ}; pg8::gemm_phase<EpiKV>(lds, g, S, E); }
            }
            {
            PHASE_IDS
            for (int i = bid * 512 + tid; i < MROWS * 4; i += G * 512) {
                const int row = i >> 2, hf = (i >> 1) & 1, sub = i & 1;
                const bf16_t* src = PMIX + (size_t)row * NMIXP + O_KR + 32 * hf + 8 * sub;
                u32x4 a = *(const u32x4*)src, b2 = *(const u32x4*)(src + 16);
                if (row < NLAT) {
                    const int s = row & 4095, pos = hf ? (s & 63) : (s >> 6);
                    const float* cp = ROPE + (pos * 16 + 8 * sub) * 2;
                    float x1[8] = {bflo(a.x), bfhi(a.x), bflo(a.y), bfhi(a.y), bflo(a.z), bfhi(a.z), bflo(a.w), bfhi(a.w)};
                    float x2[8] = {bflo(b2.x), bfhi(b2.x), bflo(b2.y), bfhi(b2.y), bflo(b2.z), bfhi(b2.z), bflo(b2.w), bfhi(b2.w)};
                    float o1[8], o2[8];
#pragma unroll
                    for (int e = 0; e < 8; ++e) { const float cv = cp[2 * e], sv = cp[2 * e + 1]; o1[e] = x1[e] * cv - x2[e] * sv; o2[e] = x1[e] * sv + x2[e] * cv; }
                    a.x = cvt_pk(o1[0], o1[1]); a.y = cvt_pk(o1[2], o1[3]); a.z = cvt_pk(o1[4], o1[5]); a.w = cvt_pk(o1[6], o1[7]);
                    b2.x = cvt_pk(o2[0], o2[1]); b2.y = cvt_pk(o2[2], o2[3]); b2.z = cvt_pk(o2[4], o2[5]); b2.w = cvt_pk(o2[6], o2[7]);
                }
                bf16_t* dst = KRB + (size_t)row * 64 + 32 * hf + 8 * sub;
                *(u32x4*)dst = a; *(u32x4*)(dst + 16) = b2;
            }
            __syncthreads();
            lru_gate_phase(PMIX, WG + (size_t)layer * 32 * 128 * 64, conv_w + (size_t)layer * 4 * 1024, conv_b + (size_t)layer * 1024, b_gate + (size_t)layer * 2 * 2048, lam_in + (size_t)layer * 2 * 1024, LA, LU, bid, G, lds);
            }
        }
        XSYNC();
        {
            PHASE_IDS
            const int nmla = 512 + (need_ctx ? 32 : 0);
            for (int u0 = bid; u0 < nmla; u0 += G) {
                int u = u0;
                if (G == 256 && u0 < 512) { const int x = bid & 7, i = bid >> 3, r = u0 >> 8; u = ((r * 16 + x * 2 + (i >> 4)) << 4) | (i & 15); }
                if (u < 512) { const int b = u >> 7, h = (u >> 4) & 7, qb = u & 15;
                    mla::attn_unit(QB, KVB, KRB, GP, OB, b * 4096 + qb * 256, h, b * 4096, NLAT + b * 256, 64, 68, (char*)lds_raw); }
                else { const int b = (u - 512) >> 3, h = (u - 512) & 7;
                    mla::attn_unit(QB, KVB, KRB, GP, OB, NLAT + b * 256, h, 0, NLAT + b * 256, 0, 4, (char*)lds_raw); }
            }
            __syncthreads();
            const int nna = 8192 + (need_ctx ? 512 : 0);
            for (int it = gw; it < nna; it += NGW) na_item(PMIX, GP, OB, rel_bias + (size_t)layer * 16 * 15 * 31, it, lane, lds + wid * 5632);
            for (int it = bid; it < (NB * NCHUNK * 2 * 256) / 512; it += G) lru_pass1_item(LA, LU, AGG, it);
        }
        XSYNC();
        { PHASE_IDS
        for (int it = bid; it < NB * NCHUNK * 8; it += G) lru_pass3_item(LA, LU, AGG, GP, OB, it, lds); }
        XSYNC();
        {
            PHASE_IDS
            const int Mrows = need_ctx ? MROWS : NLAT;
            const bool fuse_ctx = need_ctx && G == 256;
            unsigned* ctr = (unsigned*)(args.ws + WS_BAR) + 3600 + layer * 4;
            pg8::Gemm g{OB, WBR + (size_t)layer * 3 * 2048 * 1024, 3072, 1024, 1024, 1024, (size_t)2048 * 1024}; pg8::Sched S; S.init(Mrows, DM, G, bid, 3); S.rot = fuse_ctx ? 1 : 0;
            EpiMerge E{MG, MTMP, HB, fuse_ctx ? ctr : nullptr}; pg8::gemm_phase<EpiMerge>(lds, g, S, E);
            if (fuse_ctx && bid >= 96 && bid < 128) {
                pg8::Sched S2; S2.init(1024, DM, G, bid - 96, 1); S2.pm0 = 64;
                pg8::Unit u0; (void)S2.next(0, u0);
                if (threadIdx.x == 0) { unsigned sp = 0; while (__hip_atomic_load(ctr + (u0.pm - 64), __ATOMIC_RELAXED, __HIP_MEMORY_SCOPE_AGENT) < 8u && ++sp < (1u << 22)) __builtin_amdgcn_s_sleep(1);
                    __builtin_amdgcn_fence(__ATOMIC_ACQUIRE, "agent"); asm volatile("buffer_inv sc1\n\ts_waitcnt vmcnt(0)" ::: "memory"); }
                __syncthreads();
                pg8::Gemm g2{HB, WOUT + (size_t)layer * DM * DM, DM, DM, DM, 0, 0};
                EpiOut E2{x_in, ctx_in, XCUR, MOD + (size_t)layer * 5 * 6144, layer}; pg8::gemm_phase<EpiOut>(lds, g2, S2, E2);
            }
        }
        XSYNC();
        {
            PHASE_IDS
            const int Mrows = (need_ctx && G != 256) ? MROWS : NLAT;
            pg8::Gemm g{HB, WOUT + (size_t)layer * DM * DM, DM, DM, DM, 0, 0}; pg8::Sched S; S.init(Mrows, DM, G, bid, 1);
            EpiOut E{x_in, ctx_in, XCUR, MOD + (size_t)layer * 5 * 6144, layer}; pg8::gemm_phase<EpiOut>(lds, g, S, E);
        }
        XSYNC();
    }
    { PHASE_IDS
    for (int row = gw; row < NLAT; row += NGW) {
        const float* src = XCUR + (size_t)row * DM;
        f32x4 v[8]; float ss = 0.f;
#pragma unroll
        for (int jv = 0; jv < 8; ++jv) { v[jv] = *(const f32x4*)(src + 4 * (lane + 64 * jv)); ss += (v[jv][0] * v[jv][0] + v[jv][1] * v[jv][1]) + (v[jv][2] * v[jv][2] + v[jv][3] * v[jv][3]); }
        const float rinv = rsqrtf(wave_sum(ss, lane) * (1.f / DM) + EPS);
#pragma unroll
        for (int jv = 0; jv < 8; ++jv) { const int col = 4 * (lane + 64 * jv); *(f32x4*)(args.out + (size_t)row * DM + col) = v[jv] * rinv * *(const f32x4*)(fng + col); }
    } }
}

extern "C" void kernel_launch(void* const* d_in, const int* in_sizes, int n_in, void* d_out, int out_size, void* d_ws, size_t ws_size, hipStream_t stream) {
    static int grid = 0;
    if (grid == 0) {
        if (n_in != 21 || ws_size < WS_END) { fprintf(stderr, "kernel_launch: n_in %d ws %zu (need %zu): nothing launched\n", n_in, ws_size, (size_t)WS_END); grid = -1; return; }
        int dev = 0, cus = 0, per_cu = 0;
        if (hipGetDevice(&dev) != hipSuccess || hipDeviceGetAttribute(&cus, hipDeviceAttributeMultiprocessorCount, dev) != hipSuccess) { grid = -1; return; }
        if (hipFuncSetAttribute((const void*)mk_fwd, hipFuncAttributeMaxDynamicSharedMemorySize, LDS_BYTES) != hipSuccess) { fprintf(stderr, "hipFuncSetAttribute failed\n"); grid = -1; return; }
        if (hipOccupancyMaxActiveBlocksPerMultiprocessor(&per_cu, (const void*)mk_fwd, 512, LDS_BYTES) != hipSuccess || per_cu < 1) { fprintf(stderr, "occupancy query: %d\n", per_cu); per_cu = 1; }
        (void)hipGetLastError();
        grid = cus * per_cu;
    }
    if (grid < 0) return;
    if (hipMemsetAsync((char*)d_ws + WS_BAR, 0, 16384, stream) != hipSuccess) { fprintf(stderr, "memset of barrier words failed\n"); return; }
    Args a{};
    for (int i = 0; i < 21; ++i) a.in[i] = (const float*)d_in[i];
    a.out = (float*)d_out; a.ws = (unsigned char*)d_ws;
    void* kargs[] = {&a};
    hipError_t e = hipLaunchCooperativeKernel((const void*)mk_fwd, dim3(grid), dim3(512), kargs, LDS_BYTES, stream);
    if (e != hipSuccess) fprintf(stderr, "cooperative launch failed: %s (grid %d)\n", hipGetErrorString(e), grid);
}
```

```cpp
#include <hip/hip_runtime.h>
#include <hip/hip_cooperative_groups.h>
#include <cstdio>
#include <cstdint>
namespace cg = cooperative_groups;

typedef unsigned short bf16_t;
typedef short bf16x8 __attribute__((ext_vector_type(8)));
typedef float f32x4 __attribute__((ext_vector_type(4)));
typedef float f32x16 __attribute__((ext_vector_type(16)));
typedef unsigned u32x4 __attribute__((ext_vector_type(4)));
typedef unsigned u32x2 __attribute__((ext_vector_type(2)));
#define LAS __attribute__((address_space(3)))

constexpr int DM = 2048, NB = 4, SEQ = 4096, NCTXT = 256, DEPTH = 4;
constexpr int NLAT = NB * SEQ, NCTX = NB * NCTXT, MROWS = NLAT + NCTX;
constexpr int NMIX = 4928, NMIXP = 5120, NGP = 3072, NMG = 6144, NINP = NMIXP + NGP + NMG, NIN = 14144;
constexpr int O_KR = 768, O_NAQ = 832, O_NAK = 1856, O_NAV = 2880, O_PX = 3904;
constexpr float EPS = 1e-6f, LOG2E = 1.4426950408889634f;
constexpr float C_MLA = 0.07216878364870322f * LOG2E;
constexpr float C_NA = 0.125f * LOG2E;
constexpr int NCHUNK = 68;

constexpr size_t al256(size_t x) { return (x + 255) / 256 * 256; }
constexpr size_t WS_WIN = 0;
constexpr size_t WS_WUQ = WS_WIN + al256((size_t)DEPTH * NINP * DM * 2);
constexpr size_t WS_WUKV = WS_WUQ + al256((size_t)DEPTH * 1536 * 512 * 2);
constexpr size_t WS_WBR = WS_WUKV + al256((size_t)DEPTH * 2048 * 256 * 2);
constexpr size_t WS_WOUT = WS_WBR + al256((size_t)DEPTH * 3 * 2048 * 1024 * 2);
constexpr size_t WS_WG = WS_WOUT + al256((size_t)DEPTH * 2048 * 2048 * 2);
constexpr size_t WS_MOD = WS_WG + al256((size_t)DEPTH * 2 * 16 * 128 * 64 * 2);
constexpr size_t WS_ROPE = WS_MOD + al256((size_t)DEPTH * 5 * 6144 * 4);
constexpr size_t WS_XCUR = WS_ROPE + al256((size_t)64 * 16 * 2 * 4);
constexpr size_t WS_H = WS_XCUR + al256((size_t)MROWS * DM * 4);
constexpr size_t WS_PMIX = WS_H + al256((size_t)MROWS * DM * 2);
constexpr size_t WS_GP = WS_PMIX + al256((size_t)MROWS * NMIXP * 2);
constexpr size_t WS_MG = WS_GP + al256((size_t)MROWS * NGP * 2);
constexpr size_t WS_RSQ = WS_MG + al256((size_t)MROWS * NMG * 2);
constexpr size_t WS_Q = WS_RSQ + al256((size_t)MROWS * 12 * 4);
constexpr size_t WS_KV = WS_Q + al256((size_t)MROWS * 1536 * 2);
constexpr size_t WS_KR = WS_KV + al256((size_t)MROWS * 2048 * 2);
constexpr size_t WS_LA = WS_KR + al256((size_t)MROWS * 64 * 2);
constexpr size_t WS_LU = WS_LA + al256((size_t)2 * MROWS * 1024 * 4);
constexpr size_t WS_AGG = WS_LU + al256((size_t)2 * MROWS * 1024 * 4);
constexpr size_t WS_O = WS_AGG + al256((size_t)2 * NB * NCHUNK * 1024 * 2 * 4);
constexpr size_t WS_BAR = WS_O + al256((size_t)MROWS * 3072 * 2);
constexpr size_t WS_END = WS_BAR + 16384;

constexpr int LDS_BYTES = 147456;

struct Args { const float* in[21]; float* out; unsigned char* ws; };

typedef float f32x2_t __attribute__((ext_vector_type(2))); typedef __bf16 bf16x2_t __attribute__((ext_vector_type(2)));
__device__ __forceinline__ unsigned cvt_pk(float lo, float hi) { f32x2_t v = {lo, hi}; bf16x2_t b = __builtin_convertvector(v, bf16x2_t); return __builtin_bit_cast(unsigned, b); }
__device__ __forceinline__ float bflo(unsigned u) { return __uint_as_float(u << 16); }
__device__ __forceinline__ float bfhi(unsigned u) { return __uint_as_float(u & 0xffff0000u); }
__device__ __forceinline__ float bf1(bf16_t u) { return __uint_as_float(((unsigned)u) << 16); }
__device__ __forceinline__ u32x4 pack8(f32x4 a, f32x4 b) { u32x4 w; w.x = cvt_pk(a[0], a[1]); w.y = cvt_pk(a[2], a[3]); w.z = cvt_pk(b[0], b[1]); w.w = cvt_pk(b[2], b[3]); return w; }
__device__ __forceinline__ float sigmoidf_(float x) { return __builtin_amdgcn_rcpf(1.f + __expf(-x)); }
__device__ __forceinline__ float shx(float v, int lane, int m) { return __int_as_float(__builtin_amdgcn_ds_bpermute((lane ^ m) << 2, __float_as_int(v))); }
__device__ __forceinline__ float wave_sum(float v, int lane) {
#pragma unroll
    for (int o = 1; o < 64; o <<= 1) v += shx(v, lane, o);
    return v;
}
__device__ __forceinline__ int opaque_v(int x) { asm volatile("" : "+v"(x)); return x; }
__device__ __forceinline__ int crow(int r, int hi) { return (r & 3) + 8 * (r >> 2) + 4 * hi; }

namespace pg8 {
constexpr int BM = 256, BK = 64, HALF = 128, HTB = HALF * BK * 2, NXCD = 8, WGM = 4;
__host__ __device__ __forceinline__ int lds_byte(int r, int c) { const int st = (r >> 4) * 2 + (c >> 5), rr = r & 15, cc = c & 31, ob = rr * 64 + cc * 2; return st * 1024 + (ob ^ (((ob >> 9) & 1) << 5)); }
__host__ __device__ __forceinline__ void stage_rc(int b, int& R, int& C) { const int st = b / 1024, sb = b % 1024, swz = sb ^ (((sb >> 9) & 1) << 5); R = (st >> 1) * 16 + swz / 64; C = (st & 1) * 32 + (swz % 64) / 2; }
__host__ __device__ __forceinline__ int perm32(int rho) { const int n = rho >> 4, i = rho & 15; return 8 * (i >> 2) + 4 * n + (i & 3); }

struct Unit { int pm, pn, z; };
struct Gemm { const bf16_t* A; const bf16_t* Bt; int lda, ldb, K; size_t azs, bzs; };

struct Sched {
    int nM, nN, nwg, G, c, nz, rot = 0, pm0 = 0;
    __device__ void init(int M, int N, int G_, int c_, int nz_) { nM = M / BM; nN = N / BM; nwg = nM * nN; G = G_; c = c_; nz = nz_; }
    __device__ bool next(int i, Unit& u) const {
        const int it = i / nz; u.z = i - it * nz;
        const long L = (long)it * G + c; if (L >= nwg) return false;
        int wgid = (int)L; { const int q = nwg / NXCD, r = nwg % NXCD, xcd = wgid % NXCD, off = wgid / NXCD; wgid = (xcd < r ? xcd * (q + 1) : r * (q + 1) + (xcd - r) * q) + off; }
        const int nig = WGM * nN, gid = wgid / nig, fm = gid * WGM, gsz = (nM - fm) < WGM ? (nM - fm) : WGM;
        u.pm = fm + ((wgid % nig) % gsz); u.pn = (wgid % nig) / gsz;
        if (rot) u.pm = (u.pm < 4) ? nM - 4 + u.pm : u.pm - 4;
        u.pm += pm0; return true;
    }
};

template <class Epi>
__device__ __forceinline__ void gemm_phase(LAS unsigned char* lds, const Gemm g, const Sched& S, const Epi& E) {
    const int tid = opaque_v(threadIdx.x), wid = __builtin_amdgcn_readfirstlane(tid >> 6), lane = tid & 63, wr = wid >> 2, wc = wid & 3, fr = lane & 15, fq = lane >> 4;
    const int K = g.K, nt = K / BK;
    unsigned voffA[2], voffB[2];
#pragma unroll
    for (int i = 0; i < 2; ++i) { int R, C; stage_rc(tid * 16 + i * 8192, R, C); const int Rb = (R & ~31) + perm32(R & 31);
        voffA[i] = (unsigned)(R * g.lda + C) * 2u; voffB[i] = (unsigned)(Rb * g.ldb + C) * 2u; }
    const size_t kstep = (size_t)(BK * 2);
    const size_t hstepA = (size_t)HALF * g.lda * 2, hstepB = (size_t)HALF * g.ldb * 2;
    const unsigned ldsw = (unsigned)wid * 1024u;
    const int aoff = lds_byte(wr * 64 + fr, fq * 8), boff = lds_byte(wc * 32 + fr, fq * 8);
#define PG8_SA(b, h) (((b) * 2 + (h)) * HTB)
#define PG8_SB(b, h) ((4 + (b) * 2 + (h)) * HTB)
#define PG8_STAGE(bufoff, gbase, voff) do { _Pragma("unroll") for (int _i = 0; _i < 2; ++_i) \
        __builtin_amdgcn_global_load_lds((const unsigned*)((const char*)(gbase) + (voff)[_i]), (LAS unsigned*)(lds + (bufoff) + ldsw + _i * 8192), 16, 0, 0); } while (0)
#define PG8_LDA(dst, b, h) do { _Pragma("unroll") for (int m = 0; m < 4; ++m) _Pragma("unroll") for (int k = 0; k < 2; ++k) dst[m][k] = *(const LAS bf16x8*)(lds + PG8_SA(b, h) + aoff + m * 2048 + k * 1024); } while (0)
#define PG8_LDB(dst, b, h) do { _Pragma("unroll") for (int n = 0; n < 2; ++n) _Pragma("unroll") for (int k = 0; k < 2; ++k) dst[n][k] = *(const LAS bf16x8*)(lds + PG8_SB(b, h) + boff + n * 2048 + k * 1024); } while (0)
#define PG8_MMA(ai, bj, At, Bt) do { __builtin_amdgcn_s_setprio(1); _Pragma("unroll") for (int m = 0; m < 4; ++m) _Pragma("unroll") for (int n = 0; n < 2; ++n) _Pragma("unroll") for (int k = 0; k < 2; ++k) \
        acc[ai][bj][m][n] = __builtin_amdgcn_mfma_f32_16x16x32_bf16(Bt[n][k], At[m][k], acc[ai][bj][m][n], 0, 0, 0); __builtin_amdgcn_s_setprio(0); } while (0)
#define PG8_WAIT_V(n) asm volatile("s_waitcnt vmcnt(" #n ")" ::: "memory")
#define PG8_WAIT_L(n) asm volatile("s_waitcnt lgkmcnt(" #n ")" ::: "memory")
#define PG8_BAR __builtin_amdgcn_s_barrier()
#define PG8_SCHED __builtin_amdgcn_sched_barrier(0)
    Unit cur, nxt; int ui = 0;
    if (!S.next(0, cur)) return;
    f32x4 acc[2][2][4][2];
#pragma unroll
    for (int a = 0; a < 2; ++a)
#pragma unroll
        for (int b = 0; b < 2; ++b)
#pragma unroll
            for (int m = 0; m < 4; ++m)
#pragma unroll
                for (int n = 0; n < 2; ++n) acc[a][b][m][n] = (f32x4){0.f, 0.f, 0.f, 0.f};
    bf16x8 At[4][2], B0[2][2], B1[2][2];
    const char* cA = (const char*)g.A + ((size_t)cur.z * g.azs + (size_t)cur.pm * BM * g.lda) * 2;
    const char* cB = (const char*)g.Bt + ((size_t)cur.z * g.bzs + (size_t)cur.pn * BM * g.ldb) * 2;
    PG8_STAGE(PG8_SB(0, 0), cB, voffB); PG8_STAGE(PG8_SB(0, 1), cB + hstepB, voffB); PG8_STAGE(PG8_SA(0, 0), cA, voffA); PG8_STAGE(PG8_SA(0, 1), cA + hstepA, voffA);
    if (wr == 1) PG8_BAR;
    PG8_WAIT_V(2); PG8_BAR;
    PG8_STAGE(PG8_SB(1, 0), cB + kstep, voffB); PG8_STAGE(PG8_SA(1, 0), cA + kstep, voffA); PG8_STAGE(PG8_SB(1, 1), cB + hstepB + kstep, voffB);
    PG8_WAIT_V(6); PG8_BAR;
    for (;;) {
        const bool has_next = S.next(ui + 1, nxt);
        const char* nA = has_next ? (const char*)g.A + ((size_t)nxt.z * g.azs + (size_t)nxt.pm * BM * g.lda) * 2 : cA;
        const char* nB = has_next ? (const char*)g.Bt + ((size_t)nxt.z * g.bzs + (size_t)nxt.pn * BM * g.ldb) * 2 : cB;
        for (int t = 0; t < nt; t += 2) {
            const bool last = (t == nt - 2);
            const char* a1 = cA + (size_t)(t + 1) * kstep;
            const char* a2 = last ? nA : cA + (size_t)(t + 2) * kstep; const char* b2 = last ? nB : cB + (size_t)(t + 2) * kstep;
            const char* a3 = a2 + kstep; const char* b3 = b2 + kstep;
            PG8_LDB(B0, 0, 0); PG8_LDB(B1, 0, 1); PG8_SCHED; PG8_LDA(At, 0, 0); PG8_STAGE(PG8_SA(1, 1), a1 + hstepA, voffA);
            PG8_WAIT_V(8); PG8_WAIT_L(0); PG8_BAR; PG8_MMA(0, 0, At, B0); PG8_MMA(0, 1, At, B1); PG8_BAR; PG8_SCHED;
            PG8_LDA(At, 0, 1); PG8_STAGE(PG8_SB(0, 0), b2, voffB); PG8_STAGE(PG8_SB(0, 1), b2 + hstepB, voffB); PG8_STAGE(PG8_SA(0, 0), a2, voffA);
            PG8_WAIT_V(8); PG8_WAIT_L(0); PG8_BAR; PG8_MMA(1, 0, At, B0); PG8_MMA(1, 1, At, B1); PG8_BAR; PG8_SCHED;
            PG8_LDB(B0, 1, 0); PG8_LDB(B1, 1, 1); PG8_SCHED; PG8_LDA(At, 1, 0); PG8_STAGE(PG8_SA(0, 1), a2 + hstepA, voffA);
            PG8_WAIT_V(8); PG8_WAIT_L(0); PG8_BAR; PG8_MMA(0, 0, At, B0); PG8_MMA(0, 1, At, B1); PG8_BAR; PG8_SCHED;
            PG8_LDA(At, 1, 1); PG8_STAGE(PG8_SB(1, 0), b3, voffB); PG8_STAGE(PG8_SB(1, 1), b3 + hstepB, voffB); PG8_STAGE(PG8_SA(1, 0), a3, voffA);
            PG8_WAIT_V(8); PG8_WAIT_L(0); PG8_BAR; PG8_MMA(1, 0, At, B0); PG8_MMA(1, 1, At, B1); PG8_BAR; PG8_SCHED;
        }
        if (wr == 0) PG8_BAR;
        { const int l2 = opaque_v(lane); E(acc, cur, wr, wc, l2 & 15, l2 >> 4); }
        if (!has_next) break;
#pragma unroll
        for (int a = 0; a < 2; ++a)
#pragma unroll
            for (int b = 0; b < 2; ++b)
#pragma unroll
                for (int m = 0; m < 4; ++m)
#pragma unroll
                    for (int n = 0; n < 2; ++n) acc[a][b][m][n] = (f32x4){0.f, 0.f, 0.f, 0.f};
        cur = nxt; cA = nA; cB = nB; ++ui;
        if (wr == 1) PG8_BAR;
    }
    PG8_WAIT_V(0);
    PG8_BAR;
#undef PG8_SA
#undef PG8_SB
#undef PG8_STAGE
#undef PG8_LDA
#undef PG8_LDB
#undef PG8_MMA
#undef PG8_WAIT_V
#undef PG8_WAIT_L
#undef PG8_BAR
#undef PG8_SCHED
}
}
typedef f32x4 AccT[2][2][4][2];
#define EPI_FENCE(a, b) asm volatile("" : "+v"(a), "+v"(b) :: "memory")

struct EpiIn {
    bf16_t* pmix; bf16_t* gp; bf16_t* mg; float* rsq;
    __device__ __forceinline__ void operator()(const AccT& acc, const pg8::Unit& u, int wr, int wc, int fr, int fq) const {
        const int row0 = u.pm * 256 + wr * 64 + fr, pn = u.pn;
        if (pn < 20) {
#pragma unroll
            for (int ai = 0; ai < 2; ++ai)
#pragma unroll
                for (int m = 0; m < 4; ++m) {
                    __builtin_amdgcn_sched_barrier(0); const int row = row0 + ai * 128 + m * 16; float ss = 0.f;
#pragma unroll
                    for (int bj = 0; bj < 2; ++bj) {
                        const int col0 = pn * 256 + bj * 128 + wc * 32 + 8 * fq;
                        f32x4 v0 = acc[ai][bj][m][0], v1 = acc[ai][bj][m][1]; EPI_FENCE(v0, v1);
                        ss += (v0[0] * v0[0] + v0[1] * v0[1]) + (v0[2] * v0[2] + v0[3] * v0[3]) + (v1[0] * v1[0] + v1[1] * v1[1]) + (v1[2] * v1[2] + v1[3] * v1[3]);
                        const float sc = (col0 >= O_NAQ && col0 < O_NAK) ? C_NA : 1.f;
                        *(u32x4*)(pmix + (size_t)row * NMIXP + col0) = pack8(v0 * sc, v1 * sc);
                    }
                    if (pn < 3) { ss += shx(ss, fr + 16 * fq, 16); ss += shx(ss, fr + 16 * fq, 32); if (fq == 0) rsq[(size_t)row * 12 + pn * 4 + wc] = ss; }
                }
        } else if (pn < 32) {
#pragma unroll
            for (int ai = 0; ai < 2; ++ai)
#pragma unroll
                for (int m = 0; m < 4; ++m) {
                    __builtin_amdgcn_sched_barrier(0); const int row = row0 + ai * 128 + m * 16;
#pragma unroll
                    for (int bj = 0; bj < 2; ++bj) {
                        const int col0 = (pn - 20) * 256 + bj * 128 + wc * 32 + 8 * fq;
                        f32x4 v0 = acc[ai][bj][m][0], v1 = acc[ai][bj][m][1]; EPI_FENCE(v0, v1);
#pragma unroll
                        for (int e = 0; e < 4; ++e) { v0[e] = v0[e] * sigmoidf_(v0[e]); v1[e] = v1[e] * sigmoidf_(v1[e]); }
                        *(u32x4*)(gp + (size_t)row * NGP + col0) = pack8(v0, v1);
                    }
                }
        } else {
#pragma unroll
            for (int ai = 0; ai < 2; ++ai)
#pragma unroll
                for (int m = 0; m < 4; ++m) {
                    __builtin_amdgcn_sched_barrier(0); const int row = row0 + ai * 128 + m * 16;
#pragma unroll
                    for (int bj = 0; bj < 2; ++bj) {
                        const int col0 = (pn - 32) * 256 + bj * 128 + wc * 32 + 8 * fq;
                        f32x4 v0 = acc[ai][bj][m][0], v1 = acc[ai][bj][m][1]; EPI_FENCE(v0, v1);
#pragma unroll
                        for (int e = 0; e < 4; ++e) { v0[e] = sigmoidf_(v0[e]); v1[e] = sigmoidf_(v1[e]); }
                        *(u32x4*)(mg + (size_t)row * NMG + col0) = pack8(v0, v1);
                    }
                }
        }
    }
};
struct EpiQ {
    bf16_t* q; const float* rsq; const float* cs;
    __device__ __forceinline__ void operator()(const AccT& acc, const pg8::Unit& u, int wr, int wc, int fr, int fq) const {
        const int row0 = u.pm * 256 + wr * 64 + fr, pn = u.pn; const bool lat = u.pm < 64;
#pragma unroll
        for (int ai = 0; ai < 2; ++ai) {
          float rinv4[4];
          { f32x4 ra[4], rb[4];
#pragma unroll
            for (int i = 0; i < 4; ++i) { const int row = row0 + ai * 128 + i * 16; ra[i] = *(const f32x4*)(rsq + (size_t)row * 12); rb[i] = *(const f32x4*)(rsq + (size_t)row * 12 + 4); }
#pragma unroll
            for (int i = 0; i < 4; ++i) rinv4[i] = rsqrtf((((ra[i][0] + ra[i][1]) + (ra[i][2] + ra[i][3])) + ((rb[i][0] + rb[i][1]) + (rb[i][2] + rb[i][3]))) * (1.f / 512.f) + EPS) * C_MLA; }
#pragma unroll
            for (int m = 0; m < 4; ++m) {
                __builtin_amdgcn_sched_barrier(0); const int row = row0 + ai * 128 + m * 16;
                const float rinv = rinv4[m];
                const int s = row & 4095;
#pragma unroll
                for (int bj = 0; bj < 2; ++bj) {
                    const int g32 = pn * 8 + bj * 4 + wc, t6 = g32 % 6, col0 = g32 * 32 + 8 * fq;
                    f32x4 v0 = acc[ai][bj][m][0], v1 = acc[ai][bj][m][1]; EPI_FENCE(v0, v1); v0 = v0 * rinv; v1 = v1 * rinv;
                    if (t6 >= 4 && lat) {
                        const int pos = (t6 == 4) ? (s >> 6) : (s & 63);
                        const float* cp = cs + (pos * 16 + 8 * (fq & 1)) * 2;
                        const f32x4 c0 = *(const f32x4*)(cp), c1 = *(const f32x4*)(cp + 4), c2 = *(const f32x4*)(cp + 8), c3 = *(const f32x4*)(cp + 12);
                        const float cosv[8] = {c0[0], c0[2], c1[0], c1[2], c2[0], c2[2], c3[0], c3[2]};
                        const float sinv[8] = {c0[1], c0[3], c1[1], c1[3], c2[1], c2[3], c3[1], c3[3]};
                        float x[8] = {v0[0], v0[1], v0[2], v0[3], v1[0], v1[1], v1[2], v1[3]};
#pragma unroll
                        for (int e = 0; e < 8; ++e) { const float p = shx(x[e], fr + 16 * fq, 32); x[e] = (fq < 2) ? (x[e] * cosv[e] - p * sinv[e]) : (p * sinv[e] + x[e] * cosv[e]); }
                        v0 = (f32x4){x[0], x[1], x[2], x[3]}; v1 = (f32x4){x[4], x[5], x[6], x[7]};
                    }
                    *(u32x4*)(q + (size_t)row * 1536 + col0) = pack8(v0, v1);
                }
            }
        }
    }
};
struct EpiKV {
    bf16_t* kv; const float* rsq;
    __device__ __forceinline__ void operator()(const AccT& acc, const pg8::Unit& u, int wr, int wc, int fr, int fq) const {
        const int row0 = u.pm * 256 + wr * 64 + fr, pn = u.pn;
#pragma unroll
        for (int ai = 0; ai < 2; ++ai) {
          float rinv4[4];
          { f32x4 ra[4];
#pragma unroll
            for (int i = 0; i < 4; ++i) { const int row = row0 + ai * 128 + i * 16; ra[i] = *(const f32x4*)(rsq + (size_t)row * 12 + 8); }
#pragma unroll
            for (int i = 0; i < 4; ++i) rinv4[i] = rsqrtf(((ra[i][0] + ra[i][1]) + (ra[i][2] + ra[i][3])) * (1.f / 256.f) + EPS); }
#pragma unroll
            for (int m = 0; m < 4; ++m) {
                __builtin_amdgcn_sched_barrier(0); const int row = row0 + ai * 128 + m * 16;
                const float rinv = rinv4[m];
#pragma unroll
                for (int bj = 0; bj < 2; ++bj) {
                    const int col0 = pn * 256 + bj * 128 + wc * 32 + 8 * fq;
                    f32x4 v0 = acc[ai][bj][m][0], v1 = acc[ai][bj][m][1]; EPI_FENCE(v0, v1);
                    *(u32x4*)(kv + (size_t)row * 2048 + col0) = pack8(v0 * rinv, v1 * rinv);
                }
            }
        }
    }
};
struct EpiMerge {
    const bf16_t* mg; float* tmp; bf16_t* merged; unsigned* ctr;
    __device__ __forceinline__ void operator()(const AccT& acc, const pg8::Unit& u, int wr, int wc, int fr, int fq) const {
        const int row0 = u.pm * 256 + wr * 64 + fr, pn = u.pn, z = u.z;
#pragma unroll
        for (int ai = 0; ai < 2; ++ai) {
            u32x4 gw8[8], pw8[8];
#pragma unroll
            for (int i = 0; i < 8; ++i) { const int row = row0 + ai * 128 + (i >> 1) * 16, col0 = pn * 256 + (i & 1) * 128 + wc * 32 + 8 * fq;
                gw8[i] = *(const u32x4*)(mg + (size_t)row * NMG + z * 2048 + col0);
                pw8[i] = (z > 0) ? *(const u32x4*)(merged + (size_t)row * 2048 + col0) : (u32x4){0u, 0u, 0u, 0u}; }
#pragma unroll
            for (int i = 0; i < 8; ++i) { const int m = i >> 1, bj = i & 1; const int row = row0 + ai * 128 + m * 16, col0 = pn * 256 + bj * 128 + wc * 32 + 8 * fq;
                f32x4 v0 = acc[ai][bj][m][0], v1 = acc[ai][bj][m][1]; EPI_FENCE(v0, v1);
                const u32x4 gw = gw8[i], pw = pw8[i];
                v0[0] = v0[0] * bflo(gw.x) + bflo(pw.x); v0[1] = v0[1] * bfhi(gw.x) + bfhi(pw.x); v0[2] = v0[2] * bflo(gw.y) + bflo(pw.y); v0[3] = v0[3] * bfhi(gw.y) + bfhi(pw.y);
                v1[0] = v1[0] * bflo(gw.z) + bflo(pw.z); v1[1] = v1[1] * bfhi(gw.z) + bfhi(pw.z); v1[2] = v1[2] * bflo(gw.w) + bflo(pw.w); v1[3] = v1[3] * bfhi(gw.w) + bfhi(pw.w);
                *(u32x4*)(merged + (size_t)row * 2048 + col0) = pack8(v0, v1); }
        }
        if (ctr && z == 2 && u.pm >= 64) {
            asm volatile("s_waitcnt vmcnt(0)" ::: "memory"); __builtin_amdgcn_s_barrier();
            if (threadIdx.x == 0) { __builtin_amdgcn_fence(__ATOMIC_RELEASE, "agent"); asm volatile("s_waitcnt vmcnt(0)" ::: "memory");
                (void)__hip_atomic_fetch_add(ctr + (u.pm - 64), 1u, __ATOMIC_RELAXED, __HIP_MEMORY_SCOPE_AGENT); }
        }
    }
};
struct EpiOut {
    const float* xin; const float* ctxin; float* xcur; const float* mod; int layer;
    __device__ __forceinline__ void operator()(const AccT& acc, const pg8::Unit& u, int wr, int wc, int fr, int fq) const {
        const int row0 = u.pm * 256 + wr * 64 + fr, pn = u.pn; const bool lat = u.pm < 64;
        const float* gt = mod + (size_t)(lat ? (u.pm >> 4) : 4) * 6144 + 4096;
#pragma unroll
        for (int hq = 0; hq < 4; ++hq) {
            const int ai = hq >> 1, m0 = (hq & 1) * 2;
            f32x4 xa[4], xb[4];
#pragma unroll
            for (int i = 0; i < 4; ++i) { const int row = row0 + ai * 128 + (m0 + (i >> 1)) * 16, col0 = pn * 256 + (i & 1) * 128 + wc * 32 + 8 * fq;
                const float* xo = (layer == 0) ? (lat ? xin + (size_t)row * 2048 : ctxin + (size_t)(row - NLAT) * 2048) : xcur + (size_t)row * 2048;
                xa[i] = *(const f32x4*)(xo + col0); xb[i] = *(const f32x4*)(xo + col0 + 4); }
#pragma unroll
            for (int i = 0; i < 4; ++i) { const int m = m0 + (i >> 1), bj = i & 1; const int row = row0 + ai * 128 + m * 16, col0 = pn * 256 + bj * 128 + wc * 32 + 8 * fq;
                f32x4 v0 = acc[ai][bj][m][0], v1 = acc[ai][bj][m][1]; EPI_FENCE(v0, v1);
                const f32x4 g0 = *(const f32x4*)(gt + col0), g1 = *(const f32x4*)(gt + col0 + 4);
                *(f32x4*)(xcur + (size_t)row * 2048 + col0) = xa[i] + g0 * v0;
                *(f32x4*)(xcur + (size_t)row * 2048 + col0 + 4) = xb[i] + g1 * v1; }
        }
    }
};

namespace mla {
typedef short s16x4 __attribute__((ext_vector_type(4)));
constexpr int SHM_V = 16384, SHM_K = 16384, SHM_KR = 8192;
constexpr int OFF_V = 0, OFF_K = 2 * SHM_V, OFF_KR = OFF_K + 2 * SHM_K, OFF_WS = OFF_KR + 2 * SHM_KR;
constexpr float THR2 = 8.f;
#define KSWZ(row, colB) ((row) * 256 + ((colB) ^ (((row) & 15) << 4)))
#define KRSWZ(row, colB) ((row) * 128 + ((colB) ^ ((((row) >> 1) & 7) << 4)))
#define SBAR() __builtin_amdgcn_sched_barrier(0)
__device__ __forceinline__ void partialSM(f32x16& p0, f32x16& p1, float& m_reg, float& mn, float& alpha) {
    float pmax = p0[0];
#pragma unroll
    for (int r = 1; r < 16; ++r) pmax = fmaxf(pmax, p0[r]);
#pragma unroll
    for (int r = 0; r < 16; ++r) pmax = fmaxf(pmax, p1[r]);
    { auto rr = __builtin_amdgcn_permlane32_swap(__float_as_uint(pmax), __float_as_uint(pmax), false, false);
      pmax = fmaxf(__uint_as_float(rr[0]), __uint_as_float(rr[1])); }
    if (__builtin_expect(__all(pmax - m_reg <= THR2), 1)) { mn = m_reg; alpha = 1.f; }
    else { mn = fmaxf(m_reg, pmax); alpha = __builtin_amdgcn_exp2f(m_reg - mn); m_reg = mn; }
#pragma unroll
    for (int r = 0; r < 16; ++r) p0[r] = p0[r] - mn;
#pragma unroll
    for (int r = 0; r < 16; ++r) p1[r] = p1[r] - mn;
#pragma unroll
    for (int r = 0; r < 16; ++r) p0[r] = __builtin_amdgcn_exp2f(p0[r]);
}
__device__ __forceinline__ void finishSM(f32x16& p0, f32x16& p1, float alpha, float& l_reg, bf16x8& pa0, bf16x8& pa1, bf16x8& pa2, bf16x8& pa3) {
#pragma unroll
    for (int r = 0; r < 16; ++r) p1[r] = __builtin_amdgcn_exp2f(p1[r]);
    float ps = 0;
#pragma unroll
    for (int r = 0; r < 16; ++r) ps += p0[r];
#pragma unroll
    for (int r = 0; r < 16; ++r) ps += p1[r];
    { auto rr = __builtin_amdgcn_permlane32_swap(__float_as_uint(ps), __float_as_uint(ps), false, false);
      ps = __uint_as_float(rr[0]) + __uint_as_float(rr[1]); }
    l_reg = l_reg * alpha + ps;
#define PK4(P, BASE, OUT) do { unsigned a0 = cvt_pk(P[BASE + 0], P[BASE + 1]), a1 = cvt_pk(P[BASE + 2], P[BASE + 3]);   \
    unsigned b0 = cvt_pk(P[BASE + 4], P[BASE + 5]), b1 = cvt_pk(P[BASE + 6], P[BASE + 7]);                              \
    auto r0 = __builtin_amdgcn_permlane32_swap(a0, b0, false, false); auto r1 = __builtin_amdgcn_permlane32_swap(a1, b1, false, false); \
    u32x4 w = {r0[0], r1[0], r0[1], r1[1]}; OUT = *reinterpret_cast<bf16x8*>(&w); } while (0)
    PK4(p0, 0, pa0); PK4(p0, 8, pa1); PK4(p1, 0, pa2); PK4(p1, 8, pa3);
#undef PK4
}
__device__ __forceinline__ void qkt(f32x16& p0, f32x16& p1, const char* Ks, const char* KRs, const bf16x8* qr, int r32, int hi) {
    p0 = f32x16{}; p1 = f32x16{};
#pragma unroll
    for (int d0 = 0; d0 < 8; ++d0) { const int cb = (d0 * 16 + hi * 8) * 2;
        bf16x8 b0 = *reinterpret_cast<const bf16x8*>(Ks + KSWZ(r32, cb));
        bf16x8 b1 = *reinterpret_cast<const bf16x8*>(Ks + KSWZ(32 + r32, cb));
        p0 = __builtin_amdgcn_mfma_f32_32x32x16_bf16(b0, qr[d0], p0, 0, 0, 0);
        p1 = __builtin_amdgcn_mfma_f32_32x32x16_bf16(b1, qr[d0], p1, 0, 0, 0); }
#pragma unroll
    for (int d0 = 0; d0 < 4; ++d0) { const int cb = (d0 * 16 + hi * 8) * 2;
        bf16x8 b0 = *reinterpret_cast<const bf16x8*>(KRs + KRSWZ(r32, cb));
        bf16x8 b1 = *reinterpret_cast<const bf16x8*>(KRs + KRSWZ(32 + r32, cb));
        p0 = __builtin_amdgcn_mfma_f32_32x32x16_bf16(b0, qr[8 + d0], p0, 0, 0, 0);
        p1 = __builtin_amdgcn_mfma_f32_32x32x16_bf16(b1, qr[8 + d0], p1, 0, 0, 0); }
}
__device__ __forceinline__ int v_st(int k, int c) { const int kk = (k & ~0xC) | ((k & 4) << 1) | ((k & 8) >> 1); return ((kk >> 3) * 4 + (c >> 5)) * 512 + ((kk & 7) * 32 + (c & 31)) * 2; }
__device__ __forceinline__ int v_rd_base(int lane) { return ((lane & 3) << 3) | (((lane >> 2) & 3) << 6) | (((lane >> 4) & 1) << 5) | (((lane >> 5) & 1) << 8); }
constexpr int v_rd_off(int d0, int ks, int half) { return d0 * 512 + ks * 4096 + half * 2048; }
template <int OFF> __device__ __forceinline__ s16x4 tr_read(int vb) {
    s16x4 r; asm volatile("ds_read_b64_tr_b16 %0, %1 offset:%2" : "=&v"(r) : "v"(vb), "i"(OFF) : "memory"); return r;
}
template <int D0> __device__ __forceinline__ void pv_one(f32x16& od, int vb, bf16x8 pa0, bf16x8 pa1, bf16x8 pa2, bf16x8 pa3) {
    const s16x4 l0 = tr_read<v_rd_off(D0, 0, 0)>(vb), h0 = tr_read<v_rd_off(D0, 0, 1)>(vb), l1 = tr_read<v_rd_off(D0, 1, 0)>(vb), h1 = tr_read<v_rd_off(D0, 1, 1)>(vb);
    const s16x4 l2 = tr_read<v_rd_off(D0, 2, 0)>(vb), h2 = tr_read<v_rd_off(D0, 2, 1)>(vb), l3 = tr_read<v_rd_off(D0, 3, 0)>(vb), h3 = tr_read<v_rd_off(D0, 3, 1)>(vb);
    asm volatile("s_waitcnt lgkmcnt(0)" ::: "memory"); SBAR();
#define PK(L, H) (bf16x8){L[0], L[1], L[2], L[3], H[0], H[1], H[2], H[3]}
    od = __builtin_amdgcn_mfma_f32_32x32x16_bf16(pa0, PK(l0, h0), od, 0, 0, 0);
    od = __builtin_amdgcn_mfma_f32_32x32x16_bf16(pa1, PK(l1, h1), od, 0, 0, 0);
    od = __builtin_amdgcn_mfma_f32_32x32x16_bf16(pa2, PK(l2, h2), od, 0, 0, 0);
    od = __builtin_amdgcn_mfma_f32_32x32x16_bf16(pa3, PK(l3, h3), od, 0, 0, 0);
#undef PK
}
__device__ __forceinline__ void pv_d0(f32x16* o, int vb, bf16x8 pa0, bf16x8 pa1, bf16x8 pa2, bf16x8 pa3) {
    pv_one<0>(o[0], vb, pa0, pa1, pa2, pa3); pv_one<1>(o[1], vb, pa0, pa1, pa2, pa3); pv_one<2>(o[2], vb, pa0, pa1, pa2, pa3); pv_one<3>(o[3], vb, pa0, pa1, pa2, pa3);
}
__device__ __forceinline__ void attn_unit(const bf16_t* __restrict__ Q, const bf16_t* __restrict__ KV, const bf16_t* __restrict__ KR, const bf16_t* __restrict__ GP, bf16_t* __restrict__ O,
                                          int qrow0, int h, int latbase, int ctxbase, int nlt, int NT, char* lds) {
    const int tid = opaque_v(threadIdx.x), wid = tid >> 6, lane = tid & 63, r32 = lane & 31, hi = lane >> 5;
    char* V_lds = lds + OFF_V; char* K_lds = lds + OFF_K; char* KR_lds = lds + OFF_KR;
    float* ws = (float*)(lds + OFF_WS) + wid * 64; float* li_l = ws; float* al_l = ws + 32;
    float m_reg = -1e30f, l_reg = 0; f32x16 o[4] = {}; bf16x8 qr[12];
    const bf16_t* Qw = Q + (size_t)(qrow0 + wid * 32 + r32) * 1536 + h * 192 + hi * 8;
#pragma unroll
    for (int d0 = 0; d0 < 12; ++d0) qr[d0] = *reinterpret_cast<const bf16x8*>(Qw + d0 * 16);
    const int sr = tid >> 4, sc = (tid & 15) * 8, vst0 = v_st(sr, sc), vst1 = v_st(32 + sr, sc);
    const int krr = tid >> 3, krc = (tid & 7) * 16;
    const int vb0 = (int)(uintptr_t)V_lds + v_rd_base(lane);
    const bf16_t* Kh = KV + h * 256 + sc; const bf16_t* Vh = KV + h * 256 + 128 + sc;
    bf16x8 s_v0, s_v1, s_k0, s_k1, s_kr;
#define TROW(j) ((j) < nlt ? latbase + 64 * (j) : ctxbase + 64 * ((j) - nlt))
#define SLOAD(j) do { const int _rb = TROW(j); \
    s_v0 = *reinterpret_cast<const bf16x8*>(Vh + (size_t)(_rb + sr) * 2048); s_v1 = *reinterpret_cast<const bf16x8*>(Vh + (size_t)(_rb + 32 + sr) * 2048); \
    s_k0 = *reinterpret_cast<const bf16x8*>(Kh + (size_t)(_rb + sr) * 2048); s_k1 = *reinterpret_cast<const bf16x8*>(Kh + (size_t)(_rb + 32 + sr) * 2048); \
    s_kr = *reinterpret_cast<const bf16x8*>((const char*)KR + (size_t)(_rb + krr) * 128 + krc); } while (0)
#define SWRITE(b) do { *(bf16x8*)(V_lds + (b) * SHM_V + vst0) = s_v0; *(bf16x8*)(V_lds + (b) * SHM_V + vst1) = s_v1; const int kc = sc * 2; \
    *(bf16x8*)(K_lds + (b) * SHM_K + KSWZ(sr, kc)) = s_k0; *(bf16x8*)(K_lds + (b) * SHM_K + KSWZ(32 + sr, kc)) = s_k1; \
    *(bf16x8*)(KR_lds + (b) * SHM_KR + KRSWZ(krr, krc)) = s_kr; } while (0)
#define RESC(a) do { if (__any((a) < 1.f)) { if (hi == 0) al_l[r32] = (a); asm volatile("s_waitcnt lgkmcnt(0)" ::: "memory"); \
    _Pragma("unroll") for (int d = 0; d < 4; ++d) _Pragma("unroll") for (int r = 0; r < 16; ++r) o[d][r] *= al_l[crow(r, hi)]; } } while (0)
    f32x16 pA0, pA1, pB0, pB1; float mnA, mnB, alA, alB; bf16x8 pa0, pa1, pa2, pa3;
    SLOAD(0); asm volatile("s_waitcnt vmcnt(0)" ::: "memory"); SWRITE(0); __syncthreads();
    qkt(pA0, pA1, K_lds, KR_lds, qr, r32, hi); partialSM(pA0, pA1, m_reg, mnA, alA);
    SLOAD(1);
    asm volatile("s_waitcnt vmcnt(0)" ::: "memory"); SWRITE(1); __syncthreads();
    for (int j = 1; j + 1 < NT; j += 2) {
        SBAR(); qkt(pB0, pB1, K_lds + SHM_K, KR_lds + SHM_KR, qr, r32, hi);
        finishSM(pA0, pA1, alA, l_reg, pa0, pa1, pa2, pa3); SBAR();
        SLOAD(j + 1); SBAR();
        pv_d0(o, vb0, pa0, pa1, pa2, pa3); partialSM(pB0, pB1, m_reg, mnB, alB);
        __syncthreads(); asm volatile("s_waitcnt vmcnt(0)" ::: "memory"); SWRITE(0);
        RESC(alB); __syncthreads();
        SBAR(); qkt(pA0, pA1, K_lds, KR_lds, qr, r32, hi);
        finishSM(pB0, pB1, alB, l_reg, pa0, pa1, pa2, pa3); SBAR();
        SLOAD(j + 2); SBAR();
        pv_d0(o, vb0 + SHM_V, pa0, pa1, pa2, pa3); partialSM(pA0, pA1, m_reg, mnA, alA);
        __syncthreads(); asm volatile("s_waitcnt vmcnt(0)" ::: "memory"); SWRITE(1);
        RESC(alA); __syncthreads();
    }
    SBAR(); qkt(pB0, pB1, K_lds + SHM_K, KR_lds + SHM_KR, qr, r32, hi);
    finishSM(pA0, pA1, alA, l_reg, pa0, pa1, pa2, pa3); SBAR();
    pv_d0(o, vb0, pa0, pa1, pa2, pa3); partialSM(pB0, pB1, m_reg, mnB, alB);
    __syncthreads(); RESC(alB);
    finishSM(pB0, pB1, alB, l_reg, pa0, pa1, pa2, pa3); SBAR();
    pv_d0(o, vb0 + SHM_V, pa0, pa1, pa2, pa3);
    if (hi == 0) li_l[r32] = l_reg; asm volatile("s_waitcnt lgkmcnt(0)" ::: "memory");
    const int orow0 = qrow0 + wid * 32;
#pragma unroll
    for (int r = 0; r < 16; ++r) { const int orow = orow0 + crow(r, hi); const float rl = __builtin_amdgcn_rcpf(li_l[crow(r, hi)]);
#pragma unroll
        for (int d0 = 0; d0 < 4; ++d0) { const size_t idx = (size_t)orow * 3072 + h * 128 + d0 * 32 + r32;
            const float v = o[d0][r] * rl * bf1(GP[idx]); O[idx] = (bf16_t)(cvt_pk(v, 0.f) & 0xffffu); } }
    __syncthreads();
#undef TROW
#undef SLOAD
#undef SWRITE
#undef RESC
}
}

__device__ __forceinline__ void na_item(const bf16_t* __restrict__ PMIX, const bf16_t* __restrict__ GP, bf16_t* __restrict__ O, const float* __restrict__ bias, int item, int lane, LAS unsigned char* wl) {
    const int q = lane & 31, hi = lane >> 5;
    const bool lat = item < 8192;
    int b, h, gi = 0, jh = 0, qrow;
    if (lat) { b = item >> 11; h = (item >> 7) & 15; gi = (item >> 1) & 63; jh = item & 1; qrow = b * 4096 + gi * 64 + jh * 32 + q; }
    else { const int it = item - 8192; b = it >> 7; h = (it >> 3) & 15; qrow = NLAT + b * 256 + (it & 7) * 32 + q; }
    const int j = jh * 32 + q;
    const int c0 = min(max(j - 8, 0), 48), r0 = min(max(gi - 4, 0), 56);
    const bf16_t* qp = PMIX + (size_t)qrow * NMIXP + O_NAQ + h * 64 + hi * 8;
    bf16x8 qf[4];
#pragma unroll
    for (int ks = 0; ks < 4; ++ks) qf[ks] = *reinterpret_cast<const bf16x8*>(qp + ks * 16);
    f32x16 oT0 = {}, oT1 = {}; float m = -1e30f, l = 0.f;
    const int ntiles = lat ? 24 : 8;
    const float* bh = bias + h * (15 * 31);
    LAS float* lbias = (LAS float*)(wl + 4608);
    if (lat) {
#pragma unroll
        for (int i = 0; i < 4; ++i) { const int e = lane * 4 + i, krr = e >> 5, dc = e & 31; lbias[e] = bh[(r0 + krr - gi + 7) * 31 + min(dc, 30)] * LOG2E; }
        asm volatile("s_waitcnt vmcnt(0) lgkmcnt(0)" ::: "memory"); __builtin_amdgcn_wave_barrier();
    }
#define NA_TROW(t_) ((lat && (t_) < 16) ? (b * 4096 + (r0 + ((t_) >> 1)) * 64 + ((t_) & 1) * 32) : (NLAT + b * 256 + (lat ? (t_) - 16 : (t_)) * 32))
#define NA_LOAD(KF, VV, t_) do { const int kr0_ = NA_TROW(t_); const bf16_t* kp_ = PMIX + (size_t)(kr0_ + q) * NMIXP + O_NAK + h * 64 + hi * 8; \
        _Pragma("unroll") for (int ks = 0; ks < 4; ++ks) KF[ks] = *reinterpret_cast<const bf16x8*>(kp_ + ks * 16); \
        const bf16_t* vp_ = PMIX + (size_t)(kr0_ + (lane >> 1)) * NMIXP + O_NAV + h * 64 + (lane & 1) * 32; \
        _Pragma("unroll") for (int c = 0; c < 4; ++c) VV[c] = *reinterpret_cast<const u32x4*>(vp_ + c * 8); } while (0)
#define NA_TILE(KF, VV, t) do { \
        const bool local = lat && (t) < 16; const int kr = (t) >> 1, kblk = (t) & 1; \
        f32x16 p = {}; \
        _Pragma("unroll") for (int ks = 0; ks < 4; ++ks) p = __builtin_amdgcn_mfma_f32_32x32x16_bf16(KF[ks], qf[ks], p, 0, 0, 0); \
        _Pragma("unroll") for (int c = 0; c < 4; ++c) *(LAS u32x4*)(wl + (lane >> 1) * 144 + (lane & 1) * 64 + c * 16) = VV[c]; \
        if ((t) + 2 < ntiles) NA_LOAD(KF, VV, (t) + 2); \
        if (local) { \
            const LAS float* brow = lbias + kr * 32; \
            _Pragma("unroll") for (int r8 = 0; r8 < 16; r8 += 4) { float bv8[4]; \
                _Pragma("unroll") for (int r = 0; r < 4; ++r) { const int kc = kblk * 32 + crow(r8 + r, hi); bv8[r] = brow[min(max(kc - j + 15, 0), 30)]; } \
                _Pragma("unroll") for (int r = 0; r < 4; ++r) asm volatile("" : "+v"(bv8[r]));     \
                _Pragma("unroll") for (int r = 0; r < 4; ++r) { const int kc = kblk * 32 + crow(r8 + r, hi); const bool valid = (kc >= c0) && (kc < c0 + 16); p[r8 + r] = valid ? p[r8 + r] + bv8[r] : -INFINITY; } } \
        } \
        float tmax = p[0]; \
        _Pragma("unroll") for (int r = 1; r < 16; ++r) tmax = fmaxf(tmax, p[r]); \
        tmax = fmaxf(tmax, shx(tmax, lane, 32)); \
        const float mn = fmaxf(m, tmax), alpha = __builtin_amdgcn_exp2f(m - mn); m = mn; \
        float ps = 0.f; \
        _Pragma("unroll") for (int r = 0; r < 16; ++r) { p[r] = __builtin_amdgcn_exp2f(p[r] - mn); ps += p[r]; } \
        l = l * alpha + ps; \
        _Pragma("unroll") for (int r = 0; r < 16; ++r) { oT0[r] *= alpha; oT1[r] *= alpha; } \
        asm volatile("s_waitcnt lgkmcnt(0)" ::: "memory"); __builtin_amdgcn_wave_barrier(); \
        _Pragma("unroll") for (int ks = 0; ks < 2; ++ks) { \
            u32x4 pw; pw.x = cvt_pk(p[8 * ks + 0], p[8 * ks + 1]); pw.y = cvt_pk(p[8 * ks + 2], p[8 * ks + 3]); pw.z = cvt_pk(p[8 * ks + 4], p[8 * ks + 5]); pw.w = cvt_pk(p[8 * ks + 6], p[8 * ks + 7]); \
            const bf16x8 pf = *reinterpret_cast<bf16x8*>(&pw); \
            _Pragma("unroll") for (int db = 0; db < 2; ++db) { \
                bf16x8 vf; \
                _Pragma("unroll") for (int jj = 0; jj < 8; ++jj) { const int key = 16 * ks + 8 * (jj >> 2) + 4 * hi + (jj & 3); vf[jj] = *(const LAS short*)(wl + key * 144 + (32 * db + q) * 2); } \
                if (db == 0) oT0 = __builtin_amdgcn_mfma_f32_32x32x16_bf16(vf, pf, oT0, 0, 0, 0); \
                else oT1 = __builtin_amdgcn_mfma_f32_32x32x16_bf16(vf, pf, oT1, 0, 0, 0); \
            } \
        } \
        asm volatile("s_waitcnt lgkmcnt(0)" ::: "memory"); __builtin_amdgcn_wave_barrier(); \
    } while (0)
    bf16x8 kfa[4], kfb[4]; u32x4 vva[4], vvb[4];
    NA_LOAD(kfa, vva, 0); NA_LOAD(kfb, vvb, 1);
    for (int t0 = 0; t0 < ntiles; t0 += 2) {
        NA_TILE(kfa, vva, t0);
        NA_TILE(kfb, vvb, t0 + 1);
    }
#undef NA_TILE
#undef NA_TROW
#undef NA_LOAD
    const float inv = __builtin_amdgcn_rcpf(l + shx(l, lane, 32));
    const size_t ob = (size_t)qrow * 3072 + 1024 + h * 64;
#pragma unroll
    for (int db = 0; db < 2; ++db)
#pragma unroll
        for (int g = 0; g < 4; ++g) {
            const int d = 32 * db + 8 * g + 4 * hi;
            const u32x2 gw = *reinterpret_cast<const u32x2*>(GP + ob + d);
            float v0, v1, v2, v3;
            if (db == 0) { v0 = oT0[4 * g]; v1 = oT0[4 * g + 1]; v2 = oT0[4 * g + 2]; v3 = oT0[4 * g + 3]; } else { v0 = oT1[4 * g]; v1 = oT1[4 * g + 1]; v2 = oT1[4 * g + 2]; v3 = oT1[4 * g + 3]; }
            u32x2 w; w.x = cvt_pk(v0 * inv * bflo(gw.x), v1 * inv * bfhi(gw.x)); w.y = cvt_pk(v2 * inv * bflo(gw.y), v3 * inv * bfhi(gw.y));
            *reinterpret_cast<u32x2*>(O + ob + d) = w;
        }
}

__device__ __forceinline__ void lru_gate_phase(const bf16_t* __restrict__ PMIX, const bf16_t* __restrict__ WG, const float* __restrict__ convw, const float* __restrict__ convb,
                                               const float* __restrict__ bg, const float* __restrict__ lam, float* __restrict__ LA, float* __restrict__ LU, int bid, int G, LAS unsigned char* lds) {
    const int tid = opaque_v(threadIdx.x), lane = tid & 63, wid = tid >> 6;
    LAS float* xcf = (LAS float*)lds;
    LAS unsigned char* xcb = lds + 64 * 68 * 4;
    const int tl_s = tid >> 3, cg8 = (tid & 7) * 8;
    const int dir = wid >> 2, th = (wid >> 1) & 1, chh = wid & 1, q = lane & 31, hi = lane >> 5, cl = 32 * chh + q;
    int cur_blk = -1;
    f32x4 cw[4][2], cb0, cb1; bf16x8 br[4], bi[4]; float brv = 0.f, biv = 0.f, sp = 0.f;
    for (int item = bid; item < (MROWS / 64) * 16; item += G) {
        const int tt = item >> 4, blk = item & 15, row0 = tt * 64;
        if (blk != cur_blk) {
            cur_blk = blk;
            const int chs = blk * 64 + cg8;
            cb0 = *(const f32x4*)(convb + chs); cb1 = *(const f32x4*)(convb + chs + 4);
#pragma unroll
            for (int tap = 0; tap < 4; ++tap) { cw[tap][0] = *(const f32x4*)(convw + tap * 1024 + chs); cw[tap][1] = *(const f32x4*)(convw + tap * 1024 + chs + 4); }
            const bf16_t* wt = WG + (size_t)(dir * 16 + blk) * 128 * 64;
#pragma unroll
            for (int ks = 0; ks < 4; ++ks) { br[ks] = *reinterpret_cast<const bf16x8*>(wt + (size_t)cl * 64 + 16 * ks + 8 * hi); bi[ks] = *reinterpret_cast<const bf16x8*>(wt + (size_t)(64 + cl) * 64 + 16 * ks + 8 * hi); }
            brv = bg[dir * 2048 + blk * 128 + cl]; biv = bg[dir * 2048 + blk * 128 + 64 + cl];
            const float xs = __expf(-lam[dir * 1024 + blk * 64 + cl]);
            sp = xs < 0.05f ? xs * (1.f - xs * (0.5f - xs * ((1.f / 3.f) - xs * (0.25f - xs * 0.2f)))) : __logf(1.f + xs);
        }
        const int seg0 = row0 < NLAT ? (row0 & ~4095) : (NLAT + ((row0 - NLAT) & ~255)), seg1 = seg0 + (row0 < NLAT ? 4096 : 256);
        {
            const int row = row0 + tl_s, chs = blk * 64 + cg8;
            f32x4 x0 = cb0, x1 = cb1;
            u32x4 pv4[4];
#pragma unroll
            for (int tap = 0; tap < 4; ++tap) { const int rr = min(max(row + tap - 2, seg0), seg1 - 1); pv4[tap] = *(const u32x4*)(PMIX + (size_t)rr * NMIXP + O_PX + chs); }
#pragma unroll
            for (int tap = 0; tap < 4; ++tap) {
                const int rr = row + tap - 2; const float ok = (rr >= seg0 && rr < seg1) ? 1.f : 0.f; const u32x4 pv = pv4[tap];
                x0 += (cw[tap][0] * ok) * (f32x4){bflo(pv.x), bfhi(pv.x), bflo(pv.y), bfhi(pv.y)};
                x1 += (cw[tap][1] * ok) * (f32x4){bflo(pv.z), bfhi(pv.z), bflo(pv.w), bfhi(pv.w)};
            }
            *(LAS f32x4*)(xcf + tl_s * 68 + cg8) = x0; *(LAS f32x4*)(xcf + tl_s * 68 + cg8 + 4) = x1;
            *(LAS u32x4*)(xcb + tl_s * 144 + cg8 * 2) = pack8(x0, x1);
        }
        __syncthreads();
        {
            const int ch = blk * 64 + cl;
            f32x16 accR = {}, accI = {};
#pragma unroll
            for (int ks = 0; ks < 4; ++ks) {
                const bf16x8 af = *(const LAS bf16x8*)(xcb + (32 * th + q) * 144 + (16 * ks + 8 * hi) * 2);
                accR = __builtin_amdgcn_mfma_f32_32x32x16_bf16(af, br[ks], accR, 0, 0, 0);
                accI = __builtin_amdgcn_mfma_f32_32x32x16_bf16(af, bi[ks], accI, 0, 0, 0);
            }
#pragma unroll
            for (int r = 0; r < 16; ++r) {
                const int tl = 32 * th + crow(r, hi);
                const float rg = sigmoidf_(accR[r] + brv), ig = sigmoidf_(accI[r] + biv);
                const float log_a = -8.f * rg * sp, ym = -2.f * log_a, y1 = -log_a;
                const float om = ym < 0.1f ? ym * (1.f - ym * (0.5f - ym * ((1.f / 6.f) - ym * ((1.f / 24.f) - ym * (1.f / 120.f))))) : 1.f - __expf(-ym);
                const float oma = y1 < 0.1f ? y1 * (1.f - y1 * (0.5f - y1 * ((1.f / 6.f) - y1 * ((1.f / 24.f) - y1 * (1.f / 120.f))))) : 1.f - __expf(-y1);
                const float u = __builtin_sqrtf(fmaxf(om, 0.f)) * (ig * xcf[tl * 68 + cl]);
                const size_t idx = ((size_t)dir * MROWS + row0 + tl) * 1024 + ch;
                ((unsigned*)LA)[idx] = cvt_pk(oma, u);
            }
        }
        __syncthreads();
    }
}
__device__ __forceinline__ int chunk_row0(int b, int c) { return c < 4 ? NLAT + b * 256 + c * 64 : b * 4096 + (c - 4) * 64; }
__device__ __forceinline__ void lru_pass1_item(const float* __restrict__ LA, const float* __restrict__ LU, float* __restrict__ AGG, int item) {
    const int g = item * 512 + opaque_v(threadIdx.x), ch = (g & 255) * 4, dir = (g >> 8) & 1, bc = g >> 9, c = bc % NCHUNK, b = bc / NCHUNK;
    const int row0 = chunk_row0(b, c);
    const unsigned* ap = (const unsigned*)LA + ((size_t)dir * MROWS + row0) * 1024 + ch; (void)LU;
    f32x4 A = {1.f, 1.f, 1.f, 1.f}, H = {0.f, 0.f, 0.f, 0.f};
#pragma unroll 8
    for (int t = 0; t < 64; ++t) { const int tt = dir ? 63 - t : t; const u32x4 w = *(const u32x4*)(ap + (size_t)tt * 1024);
        const f32x4 a = {1.f - bflo(w.x), 1.f - bflo(w.y), 1.f - bflo(w.z), 1.f - bflo(w.w)}, u = {bfhi(w.x), bfhi(w.y), bfhi(w.z), bfhi(w.w)}; A *= a; H = a * H + u; }
    float* o = AGG + (((size_t)(dir * NB + b) * NCHUNK + c) * 1024 + ch) * 2;
    *(f32x4*)o = (f32x4){A[0], H[0], A[1], H[1]}; *(f32x4*)(o + 4) = (f32x4){A[2], H[2], A[3], H[3]};
}
__device__ __forceinline__ void lru_pass3_item(const float* __restrict__ LA, const float* __restrict__ LU, const float* __restrict__ AGG, const bf16_t* __restrict__ GP, bf16_t* __restrict__ O, int item, LAS unsigned char* lds) {
    const int tid = opaque_v(threadIdx.x);
    const int cg = item & 7, bc = item >> 3, c = bc % NCHUNK, b = bc / NCHUNK, row0 = chunk_row0(b, c), ch0 = cg * 128;
    LAS unsigned* S = (LAS unsigned*)lds;
    LAS float* CX = (LAS float*)(lds + 65536);
    {
        u32x4 tv[8];
#pragma unroll
        for (int p = 0; p < 8; ++p) { const int e = p * 512 + tid, arr = e >> 11, rem = e & 2047, tok = rem >> 5, c4 = rem & 31;
            tv[p] = *(const u32x4*)((const unsigned*)LA + ((size_t)arr * MROWS + row0 + tok) * 1024 + ch0 + c4 * 4); }
#pragma unroll
        for (int p = 0; p < 8; ++p) { const int e = p * 512 + tid, arr = e >> 11, rem = e & 2047, tok = rem >> 5, c4 = rem & 31;
            *(LAS u32x4*)(S + (arr * 64 + tok) * 128 + c4 * 4) = tv[p]; }
    }
    const int dir = (tid >> 7) & 1, ch = tid & 127, half = tid >> 8;
    float cA = 1.f, cH = 0.f;
    {
        const float* ag = AGG + ((size_t)(dir * NB + b) * NCHUNK * 1024 + ch0 + ch) * 2;
        const int n = dir == 0 ? c : (c < 4 ? 3 - c : 4 + (NCHUNK - 1 - c));
        const int k0 = half ? (n >> 1) : 0, k1 = half ? n : (n >> 1);
#pragma unroll 8
        for (int k = k0; k < k1; ++k) { const int cc = dir == 0 ? k : ((c < 4 || k < 4) ? 3 - k : NCHUNK - 1 - (k - 4));
            const f32x2_t q_ = *(const f32x2_t*)(ag + (size_t)cc * 2048); cA *= q_[0]; cH = q_[0] * cH + q_[1]; }
    }
    if (half) { CX[(tid - 256) * 2] = cA; CX[(tid - 256) * 2 + 1] = cH; }
    __syncthreads();
    if (tid < 256) {
        float h = CX[tid * 2] * cH + CX[tid * 2 + 1];
        LAS unsigned* su = S + dir * 64 * 128 + ch;
#pragma unroll 8
        for (int t = 0; t < 64; ++t) { const int tt = dir ? 63 - t : t; const unsigned w = su[tt * 128]; h = (1.f - bflo(w)) * h + bfhi(w); su[tt * 128] = __float_as_uint(h); }
    }
    __syncthreads();
#pragma unroll
    for (int p = 0; p < 4; ++p) { const int e = p * 512 + tid, tok = e >> 5, c4 = e & 31;
        const f32x4 hf = *(const LAS f32x4*)(S + (0 * 64 + tok) * 128 + c4 * 4), hb = *(const LAS f32x4*)(S + (1 * 64 + tok) * 128 + c4 * 4);
        const size_t oi = (size_t)(row0 + tok) * 3072 + 2048 + ch0 + c4 * 4; const u32x2 gw = *(const u32x2*)(GP + oi);
        u32x2 w; w.x = cvt_pk((hf[0] + hb[0]) * bflo(gw.x), (hf[1] + hb[1]) * bfhi(gw.x)); w.y = cvt_pk((hf[2] + hb[2]) * bflo(gw.y), (hf[3] + hb[3]) * bfhi(gw.y));
        *(u32x2*)(O + oi) = w; }
    __syncthreads();
}

__device__ __forceinline__ void transpose_item(const float* __restrict__ W, int ld_src, int k0, int n0src, const float* __restrict__ kscale, bf16_t* __restrict__ WT, int ldt, int n0dst, LAS float* scr, int lane) {
#pragma unroll 8
    for (int i = 0; i < 32; ++i) { const int kk = 2 * i + (lane >> 5); float v = W[(size_t)(k0 + kk) * ld_src + n0src + (lane & 31)]; if (kscale) v *= kscale[k0 + kk]; scr[kk * 33 + (lane & 31)] = v; }
    asm volatile("s_waitcnt lgkmcnt(0)" ::: "memory"); __builtin_amdgcn_wave_barrier();
    const int c = lane & 7;
#pragma unroll
    for (int jn = 0; jn < 4; ++jn) { const int n = (lane >> 3) + 8 * jn; const LAS float* s = scr + (8 * c) * 33 + n;
        u32x4 o; o.x = cvt_pk(s[0 * 33], s[1 * 33]); o.y = cvt_pk(s[2 * 33], s[3 * 33]); o.z = cvt_pk(s[4 * 33], s[5 * 33]); o.w = cvt_pk(s[6 * 33], s[7 * 33]);
        *(u32x4*)(WT + (size_t)(n0dst + n) * ldt + k0 + 8 * c) = o; }
    asm volatile("s_waitcnt lgkmcnt(0)" ::: "memory"); __builtin_amdgcn_wave_barrier();
}


#define XB_TMO      128
#define XB_XCNT(j)  (256  + 64 * (j))
#define XB_XSUB(j)  (1280 + 64 * (j))
#define XB_XGEN(j)  (2304 + 64 * (j))
#define XB_TOP      3328
#define XB_TOPGEN   3392
#define XCD_BAR_WORDS 3456
#define XB_SPIN_CAP (1u << 22)
__device__ __forceinline__ unsigned xb_ld(unsigned* p)              { return __hip_atomic_load(p, __ATOMIC_RELAXED, __HIP_MEMORY_SCOPE_AGENT); }
__device__ __forceinline__ unsigned xb_add(unsigned* p, unsigned v) { return __hip_atomic_fetch_add(p, v, __ATOMIC_RELAXED, __HIP_MEMORY_SCOPE_AGENT); }
__device__ __forceinline__ unsigned xb_xcc_id() { return (unsigned)__builtin_amdgcn_s_getreg((3 << 11) | 20) & 0xFu; }
#define XB_SPIN(cond, bar) do { unsigned _sp = 0; while (cond) { __builtin_amdgcn_s_sleep(1); \
    if ((++_sp & 255u) == 0u) { if (xb_ld(&(bar)[XB_TMO])) break; if (_sp > XB_SPIN_CAP) { atomicAdd(&(bar)[XB_TMO], 1u); break; } } } } while (0)
struct XcdBarrier { unsigned* bar; unsigned x; volatile LAS unsigned* st; };
__device__ __forceinline__ XcdBarrier xcd_barrier_post(unsigned* bar, volatile LAS unsigned* st) {
    XcdBarrier b; b.bar = bar; b.x = xb_xcc_id(); b.st = st;
    if (threadIdx.x == 0) (void)xb_add(&bar[XB_XCNT(b.x)], 1u);
    return b;
}
__device__ __forceinline__ void xcd_barrier_complete(unsigned* bar, unsigned x, unsigned& nloc, unsigned& nx) {
    const unsigned G = gridDim.x * gridDim.y * gridDim.z;
    unsigned sum, cnt, mine, sp = 0u;
    for (;;) {
        sum = 0u; cnt = 0u; mine = 0u;
#pragma unroll
        for (unsigned j = 0; j < 16; ++j) { const unsigned c = xb_ld(&bar[XB_XCNT(j)]); sum += c; cnt += (c > 0u) ? 1u : 0u; mine = (j == x) ? c : mine; }
        if (sum == G) break;
        __builtin_amdgcn_s_sleep(1);
        if ((++sp & 255u) == 0u) { if (xb_ld(&bar[XB_TMO])) break; if (sp > XB_SPIN_CAP) { atomicAdd(&bar[XB_TMO], 1u); break; } }
    }
    nloc = mine > 0u ? mine : 1u; nx = cnt > 0u ? cnt : 1u;
}
__device__ __forceinline__ void xcd_barrier(const XcdBarrier& b) {
    asm volatile("s_waitcnt vmcnt(0)" ::: "memory");
    __syncthreads();
    if (threadIdx.x == 0) {
        unsigned* bar = b.bar;
        __builtin_amdgcn_s_waitcnt(0);
        unsigned nloc = b.st[0], nx = b.st[1];
        if (nloc == 0u) { xcd_barrier_complete(bar, b.x, nloc, nx); b.st[0] = nloc; b.st[1] = nx; }
        const unsigned old = xb_add(&bar[XB_XSUB(b.x)], 1u);
        const unsigned gen = old / nloc;
        if (old + 1u == (gen + 1u) * nloc) {
            __builtin_amdgcn_fence(__ATOMIC_RELEASE, "agent");
            asm volatile("s_waitcnt vmcnt(0)" ::: "memory");
            const unsigned og = xb_add(&bar[XB_TOP], 1u);
            const unsigned tg = og / nx;
            if (og + 1u == (tg + 1u) * nx) xb_add(&bar[XB_TOPGEN], 1u);
            else XB_SPIN(xb_ld(&bar[XB_TOPGEN]) == tg, bar);
            __builtin_amdgcn_fence(__ATOMIC_ACQUIRE, "agent");
            xb_add(&bar[XB_XGEN(b.x)], 1u);
            asm volatile("s_waitcnt vmcnt(0)" ::: "memory");
        } else {
            XB_SPIN(xb_ld(&bar[XB_XGEN(b.x)]) == gen, bar);
            __builtin_amdgcn_fence(__ATOMIC_ACQUIRE, "agent");
            asm volatile("s_waitcnt vmcnt(0)" ::: "memory");
        }
    }
    __syncthreads();
}
#define GRID_SYNC() do { asm volatile("s_waitcnt vmcnt(0) lgkmcnt(0)" ::: "memory"); grid.sync(); \
    if (threadIdx.x < 64) asm volatile("buffer_inv sc1\n\ts_waitcnt vmcnt(0)" ::: "memory"); __syncthreads(); } while (0)
__device__ __forceinline__ unsigned char* opaque_p(unsigned char* p) { asm volatile("" : "+s"(p)); return p; }
__device__ __forceinline__ int opaque_s(int x) { asm volatile("" : "+s"(x)); return x; }
#define x_in (args.in[0])
#define c_in (args.in[1])
#define ctx_in (args.in[2])
#define cctx_in (args.in[3])
#define ada_w (args.in[4])
#define ada_b (args.in[5])
#define norm_g (args.in[6])
#define w_in (args.in[7])
#define qng (args.in[8])
#define kvng (args.in[9])
#define w_uq (args.in[10])
#define w_ukv (args.in[11])
#define rel_bias (args.in[12])
#define conv_w (args.in[13])
#define conv_b (args.in[14])
#define w_gate (args.in[15])
#define b_gate (args.in[16])
#define lam_in (args.in[17])
#define w_branch (args.in[18])
#define w_out (args.in[19])
#define fng (args.in[20])
#define WIN ((bf16_t*)(ws + WS_WIN))
#define WUQ ((bf16_t*)(ws + WS_WUQ))
#define WUKV ((bf16_t*)(ws + WS_WUKV))
#define WBR ((bf16_t*)(ws + WS_WBR))
#define WOUT ((bf16_t*)(ws + WS_WOUT))
#define WG ((bf16_t*)(ws + WS_WG))
#define MOD ((float*)(ws + WS_MOD))
#define ROPE ((float*)(ws + WS_ROPE))
#define XCUR ((float*)(ws + WS_XCUR))
#define HB ((bf16_t*)(ws + WS_H))
#define PMIX ((bf16_t*)(ws + WS_PMIX))
#define GP ((bf16_t*)(ws + WS_GP))
#define MG ((bf16_t*)(ws + WS_MG))
#define RSQ ((float*)(ws + WS_RSQ))
#define QB ((bf16_t*)(ws + WS_Q))
#define KVB ((bf16_t*)(ws + WS_KV))
#define KRB ((bf16_t*)(ws + WS_KR))
#define LA ((float*)(ws + WS_LA))
#define LU ((float*)(ws + WS_LU))
#define AGG ((float*)(ws + WS_AGG))
#define OB ((bf16_t*)(ws + WS_O))
#define MTMP LA
__global__ void __launch_bounds__(512, 2) mk_fwd(Args args) {
    extern __shared__ __attribute__((aligned(16))) unsigned char lds_raw[];
    cg::grid_group grid = cg::this_grid();
    LAS unsigned char* lds = (LAS unsigned char*)lds_raw;
    volatile LAS unsigned* xb_st = (volatile LAS unsigned*)(lds + LDS_BYTES - 64);
    if (threadIdx.x == 0) { xb_st[0] = 0u; xb_st[1] = 0u; }
    __syncthreads();
    (void)xcd_barrier_post((unsigned*)(args.ws + WS_BAR), xb_st);
#define XSYNC() do { XcdBarrier b_; b_.bar = (unsigned*)(args.ws + WS_BAR); b_.x = xb_xcc_id(); b_.st = (volatile LAS unsigned*)(lds + LDS_BYTES - 64); xcd_barrier(b_); } while (0)
#define PHASE_IDS const int tid = opaque_v(threadIdx.x), lane = tid & 63, wid = __builtin_amdgcn_readfirstlane(tid >> 6), G = opaque_s(gridDim.x), bid = opaque_s(blockIdx.x), NGW = G * 8, gw = bid * 8 + wid; unsigned char* ws = args.ws + (size_t)(unsigned)opaque_s(0); (void)lane; (void)gw; (void)NGW; (void)ws; (void)tid;

    {
        PHASE_IDS
        LAS float* scr = (LAS float*)(lds + wid * 8448);
        constexpr int I_IN = 32 * 442, I_UQ = 8 * 48, I_UKV = 4 * 64, I_BR = 3 * 16 * 64, I_OUT = 32 * 64, I_G = 32 * 4, I_L = I_IN + I_UQ + I_UKV + I_BR + I_OUT + I_G;
        for (int it = gw; it < DEPTH * I_L; it += NGW) {
            const int L = it / I_L; int r = it - L * I_L;
            if (r < I_IN) { const int kb = r / 442, nb = r % 442, n0 = nb * 32;
                transpose_item(w_in + (size_t)L * DM * NIN, NIN, kb * 64, n0, nullptr, WIN + (size_t)L * NINP * DM, DM, n0 < NMIX ? n0 : n0 + (NMIXP - NMIX), scr, lane); continue; } r -= I_IN;
            if (r < I_UQ) { const int kb = r / 48, nb = r % 48;
                transpose_item(w_uq + (size_t)L * 512 * 1536, 1536, kb * 64, nb * 32, qng + L * 512, WUQ + (size_t)L * 1536 * 512, 512, nb * 32, scr, lane); continue; } r -= I_UQ;
            if (r < I_UKV) { const int kb = r / 64, nb = r % 64;
                transpose_item(w_ukv + (size_t)L * 256 * 2048, 2048, kb * 64, nb * 32, kvng + L * 256, WUKV + (size_t)L * 2048 * 256, 256, nb * 32, scr, lane); continue; } r -= I_UKV;
            if (r < I_BR) { const int n3 = r / 1024, rr = r % 1024, kb = rr / 64, nb = rr % 64;
                transpose_item(w_branch + ((size_t)L * 3 + n3) * 1024 * 2048, 2048, kb * 64, nb * 32, nullptr, WBR + ((size_t)L * 3 + n3) * 2048 * 1024, 1024, nb * 32, scr, lane); continue; } r -= I_BR;
            if (r < I_OUT) { const int kb = r / 64, nb = r % 64;
                transpose_item(w_out + (size_t)L * DM * DM, DM, kb * 64, nb * 32, nullptr, WOUT + (size_t)L * DM * DM, DM, nb * 32, scr, lane); continue; } r -= I_OUT;
            { const int db = r / 4, nb = r % 4;
              transpose_item(w_gate + ((size_t)L * 32 + db) * 64 * 128, 128, 0, nb * 32, nullptr, WG + ((size_t)L * 32 + db) * 128 * 64, 64, nb * 32, scr, lane); }
        }
        for (int i = bid * 512 + tid; i < DEPTH * (NMIXP - NMIX) * (DM / 8); i += G * 512) {
            const int L = i / ((NMIXP - NMIX) * (DM / 8)), r = i % ((NMIXP - NMIX) * (DM / 8));
            *(u32x4*)(WIN + ((size_t)L * NINP + NMIX) * DM + (size_t)r * 8) = (u32x4){0u, 0u, 0u, 0u};
        }
        __syncthreads();
        LAS float* sil = (LAS float*)(lds + 69632);
        LAS float* red = (LAS float*)(lds + 69632 + 40960);
        for (int i = tid; i < 5 * 2048; i += 512) { const float v = i < 4 * 2048 ? c_in[i] : cctx_in[i - 4 * 2048]; sil[i] = v * (1.f / (1.f + expf(-v))); }
        __syncthreads();
        for (int it = bid; it < DEPTH * 96; it += G) {
            const int L = it / 96, cb = it % 96, ksl = tid >> 6, col = cb * 64 + (tid & 63);
            float a5[5] = {0.f, 0.f, 0.f, 0.f, 0.f};
            const float* wp = ada_w + (size_t)L * DM * 6144 + col;
            for (int k = ksl * 256; k < ksl * 256 + 256; ++k) { const float w = wp[(size_t)k * 6144];
#pragma unroll
                for (int r = 0; r < 5; ++r) a5[r] += sil[r * 2048 + k] * w; }
#pragma unroll
            for (int r = 0; r < 5; ++r) red[(ksl * 5 + r) * 64 + (tid & 63)] = a5[r];
            __syncthreads();
            if (tid < 320) { const int r = tid >> 6, cc = tid & 63; float s = 0.f;
#pragma unroll
                for (int k = 0; k < 8; ++k) s += red[(k * 5 + r) * 64 + cc];
                MOD[((size_t)L * 5 + r) * 6144 + cb * 64 + cc] = s + ada_b[(size_t)L * 6144 + cb * 64 + cc]; }
            __syncthreads();
        }
        if (bid == G - 1) for (int i = tid; i < 1024; i += 512) { const int pos = i >> 4, k = i & 15;
            const float inv = 1.0f / powf(10000.f, (float)k * (1.f / 16.f)), ang = (float)pos * inv; ROPE[2 * i] = cosf(ang); ROPE[2 * i + 1] = sinf(ang); }
    }
    GRID_SYNC();

    for (int layer = 0; layer < DEPTH; ++layer) {
        const bool need_ctx = layer < DEPTH - 1;
        { PHASE_IDS
        for (int row = gw; row < MROWS; row += NGW) {
            const bool lat = row < NLAT;
            const float* src = (layer == 0) ? (lat ? x_in + (size_t)row * DM : ctx_in + (size_t)(row - NLAT) * DM) : XCUR + (size_t)row * DM;
            const float* mr = MOD + (size_t)layer * 5 * 6144 + (size_t)(lat ? (row >> 12) : 4) * 6144;
            f32x4 v[8]; float ss = 0.f;
#pragma unroll
            for (int jv = 0; jv < 8; ++jv) { v[jv] = *(const f32x4*)(src + 4 * (lane + 64 * jv)); ss += (v[jv][0] * v[jv][0] + v[jv][1] * v[jv][1]) + (v[jv][2] * v[jv][2] + v[jv][3] * v[jv][3]); }
            const float rinv = rsqrtf(wave_sum(ss, lane) * (1.f / DM) + EPS);
#pragma unroll
            for (int jv = 0; jv < 8; ++jv) { const int col = 4 * (lane + 64 * jv);
                const f32x4 gg = *(const f32x4*)(norm_g + layer * DM + col), sh = *(const f32x4*)(mr + col), sc = *(const f32x4*)(mr + 2048 + col);
                const f32x4 hh = (v[jv] * rinv * gg) * (sc + 1.f) + sh;
                u32x2 w; w.x = cvt_pk(hh[0], hh[1]); w.y = cvt_pk(hh[2], hh[3]); *(u32x2*)(HB + (size_t)row * DM + col) = w; }
        } }
        XSYNC();
        {
            PHASE_IDS
            pg8::Gemm g{HB, WIN + (size_t)layer * NINP * DM, DM, DM, DM, 0, 0}; pg8::Sched S; S.init(MROWS, NINP, G, bid, 1);
            EpiIn E{PMIX, GP, MG, RSQ};
            pg8::gemm_phase<EpiIn>(lds, g, S, E);
        }
        XSYNC();
        {
            {
            PHASE_IDS
            { pg8::Gemm g{PMIX, WUQ + (size_t)layer * 1536 * 512, NMIXP, 512, 512, 0, 0}; pg8::Sched S; S.init(MROWS, 1536, G, bid, 1);
              EpiQ E{QB, RSQ, ROPE}; pg8::gemm_phase<EpiQ>(lds, g, S, E); }
            { pg8::Gemm g{PMIX + 512, WUKV + (size_t)layer * 2048 * 256, NMIXP, 256, 256, 0, 0}; pg8::Sched S; S.init(MROWS, 2048, G, bid, 1);
              EpiKV E{KVB, RSQ}; pg8::gemm_phase<EpiKV>(lds, g, S, E); }
            }
            {
            PHASE_IDS
            for (int i = bid * 512 + tid; i < MROWS * 4; i += G * 512) {
                const int row = i >> 2, hf = (i >> 1) & 1, sub = i & 1;
                const bf16_t* src = PMIX + (size_t)row * NMIXP + O_KR + 32 * hf + 8 * sub;
                u32x4 a = *(const u32x4*)src, b2 = *(const u32x4*)(src + 16);
                if (row < NLAT) {
                    const int s = row & 4095, pos = hf ? (s & 63) : (s >> 6);
                    const float* cp = ROPE + (pos * 16 + 8 * sub) * 2;
                    float x1[8] = {bflo(a.x), bfhi(a.x), bflo(a.y), bfhi(a.y), bflo(a.z), bfhi(a.z), bflo(a.w), bfhi(a.w)};
                    float x2[8] = {bflo(b2.x), bfhi(b2.x), bflo(b2.y), bfhi(b2.y), bflo(b2.z), bfhi(b2.z), bflo(b2.w), bfhi(b2.w)};
                    float o1[8], o2[8];
#pragma unroll
                    for (int e = 0; e < 8; ++e) { const float cv = cp[2 * e], sv = cp[2 * e + 1]; o1[e] = x1[e] * cv - x2[e] * sv; o2[e] = x1[e] * sv + x2[e] * cv; }
                    a.x = cvt_pk(o1[0], o1[1]); a.y = cvt_pk(o1[2], o1[3]); a.z = cvt_pk(o1[4], o1[5]); a.w = cvt_pk(o1[6], o1[7]);
                    b2.x = cvt_pk(o2[0], o2[1]); b2.y = cvt_pk(o2[2], o2[3]); b2.z = cvt_pk(o2[4], o2[5]); b2.w = cvt_pk(o2[6], o2[7]);
                }
                bf16_t* dst = KRB + (size_t)row * 64 + 32 * hf + 8 * sub;
                *(u32x4*)dst = a; *(u32x4*)(dst + 16) = b2;
            }
            __syncthreads();
            lru_gate_phase(PMIX, WG + (size_t)layer * 32 * 128 * 64, conv_w + (size_t)layer * 4 * 1024, conv_b + (size_t)layer * 1024, b_gate + (size_t)layer * 2 * 2048, lam_in + (size_t)layer * 2 * 1024, LA, LU, bid, G, lds);
            }
        }
        XSYNC();
        {
            PHASE_IDS
            const int nmla = 512 + (need_ctx ? 32 : 0);
            for (int u0 = bid; u0 < nmla; u0 += G) {
                int u = u0;
                if (G == 256 && u0 < 512) { const int x = bid & 7, i = bid >> 3, r = u0 >> 8; u = ((r * 16 + x * 2 + (i >> 4)) << 4) | (i & 15); }
                if (u < 512) { const int b = u >> 7, h = (u >> 4) & 7, qb = u & 15;
                    mla::attn_unit(QB, KVB, KRB, GP, OB, b * 4096 + qb * 256, h, b * 4096, NLAT + b * 256, 64, 68, (char*)lds_raw); }
                else { const int b = (u - 512) >> 3, h = (u - 512) & 7;
                    mla::attn_unit(QB, KVB, KRB, GP, OB, NLAT + b * 256, h, 0, NLAT + b * 256, 0, 4, (char*)lds_raw); }
            }
            __syncthreads();
            const int nna = 8192 + (need_ctx ? 512 : 0);
            for (int it = gw; it < nna; it += NGW) na_item(PMIX, GP, OB, rel_bias + (size_t)layer * 16 * 15 * 31, it, lane, lds + wid * 5632);
            for (int it = bid; it < (NB * NCHUNK * 2 * 256) / 512; it += G) lru_pass1_item(LA, LU, AGG, it);
        }
        XSYNC();
        { PHASE_IDS
        for (int it = bid; it < NB * NCHUNK * 8; it += G) lru_pass3_item(LA, LU, AGG, GP, OB, it, lds); }
        XSYNC();
        {
            PHASE_IDS
            const int Mrows = need_ctx ? MROWS : NLAT;
            const bool fuse_ctx = need_ctx && G == 256;
            unsigned* ctr = (unsigned*)(args.ws + WS_BAR) + 3600 + layer * 4;
            pg8::Gemm g{OB, WBR + (size_t)layer * 3 * 2048 * 1024, 3072, 1024, 1024, 1024, (size_t)2048 * 1024}; pg8::Sched S; S.init(Mrows, DM, G, bid, 3); S.rot = fuse_ctx ? 1 : 0;
            EpiMerge E{MG, MTMP, HB, fuse_ctx ? ctr : nullptr}; pg8::gemm_phase<EpiMerge>(lds, g, S, E);
            if (fuse_ctx && bid >= 96 && bid < 128) {
                pg8::Sched S2; S2.init(1024, DM, G, bid - 96, 1); S2.pm0 = 64;
                pg8::Unit u0; (void)S2.next(0, u0);
                if (threadIdx.x == 0) { unsigned sp = 0; while (__hip_atomic_load(ctr + (u0.pm - 64), __ATOMIC_RELAXED, __HIP_MEMORY_SCOPE_AGENT) < 8u && ++sp < (1u << 22)) __builtin_amdgcn_s_sleep(1);
                    __builtin_amdgcn_fence(__ATOMIC_ACQUIRE, "agent"); asm volatile("buffer_inv sc1\n\ts_waitcnt vmcnt(0)" ::: "memory"); }
                __syncthreads();
                pg8::Gemm g2{HB, WOUT + (size_t)layer * DM * DM, DM, DM, DM, 0, 0};
                EpiOut E2{x_in, ctx_in, XCUR, MOD + (size_t)layer * 5 * 6144, layer}; pg8::gemm_phase<EpiOut>(lds, g2, S2, E2);
            }
        }
        XSYNC();
        {
            PHASE_IDS
            const int Mrows = (need_ctx && G != 256) ? MROWS : NLAT;
            pg8::Gemm g{HB, WOUT + (size_t)layer * DM * DM, DM, DM, DM, 0, 0}; pg8::Sched S; S.init(Mrows, DM, G, bid, 1);
            EpiOut E{x_in, ctx_in, XCUR, MOD + (size_t)layer * 5 * 6144, layer}; pg8::gemm_phase<EpiOut>(lds, g, S, E);
        }
        XSYNC();
    }
    { PHASE_IDS
    for (int row = gw; row < NLAT; row += NGW) {
        const float* src = XCUR + (size_t)row * DM;
        f32x4 v[8]; float ss = 0.f;
#pragma unroll
        for (int jv = 0; jv < 8; ++jv) { v[jv] = *(const f32x4*)(src + 4 * (lane + 64 * jv)); ss += (v[jv][0] * v[jv][0] + v[jv][1] * v[jv][1]) + (v[jv][2] * v[jv][2] + v[jv][3] * v[jv][3]); }
        const float rinv = rsqrtf(wave_sum(ss, lane) * (1.f / DM) + EPS);
#pragma unroll
        for (int jv = 0; jv < 8; ++jv) { const int col = 4 * (lane + 64 * jv); *(f32x4*)(args.out + (size_t)row * DM + col) = v[jv] * rinv * *(const f32x4*)(fng + col); }
    } }
}

extern "C" void kernel_launch(void* const* d_in, const int* in_sizes, int n_in, void* d_out, int out_size, void* d_ws, size_t ws_size, hipStream_t stream) {
    static int grid = 0;
    if (grid == 0) {
        if (n_in != 21 || ws_size < WS_END) { fprintf(stderr, "kernel_launch: n_in %d ws %zu (need %zu): nothing launched\n", n_in, ws_size, (size_t)WS_END); grid = -1; return; }
        int dev = 0, cus = 0, per_cu = 0;
        if (hipGetDevice(&dev) != hipSuccess || hipDeviceGetAttribute(&cus, hipDeviceAttributeMultiprocessorCount, dev) != hipSuccess) { grid = -1; return; }
        if (hipFuncSetAttribute((const void*)mk_fwd, hipFuncAttributeMaxDynamicSharedMemorySize, LDS_BYTES) != hipSuccess) { fprintf(stderr, "hipFuncSetAttribute failed\n"); grid = -1; return; }
        if (hipOccupancyMaxActiveBlocksPerMultiprocessor(&per_cu, (const void*)mk_fwd, 512, LDS_BYTES) != hipSuccess || per_cu < 1) { fprintf(stderr, "occupancy query: %d\n", per_cu); per_cu = 1; }
        (void)hipGetLastError();
        grid = cus * per_cu;
    }
    if (grid < 0) return;
    if (hipMemsetAsync((char*)d_ws + WS_BAR, 0, 16384, stream) != hipSuccess) { fprintf(stderr, "memset of barrier words failed\n"); return; }
    Args a{};
    for (int i = 0; i < 21; ++i) a.in[i] = (const float*)d_in[i];
    a.out = (float*)d_out; a.ws = (unsigned char*)d_ws;
    void* kargs[] = {&a};
    hipError_t e = hipLaunchCooperativeKernel((const void*)mk_fwd, dim3(grid), dim3(512), kargs, LDS_BYTES, stream);
    if (e != hipSuccess) fprintf(stderr, "cooperative launch failed: %s (grid %d)\n", hipGetErrorString(e), grid);
}
```

```cpp
#include <hip/hip_runtime.h>
#include <hip/hip_cooperative_groups.h>
#include <cstdio>
#include <cstdint>
namespace cg = cooperative_groups;

typedef unsigned short bf16_t;
typedef short bf16x8 __attribute__((ext_vector_type(8)));
typedef float f32x4 __attribute__((ext_vector_type(4)));
typedef float f32x16 __attribute__((ext_vector_type(16)));
typedef unsigned u32x4 __attribute__((ext_vector_type(4)));
typedef unsigned u32x2 __attribute__((ext_vector_type(2)));
#define LAS __attribute__((address_space(3)))

constexpr int DM = 2048, NB = 4, SEQ = 4096, NCTXT = 256, DEPTH = 4;
constexpr int NLAT = NB * SEQ, NCTX = NB * NCTXT, MROWS = NLAT + NCTX;
constexpr int NMIX = 4928, NMIXP = 5120, NGP = 3072, NMG = 6144, NINP = NMIXP + NGP + NMG, NIN = 14144;
constexpr int O_KR = 768, O_NAQ = 832, O_NAK = 1856, O_NAV = 2880, O_PX = 3904;
constexpr float EPS = 1e-6f, LOG2E = 1.4426950408889634f;
constexpr float C_MLA = 0.07216878364870322f * LOG2E;
constexpr float C_NA = 0.125f * LOG2E;
constexpr int NCHUNK = 68;

constexpr size_t al256(size_t x) { return (x + 255) / 256 * 256; }
constexpr size_t WS_WIN = 0;
constexpr size_t WS_WUQ = WS_WIN + al256((size_t)DEPTH * NINP * DM * 2);
constexpr size_t WS_WUKV = WS_WUQ + al256((size_t)DEPTH * 1536 * 512 * 2);
constexpr size_t WS_WBR = WS_WUKV + al256((size_t)DEPTH * 2048 * 256 * 2);
constexpr size_t WS_WOUT = WS_WBR + al256((size_t)DEPTH * 3 * 2048 * 1024 * 2);
constexpr size_t WS_WG = WS_WOUT + al256((size_t)DEPTH * 2048 * 2048 * 2);
constexpr size_t WS_MOD = WS_WG + al256((size_t)DEPTH * 2 * 16 * 128 * 64 * 2);
constexpr size_t WS_ROPE = WS_MOD + al256((size_t)DEPTH * 5 * 6144 * 4);
constexpr size_t WS_XCUR = WS_ROPE + al256((size_t)64 * 16 * 2 * 4);
constexpr size_t WS_H = WS_XCUR + al256((size_t)MROWS * DM * 4);
constexpr size_t WS_PMIX = WS_H + al256((size_t)MROWS * DM * 2);
constexpr size_t WS_GP = WS_PMIX + al256((size_t)MROWS * NMIXP * 2);
constexpr size_t WS_MG = WS_GP + al256((size_t)MROWS * NGP * 2);
constexpr size_t WS_RSQ = WS_MG + al256((size_t)MROWS * NMG * 2);
constexpr size_t WS_Q = WS_RSQ + al256((size_t)MROWS * 12 * 4);
constexpr size_t WS_KV = WS_Q + al256((size_t)MROWS * 1536 * 2);
constexpr size_t WS_KR = WS_KV + al256((size_t)MROWS * 2048 * 2);
constexpr size_t WS_LA = WS_KR + al256((size_t)MROWS * 64 * 2);
constexpr size_t WS_LU = WS_LA + al256((size_t)2 * MROWS * 1024 * 4);
constexpr size_t WS_AGG = WS_LU + al256((size_t)2 * MROWS * 1024 * 4);
constexpr size_t WS_O = WS_AGG + al256((size_t)2 * NB * NCHUNK * 1024 * 2 * 4);
constexpr size_t WS_BAR = WS_O + al256((size_t)MROWS * 3072 * 2);
constexpr size_t WS_END = WS_BAR + 16384;

constexpr int LDS_BYTES = 147456;

struct Args { const float* in[21]; float* out; unsigned char* ws; };

typedef float f32x2_t __attribute__((ext_vector_type(2))); typedef __bf16 bf16x2_t __attribute__((ext_vector_type(2)));
__device__ __forceinline__ unsigned cvt_pk(float lo, float hi) { f32x2_t v = {lo, hi}; bf16x2_t b = __builtin_convertvector(v, bf16x2_t); return __builtin_bit_cast(unsigned, b); }
__device__ __forceinline__ float bflo(unsigned u) { return __uint_as_float(u << 16); }
__device__ __forceinline__ float bfhi(unsigned u) { return __uint_as_float(u & 0xffff0000u); }
__device__ __forceinline__ float bf1(bf16_t u) { return __uint_as_float(((unsigned)u) << 16); }
__device__ __forceinline__ u32x4 pack8(f32x4 a, f32x4 b) { u32x4 w; w.x = cvt_pk(a[0], a[1]); w.y = cvt_pk(a[2], a[3]); w.z = cvt_pk(b[0], b[1]); w.w = cvt_pk(b[2], b[3]); return w; }
__device__ __forceinline__ float sigmoidf_(float x) { return __builtin_amdgcn_rcpf(1.f + __expf(-x)); }
__device__ __forceinline__ float shx(float v, int lane, int m) { return __int_as_float(__builtin_amdgcn_ds_bpermute((lane ^ m) << 2, __float_as_int(v))); }
__device__ __forceinline__ float wave_sum(float v, int lane) {
#pragma unroll
    for (int o = 1; o < 64; o <<= 1) v += shx(v, lane, o);
    return v;
}
__device__ __forceinline__ int opaque_v(int x) { asm volatile("" : "+v"(x)); return x; }
__device__ __forceinline__ int crow(int r, int hi) { return (r & 3) + 8 * (r >> 2) + 4 * hi; }

namespace pg8 {
constexpr int BM = 256, BK = 64, HALF = 128, HTB = HALF * BK * 2, NXCD = 8, WGM = 4;
__host__ __device__ __forceinline__ int lds_byte(int r, int c) { const int st = (r >> 4) * 2 + (c >> 5), rr = r & 15, cc = c & 31, ob = rr * 64 + cc * 2; return st * 1024 + (ob ^ (((ob >> 9) & 1) << 5)); }
__host__ __device__ __forceinline__ void stage_rc(int b, int& R, int& C) { const int st = b / 1024, sb = b % 1024, swz = sb ^ (((sb >> 9) & 1) << 5); R = (st >> 1) * 16 + swz / 64; C = (st & 1) * 32 + (swz % 64) / 2; }
__host__ __device__ __forceinline__ int perm32(int rho) { const int n = rho >> 4, i = rho & 15; return 8 * (i >> 2) + 4 * n + (i & 3); }

struct Unit { int pm, pn, z; };
struct Gemm { const bf16_t* A; const bf16_t* Bt; int lda, ldb, K; size_t azs, bzs; };

struct Sched {
    int nM, nN, nwg, G, c, nz, rot = 0, pm0 = 0;
    __device__ void init(int M, int N, int G_, int c_, int nz_) { nM = M / BM; nN = N / BM; nwg = nM * nN; G = G_; c = c_; nz = nz_; }
    __device__ bool next(int i, Unit& u) const {
        const int it = i / nz; u.z = i - it * nz;
        const long L = (long)it * G + c; if (L >= nwg) return false;
        int wgid = (int)L; { const int q = nwg / NXCD, r = nwg % NXCD, xcd = wgid % NXCD, off = wgid / NXCD; wgid = (xcd < r ? xcd * (q + 1) : r * (q + 1) + (xcd - r) * q) + off; }
        const int nig = WGM * nN, gid = wgid / nig, fm = gid * WGM, gsz = (nM - fm) < WGM ? (nM - fm) : WGM;
        u.pm = fm + ((wgid % nig) % gsz); u.pn = (wgid % nig) / gsz;
        if (rot) u.pm = (u.pm < 4) ? nM - 4 + u.pm : u.pm - 4;
        u.pm += pm0; return true;
    }
};

template <class Epi>
__device__ __forceinline__ void gemm_phase(LAS unsigned char* lds, const Gemm g, const Sched& S, const Epi& E) {
    const int tid = opaque_v(threadIdx.x), wid = __builtin_amdgcn_readfirstlane(tid >> 6), lane = tid & 63, wr = wid >> 2, wc = wid & 3, fr = lane & 15, fq = lane >> 4;
    const int K = g.K, nt = K / BK;
    unsigned voffA[2], voffB[2];
#pragma unroll
    for (int i = 0; i < 2; ++i) { int R, C; stage_rc(tid * 16 + i * 8192, R, C); const int Rb = (R & ~31) + perm32(R & 31);
        voffA[i] = (unsigned)(R * g.lda + C) * 2u; voffB[i] = (unsigned)(Rb * g.ldb + C) * 2u; }
    const size_t kstep = (size_t)(BK * 2);
    const size_t hstepA = (size_t)HALF * g.lda * 2, hstepB = (size_t)HALF * g.ldb * 2;
    const unsigned ldsw = (unsigned)wid * 1024u;
    const int aoff = lds_byte(wr * 64 + fr, fq * 8), boff = lds_byte(wc * 32 + fr, fq * 8);
#define PG8_SA(b, h) (((b) * 2 + (h)) * HTB)
#define PG8_SB(b, h) ((4 + (b) * 2 + (h)) * HTB)
#define PG8_STAGE(bufoff, gbase, voff) do { _Pragma("unroll") for (int _i = 0; _i < 2; ++_i) \
        __builtin_amdgcn_global_load_lds((const unsigned*)((const char*)(gbase) + (voff)[_i]), (LAS unsigned*)(lds + (bufoff) + ldsw + _i * 8192), 16, 0, 0); } while (0)
#define PG8_LDA(dst, b, h) do { _Pragma("unroll") for (int m = 0; m < 4; ++m) _Pragma("unroll") for (int k = 0; k < 2; ++k) dst[m][k] = *(const LAS bf16x8*)(lds + PG8_SA(b, h) + aoff + m * 2048 + k * 1024); } while (0)
#define PG8_LDB(dst, b, h) do { _Pragma("unroll") for (int n = 0; n < 2; ++n) _Pragma("unroll") for (int k = 0; k < 2; ++k) dst[n][k] = *(const LAS bf16x8*)(lds + PG8_SB(b, h) + boff + n * 2048 + k * 1024); } while (0)
#define PG8_MMA(ai, bj, At, Bt) do { __builtin_amdgcn_s_setprio(1); _Pragma("unroll") for (int m = 0; m < 4; ++m) _Pragma("unroll") for (int n = 0; n < 2; ++n) _Pragma("unroll") for (int k = 0; k < 2; ++k) \
        acc[ai][bj][m][n] = __builtin_amdgcn_mfma_f32_16x16x32_bf16(Bt[n][k], At[m][k], acc[ai][bj][m][n], 0, 0, 0); __builtin_amdgcn_s_setprio(0); } while (0)
#define PG8_WAIT_V(n) asm volatile("s_waitcnt vmcnt(" #n ")" ::: "memory")
#define PG8_WAIT_L(n) asm volatile("s_waitcnt lgkmcnt(" #n ")" ::: "memory")
#define PG8_BAR __builtin_amdgcn_s_barrier()
#define PG8_SCHED __builtin_amdgcn_sched_barrier(0)
    Unit cur, nxt; int ui = 0;
    if (!S.next(0, cur)) return;
    f32x4 acc[2][2][4][2];
#pragma unroll
    for (int a = 0; a < 2; ++a)
#pragma unroll
        for (int b = 0; b < 2; ++b)
#pragma unroll
            for (int m = 0; m < 4; ++m)
#pragma unroll
                for (int n = 0; n < 2; ++n) acc[a][b][m][n] = (f32x4){0.f, 0.f, 0.f, 0.f};
    bf16x8 At[4][2], B0[2][2], B1[2][2];
    const char* cA = (const char*)g.A + ((size_t)cur.z * g.azs + (size_t)cur.pm * BM * g.lda) * 2;
    const char* cB = (const char*)g.Bt + ((size_t)cur.z * g.bzs + (size_t)cur.pn * BM * g.ldb) * 2;
    PG8_STAGE(PG8_SB(0, 0), cB, voffB); PG8_STAGE(PG8_SB(0, 1), cB + hstepB, voffB); PG8_STAGE(PG8_SA(0, 0), cA, voffA); PG8_STAGE(PG8_SA(0, 1), cA + hstepA, voffA);
    if (wr == 1) PG8_BAR;
    PG8_WAIT_V(2); PG8_BAR;
    PG8_STAGE(PG8_SB(1, 0), cB + kstep, voffB); PG8_STAGE(PG8_SA(1, 0), cA + kstep, voffA); PG8_STAGE(PG8_SB(1, 1), cB + hstepB + kstep, voffB);
    PG8_WAIT_V(6); PG8_BAR;
    for (;;) {
        const bool has_next = S.next(ui + 1, nxt);
        const char* nA = has_next ? (const char*)g.A + ((size_t)nxt.z * g.azs + (size_t)nxt.pm * BM * g.lda) * 2 : cA;
        const char* nB = has_next ? (const char*)g.Bt + ((size_t)nxt.z * g.bzs + (size_t)nxt.pn * BM * g.ldb) * 2 : cB;
        for (int t = 0; t < nt; t += 2) {
            const bool last = (t == nt - 2);
            const char* a1 = cA + (size_t)(t + 1) * kstep;
            const char* a2 = last ? nA : cA + (size_t)(t + 2) * kstep; const char* b2 = last ? nB : cB + (size_t)(t + 2) * kstep;
            const char* a3 = a2 + kstep; const char* b3 = b2 + kstep;
            PG8_LDB(B0, 0, 0); PG8_LDB(B1, 0, 1); PG8_SCHED; PG8_LDA(At, 0, 0); PG8_STAGE(PG8_SA(1, 1), a1 + hstepA, voffA);
            PG8_WAIT_V(8); PG8_WAIT_L(0); PG8_BAR; PG8_MMA(0, 0, At, B0); PG8_MMA(0, 1, At, B1); PG8_BAR; PG8_SCHED;
            PG8_LDA(At, 0, 1); PG8_STAGE(PG8_SB(0, 0), b2, voffB); PG8_STAGE(PG8_SB(0, 1), b2 + hstepB, voffB); PG8_STAGE(PG8_SA(0, 0), a2, voffA);
            PG8_WAIT_V(8); PG8_WAIT_L(0); PG8_BAR; PG8_MMA(1, 0, At, B0); PG8_MMA(1, 1, At, B1); PG8_BAR; PG8_SCHED;
            PG8_LDB(B0, 1, 0); PG8_LDB(B1, 1, 1); PG8_SCHED; PG8_LDA(At, 1, 0); PG8_STAGE(PG8_SA(0, 1), a2 + hstepA, voffA);
            PG8_WAIT_V(8); PG8_WAIT_L(0); PG8_BAR; PG8_MMA(0, 0, At, B0); PG8_MMA(0, 1, At, B1); PG8_BAR; PG8_SCHED;
            PG8_LDA(At, 1, 1); PG8_STAGE(PG8_SB(1, 0), b3, voffB); PG8_STAGE(PG8_SB(1, 1), b3 + hstepB, voffB); PG8_STAGE(PG8_SA(1, 0), a3, voffA);
            PG8_WAIT_V(8); PG8_WAIT_L(0); PG8_BAR; PG8_MMA(1, 0, At, B0); PG8_MMA(1, 1, At, B1); PG8_BAR; PG8_SCHED;
        }
        if (wr == 0) PG8_BAR;
        { const int l2 = opaque_v(lane); E(acc, cur, wr, wc, l2 & 15, l2 >> 4); }
        if (!has_next) break;
#pragma unroll
        for (int a = 0; a < 2; ++a)
#pragma unroll
            for (int b = 0; b < 2; ++b)
#pragma unroll
                for (int m = 0; m < 4; ++m)
#pragma unroll
                    for (int n = 0; n < 2; ++n) acc[a][b][m][n] = (f32x4){0.f, 0.f, 0.f, 0.f};
        cur = nxt; cA = nA; cB = nB; ++ui;
        if (wr == 1) PG8_BAR;
    }
    PG8_WAIT_V(0);
    PG8_BAR;
#undef PG8_SA
#undef PG8_SB
#undef PG8_STAGE
#undef PG8_LDA
#undef PG8_LDB
#undef PG8_MMA
#undef PG8_WAIT_V
#undef PG8_WAIT_L
#undef PG8_BAR
#undef PG8_SCHED
}
}
typedef f32x4 AccT[2][2][4][2];
#define EPI_FENCE(a, b) asm volatile("" : "+v"(a), "+v"(b) :: "memory")

struct EpiIn {
    bf16_t* pmix; bf16_t* gp; bf16_t* mg; float* rsq;
    __device__ __forceinline__ void operator()(const AccT& acc, const pg8::Unit& u, int wr, int wc, int fr, int fq) const {
        const int row0 = u.pm * 256 + wr * 64 + fr, pn = u.pn;
        if (pn < 20) {
#pragma unroll
            for (int ai = 0; ai < 2; ++ai)
#pragma unroll
                for (int m = 0; m < 4; ++m) {
                    __builtin_amdgcn_sched_barrier(0); const int row = row0 + ai * 128 + m * 16; float ss = 0.f;
#pragma unroll
                    for (int bj = 0; bj < 2; ++bj) {
                        const int col0 = pn * 256 + bj * 128 + wc * 32 + 8 * fq;
                        f32x4 v0 = acc[ai][bj][m][0], v1 = acc[ai][bj][m][1]; EPI_FENCE(v0, v1);
                        ss += (v0[0] * v0[0] + v0[1] * v0[1]) + (v0[2] * v0[2] + v0[3] * v0[3]) + (v1[0] * v1[0] + v1[1] * v1[1]) + (v1[2] * v1[2] + v1[3] * v1[3]);
                        const float sc = (col0 >= O_NAQ && col0 < O_NAK) ? C_NA : 1.f;
                        __builtin_nontemporal_store(pack8(v0 * sc, v1 * sc), (u32x4*)(pmix + (size_t)row * NMIXP + col0));
                    }
                    if (pn < 3) { ss += shx(ss, fr + 16 * fq, 16); ss += shx(ss, fr + 16 * fq, 32); if (fq == 0) rsq[(size_t)row * 12 + pn * 4 + wc] = ss; }
                }
        } else if (pn < 32) {
#pragma unroll
            for (int ai = 0; ai < 2; ++ai)
#pragma unroll
                for (int m = 0; m < 4; ++m) {
                    __builtin_amdgcn_sched_barrier(0); const int row = row0 + ai * 128 + m * 16;
#pragma unroll
                    for (int bj = 0; bj < 2; ++bj) {
                        const int col0 = (pn - 20) * 256 + bj * 128 + wc * 32 + 8 * fq;
                        f32x4 v0 = acc[ai][bj][m][0], v1 = acc[ai][bj][m][1]; EPI_FENCE(v0, v1);
#pragma unroll
                        for (int e = 0; e < 4; ++e) { v0[e] = v0[e] * sigmoidf_(v0[e]); v1[e] = v1[e] * sigmoidf_(v1[e]); }
                        __builtin_nontemporal_store(pack8(v0, v1), (u32x4*)(gp + (size_t)row * NGP + col0));
                    }
                }
        } else {
#pragma unroll
            for (int ai = 0; ai < 2; ++ai)
#pragma unroll
                for (int m = 0; m < 4; ++m) {
                    __builtin_amdgcn_sched_barrier(0); const int row = row0 + ai * 128 + m * 16;
#pragma unroll
                    for (int bj = 0; bj < 2; ++bj) {
                        const int col0 = (pn - 32) * 256 + bj * 128 + wc * 32 + 8 * fq;
                        f32x4 v0 = acc[ai][bj][m][0], v1 = acc[ai][bj][m][1]; EPI_FENCE(v0, v1);
#pragma unroll
                        for (int e = 0; e < 4; ++e) { v0[e] = sigmoidf_(v0[e]); v1[e] = sigmoidf_(v1[e]); }
                        __builtin_nontemporal_store(pack8(v0, v1), (u32x4*)(mg + (size_t)row * NMG + col0));
                    }
                }
        }
    }
};
struct EpiQ {
    bf16_t* q; const float* rsq; const float* cs;
    __device__ __forceinline__ void operator()(const AccT& acc, const pg8::Unit& u, int wr, int wc, int fr, int fq) const {
        const int row0 = u.pm * 256 + wr * 64 + fr, pn = u.pn; const bool lat = u.pm < 64;
#pragma unroll
        for (int ai = 0; ai < 2; ++ai) {
          float rinv4[4];
          { f32x4 ra[4], rb[4];
#pragma unroll
            for (int i = 0; i < 4; ++i) { const int row = row0 + ai * 128 + i * 16; ra[i] = *(const f32x4*)(rsq + (size_t)row * 12); rb[i] = *(const f32x4*)(rsq + (size_t)row * 12 + 4); }
#pragma unroll
            for (int i = 0; i < 4; ++i) rinv4[i] = rsqrtf((((ra[i][0] + ra[i][1]) + (ra[i][2] + ra[i][3])) + ((rb[i][0] + rb[i][1]) + (rb[i][2] + rb[i][3]))) * (1.f / 512.f) + EPS) * C_MLA; }
#pragma unroll
            for (int m = 0; m < 4; ++m) {
                __builtin_amdgcn_sched_barrier(0); const int row = row0 + ai * 128 + m * 16;
                const float rinv = rinv4[m];
                const int s = row & 4095;
#pragma unroll
                for (int bj = 0; bj < 2; ++bj) {
                    const int g32 = pn * 8 + bj * 4 + wc, t6 = g32 % 6, col0 = g32 * 32 + 8 * fq;
                    f32x4 v0 = acc[ai][bj][m][0], v1 = acc[ai][bj][m][1]; EPI_FENCE(v0, v1); v0 = v0 * rinv; v1 = v1 * rinv;
                    if (t6 >= 4 && lat) {
                        const int pos = (t6 == 4) ? (s >> 6) : (s & 63);
                        const float* cp = cs + (pos * 16 + 8 * (fq & 1)) * 2;
                        const f32x4 c0 = *(const f32x4*)(cp), c1 = *(const f32x4*)(cp + 4), c2 = *(const f32x4*)(cp + 8), c3 = *(const f32x4*)(cp + 12);
                        const float cosv[8] = {c0[0], c0[2], c1[0], c1[2], c2[0], c2[2], c3[0], c3[2]};
                        const float sinv[8] = {c0[1], c0[3], c1[1], c1[3], c2[1], c2[3], c3[1], c3[3]};
                        float x[8] = {v0[0], v0[1], v0[2], v0[3], v1[0], v1[1], v1[2], v1[3]};
#pragma unroll
                        for (int e = 0; e < 8; ++e) { const float p = shx(x[e], fr + 16 * fq, 32); x[e] = (fq < 2) ? (x[e] * cosv[e] - p * sinv[e]) : (p * sinv[e] + x[e] * cosv[e]); }
                        v0 = (f32x4){x[0], x[1], x[2], x[3]}; v1 = (f32x4){x[4], x[5], x[6], x[7]};
                    }
                    *(u32x4*)(q + (size_t)row * 1536 + col0) = pack8(v0, v1);
                }
            }
        }
    }
};
struct EpiKV {
    bf16_t* kv; const float* rsq;
    __device__ __forceinline__ void operator()(const AccT& acc, const pg8::Unit& u, int wr, int wc, int fr, int fq) const {
        const int row0 = u.pm * 256 + wr * 64 + fr, pn = u.pn;
#pragma unroll
        for (int ai = 0; ai < 2; ++ai) {
          float rinv4[4];
          { f32x4 ra[4];
#pragma unroll
            for (int i = 0; i < 4; ++i) { const int row = row0 + ai * 128 + i * 16; ra[i] = *(const f32x4*)(rsq + (size_t)row * 12 + 8); }
#pragma unroll
            for (int i = 0; i < 4; ++i) rinv4[i] = rsqrtf(((ra[i][0] + ra[i][1]) + (ra[i][2] + ra[i][3])) * (1.f / 256.f) + EPS); }
#pragma unroll
            for (int m = 0; m < 4; ++m) {
                __builtin_amdgcn_sched_barrier(0); const int row = row0 + ai * 128 + m * 16;
                const float rinv = rinv4[m];
#pragma unroll
                for (int bj = 0; bj < 2; ++bj) {
                    const int col0 = pn * 256 + bj * 128 + wc * 32 + 8 * fq;
                    f32x4 v0 = acc[ai][bj][m][0], v1 = acc[ai][bj][m][1]; EPI_FENCE(v0, v1);
                    *(u32x4*)(kv + (size_t)row * 2048 + col0) = pack8(v0 * rinv, v1 * rinv);
                }
            }
        }
    }
};
struct EpiMerge {
    const bf16_t* mg; float* tmp; bf16_t* merged; unsigned* ctr;
    __device__ __forceinline__ void operator()(const AccT& acc, const pg8::Unit& u, int wr, int wc, int fr, int fq) const {
        const int row0 = u.pm * 256 + wr * 64 + fr, pn = u.pn, z = u.z;
#pragma unroll
        for (int ai = 0; ai < 2; ++ai) {
            u32x4 gw8[8], pw8[8];
#pragma unroll
            for (int i = 0; i < 8; ++i) { const int row = row0 + ai * 128 + (i >> 1) * 16, col0 = pn * 256 + (i & 1) * 128 + wc * 32 + 8 * fq;
                gw8[i] = *(const u32x4*)(mg + (size_t)row * NMG + z * 2048 + col0);
                pw8[i] = (z > 0) ? *(const u32x4*)(merged + (size_t)row * 2048 + col0) : (u32x4){0u, 0u, 0u, 0u}; }
#pragma unroll
            for (int i = 0; i < 8; ++i) { const int m = i >> 1, bj = i & 1; const int row = row0 + ai * 128 + m * 16, col0 = pn * 256 + bj * 128 + wc * 32 + 8 * fq;
                f32x4 v0 = acc[ai][bj][m][0], v1 = acc[ai][bj][m][1]; EPI_FENCE(v0, v1);
                const u32x4 gw = gw8[i], pw = pw8[i];
                v0[0] = v0[0] * bflo(gw.x) + bflo(pw.x); v0[1] = v0[1] * bfhi(gw.x) + bfhi(pw.x); v0[2] = v0[2] * bflo(gw.y) + bflo(pw.y); v0[3] = v0[3] * bfhi(gw.y) + bfhi(pw.y);
                v1[0] = v1[0] * bflo(gw.z) + bflo(pw.z); v1[1] = v1[1] * bfhi(gw.z) + bfhi(pw.z); v1[2] = v1[2] * bflo(gw.w) + bflo(pw.w); v1[3] = v1[3] * bfhi(gw.w) + bfhi(pw.w);
                *(u32x4*)(merged + (size_t)row * 2048 + col0) = pack8(v0, v1); }
        }
        if (ctr && z == 2 && u.pm >= 64) {
            asm volatile("s_waitcnt vmcnt(0)" ::: "memory"); __builtin_amdgcn_s_barrier();
            if (threadIdx.x == 0) { __builtin_amdgcn_fence(__ATOMIC_RELEASE, "agent"); asm volatile("s_waitcnt vmcnt(0)" ::: "memory");
                (void)__hip_atomic_fetch_add(ctr + (u.pm - 64), 1u, __ATOMIC_RELAXED, __HIP_MEMORY_SCOPE_AGENT); }
        }
    }
};
struct EpiOut {
    const float* xin; const float* ctxin; float* xcur; const float* mod; int layer;
    __device__ __forceinline__ void operator()(const AccT& acc, const pg8::Unit& u, int wr, int wc, int fr, int fq) const {
        const int row0 = u.pm * 256 + wr * 64 + fr, pn = u.pn; const bool lat = u.pm < 64;
        const float* gt = mod + (size_t)(lat ? (u.pm >> 4) : 4) * 6144 + 4096;
#pragma unroll
        for (int hq = 0; hq < 4; ++hq) {
            const int ai = hq >> 1, m0 = (hq & 1) * 2;
            f32x4 xa[4], xb[4];
#pragma unroll
            for (int i = 0; i < 4; ++i) { const int row = row0 + ai * 128 + (m0 + (i >> 1)) * 16, col0 = pn * 256 + (i & 1) * 128 + wc * 32 + 8 * fq;
                const float* xo = (layer == 0) ? (lat ? xin + (size_t)row * 2048 : ctxin + (size_t)(row - NLAT) * 2048) : xcur + (size_t)row * 2048;
                xa[i] = *(const f32x4*)(xo + col0); xb[i] = *(const f32x4*)(xo + col0 + 4); }
#pragma unroll
            for (int i = 0; i < 4; ++i) { const int m = m0 + (i >> 1), bj = i & 1; const int row = row0 + ai * 128 + m * 16, col0 = pn * 256 + bj * 128 + wc * 32 + 8 * fq;
                f32x4 v0 = acc[ai][bj][m][0], v1 = acc[ai][bj][m][1]; EPI_FENCE(v0, v1);
                const f32x4 g0 = *(const f32x4*)(gt + col0), g1 = *(const f32x4*)(gt + col0 + 4);
                *(f32x4*)(xcur + (size_t)row * 2048 + col0) = xa[i] + g0 * v0;
                *(f32x4*)(xcur + (size_t)row * 2048 + col0 + 4) = xb[i] + g1 * v1; }
        }
    }
};

namespace mla {
typedef short s16x4 __attribute__((ext_vector_type(4)));
constexpr int SHM_V = 16384, SHM_K = 16384, SHM_KR = 8192;
constexpr int OFF_V = 0, OFF_K = 2 * SHM_V, OFF_KR = OFF_K + 2 * SHM_K, OFF_WS = OFF_KR + 2 * SHM_KR;
constexpr float THR2 = 8.f;
#define KSWZ(row, colB) ((row) * 256 + ((colB) ^ (((row) & 15) << 4)))
#define KRSWZ(row, colB) ((row) * 128 + ((colB) ^ ((((row) >> 1) & 7) << 4)))
#define SBAR() __builtin_amdgcn_sched_barrier(0)
__device__ __forceinline__ void partialSM(f32x16& p0, f32x16& p1, float& m_reg, float& mn, float& alpha) {
    float pmax = p0[0];
#pragma unroll
    for (int r = 1; r < 16; ++r) pmax = fmaxf(pmax, p0[r]);
#pragma unroll
    for (int r = 0; r < 16; ++r) pmax = fmaxf(pmax, p1[r]);
    { auto rr = __builtin_amdgcn_permlane32_swap(__float_as_uint(pmax), __float_as_uint(pmax), false, false);
      pmax = fmaxf(__uint_as_float(rr[0]), __uint_as_float(rr[1])); }
    if (__builtin_expect(__all(pmax - m_reg <= THR2), 1)) { mn = m_reg; alpha = 1.f; }
    else { mn = fmaxf(m_reg, pmax); alpha = __builtin_amdgcn_exp2f(m_reg - mn); m_reg = mn; }
#pragma unroll
    for (int r = 0; r < 16; ++r) p0[r] = p0[r] - mn;
#pragma unroll
    for (int r = 0; r < 16; ++r) p1[r] = p1[r] - mn;
#pragma unroll
    for (int r = 0; r < 16; ++r) p0[r] = __builtin_amdgcn_exp2f(p0[r]);
}
__device__ __forceinline__ void finishSM(f32x16& p0, f32x16& p1, float alpha, float& l_reg, bf16x8& pa0, bf16x8& pa1, bf16x8& pa2, bf16x8& pa3) {
#pragma unroll
    for (int r = 0; r < 16; ++r) p1[r] = __builtin_amdgcn_exp2f(p1[r]);
    float ps = 0;
#pragma unroll
    for (int r = 0; r < 16; ++r) ps += p0[r];
#pragma unroll
    for (int r = 0; r < 16; ++r) ps += p1[r];
    { auto rr = __builtin_amdgcn_permlane32_swap(__float_as_uint(ps), __float_as_uint(ps), false, false);
      ps = __uint_as_float(rr[0]) + __uint_as_float(rr[1]); }
    l_reg = l_reg * alpha + ps;
#define PK4(P, BASE, OUT) do { unsigned a0 = cvt_pk(P[BASE + 0], P[BASE + 1]), a1 = cvt_pk(P[BASE + 2], P[BASE + 3]);   \
    unsigned b0 = cvt_pk(P[BASE + 4], P[BASE + 5]), b1 = cvt_pk(P[BASE + 6], P[BASE + 7]);                              \
    auto r0 = __builtin_amdgcn_permlane32_swap(a0, b0, false, false); auto r1 = __builtin_amdgcn_permlane32_swap(a1, b1, false, false); \
    u32x4 w = {r0[0], r1[0], r0[1], r1[1]}; OUT = *reinterpret_cast<bf16x8*>(&w); } while (0)
    PK4(p0, 0, pa0); PK4(p0, 8, pa1); PK4(p1, 0, pa2); PK4(p1, 8, pa3);
#undef PK4
}
__device__ __forceinline__ void qkt(f32x16& p0, f32x16& p1, const char* Ks, const char* KRs, const bf16x8* qr, int r32, int hi) {
    p0 = f32x16{}; p1 = f32x16{};
#pragma unroll
    for (int d0 = 0; d0 < 8; ++d0) { const int cb = (d0 * 16 + hi * 8) * 2;
        bf16x8 b0 = *reinterpret_cast<const bf16x8*>(Ks + KSWZ(r32, cb));
        bf16x8 b1 = *reinterpret_cast<const bf16x8*>(Ks + KSWZ(32 + r32, cb));
        p0 = __builtin_amdgcn_mfma_f32_32x32x16_bf16(b0, qr[d0], p0, 0, 0, 0);
        p1 = __builtin_amdgcn_mfma_f32_32x32x16_bf16(b1, qr[d0], p1, 0, 0, 0); }
#pragma unroll
    for (int d0 = 0; d0 < 4; ++d0) { const int cb = (d0 * 16 + hi * 8) * 2;
        bf16x8 b0 = *reinterpret_cast<const bf16x8*>(KRs + KRSWZ(r32, cb));
        bf16x8 b1 = *reinterpret_cast<const bf16x8*>(KRs + KRSWZ(32 + r32, cb));
        p0 = __builtin_amdgcn_mfma_f32_32x32x16_bf16(b0, qr[8 + d0], p0, 0, 0, 0);
        p1 = __builtin_amdgcn_mfma_f32_32x32x16_bf16(b1, qr[8 + d0], p1, 0, 0, 0); }
}
__device__ __forceinline__ int v_st(int k, int c) { const int kk = (k & ~0xC) | ((k & 4) << 1) | ((k & 8) >> 1); return ((kk >> 3) * 4 + (c >> 5)) * 512 + ((kk & 7) * 32 + (c & 31)) * 2; }
__device__ __forceinline__ int v_rd_base(int lane) { return ((lane & 3) << 3) | (((lane >> 2) & 3) << 6) | (((lane >> 4) & 1) << 5) | (((lane >> 5) & 1) << 8); }
constexpr int v_rd_off(int d0, int ks, int half) { return d0 * 512 + ks * 4096 + half * 2048; }
template <int OFF> __device__ __forceinline__ s16x4 tr_read(int vb) {
    s16x4 r; asm volatile("ds_read_b64_tr_b16 %0, %1 offset:%2" : "=&v"(r) : "v"(vb), "i"(OFF) : "memory"); return r;
}
template <int D0> __device__ __forceinline__ void pv_one(f32x16& od, int vb, bf16x8 pa0, bf16x8 pa1, bf16x8 pa2, bf16x8 pa3) {
    const s16x4 l0 = tr_read<v_rd_off(D0, 0, 0)>(vb), h0 = tr_read<v_rd_off(D0, 0, 1)>(vb), l1 = tr_read<v_rd_off(D0, 1, 0)>(vb), h1 = tr_read<v_rd_off(D0, 1, 1)>(vb);
    const s16x4 l2 = tr_read<v_rd_off(D0, 2, 0)>(vb), h2 = tr_read<v_rd_off(D0, 2, 1)>(vb), l3 = tr_read<v_rd_off(D0, 3, 0)>(vb), h3 = tr_read<v_rd_off(D0, 3, 1)>(vb);
    asm volatile("s_waitcnt lgkmcnt(0)" ::: "memory"); SBAR();
#define PK(L, H) (bf16x8){L[0], L[1], L[2], L[3], H[0], H[1], H[2], H[3]}
    od = __builtin_amdgcn_mfma_f32_32x32x16_bf16(pa0, PK(l0, h0), od, 0, 0, 0);
    od = __builtin_amdgcn_mfma_f32_32x32x16_bf16(pa1, PK(l1, h1), od, 0, 0, 0);
    od = __builtin_amdgcn_mfma_f32_32x32x16_bf16(pa2, PK(l2, h2), od, 0, 0, 0);
    od = __builtin_amdgcn_mfma_f32_32x32x16_bf16(pa3, PK(l3, h3), od, 0, 0, 0);
#undef PK
}
__device__ __forceinline__ void pv_d0(f32x16* o, int vb, bf16x8 pa0, bf16x8 pa1, bf16x8 pa2, bf16x8 pa3) {
    pv_one<0>(o[0], vb, pa0, pa1, pa2, pa3); pv_one<1>(o[1], vb, pa0, pa1, pa2, pa3); pv_one<2>(o[2], vb, pa0, pa1, pa2, pa3); pv_one<3>(o[3], vb, pa0, pa1, pa2, pa3);
}
__device__ __forceinline__ void attn_unit(const bf16_t* __restrict__ Q, const bf16_t* __restrict__ KV, const bf16_t* __restrict__ KR, const bf16_t* __restrict__ GP, bf16_t* __restrict__ O,
                                          int qrow0, int h, int latbase, int ctxbase, int nlt, int NT, char* lds) {
    const int tid = opaque_v(threadIdx.x), wid = tid >> 6, lane = tid & 63, r32 = lane & 31, hi = lane >> 5;
    char* V_lds = lds + OFF_V; char* K_lds = lds + OFF_K; char* KR_lds = lds + OFF_KR;
    float* ws = (float*)(lds + OFF_WS) + wid * 64; float* li_l = ws; float* al_l = ws + 32;
    float m_reg = -1e30f, l_reg = 0; f32x16 o[4] = {}; bf16x8 qr[12];
    const bf16_t* Qw = Q + (size_t)(qrow0 + wid * 32 + r32) * 1536 + h * 192 + hi * 8;
#pragma unroll
    for (int d0 = 0; d0 < 12; ++d0) qr[d0] = *reinterpret_cast<const bf16x8*>(Qw + d0 * 16);
    const int sr = tid >> 4, sc = (tid & 15) * 8, vst0 = v_st(sr, sc), vst1 = v_st(32 + sr, sc);
    const int krr = tid >> 3, krc = (tid & 7) * 16;
    const int vb0 = (int)(uintptr_t)V_lds + v_rd_base(lane);
    const bf16_t* Kh = KV + h * 256 + sc; const bf16_t* Vh = KV + h * 256 + 128 + sc;
    bf16x8 s_v0, s_v1, s_k0, s_k1, s_kr;
#define TROW(j) ((j) < nlt ? latbase + 64 * (j) : ctxbase + 64 * ((j) - nlt))
#define SLOAD(j) do { const int _rb = TROW(j); \
    s_v0 = *reinterpret_cast<const bf16x8*>(Vh + (size_t)(_rb + sr) * 2048); s_v1 = *reinterpret_cast<const bf16x8*>(Vh + (size_t)(_rb + 32 + sr) * 2048); \
    s_k0 = *reinterpret_cast<const bf16x8*>(Kh + (size_t)(_rb + sr) * 2048); s_k1 = *reinterpret_cast<const bf16x8*>(Kh + (size_t)(_rb + 32 + sr) * 2048); \
    s_kr = *reinterpret_cast<const bf16x8*>((const char*)KR + (size_t)(_rb + krr) * 128 + krc); } while (0)
#define SWRITE(b) do { *(bf16x8*)(V_lds + (b) * SHM_V + vst0) = s_v0; *(bf16x8*)(V_lds + (b) * SHM_V + vst1) = s_v1; const int kc = sc * 2; \
    *(bf16x8*)(K_lds + (b) * SHM_K + KSWZ(sr, kc)) = s_k0; *(bf16x8*)(K_lds + (b) * SHM_K + KSWZ(32 + sr, kc)) = s_k1; \
    *(bf16x8*)(KR_lds + (b) * SHM_KR + KRSWZ(krr, krc)) = s_kr; } while (0)
#define RESC(a) do { if (__any((a) < 1.f)) { if (hi == 0) al_l[r32] = (a); asm volatile("s_waitcnt lgkmcnt(0)" ::: "memory"); \
    _Pragma("unroll") for (int d = 0; d < 4; ++d) _Pragma("unroll") for (int r = 0; r < 16; ++r) o[d][r] *= al_l[crow(r, hi)]; } } while (0)
    f32x16 pA0, pA1, pB0, pB1; float mnA, mnB, alA, alB; bf16x8 pa0, pa1, pa2, pa3;
    SLOAD(0); asm volatile("s_waitcnt vmcnt(0)" ::: "memory"); SWRITE(0); __syncthreads();
    qkt(pA0, pA1, K_lds, KR_lds, qr, r32, hi); partialSM(pA0, pA1, m_reg, mnA, alA);
    SLOAD(1);
    asm volatile("s_waitcnt vmcnt(0)" ::: "memory"); SWRITE(1); __syncthreads();
    for (int j = 1; j + 1 < NT; j += 2) {
        SBAR(); qkt(pB0, pB1, K_lds + SHM_K, KR_lds + SHM_KR, qr, r32, hi);
        finishSM(pA0, pA1, alA, l_reg, pa0, pa1, pa2, pa3); SBAR();
        SLOAD(j + 1); SBAR();
        pv_d0(o, vb0, pa0, pa1, pa2, pa3); partialSM(pB0, pB1, m_reg, mnB, alB);
        __syncthreads(); asm volatile("s_waitcnt vmcnt(0)" ::: "memory"); SWRITE(0);
        RESC(alB); __syncthreads();
        SBAR(); qkt(pA0, pA1, K_lds, KR_lds, qr, r32, hi);
        finishSM(pB0, pB1, alB, l_reg, pa0, pa1, pa2, pa3); SBAR();
        SLOAD(j + 2); SBAR();
        pv_d0(o, vb0 + SHM_V, pa0, pa1, pa2, pa3); partialSM(pA0, pA1, m_reg, mnA, alA);
        __syncthreads(); asm volatile("s_waitcnt vmcnt(0)" ::: "memory"); SWRITE(1);
        RESC(alA); __syncthreads();
    }
    SBAR(); qkt(pB0, pB1, K_lds + SHM_K, KR_lds + SHM_KR, qr, r32, hi);
    finishSM(pA0, pA1, alA, l_reg, pa0, pa1, pa2, pa3); SBAR();
    pv_d0(o, vb0, pa0, pa1, pa2, pa3); partialSM(pB0, pB1, m_reg, mnB, alB);
    __syncthreads(); RESC(alB);
    finishSM(pB0, pB1, alB, l_reg, pa0, pa1, pa2, pa3); SBAR();
    pv_d0(o, vb0 + SHM_V, pa0, pa1, pa2, pa3);
    if (hi == 0) li_l[r32] = l_reg; asm volatile("s_waitcnt lgkmcnt(0)" ::: "memory");
    const int orow0 = qrow0 + wid * 32;
#pragma unroll
    for (int r = 0; r < 16; ++r) { const int orow = orow0 + crow(r, hi); const float rl = __builtin_amdgcn_rcpf(li_l[crow(r, hi)]);
#pragma unroll
        for (int d0 = 0; d0 < 4; ++d0) { const size_t idx = (size_t)orow * 3072 + h * 128 + d0 * 32 + r32;
            const float v = o[d0][r] * rl * bf1(GP[idx]); O[idx] = (bf16_t)(cvt_pk(v, 0.f) & 0xffffu); } }
    __syncthreads();
#undef TROW
#undef SLOAD
#undef SWRITE
#undef RESC
}
}

__device__ __forceinline__ void na_item(const bf16_t* __restrict__ PMIX, const bf16_t* __restrict__ GP, bf16_t* __restrict__ O, const float* __restrict__ bias, int item, int lane, LAS unsigned char* wl) {
    const int q = lane & 31, hi = lane >> 5;
    const bool lat = item < 8192;
    int b, h, gi = 0, jh = 0, qrow;
    if (lat) { b = item >> 11; h = (item >> 7) & 15; gi = (item >> 1) & 63; jh = item & 1; qrow = b * 4096 + gi * 64 + jh * 32 + q; }
    else { const int it = item - 8192; b = it >> 7; h = (it >> 3) & 15; qrow = NLAT + b * 256 + (it & 7) * 32 + q; }
    const int j = jh * 32 + q;
    const int c0 = min(max(j - 8, 0), 48), r0 = min(max(gi - 4, 0), 56);
    const bf16_t* qp = PMIX + (size_t)qrow * NMIXP + O_NAQ + h * 64 + hi * 8;
    bf16x8 qf[4];
#pragma unroll
    for (int ks = 0; ks < 4; ++ks) qf[ks] = *reinterpret_cast<const bf16x8*>(qp + ks * 16);
    f32x16 oT0 = {}, oT1 = {}; float m = -1e30f, l = 0.f;
    const int ntiles = lat ? 24 : 8;
    const float* bh = bias + h * (15 * 31);
    LAS float* lbias = (LAS float*)(wl + 4608);
    if (lat) {
#pragma unroll
        for (int i = 0; i < 4; ++i) { const int e = lane * 4 + i, krr = e >> 5, dc = e & 31; lbias[e] = bh[(r0 + krr - gi + 7) * 31 + min(dc, 30)] * LOG2E; }
        asm volatile("s_waitcnt vmcnt(0) lgkmcnt(0)" ::: "memory"); __builtin_amdgcn_wave_barrier();
    }
#define NA_TROW(t_) ((lat && (t_) < 16) ? (b * 4096 + (r0 + ((t_) >> 1)) * 64 + ((t_) & 1) * 32) : (NLAT + b * 256 + (lat ? (t_) - 16 : (t_)) * 32))
#define NA_LOAD(KF, VV, t_) do { const int kr0_ = NA_TROW(t_); const bf16_t* kp_ = PMIX + (size_t)(kr0_ + q) * NMIXP + O_NAK + h * 64 + hi * 8; \
        _Pragma("unroll") for (int ks = 0; ks < 4; ++ks) KF[ks] = *reinterpret_cast<const bf16x8*>(kp_ + ks * 16); \
        const bf16_t* vp_ = PMIX + (size_t)(kr0_ + (lane >> 1)) * NMIXP + O_NAV + h * 64 + (lane & 1) * 32; \
        _Pragma("unroll") for (int c = 0; c < 4; ++c) VV[c] = *reinterpret_cast<const u32x4*>(vp_ + c * 8); } while (0)
#define NA_TILE(KF, VV, t) do { \
        const bool local = lat && (t) < 16; const int kr = (t) >> 1, kblk = (t) & 1; \
        f32x16 p = {}; \
        _Pragma("unroll") for (int ks = 0; ks < 4; ++ks) p = __builtin_amdgcn_mfma_f32_32x32x16_bf16(KF[ks], qf[ks], p, 0, 0, 0); \
        _Pragma("unroll") for (int c = 0; c < 4; ++c) *(LAS u32x4*)(wl + (lane >> 1) * 144 + (lane & 1) * 64 + c * 16) = VV[c]; \
        if ((t) + 2 < ntiles) NA_LOAD(KF, VV, (t) + 2); \
        if (local) { \
            const LAS float* brow = lbias + kr * 32; \
            _Pragma("unroll") for (int r8 = 0; r8 < 16; r8 += 4) { float bv8[4]; \
                _Pragma("unroll") for (int r = 0; r < 4; ++r) { const int kc = kblk * 32 + crow(r8 + r, hi); bv8[r] = brow[min(max(kc - j + 15, 0), 30)]; } \
                _Pragma("unroll") for (int r = 0; r < 4; ++r) asm volatile("" : "+v"(bv8[r]));     \
                _Pragma("unroll") for (int r = 0; r < 4; ++r) { const int kc = kblk * 32 + crow(r8 + r, hi); const bool valid = (kc >= c0) && (kc < c0 + 16); p[r8 + r] = valid ? p[r8 + r] + bv8[r] : -INFINITY; } } \
        } \
        float tmax = p[0]; \
        _Pragma("unroll") for (int r = 1; r < 16; ++r) tmax = fmaxf(tmax, p[r]); \
        tmax = fmaxf(tmax, shx(tmax, lane, 32)); \
        const float mn = fmaxf(m, tmax), alpha = __builtin_amdgcn_exp2f(m - mn); m = mn; \
        float ps = 0.f; \
        _Pragma("unroll") for (int r = 0; r < 16; ++r) { p[r] = __builtin_amdgcn_exp2f(p[r] - mn); ps += p[r]; } \
        l = l * alpha + ps; \
        _Pragma("unroll") for (int r = 0; r < 16; ++r) { oT0[r] *= alpha; oT1[r] *= alpha; } \
        asm volatile("s_waitcnt lgkmcnt(0)" ::: "memory"); __builtin_amdgcn_wave_barrier(); \
        _Pragma("unroll") for (int ks = 0; ks < 2; ++ks) { \
            u32x4 pw; pw.x = cvt_pk(p[8 * ks + 0], p[8 * ks + 1]); pw.y = cvt_pk(p[8 * ks + 2], p[8 * ks + 3]); pw.z = cvt_pk(p[8 * ks + 4], p[8 * ks + 5]); pw.w = cvt_pk(p[8 * ks + 6], p[8 * ks + 7]); \
            const bf16x8 pf = *reinterpret_cast<bf16x8*>(&pw); \
            _Pragma("unroll") for (int db = 0; db < 2; ++db) { \
                bf16x8 vf; \
                _Pragma("unroll") for (int jj = 0; jj < 8; ++jj) { const int key = 16 * ks + 8 * (jj >> 2) + 4 * hi + (jj & 3); vf[jj] = *(const LAS short*)(wl + key * 144 + (32 * db + q) * 2); } \
                if (db == 0) oT0 = __builtin_amdgcn_mfma_f32_32x32x16_bf16(vf, pf, oT0, 0, 0, 0); \
                else oT1 = __builtin_amdgcn_mfma_f32_32x32x16_bf16(vf, pf, oT1, 0, 0, 0); \
            } \
        } \
        asm volatile("s_waitcnt lgkmcnt(0)" ::: "memory"); __builtin_amdgcn_wave_barrier(); \
    } while (0)
    bf16x8 kfa[4], kfb[4]; u32x4 vva[4], vvb[4];
    NA_LOAD(kfa, vva, 0); NA_LOAD(kfb, vvb, 1);
    for (int t0 = 0; t0 < ntiles; t0 += 2) {
        NA_TILE(kfa, vva, t0);
        NA_TILE(kfb, vvb, t0 + 1);
    }
#undef NA_TILE
#undef NA_TROW
#undef NA_LOAD
    const float inv = __builtin_amdgcn_rcpf(l + shx(l, lane, 32));
    const size_t ob = (size_t)qrow * 3072 + 1024 + h * 64;
#pragma unroll
    for (int db = 0; db < 2; ++db)
#pragma unroll
        for (int g = 0; g < 4; ++g) {
            const int d = 32 * db + 8 * g + 4 * hi;
            const u32x2 gw = *reinterpret_cast<const u32x2*>(GP + ob + d);
            float v0, v1, v2, v3;
            if (db == 0) { v0 = oT0[4 * g]; v1 = oT0[4 * g + 1]; v2 = oT0[4 * g + 2]; v3 = oT0[4 * g + 3]; } else { v0 = oT1[4 * g]; v1 = oT1[4 * g + 1]; v2 = oT1[4 * g + 2]; v3 = oT1[4 * g + 3]; }
            u32x2 w; w.x = cvt_pk(v0 * inv * bflo(gw.x), v1 * inv * bfhi(gw.x)); w.y = cvt_pk(v2 * inv * bflo(gw.y), v3 * inv * bfhi(gw.y));
            *reinterpret_cast<u32x2*>(O + ob + d) = w;
        }
}

__device__ __forceinline__ void lru_gate_phase(const bf16_t* __restrict__ PMIX, const bf16_t* __restrict__ WG, const float* __restrict__ convw, const float* __restrict__ convb,
                                               const float* __restrict__ bg, const float* __restrict__ lam, float* __restrict__ LA, float* __restrict__ LU, int bid, int G, LAS unsigned char* lds) {
    const int tid = opaque_v(threadIdx.x), lane = tid & 63, wid = tid >> 6;
    LAS float* xcf = (LAS float*)lds;
    LAS unsigned char* xcb = lds + 64 * 68 * 4;
    const int tl_s = tid >> 3, cg8 = (tid & 7) * 8;
    const int dir = wid >> 2, th = (wid >> 1) & 1, chh = wid & 1, q = lane & 31, hi = lane >> 5, cl = 32 * chh + q;
    int cur_blk = -1;
    f32x4 cw[4][2], cb0, cb1; bf16x8 br[4], bi[4]; float brv = 0.f, biv = 0.f, sp = 0.f;
    for (int item = bid; item < (MROWS / 64) * 16; item += G) {
        const int tt = item >> 4, blk = item & 15, row0 = tt * 64;
        if (blk != cur_blk) {
            cur_blk = blk;
            const int chs = blk * 64 + cg8;
            cb0 = *(const f32x4*)(convb + chs); cb1 = *(const f32x4*)(convb + chs + 4);
#pragma unroll
            for (int tap = 0; tap < 4; ++tap) { cw[tap][0] = *(const f32x4*)(convw + tap * 1024 + chs); cw[tap][1] = *(const f32x4*)(convw + tap * 1024 + chs + 4); }
            const bf16_t* wt = WG + (size_t)(dir * 16 + blk) * 128 * 64;
#pragma unroll
            for (int ks = 0; ks < 4; ++ks) { br[ks] = *reinterpret_cast<const bf16x8*>(wt + (size_t)cl * 64 + 16 * ks + 8 * hi); bi[ks] = *reinterpret_cast<const bf16x8*>(wt + (size_t)(64 + cl) * 64 + 16 * ks + 8 * hi); }
            brv = bg[dir * 2048 + blk * 128 + cl]; biv = bg[dir * 2048 + blk * 128 + 64 + cl];
            const float xs = __expf(-lam[dir * 1024 + blk * 64 + cl]);
            sp = xs < 0.05f ? xs * (1.f - xs * (0.5f - xs * ((1.f / 3.f) - xs * (0.25f - xs * 0.2f)))) : __logf(1.f + xs);
        }
        const int seg0 = row0 < NLAT ? (row0 & ~4095) : (NLAT + ((row0 - NLAT) & ~255)), seg1 = seg0 + (row0 < NLAT ? 4096 : 256);
        {
            const int row = row0 + tl_s, chs = blk * 64 + cg8;
            f32x4 x0 = cb0, x1 = cb1;
            u32x4 pv4[4];
#pragma unroll
            for (int tap = 0; tap < 4; ++tap) { const int rr = min(max(row + tap - 2, seg0), seg1 - 1); pv4[tap] = *(const u32x4*)(PMIX + (size_t)rr * NMIXP + O_PX + chs); }
#pragma unroll
            for (int tap = 0; tap < 4; ++tap) {
                const int rr = row + tap - 2; const float ok = (rr >= seg0 && rr < seg1) ? 1.f : 0.f; const u32x4 pv = pv4[tap];
                x0 += (cw[tap][0] * ok) * (f32x4){bflo(pv.x), bfhi(pv.x), bflo(pv.y), bfhi(pv.y)};
                x1 += (cw[tap][1] * ok) * (f32x4){bflo(pv.z), bfhi(pv.z), bflo(pv.w), bfhi(pv.w)};
            }
            *(LAS f32x4*)(xcf + tl_s * 68 + cg8) = x0; *(LAS f32x4*)(xcf + tl_s * 68 + cg8 + 4) = x1;
            *(LAS u32x4*)(xcb + tl_s * 144 + cg8 * 2) = pack8(x0, x1);
        }
        __syncthreads();
        {
            const int ch = blk * 64 + cl;
            f32x16 accR = {}, accI = {};
#pragma unroll
            for (int ks = 0; ks < 4; ++ks) {
                const bf16x8 af = *(const LAS bf16x8*)(xcb + (32 * th + q) * 144 + (16 * ks + 8 * hi) * 2);
                accR = __builtin_amdgcn_mfma_f32_32x32x16_bf16(af, br[ks], accR, 0, 0, 0);
                accI = __builtin_amdgcn_mfma_f32_32x32x16_bf16(af, bi[ks], accI, 0, 0, 0);
            }
#pragma unroll
            for (int r = 0; r < 16; ++r) {
                const int tl = 32 * th + crow(r, hi);
                const float rg = sigmoidf_(accR[r] + brv), ig = sigmoidf_(accI[r] + biv);
                const float log_a = -8.f * rg * sp, ym = -2.f * log_a, y1 = -log_a;
                const float om = ym < 0.1f ? ym * (1.f - ym * (0.5f - ym * ((1.f / 6.f) - ym * ((1.f / 24.f) - ym * (1.f / 120.f))))) : 1.f - __expf(-ym);
                const float oma = y1 < 0.1f ? y1 * (1.f - y1 * (0.5f - y1 * ((1.f / 6.f) - y1 * ((1.f / 24.f) - y1 * (1.f / 120.f))))) : 1.f - __expf(-y1);
                const float u = __builtin_sqrtf(fmaxf(om, 0.f)) * (ig * xcf[tl * 68 + cl]);
                const size_t idx = ((size_t)dir * MROWS + row0 + tl) * 1024 + ch;
                ((unsigned*)LA)[idx] = cvt_pk(oma, u);
            }
        }
        __syncthreads();
    }
}
__device__ __forceinline__ int chunk_row0(int b, int c) { return c < 4 ? NLAT + b * 256 + c * 64 : b * 4096 + (c - 4) * 64; }
__device__ __forceinline__ void lru_pass1_item(const float* __restrict__ LA, const float* __restrict__ LU, float* __restrict__ AGG, int item) {
    const int g = item * 512 + opaque_v(threadIdx.x), ch = (g & 255) * 4, dir = (g >> 8) & 1, bc = g >> 9, c = bc % NCHUNK, b = bc / NCHUNK;
    const int row0 = chunk_row0(b, c);
    const unsigned* ap = (const unsigned*)LA + ((size_t)dir * MROWS + row0) * 1024 + ch; (void)LU;
    f32x4 A = {1.f, 1.f, 1.f, 1.f}, H = {0.f, 0.f, 0.f, 0.f};
#pragma unroll 8
    for (int t = 0; t < 64; ++t) { const int tt = dir ? 63 - t : t; const u32x4 w = *(const u32x4*)(ap + (size_t)tt * 1024);
        const f32x4 a = {1.f - bflo(w.x), 1.f - bflo(w.y), 1.f - bflo(w.z), 1.f - bflo(w.w)}, u = {bfhi(w.x), bfhi(w.y), bfhi(w.z), bfhi(w.w)}; A *= a; H = a * H + u; }
    float* o = AGG + (((size_t)(dir * NB + b) * NCHUNK + c) * 1024 + ch) * 2;
    *(f32x4*)o = (f32x4){A[0], H[0], A[1], H[1]}; *(f32x4*)(o + 4) = (f32x4){A[2], H[2], A[3], H[3]};
}
__device__ __forceinline__ void lru_pass3_item(const float* __restrict__ LA, const float* __restrict__ LU, const float* __restrict__ AGG, const bf16_t* __restrict__ GP, bf16_t* __restrict__ O, int item, LAS unsigned char* lds) {
    const int tid = opaque_v(threadIdx.x);
    const int cg = item & 7, bc = item >> 3, c = bc % NCHUNK, b = bc / NCHUNK, row0 = chunk_row0(b, c), ch0 = cg * 128;
    LAS unsigned* S = (LAS unsigned*)lds;
    LAS float* CX = (LAS float*)(lds + 65536);
    {
        u32x4 tv[8];
#pragma unroll
        for (int p = 0; p < 8; ++p) { const int e = p * 512 + tid, arr = e >> 11, rem = e & 2047, tok = rem >> 5, c4 = rem & 31;
            tv[p] = *(const u32x4*)((const unsigned*)LA + ((size_t)arr * MROWS + row0 + tok) * 1024 + ch0 + c4 * 4); }
#pragma unroll
        for (int p = 0; p < 8; ++p) { const int e = p * 512 + tid, arr = e >> 11, rem = e & 2047, tok = rem >> 5, c4 = rem & 31;
            *(LAS u32x4*)(S + (arr * 64 + tok) * 128 + c4 * 4) = tv[p]; }
    }
    const int dir = (tid >> 7) & 1, ch = tid & 127, half = tid >> 8;
    float cA = 1.f, cH = 0.f;
    {
        const float* ag = AGG + ((size_t)(dir * NB + b) * NCHUNK * 1024 + ch0 + ch) * 2;
        const int n = dir == 0 ? c : (c < 4 ? 3 - c : 4 + (NCHUNK - 1 - c));
        const int k0 = half ? (n >> 1) : 0, k1 = half ? n : (n >> 1);
#pragma unroll 8
        for (int k = k0; k < k1; ++k) { const int cc = dir == 0 ? k : ((c < 4 || k < 4) ? 3 - k : NCHUNK - 1 - (k - 4));
            const f32x2_t q_ = *(const f32x2_t*)(ag + (size_t)cc * 2048); cA *= q_[0]; cH = q_[0] * cH + q_[1]; }
    }
    if (half) { CX[(tid - 256) * 2] = cA; CX[(tid - 256) * 2 + 1] = cH; }
    __syncthreads();
    if (tid < 256) {
        float h = CX[tid * 2] * cH + CX[tid * 2 + 1];
        LAS unsigned* su = S + dir * 64 * 128 + ch;
#pragma unroll 8
        for (int t = 0; t < 64; ++t) { const int tt = dir ? 63 - t : t; const unsigned w = su[tt * 128]; h = (1.f - bflo(w)) * h + bfhi(w); su[tt * 128] = __float_as_uint(h); }
    }
    __syncthreads();
#pragma unroll
    for (int p = 0; p < 4; ++p) { const int e = p * 512 + tid, tok = e >> 5, c4 = e & 31;
        const f32x4 hf = *(const LAS f32x4*)(S + (0 * 64 + tok) * 128 + c4 * 4), hb = *(const LAS f32x4*)(S + (1 * 64 + tok) * 128 + c4 * 4);
        const size_t oi = (size_t)(row0 + tok) * 3072 + 2048 + ch0 + c4 * 4; const u32x2 gw = *(const u32x2*)(GP + oi);
        u32x2 w; w.x = cvt_pk((hf[0] + hb[0]) * bflo(gw.x), (hf[1] + hb[1]) * bfhi(gw.x)); w.y = cvt_pk((hf[2] + hb[2]) * bflo(gw.y), (hf[3] + hb[3]) * bfhi(gw.y));
        *(u32x2*)(O + oi) = w; }
    __syncthreads();
}

__device__ __forceinline__ void transpose_item(const float* __restrict__ W, int ld_src, int k0, int n0src, const float* __restrict__ kscale, bf16_t* __restrict__ WT, int ldt, int n0dst, LAS float* scr, int lane) {
#pragma unroll 8
    for (int i = 0; i < 32; ++i) { const int kk = 2 * i + (lane >> 5); float v = W[(size_t)(k0 + kk) * ld_src + n0src + (lane & 31)]; if (kscale) v *= kscale[k0 + kk]; scr[kk * 33 + (lane & 31)] = v; }
    asm volatile("s_waitcnt lgkmcnt(0)" ::: "memory"); __builtin_amdgcn_wave_barrier();
    const int c = lane & 7;
#pragma unroll
    for (int jn = 0; jn < 4; ++jn) { const int n = (lane >> 3) + 8 * jn; const LAS float* s = scr + (8 * c) * 33 + n;
        u32x4 o; o.x = cvt_pk(s[0 * 33], s[1 * 33]); o.y = cvt_pk(s[2 * 33], s[3 * 33]); o.z = cvt_pk(s[4 * 33], s[5 * 33]); o.w = cvt_pk(s[6 * 33], s[7 * 33]);
        *(u32x4*)(WT + (size_t)(n0dst + n) * ldt + k0 + 8 * c) = o; }
    asm volatile("s_waitcnt lgkmcnt(0)" ::: "memory"); __builtin_amdgcn_wave_barrier();
}


#define XB_TMO      128
#define XB_XCNT(j)  (256  + 64 * (j))
#define XB_XSUB(j)  (1280 + 64 * (j))
#define XB_XGEN(j)  (2304 + 64 * (j))
#define XB_TOP      3328
#define XB_TOPGEN   3392
#define XCD_BAR_WORDS 3456
#define XB_SPIN_CAP (1u << 22)
__device__ __forceinline__ unsigned xb_ld(unsigned* p)              { return __hip_atomic_load(p, __ATOMIC_RELAXED, __HIP_MEMORY_SCOPE_AGENT); }
__device__ __forceinline__ unsigned xb_add(unsigned* p, unsigned v) { return __hip_atomic_fetch_add(p, v, __ATOMIC_RELAXED, __HIP_MEMORY_SCOPE_AGENT); }
__device__ __forceinline__ unsigned xb_xcc_id() { return (unsigned)__builtin_amdgcn_s_getreg((3 << 11) | 20) & 0xFu; }
#define XB_SPIN(cond, bar) do { unsigned _sp = 0; while (cond) { __builtin_amdgcn_s_sleep(1); \
    if ((++_sp & 255u) == 0u) { if (xb_ld(&(bar)[XB_TMO])) break; if (_sp > XB_SPIN_CAP) { atomicAdd(&(bar)[XB_TMO], 1u); break; } } } } while (0)
struct XcdBarrier { unsigned* bar; unsigned x; volatile LAS unsigned* st; };
__device__ __forceinline__ XcdBarrier xcd_barrier_post(unsigned* bar, volatile LAS unsigned* st) {
    XcdBarrier b; b.bar = bar; b.x = xb_xcc_id(); b.st = st;
    if (threadIdx.x == 0) (void)xb_add(&bar[XB_XCNT(b.x)], 1u);
    return b;
}
__device__ __forceinline__ void xcd_barrier_complete(unsigned* bar, unsigned x, unsigned& nloc, unsigned& nx) {
    const unsigned G = gridDim.x * gridDim.y * gridDim.z;
    unsigned sum, cnt, mine, sp = 0u;
    for (;;) {
        sum = 0u; cnt = 0u; mine = 0u;
#pragma unroll
        for (unsigned j = 0; j < 16; ++j) { const unsigned c = xb_ld(&bar[XB_XCNT(j)]); sum += c; cnt += (c > 0u) ? 1u : 0u; mine = (j == x) ? c : mine; }
        if (sum == G) break;
        __builtin_amdgcn_s_sleep(1);
        if ((++sp & 255u) == 0u) { if (xb_ld(&bar[XB_TMO])) break; if (sp > XB_SPIN_CAP) { atomicAdd(&bar[XB_TMO], 1u); break; } }
    }
    nloc = mine > 0u ? mine : 1u; nx = cnt > 0u ? cnt : 1u;
}
__device__ __forceinline__ void xcd_barrier(const XcdBarrier& b) {
    asm volatile("s_waitcnt vmcnt(0)" ::: "memory");
    __syncthreads();
    if (threadIdx.x == 0) {
        unsigned* bar = b.bar;
        __builtin_amdgcn_s_waitcnt(0);
        unsigned nloc = b.st[0], nx = b.st[1];
        if (nloc == 0u) { xcd_barrier_complete(bar, b.x, nloc, nx); b.st[0] = nloc; b.st[1] = nx; }
        const unsigned old = xb_add(&bar[XB_XSUB(b.x)], 1u);
        const unsigned gen = old / nloc;
        if (old + 1u == (gen + 1u) * nloc) {
            __builtin_amdgcn_fence(__ATOMIC_RELEASE, "agent");
            asm volatile("s_waitcnt vmcnt(0)" ::: "memory");
            const unsigned og = xb_add(&bar[XB_TOP], 1u);
            const unsigned tg = og / nx;
            if (og + 1u == (tg + 1u) * nx) xb_add(&bar[XB_TOPGEN], 1u);
            else XB_SPIN(xb_ld(&bar[XB_TOPGEN]) == tg, bar);
            __builtin_amdgcn_fence(__ATOMIC_ACQUIRE, "agent");
            xb_add(&bar[XB_XGEN(b.x)], 1u);
            asm volatile("s_waitcnt vmcnt(0)" ::: "memory");
        } else {
            XB_SPIN(xb_ld(&bar[XB_XGEN(b.x)]) == gen, bar);
            __builtin_amdgcn_fence(__ATOMIC_ACQUIRE, "agent");
            asm volatile("s_waitcnt vmcnt(0)" ::: "memory");
        }
    }
    __syncthreads();
}
#define GRID_SYNC() do { asm volatile("s_waitcnt vmcnt(0) lgkmcnt(0)" ::: "memory"); grid.sync(); \
    if (threadIdx.x < 64) asm volatile("buffer_inv sc1\n\ts_waitcnt vmcnt(0)" ::: "memory"); __syncthreads(); } while (0)
__device__ __forceinline__ unsigned char* opaque_p(unsigned char* p) { asm volatile("" : "+s"(p)); return p; }
__device__ __forceinline__ int opaque_s(int x) { asm volatile("" : "+s"(x)); return x; }
#define x_in (args.in[0])
#define c_in (args.in[1])
#define ctx_in (args.in[2])
#define cctx_in (args.in[3])
#define ada_w (args.in[4])
#define ada_b (args.in[5])
#define norm_g (args.in[6])
#define w_in (args.in[7])
#define qng (args.in[8])
#define kvng (args.in[9])
#define w_uq (args.in[10])
#define w_ukv (args.in[11])
#define rel_bias (args.in[12])
#define conv_w (args.in[13])
#define conv_b (args.in[14])
#define w_gate (args.in[15])
#define b_gate (args.in[16])
#define lam_in (args.in[17])
#define w_branch (args.in[18])
#define w_out (args.in[19])
#define fng (args.in[20])
#define WIN ((bf16_t*)(ws + WS_WIN))
#define WUQ ((bf16_t*)(ws + WS_WUQ))
#define WUKV ((bf16_t*)(ws + WS_WUKV))
#define WBR ((bf16_t*)(ws + WS_WBR))
#define WOUT ((bf16_t*)(ws + WS_WOUT))
#define WG ((bf16_t*)(ws + WS_WG))
#define MOD ((float*)(ws + WS_MOD))
#define ROPE ((float*)(ws + WS_ROPE))
#define XCUR ((float*)(ws + WS_XCUR))
#define HB ((bf16_t*)(ws + WS_H))
#define PMIX ((bf16_t*)(ws + WS_PMIX))
#define GP ((bf16_t*)(ws + WS_GP))
#define MG ((bf16_t*)(ws + WS_MG))
#define RSQ ((float*)(ws + WS_RSQ))
#define QB ((bf16_t*)(ws + WS_Q))
#define KVB ((bf16_t*)(ws + WS_KV))
#define KRB ((bf16_t*)(ws + WS_KR))
#define LA ((float*)(ws + WS_LA))
#define LU ((float*)(ws + WS_LU))
#define AGG ((float*)(ws + WS_AGG))
#define OB ((bf16_t*)(ws + WS_O))
#define MTMP LA
__global__ void __launch_bounds__(512, 2) mk_fwd(Args args) {
    extern __shared__ __attribute__((aligned(16))) unsigned char lds_raw[];
    cg::grid_group grid = cg::this_grid();
    LAS unsigned char* lds = (LAS unsigned char*)lds_raw;
    volatile LAS unsigned* xb_st = (volatile LAS unsigned*)(lds + LDS_BYTES - 64);
    if (threadIdx.x == 0) { xb_st[0] = 0u; xb_st[1] = 0u; }
    __syncthreads();
    (void)xcd_barrier_post((unsigned*)(args.ws + WS_BAR), xb_st);
#define XSYNC() do { XcdBarrier b_; b_.bar = (unsigned*)(args.ws + WS_BAR); b_.x = xb_xcc_id(); b_.st = (volatile LAS unsigned*)(lds + LDS_BYTES - 64); xcd_barrier(b_); } while (0)
#define PHASE_IDS const int tid = opaque_v(threadIdx.x), lane = tid & 63, wid = __builtin_amdgcn_readfirstlane(tid >> 6), G = opaque_s(gridDim.x), bid = opaque_s(blockIdx.x), NGW = G * 8, gw = bid * 8 + wid; unsigned char* ws = args.ws + (size_t)(unsigned)opaque_s(0); (void)lane; (void)gw; (void)NGW; (void)ws; (void)tid;

    {
        PHASE_IDS
        LAS float* scr = (LAS float*)(lds + wid * 8448);
        constexpr int I_IN = 32 * 442, I_UQ = 8 * 48, I_UKV = 4 * 64, I_BR = 3 * 16 * 64, I_OUT = 32 * 64, I_G = 32 * 4, I_L = I_IN + I_UQ + I_UKV + I_BR + I_OUT + I_G;
        for (int it = gw; it < DEPTH * I_L; it += NGW) {
            const int L = it / I_L; int r = it - L * I_L;
            if (r < I_IN) { const int kb = r / 442, nb = r % 442, n0 = nb * 32;
                transpose_item(w_in + (size_t)L * DM * NIN, NIN, kb * 64, n0, nullptr, WIN + (size_t)L * NINP * DM, DM, n0 < NMIX ? n0 : n0 + (NMIXP - NMIX), scr, lane); continue; } r -= I_IN;
            if (r < I_UQ) { const int kb = r / 48, nb = r % 48;
                transpose_item(w_uq + (size_t)L * 512 * 1536, 1536, kb * 64, nb * 32, qng + L * 512, WUQ + (size_t)L * 1536 * 512, 512, nb * 32, scr, lane); continue; } r -= I_UQ;
            if (r < I_UKV) { const int kb = r / 64, nb = r % 64;
                transpose_item(w_ukv + (size_t)L * 256 * 2048, 2048, kb * 64, nb * 32, kvng + L * 256, WUKV + (size_t)L * 2048 * 256, 256, nb * 32, scr, lane); continue; } r -= I_UKV;
            if (r < I_BR) { const int n3 = r / 1024, rr = r % 1024, kb = rr / 64, nb = rr % 64;
                transpose_item(w_branch + ((size_t)L * 3 + n3) * 1024 * 2048, 2048, kb * 64, nb * 32, nullptr, WBR + ((size_t)L * 3 + n3) * 2048 * 1024, 1024, nb * 32, scr, lane); continue; } r -= I_BR;
            if (r < I_OUT) { const int kb = r / 64, nb = r % 64;
                transpose_item(w_out + (size_t)L * DM * DM, DM, kb * 64, nb * 32, nullptr, WOUT + (size_t)L * DM * DM, DM, nb * 32, scr, lane); continue; } r -= I_OUT;
            { const int db = r / 4, nb = r % 4;
              transpose_item(w_gate + ((size_t)L * 32 + db) * 64 * 128, 128, 0, nb * 32, nullptr, WG + ((size_t)L * 32 + db) * 128 * 64, 64, nb * 32, scr, lane); }
        }
        for (int i = bid * 512 + tid; i < DEPTH * (NMIXP - NMIX) * (DM / 8); i += G * 512) {
            const int L = i / ((NMIXP - NMIX) * (DM / 8)), r = i % ((NMIXP - NMIX) * (DM / 8));
            *(u32x4*)(WIN + ((size_t)L * NINP + NMIX) * DM + (size_t)r * 8) = (u32x4){0u, 0u, 0u, 0u};
        }
        __syncthreads();
        LAS float* sil = (LAS float*)(lds + 69632);
        LAS float* red = (LAS float*)(lds + 69632 + 40960);
        for (int i = tid; i < 5 * 2048; i += 512) { const float v = i < 4 * 2048 ? c_in[i] : cctx_in[i - 4 * 2048]; sil[i] = v * (1.f / (1.f + expf(-v))); }
        __syncthreads();
        for (int it = bid; it < DEPTH * 96; it += G) {
            const int L = it / 96, cb = it % 96, ksl = tid >> 6, col = cb * 64 + (tid & 63);
            float a5[5] = {0.f, 0.f, 0.f, 0.f, 0.f};
            const float* wp = ada_w + (size_t)L * DM * 6144 + col;
            for (int k = ksl * 256; k < ksl * 256 + 256; ++k) { const float w = wp[(size_t)k * 6144];
#pragma unroll
                for (int r = 0; r < 5; ++r) a5[r] += sil[r * 2048 + k] * w; }
#pragma unroll
            for (int r = 0; r < 5; ++r) red[(ksl * 5 + r) * 64 + (tid & 63)] = a5[r];
            __syncthreads();
            if (tid < 320) { const int r = tid >> 6, cc = tid & 63; float s = 0.f;
#pragma unroll
                for (int k = 0; k < 8; ++k) s += red[(k * 5 + r) * 64 + cc];
                MOD[((size_t)L * 5 + r) * 6144 + cb * 64 + cc] = s + ada_b[(size_t)L * 6144 + cb * 64 + cc]; }
            __syncthreads();
        }
        if (bid == G - 1) for (int i = tid; i < 1024; i += 512) { const int pos = i >> 4, k = i & 15;
            const float inv = 1.0f / powf(10000.f, (float)k * (1.f / 16.f)), ang = (float)pos * inv; ROPE[2 * i] = cosf(ang); ROPE[2 * i + 1] = sinf(ang); }
    }
    GRID_SYNC();

    for (int layer = 0; layer < DEPTH; ++layer) {
        const bool need_ctx = layer < DEPTH - 1;
        { PHASE_IDS
        for (int row = gw; row < MROWS; row += NGW) {
            const bool lat = row < NLAT;
            const float* src = (layer == 0) ? (lat ? x_in + (size_t)row * DM : ctx_in + (size_t)(row - NLAT) * DM) : XCUR + (size_t)row * DM;
            const float* mr = MOD + (size_t)layer * 5 * 6144 + (size_t)(lat ? (row >> 12) : 4) * 6144;
            f32x4 v[8]; float ss = 0.f;
#pragma unroll
            for (int jv = 0; jv < 8; ++jv) { v[jv] = *(const f32x4*)(src + 4 * (lane + 64 * jv)); ss += (v[jv][0] * v[jv][0] + v[jv][1] * v[jv][1]) + (v[jv][2] * v[jv][2] + v[jv][3] * v[jv][3]); }
            const float rinv = rsqrtf(wave_sum(ss, lane) * (1.f / DM) + EPS);
#pragma unroll
            for (int jv = 0; jv < 8; ++jv) { const int col = 4 * (lane + 64 * jv);
                const f32x4 gg = *(const f32x4*)(norm_g + layer * DM + col), sh = *(const f32x4*)(mr + col), sc = *(const f32x4*)(mr + 2048 + col);
                const f32x4 hh = (v[jv] * rinv * gg) * (sc + 1.f) + sh;
                u32x2 w; w.x = cvt_pk(hh[0], hh[1]); w.y = cvt_pk(hh[2], hh[3]); *(u32x2*)(HB + (size_t)row * DM + col) = w; }
        } }
        XSYNC();
        {
            PHASE_IDS
            pg8::Gemm g{HB, WIN + (size_t)layer * NINP * DM, DM, DM, DM, 0, 0}; pg8::Sched S; S.init(MROWS, NINP, G, bid, 1);
            EpiIn E{PMIX, GP, MG, RSQ};
            pg8::gemm_phase<EpiIn>(lds, g, S, E);
        }
        XSYNC();
        {
            {
            PHASE_IDS
            { pg8::Gemm g{PMIX, WUQ + (size_t)layer * 1536 * 512, NMIXP, 512, 512, 0, 0}; pg8::Sched S; S.init(MROWS, 1536, G, bid, 1);
              EpiQ E{QB, RSQ, ROPE}; pg8::gemm_phase<EpiQ>(lds, g, S, E); }
            { pg8::Gemm g{PMIX + 512, WUKV + (size_t)layer * 2048 * 256, NMIXP, 256, 256, 0, 0}; pg8::Sched S; S.init(MROWS, 2048, G, bid, 1);
              EpiKV E{KVB, RSQ}; pg8::gemm_phase<EpiKV>(lds, g, S, E); }
            }
            {
            PHASE_IDS
            for (int i = bid * 512 + tid; i < MROWS * 4; i += G * 512) {
                const int row = i >> 2, hf = (i >> 1) & 1, sub = i & 1;
                const bf16_t* src = PMIX + (size_t)row * NMIXP + O_KR + 32 * hf + 8 * sub;
                u32x4 a = *(const u32x4*)src, b2 = *(const u32x4*)(src + 16);
                if (row < NLAT) {
                    const int s = row & 4095, pos = hf ? (s & 63) : (s >> 6);
                    const float* cp = ROPE + (pos * 16 + 8 * sub) * 2;
                    float x1[8] = {bflo(a.x), bfhi(a.x), bflo(a.y), bfhi(a.y), bflo(a.z), bfhi(a.z), bflo(a.w), bfhi(a.w)};
                    float x2[8] = {bflo(b2.x), bfhi(b2.x), bflo(b2.y), bfhi(b2.y), bflo(b2.z), bfhi(b2.z), bflo(b2.w), bfhi(b2.w)};
                    float o1[8], o2[8];
#pragma unroll
                    for (int e = 0; e < 8; ++e) { const float cv = cp[2 * e], sv = cp[2 * e + 1]; o1[e] = x1[e] * cv - x2[e] * sv; o2[e] = x1[e] * sv + x2[e] * cv; }
                    a.x = cvt_pk(o1[0], o1[1]); a.y = cvt_pk(o1[2], o1[3]); a.z = cvt_pk(o1[4], o1[5]); a.w = cvt_pk(o1[6], o1[7]);
                    b2.x = cvt_pk(o2[0], o2[1]); b2.y = cvt_pk(o2[2], o2[3]); b2.z = cvt_pk(o2[4], o2[5]); b2.w = cvt_pk(o2[6], o2[7]);
                }
                bf16_t* dst = KRB + (size_t)row * 64 + 32 * hf + 8 * sub;
                *(u32x4*)dst = a; *(u32x4*)(dst + 16) = b2;
            }
            __syncthreads();
            lru_gate_phase(PMIX, WG + (size_t)layer * 32 * 128 * 64, conv_w + (size_t)layer * 4 * 1024, conv_b + (size_t)layer * 1024, b_gate + (size_t)layer * 2 * 2048, lam_in + (size_t)layer * 2 * 1024, LA, LU, bid, G, lds);
            }
        }
        XSYNC();
        {
            PHASE_IDS
            const int nmla = 512 + (need_ctx ? 32 : 0);
            for (int u0 = bid; u0 < nmla; u0 += G) {
                int u = u0;
                if (G == 256 && u0 < 512) { const int x = bid & 7, i = bid >> 3, r = u0 >> 8; u = ((r * 16 + x * 2 + (i >> 4)) << 4) | (i & 15); }
                if (u < 512) { const int b = u >> 7, h = (u >> 4) & 7, qb = u & 15;
                    mla::attn_unit(QB, KVB, KRB, GP, OB, b * 4096 + qb * 256, h, b * 4096, NLAT + b * 256, 64, 68, (char*)lds_raw); }
                else { const int b = (u - 512) >> 3, h = (u - 512) & 7;
                    mla::attn_unit(QB, KVB, KRB, GP, OB, NLAT + b * 256, h, 0, NLAT + b * 256, 0, 4, (char*)lds_raw); }
            }
            __syncthreads();
            const int nna = 8192 + (need_ctx ? 512 : 0);
            for (int it = gw; it < nna; it += NGW) na_item(PMIX, GP, OB, rel_bias + (size_t)layer * 16 * 15 * 31, it, lane, lds + wid * 5632);
            for (int it = bid; it < (NB * NCHUNK * 2 * 256) / 512; it += G) lru_pass1_item(LA, LU, AGG, it);
        }
        XSYNC();
        { PHASE_IDS
        for (int it = bid; it < NB * NCHUNK * 8; it += G) lru_pass3_item(LA, LU, AGG, GP, OB, it, lds); }
        XSYNC();
        {
            PHASE_IDS
            const int Mrows = need_ctx ? MROWS : NLAT;
            const bool fuse_ctx = need_ctx && G == 256;
            unsigned* ctr = (unsigned*)(args.ws + WS_BAR) + 3600 + layer * 4;
            pg8::Gemm g{OB, WBR + (size_t)layer * 3 * 2048 * 1024, 3072, 1024, 1024, 1024, (size_t)2048 * 1024}; pg8::Sched S; S.init(Mrows, DM, G, bid, 3); S.rot = fuse_ctx ? 1 : 0;
            EpiMerge E{MG, MTMP, HB, fuse_ctx ? ctr : nullptr}; pg8::gemm_phase<EpiMerge>(lds, g, S, E);
            if (fuse_ctx && bid >= 96 && bid < 128) {
                pg8::Sched S2; S2.init(1024, DM, G, bid - 96, 1); S2.pm0 = 64;
                pg8::Unit u0; (void)S2.next(0, u0);
                if (threadIdx.x == 0) { unsigned sp = 0; while (__hip_atomic_load(ctr + (u0.pm - 64), __ATOMIC_RELAXED, __HIP_MEMORY_SCOPE_AGENT) < 8u && ++sp < (1u << 22)) __builtin_amdgcn_s_sleep(1);
                    __builtin_amdgcn_fence(__ATOMIC_ACQUIRE, "agent"); asm volatile("buffer_inv sc1\n\ts_waitcnt vmcnt(0)" ::: "memory"); }
                __syncthreads();
                pg8::Gemm g2{HB, WOUT + (size_t)layer * DM * DM, DM, DM, DM, 0, 0};
                EpiOut E2{x_in, ctx_in, XCUR, MOD + (size_t)layer * 5 * 6144, layer}; pg8::gemm_phase<EpiOut>(lds, g2, S2, E2);
            }
        }
        XSYNC();
        {
            PHASE_IDS
            const int Mrows = (need_ctx && G != 256) ? MROWS : NLAT;
            pg8::Gemm g{HB, WOUT + (size_t)layer * DM * DM, DM, DM, DM, 0, 0}; pg8::Sched S; S.init(Mrows, DM, G, bid, 1);
            EpiOut E{x_in, ctx_in, XCUR, MOD + (size_t)layer * 5 * 6144, layer}; pg8::gemm_phase<EpiOut>(lds, g, S, E);
        }
        XSYNC();
    }
    { PHASE_IDS
    for (int row = gw; row < NLAT; row += NGW) {
        const float* src = XCUR + (size_t)row * DM;
        f32x4 v[8]; float ss = 0.f;
#pragma unroll
        for (int jv = 0; jv < 8; ++jv) { v[jv] = *(const f32x4*)(src + 4 * (lane + 64 * jv)); ss += (v[jv][0] * v[jv][0] + v[jv][1] * v[jv][1]) + (v[jv][2] * v[jv][2] + v[jv][3] * v[jv][3]); }
        const float rinv = rsqrtf(wave_sum(ss, lane) * (1.f / DM) + EPS);
#pragma unroll
        for (int jv = 0; jv < 8; ++jv) { const int col = 4 * (lane + 64 * jv); *(f32x4*)(args.out + (size_t)row * DM + col) = v[jv] * rinv * *(const f32x4*)(fng + col); }
    } }
}

extern "C" void kernel_launch(void* const* d_in, const int* in_sizes, int n_in, void* d_out, int out_size, void* d_ws, size_t ws_size, hipStream_t stream) {
    static int grid = 0;
    if (grid == 0) {
        if (n_in != 21 || ws_size < WS_END) { fprintf(stderr, "kernel_launch: n_in %d ws %zu (need %zu): nothing launched\n", n_in, ws_size, (size_t)WS_END); grid = -1; return; }
        int dev = 0, cus = 0, per_cu = 0;
        if (hipGetDevice(&dev) != hipSuccess || hipDeviceGetAttribute(&cus, hipDeviceAttributeMultiprocessorCount, dev) != hipSuccess) { grid = -1; return; }
        if (hipFuncSetAttribute((const void*)mk_fwd, hipFuncAttributeMaxDynamicSharedMemorySize, LDS_BYTES) != hipSuccess) { fprintf(stderr, "hipFuncSetAttribute failed\n"); grid = -1; return; }
        if (hipOccupancyMaxActiveBlocksPerMultiprocessor(&per_cu, (const void*)mk_fwd, 512, LDS_BYTES) != hipSuccess || per_cu < 1) { fprintf(stderr, "occupancy query: %d\n", per_cu); per_cu = 1; }
        (void)hipGetLastError();
        grid = cus * per_cu;
    }
    if (grid < 0) return;
    if (hipMemsetAsync((char*)d_ws + WS_BAR, 0, 16384, stream) != hipSuccess) { fprintf(stderr, "memset of barrier words failed\n"); return; }
    Args a{};
    for (int i = 0; i < 21; ++i) a.in[i] = (const float*)d_in[i];
    a.out = (float*)d_out; a.ws = (unsigned char*)d_ws;
    void* kargs[] = {&a};
    hipError_t e = hipLaunchCooperativeKernel((const void*)mk_fwd, dim3(grid), dim3(512), kargs, LDS_BYTES, stream);
    if (e != hipSuccess) fprintf(stderr, "cooperative launch failed: %s (grid %d)\n", hipGetErrorString(e), grid);
}
```
